# Optimizing an MI355X kernel written in HIP

```python
import jax
import jax.numpy as jnp
from jax import lax
import numpy as np

D_MODEL = 1024
BATCH = 4
SEQ = 4096
DEPTH = 4

GRID_W = 64
CTX_LEN = 256
N_EVEN = (DEPTH + 1) // 2
N_ODD = DEPTH // 2
A_Q_HEADS = 8
A_KV_HEADS = 2
HEAD_DIM = 64
WINDOW = 128
CONV_CH = 512
CONV_WIDTH = 31
MLA_HEADS = 16
MLA_NOPE = 64
MLA_ROPE = 32
MLA_V = 64
MLA_QK = MLA_NOPE + MLA_ROPE
Q_LORA = 768
KV_LORA = 256
Q_BLOCK = 128
N_EXPERTS = 32
TOP_K = 4
D_EXPERT = 1024
SWIGLU_LIMIT = 7.0
SWIGLU_ALPHA = 1.702
MOE_BLOCK = 256

ROPE_THETA = 10000.0
EPS = 1e-6
NEG_INF = -1e30
AB_IN = A_Q_HEADS * HEAD_DIM + 2 * A_KV_HEADS * HEAD_DIM + 2 * CONV_CH
AB_MIX = A_Q_HEADS * HEAD_DIM + CONV_CH
C_IN = Q_LORA + KV_LORA + MLA_ROPE

kernel_name = 'hybrid_dit_window_conv_mla_moe'


def rms_norm(x, g):
    xf = x.astype(jnp.float32)
    y = xf * lax.rsqrt(jnp.mean(xf * xf, axis=-1, keepdims=True) + EPS)
    return (y * g.astype(jnp.float32)).astype(x.dtype)


def layer_norm(x, g, b):
    xf = x.astype(jnp.float32)
    mu = jnp.mean(xf, axis=-1, keepdims=True)
    xc = xf - mu
    y = xc * lax.rsqrt(jnp.mean(xc * xc, axis=-1, keepdims=True) + EPS)
    return (y * g.astype(jnp.float32) + b.astype(jnp.float32)).astype(x.dtype)


def modulate(h, shift, scale):
    return h * (1.0 + scale) + shift


def axial_rope_tables(n_tok, rot_dims):
    rows = n_tok // GRID_W
    row = jnp.broadcast_to(jnp.arange(rows)[:, None], (rows, GRID_W)).reshape(-1).astype(jnp.float32)
    col = jnp.broadcast_to(jnp.arange(GRID_W)[None, :], (rows, GRID_W)).reshape(-1).astype(jnp.float32)
    axis_dims = rot_dims // 2
    inv = ROPE_THETA ** (-(jnp.arange(axis_dims // 2, dtype=jnp.float32) * 2.0) / axis_dims)
    ang = jnp.concatenate([row[:, None] * inv, col[:, None] * inv], axis=-1)
    return jnp.cos(ang), jnp.sin(ang)


def apply_axial_rope(x, cos, sin):
    n = x.shape[-1] // 4
    xf = x.astype(jnp.float32).reshape(x.shape[:-1] + (2, 2, n))
    c = cos.reshape(-1, 1, 2, n)
    s = sin.reshape(-1, 1, 2, n)
    x1 = xf[..., 0, :]
    x2 = xf[..., 1, :]
    out = jnp.stack([x1 * c - x2 * s, x2 * c + x1 * s], axis=-2)
    return out.reshape(x.shape).astype(x.dtype)


def window_sink_attention(q, k, v, k_ctx, v_ctx, sink):
    b, s, hq, hd = q.shape
    hkv = k.shape[2]
    g = hq // hkv
    w = WINDOW
    nb = s // w
    scale = hd ** -0.5
    qb = q.reshape(b, nb, w, hkv, g, hd)

    def band(t):
        tp = jnp.pad(t, ((0, 0), (w, w), (0, 0), (0, 0))).reshape(b, nb + 2, w, hkv, hd)
        return jnp.concatenate([tp[:, :-2], tp[:, 1:-1], tp[:, 2:]], axis=2)

    kb = band(k)
    vb = band(v)
    s_loc = jnp.einsum('bnqhgd,bnkhd->bnhgqk', qb, kb).astype(jnp.float32) * scale
    qi = jnp.arange(w)[:, None]
    ki = jnp.arange(3 * w)[None, :]
    rel = ki - w - qi
    kpos = jnp.arange(nb)[:, None, None] * w - w + ki[None]
    valid = (jnp.abs(rel) <= w)[None] & (kpos >= 0) & (kpos < s)
    s_loc = jnp.where(valid[None, :, None, None], s_loc, NEG_INF)
    s_ctx = jnp.einsum('bnqhgd,bkhd->bnhgqk', qb, k_ctx).astype(jnp.float32) * scale
    s_sink = jnp.broadcast_to(sink.astype(jnp.float32).reshape(1, 1, hkv, g, 1, 1), s_loc.shape[:-1] + (1,))
    p = jax.nn.softmax(jnp.concatenate([s_loc, s_ctx, s_sink], axis=-1), axis=-1)
    p_loc = p[..., :3 * w].astype(v.dtype)
    p_ctx = p[..., 3 * w:-1].astype(v.dtype)
    o = jnp.einsum('bnhgqk,bnkhd->bnqhgd', p_loc, vb) + jnp.einsum('bnhgqk,bkhd->bnqhgd', p_ctx, v_ctx)
    return o.reshape(b, s, hq * hd)


def ctx_sink_attention(q, k, v, sink):
    b, l, hq, hd = q.shape
    hkv = k.shape[2]
    g = hq // hkv
    qg = q.reshape(b, l, hkv, g, hd)
    sc = jnp.einsum('bqhgd,bkhd->bhgqk', qg, k).astype(jnp.float32) * (hd ** -0.5)
    sk = jnp.broadcast_to(sink.astype(jnp.float32).reshape(1, hkv, g, 1, 1), sc.shape[:-1] + (1,))
    p = jax.nn.softmax(jnp.concatenate([sc, sk], axis=-1), axis=-1)[..., :-1].astype(v.dtype)
    return jnp.einsum('bhgqk,bkhd->bqhgd', p, v).reshape(b, l, hq * hd)


def conformer_conv(u, dw_w, dw_b, ln_g, ln_b):
    a, gt = jnp.split(u, 2, axis=-1)
    z = a * jax.nn.sigmoid(gt)
    z = lax.conv_general_dilated(z, dw_w[:, None, :].astype(z.dtype), window_strides=(1,),
                                 padding=[(CONV_WIDTH // 2, CONV_WIDTH // 2)],
                                 dimension_numbers=('NWC', 'WIO', 'NWC'),
                                 feature_group_count=CONV_CH) + dw_b
    return jax.nn.silu(layer_norm(z, ln_g, ln_b))


def mixer_window_conv(h_lat, h_ctx, w_in, w_out, q_g, k_g, sink, dw_w, dw_b, ln_g, ln_b, cos, sin, with_ctx_out):
    dq = A_Q_HEADS * HEAD_DIM
    dkv = A_KV_HEADS * HEAD_DIM

    def project(h):
        b, l = h.shape[:2]
        p = h @ w_in
        q = rms_norm(p[..., :dq].reshape(b, l, A_Q_HEADS, HEAD_DIM), q_g)
        k = rms_norm(p[..., dq:dq + dkv].reshape(b, l, A_KV_HEADS, HEAD_DIM), k_g)
        v = p[..., dq + dkv:dq + 2 * dkv].reshape(b, l, A_KV_HEADS, HEAD_DIM)
        return q, k, v, p[..., dq + 2 * dkv:]

    q_l, k_l, v_l, u_l = project(h_lat)
    q_c, k_c, v_c, u_c = project(h_ctx)
    q_l = apply_axial_rope(q_l, cos, sin)
    k_l = apply_axial_rope(k_l, cos, sin)
    a_l = window_sink_attention(q_l, k_l, v_l, k_c, v_c, sink)
    b_l = conformer_conv(u_l, dw_w, dw_b, ln_g, ln_b)
    y_l = jnp.concatenate([a_l, b_l], axis=-1) @ w_out
    y_c = None
    if with_ctx_out:
        a_c = ctx_sink_attention(q_c, k_c, v_c, sink)
        b_c = conformer_conv(u_c, dw_w, dw_b, ln_g, ln_b)
        y_c = jnp.concatenate([a_c, b_c], axis=-1) @ w_out
    return y_l, y_c


def mla_attention(q, k_nope, k_rope, v):
    b, lq, h, dqk = q.shape
    scale = dqk ** -0.5
    nq = lq // Q_BLOCK
    qb = jnp.moveaxis(q.reshape(b, nq, Q_BLOCK, h, dqk), 1, 0)

    def one_block(qblk):
        sc = (jnp.einsum('bqhd,bkhd->bhqk', qblk[..., :MLA_NOPE], k_nope)
              + jnp.einsum('bqhr,bkr->bhqk', qblk[..., MLA_NOPE:], k_rope)).astype(jnp.float32) * scale
        p = jax.nn.softmax(sc, axis=-1).astype(v.dtype)
        return jnp.einsum('bhqk,bkhd->bqhd', p, v)

    o = lax.map(one_block, qb)
    return jnp.moveaxis(o, 0, 1).reshape(b, lq, h * MLA_V)


def mixer_mla(h_lat, h_ctx, w_in, q_a_g, kv_a_g, w_q_b, w_kv_b, q_g, k_g, kr_g, w_out, cos, sin, with_ctx_out):
    def project(h):
        b, l = h.shape[:2]
        p = h @ w_in
        cq = rms_norm(p[..., :Q_LORA], q_a_g)
        ckv = rms_norm(p[..., Q_LORA:Q_LORA + KV_LORA], kv_a_g)
        k_rope = rms_norm(p[..., Q_LORA + KV_LORA:], kr_g)
        q = rms_norm((cq @ w_q_b).reshape(b, l, MLA_HEADS, MLA_QK), q_g)
        kv = (ckv @ w_kv_b).reshape(b, l, MLA_HEADS, MLA_NOPE + MLA_V)
        k_nope = rms_norm(kv[..., :MLA_NOPE], k_g)
        return q, k_nope, k_rope, kv[..., MLA_NOPE:]

    q_l, kn_l, kr_l, v_l = project(h_lat)
    q_c, kn_c, kr_c, v_c = project(h_ctx)
    q_l = jnp.concatenate([q_l[..., :MLA_NOPE], apply_axial_rope(q_l[..., MLA_NOPE:], cos, sin)], axis=-1)
    kr_l = apply_axial_rope(kr_l[:, :, None, :], cos, sin)[:, :, 0, :]
    o_l = mla_attention(q_l, jnp.concatenate([kn_l, kn_c], axis=1), jnp.concatenate([kr_l, kr_c], axis=1),
                        jnp.concatenate([v_l, v_c], axis=1))
    y_l = o_l @ w_out
    y_c = None
    if with_ctx_out:
        y_c = mla_attention(q_c, kn_c, kr_c, v_c) @ w_out
    return y_l, y_c


def moe_ffn(h, router_w, router_b, w_gu, b_gu, w_down, b_down):
    t, d = h.shape
    logits = (h @ router_w + router_b).astype(jnp.float32)
    top_val, top_idx = lax.top_k(logits, TOP_K)
    gates = jax.nn.softmax(top_val, axis=-1)
    n = t * TOP_K
    e_flat = top_idx.reshape(-1)
    tok_flat = jnp.arange(n, dtype=jnp.int32) // TOP_K
    order = jnp.argsort(e_flat)
    e_sorted = e_flat[order]
    tok_sorted = tok_flat[order]
    gate_sorted = gates.reshape(-1)[order]
    counts = jnp.zeros((N_EXPERTS,), jnp.int32).at[e_flat].add(1)
    starts = jnp.cumsum(counts) - counts
    padded = (counts + MOE_BLOCK - 1) // MOE_BLOCK * MOE_BLOCK
    pad_ends = jnp.cumsum(padded)
    pad_starts = pad_ends - padded
    dest = pad_starts[e_sorted] + jnp.arange(n, dtype=jnp.int32) - starts[e_sorted]
    n_blocks = -(-n // MOE_BLOCK) + N_EXPERTS
    row_tok = jnp.zeros((n_blocks * MOE_BLOCK,), jnp.int32).at[dest].set(tok_sorted)
    block_start = jnp.arange(n_blocks, dtype=jnp.int32) * MOE_BLOCK
    block_expert = jnp.minimum(jnp.searchsorted(pad_ends, block_start, side='right'), N_EXPERTS - 1)
    xb = h[row_tok].reshape(n_blocks, MOE_BLOCK, d)

    def expert_block(args):
        xblk, e = args
        gu = xblk @ w_gu[e] + b_gu[e]
        gate = jnp.minimum(gu[:, :D_EXPERT], SWIGLU_LIMIT)
        up = jnp.clip(gu[:, D_EXPERT:], -SWIGLU_LIMIT, SWIGLU_LIMIT)
        act = (up + 1.0) * (gate * jax.nn.sigmoid(SWIGLU_ALPHA * gate))
        return act @ w_down[e] + b_down[e]

    yb = lax.map(expert_block, (xb, block_expert)).reshape(n_blocks * MOE_BLOCK, d)
    contrib = yb[dest] * gate_sorted[:, None].astype(yb.dtype)
    return jnp.zeros_like(h).at[tok_sorted].add(contrib)


def setup_inputs(seed: int = 0) -> dict:
    key = jax.random.key(seed)
    ks = jax.random.split(key, 40)
    f32 = jnp.float32
    D = D_MODEL

    def nrm(k, shape, scale):
        return jax.random.normal(k, shape, f32) * scale

    return {
        'x': nrm(ks[0], (BATCH, SEQ, D), 1.0),
        'c': nrm(ks[1], (BATCH, D), 1.0),
        'ctx': nrm(ks[2], (BATCH, CTX_LEN, D), 1.0),
        'c_ctx': nrm(ks[3], (D,), 1.0),
        'mod_w': nrm(ks[4], (DEPTH, D, 6 * D), 0.5 * D ** -0.5),
        'mod_b': nrm(ks[5], (DEPTH, 6 * D), 0.02),
        'norm_mix_g': 1.0 + nrm(ks[6], (DEPTH, D), 0.02),
        'norm_ffn_g': 1.0 + nrm(ks[7], (DEPTH, D), 0.02),
        'ab_w_in': nrm(ks[8], (N_EVEN, D, AB_IN), D ** -0.5),
        'ab_w_out': nrm(ks[9], (N_EVEN, AB_MIX, D), AB_MIX ** -0.5),
        'a_q_norm': 1.0 + nrm(ks[10], (N_EVEN, HEAD_DIM), 0.02),
        'a_k_norm': 1.0 + nrm(ks[11], (N_EVEN, HEAD_DIM), 0.02),
        'a_sink': nrm(ks[12], (N_EVEN, A_Q_HEADS), 0.5),
        'b_dw_w': nrm(ks[13], (N_EVEN, CONV_WIDTH, CONV_CH), CONV_WIDTH ** -0.5),
        'b_dw_b': nrm(ks[14], (N_EVEN, CONV_CH), 0.02),
        'b_ln_g': 1.0 + nrm(ks[15], (N_EVEN, CONV_CH), 0.02),
        'b_ln_b': nrm(ks[16], (N_EVEN, CONV_CH), 0.02),
        'c_w_in': nrm(ks[17], (N_ODD, D, C_IN), D ** -0.5),
        'c_q_a_norm': 1.0 + nrm(ks[18], (N_ODD, Q_LORA), 0.02),
        'c_kv_a_norm': 1.0 + nrm(ks[19], (N_ODD, KV_LORA), 0.02),
        'c_w_q_b': nrm(ks[20], (N_ODD, Q_LORA, MLA_HEADS * MLA_QK), Q_LORA ** -0.5),
        'c_w_kv_b': nrm(ks[21], (N_ODD, KV_LORA, MLA_HEADS * (MLA_NOPE + MLA_V)), KV_LORA ** -0.5),
        'c_q_norm': 1.0 + nrm(ks[22], (N_ODD, MLA_QK), 0.02),
        'c_k_norm': 1.0 + nrm(ks[23], (N_ODD, MLA_NOPE), 0.02),
        'c_kr_norm': 1.0 + nrm(ks[24], (N_ODD, MLA_ROPE), 0.02),
        'c_w_out': nrm(ks[25], (N_ODD, MLA_HEADS * MLA_V, D), (MLA_HEADS * MLA_V) ** -0.5),
        'router_w': nrm(ks[26], (DEPTH, D, N_EXPERTS), D ** -0.5),
        'router_b': nrm(ks[27], (DEPTH, N_EXPERTS), 0.01),
        'exp_w_gu': nrm(ks[28], (DEPTH, N_EXPERTS, D, 2 * D_EXPERT), D ** -0.5),
        'exp_b_gu': nrm(ks[29], (DEPTH, N_EXPERTS, 2 * D_EXPERT), 0.01),
        'exp_w_down': nrm(ks[30], (DEPTH, N_EXPERTS, D_EXPERT, D), D_EXPERT ** -0.5),
        'exp_b_down': nrm(ks[31], (DEPTH, N_EXPERTS, D), 0.01),
    }


def reference(x, c, ctx, c_ctx, mod_w, mod_b, norm_mix_g, norm_ffn_g,
              ab_w_in, ab_w_out, a_q_norm, a_k_norm, a_sink, b_dw_w, b_dw_b, b_ln_g, b_ln_b,
              c_w_in, c_q_a_norm, c_kv_a_norm, c_w_q_b, c_w_kv_b, c_q_norm, c_k_norm, c_kr_norm, c_w_out,
              router_w, router_b, exp_w_gu, exp_b_gu, exp_w_down, exp_b_down):
    b, s_len, d = x.shape
    cos_a, sin_a = axial_rope_tables(s_len, HEAD_DIM)
    cos_c, sin_c = axial_rope_tables(s_len, MLA_ROPE)
    silu_c = jax.nn.silu(c)
    silu_cc = jax.nn.silu(c_ctx)
    n_lat = b * s_len
    for layer in range(DEPTH):
        keep_ctx = layer < DEPTH - 1
        mod_l = (silu_c @ mod_w[layer] + mod_b[layer])[:, None, :]
        mod_c = silu_cc @ mod_w[layer] + mod_b[layer]
        sh1, sc1, g1, sh2, sc2, g2 = jnp.split(mod_l, 6, axis=-1)
        csh1, csc1, cg1, csh2, csc2, cg2 = jnp.split(mod_c, 6, axis=-1)
        h_l = modulate(rms_norm(x, norm_mix_g[layer]), sh1, sc1)
        h_c = modulate(rms_norm(ctx, norm_mix_g[layer]), csh1, csc1)
        i = layer // 2
        if layer % 2 == 0:
            y_l, y_c = mixer_window_conv(h_l, h_c, ab_w_in[i], ab_w_out[i], a_q_norm[i], a_k_norm[i], a_sink[i],
                                         b_dw_w[i], b_dw_b[i], b_ln_g[i], b_ln_b[i], cos_a, sin_a, keep_ctx)
        else:
            y_l, y_c = mixer_mla(h_l, h_c, c_w_in[i], c_q_a_norm[i], c_kv_a_norm[i], c_w_q_b[i], c_w_kv_b[i],
                                 c_q_norm[i], c_k_norm[i], c_kr_norm[i], c_w_out[i], cos_c, sin_c, keep_ctx)
        x = x + g1 * y_l
        f_l = modulate(rms_norm(x, norm_ffn_g[layer]), sh2, sc2)
        if keep_ctx:
            ctx = ctx + cg1 * y_c
            f_c = modulate(rms_norm(ctx, norm_ffn_g[layer]), csh2, csc2)
            tokens = jnp.concatenate([f_l.reshape(-1, d), f_c.reshape(-1, d)], axis=0)
            y = moe_ffn(tokens, router_w[layer], router_b[layer], exp_w_gu[layer], exp_b_gu[layer],
                        exp_w_down[layer], exp_b_down[layer])
            x = x + g2 * y[:n_lat].reshape(x.shape)
            ctx = ctx + cg2 * y[n_lat:].reshape(ctx.shape)
        else:
            y = moe_ffn(f_l.reshape(-1, d), router_w[layer], router_b[layer], exp_w_gu[layer], exp_b_gu[layer],
                        exp_w_down[layer], exp_b_down[layer])
            x = x + g2 * y.reshape(x.shape)
    return x
```

```cpp
#include <hip/hip_runtime.h>
#include <cstdio>
#include <cstdint>
#define MK_MULTI 0
#define MK_DEBUG 0
#define MK_DBG_THR 1e-3f
namespace mk {
#define LAS __attribute__((address_space(3)))
#define GAS __attribute__((address_space(1)))
typedef unsigned short bf16;
typedef short bf16x8 __attribute__((ext_vector_type(8)));
typedef short s16x4 __attribute__((ext_vector_type(4)));
typedef float f32x2 __attribute__((ext_vector_type(2)));
typedef float f32x4 __attribute__((ext_vector_type(4)));
typedef float f32x16 __attribute__((ext_vector_type(16)));
typedef unsigned u32x2 __attribute__((ext_vector_type(2)));
typedef unsigned u32x4 __attribute__((ext_vector_type(4)));

constexpr int D = 1024, NBATCH = 4, S = 4096, CL = 256, NL = NBATCH * S, NC = NBATCH * CL, T = NL + NC;
constexpr int NWAVES = 8, NTHR = 512;
constexpr float EPS = 1e-6f;
constexpr float LOG2E = 1.4426950408889634f;
constexpr float QSCALE_A = 0.125f * LOG2E;
constexpr float QSCALE_C = 0.10206207261596575f * LOG2E;

constexpr size_t al256(size_t x) { return (x + 255) & ~(size_t)255; }
constexpr size_t CTL_BYTES = 65536;
constexpr int CW_BAR = 1024, CW_CNT = 8192;
constexpr size_t WS_CTL = 0;
constexpr size_t WS_MOD = WS_CTL + CTL_BYTES;
constexpr size_t WS_COSA = WS_MOD + al256((size_t)4 * 5 * 6144 * 4);
constexpr size_t WS_SINA = WS_COSA + 4096 * 32 * 4;
constexpr size_t WS_COSC = WS_SINA + 4096 * 32 * 4;
constexpr size_t WS_SINC = WS_COSC + 4096 * 16 * 4;
constexpr size_t WS_WR = WS_SINC + 4096 * 16 * 4;
constexpr size_t WS_WINA = WS_WR + (size_t)4 * 2 * 32 * 1024 * 2;
constexpr size_t WS_WOUTA = WS_WINA + (size_t)2 * 1792 * 1024 * 2;
constexpr size_t WS_WINC = WS_WOUTA + (size_t)2 * 1024 * 1024 * 2;
constexpr size_t WS_WQB = WS_WINC + (size_t)2 * 1280 * 1024 * 2;
constexpr size_t WS_WKVB = WS_WQB + (size_t)2 * 1536 * 768 * 2;
constexpr size_t WS_WOUTC = WS_WKVB + (size_t)2 * 2048 * 256 * 2;
constexpr size_t WS_WGU = WS_WOUTC + (size_t)2 * 1024 * 1024 * 2;
constexpr size_t WS_WDN = WS_WGU + (size_t)128 * 2048 * 1024 * 2;
constexpr size_t WS_X = WS_WDN + (size_t)128 * 1024 * 1024 * 2;
constexpr size_t WS_H = WS_X + (size_t)T * D * 4;
constexpr size_t WS_QA = WS_H + (size_t)T * D * 2;
constexpr size_t WS_KA = WS_QA + (size_t)T * 512 * 2;
constexpr size_t WS_VA = WS_KA + (size_t)T * 128 * 2;
constexpr size_t WS_Z = WS_VA + (size_t)T * 128 * 2;
constexpr size_t WS_P = WS_Z + (size_t)T * 512 * 2;
constexpr int PP = 1056;
constexpr size_t WS_RS = WS_P + (size_t)T * PP * 2;
constexpr size_t WS_QC = WS_RS + (size_t)T * 2 * 4;
constexpr size_t WS_KC = WS_QC + (size_t)T * 1536 * 2;
constexpr size_t WS_VC = WS_KC + (size_t)T * 1536 * 2;
constexpr size_t WS_MIX = WS_VC + (size_t)T * 1024 * 2;
constexpr size_t WS_F = WS_MIX + (size_t)T * 1024 * 2;
constexpr size_t WS_GATE = WS_F + (size_t)T * 1024 * 2;
constexpr size_t WS_LIST = WS_GATE + (size_t)T * 4 * 4;
constexpr int ACT_ROWS = 304 * 256;
constexpr size_t WS_ACT = WS_LIST + (size_t)32 * T * 4;
constexpr size_t WS_YB = WS_ACT + (size_t)ACT_ROWS * 1024 * 2;
constexpr size_t WS_SSX = WS_YB + (size_t)T * 4 * 1024 * 2;
constexpr size_t WS_SSP = WS_SSX + (size_t)T * 16 * 4;
constexpr size_t WS_END = WS_SSP + (size_t)T * 16 * 4;

constexpr int STAGE_BYTES = 131072;
constexpr int LDS_IDX = 131072;
constexpr int MAXU = 12;
constexpr int LDS_TAB = LDS_IDX + MAXU * 1024;
constexpr int LDS_MISC = LDS_TAB + 1024;
constexpr int LDS_BYTES = LDS_MISC + 256;

__device__ __forceinline__ unsigned pk2(float lo, float hi) {
    typedef __bf16 bf2 __attribute__((ext_vector_type(2)));
    return __builtin_bit_cast(unsigned, __builtin_convertvector((f32x2){lo, hi}, bf2));
}
__device__ __forceinline__ float bflo(unsigned u) { return __uint_as_float(u << 16); }
__device__ __forceinline__ float bfhi(unsigned u) { return __uint_as_float(u & 0xffff0000u); }
__device__ __forceinline__ float bf1(bf16 u) { return __uint_as_float(((unsigned)u) << 16); }
__device__ __forceinline__ float fsigm(float v) { return __builtin_amdgcn_rcpf(1.f + __builtin_amdgcn_exp2f(-1.4426950408889634f * v)); }
__device__ __forceinline__ float fsilu(float v) { return v * fsigm(v); }
__device__ __forceinline__ int modrow(int row) { return row < NL ? (row >> 12) : 4; }
#define WS_DPP(v, ctrl) ((v) + __int_as_float(__builtin_amdgcn_update_dpp(0, __float_as_int(v), (ctrl), 0xF, 0xF, false)))
__device__ __forceinline__ float wave_sum(float v) {
    v = WS_DPP(v, 0xB1); v = WS_DPP(v, 0x4E); v = WS_DPP(v, 0x141); v = WS_DPP(v, 0x140);
    v += __shfl_xor(v, 16); v += __shfl_xor(v, 32);
    return v;
}
__device__ __forceinline__ int otid() { int t = threadIdx.x; asm volatile("" : "+v"(t)); return t; }
#define LDS_WAIT() asm volatile("s_waitcnt lgkmcnt(0)" ::: "memory")
#define VM_WAIT() asm volatile("s_waitcnt vmcnt(0)" ::: "memory")

#define XB_TMO      128
#define XB_XCNT(j)  (256  + 64 * (j))
#define XB_XSUB(j)  (1280 + 64 * (j))
#define XB_XGEN(j)  (2304 + 64 * (j))
#define XB_TOP      3328
#define XB_TOPGEN   3392
#define XCD_BAR_WORDS 3456
#define XB_SPIN_CAP (1u << 18)
__device__ __forceinline__ unsigned xb_ld(unsigned* p)              { return __hip_atomic_load(p, __ATOMIC_RELAXED, __HIP_MEMORY_SCOPE_AGENT); }
__device__ __forceinline__ unsigned xb_add(unsigned* p, unsigned v) { return __hip_atomic_fetch_add(p, v, __ATOMIC_RELAXED, __HIP_MEMORY_SCOPE_AGENT); }
__device__ __forceinline__ unsigned xb_xcc_id() { return (unsigned)__builtin_amdgcn_s_getreg((3 << 11) | 20) & 0xFu; }
#define XB_SPIN(cond, bar) do { unsigned _sp = 0; while (cond) { __builtin_amdgcn_s_sleep(1); \
    if ((++_sp & 255u) == 0u) { if (xb_ld(&(bar)[XB_TMO])) break; if (_sp > XB_SPIN_CAP) { atomicAdd(&(bar)[XB_TMO], 1u); break; } } } } while (0)
struct XcdBarrier { unsigned* bar; unsigned x; volatile LAS unsigned* st; };
__device__ __forceinline__ XcdBarrier xcd_barrier_post(unsigned* bar, volatile LAS unsigned* st) {
    XcdBarrier b; b.bar = bar; b.x = xb_xcc_id(); b.st = st;
    if (threadIdx.x == 0) (void)xb_add(&bar[XB_XCNT(b.x)], 1u);
    return b;
}
__device__ __forceinline__ void xcd_barrier_complete(unsigned* bar, unsigned x, unsigned& nloc, unsigned& nx) {
    const unsigned G = gridDim.x * gridDim.y * gridDim.z;
    unsigned sum, cnt, mine, sp = 0u;
    for (;;) {
        sum = 0u; cnt = 0u; mine = 0u;
#pragma unroll
        for (unsigned j = 0; j < 16; ++j) { const unsigned c = xb_ld(&bar[XB_XCNT(j)]); sum += c; cnt += (c > 0u) ? 1u : 0u; mine = (j == x) ? c : mine; }
        if (sum == G) break;
        __builtin_amdgcn_s_sleep(1);
        if ((++sp & 255u) == 0u) { if (xb_ld(&bar[XB_TMO])) break; if (sp > XB_SPIN_CAP) { atomicAdd(&bar[XB_TMO], 1u); break; } }
    }
    nloc = mine > 0u ? mine : 1u; nx = cnt > 0u ? cnt : 1u;
}
__device__ __forceinline__ void xcd_barrier(const XcdBarrier& b) {
    asm volatile("s_waitcnt vmcnt(0)" ::: "memory");
    __syncthreads();
    if (otid() == 0) {
        unsigned* bar = b.bar;
        __builtin_amdgcn_s_waitcnt(0);
        unsigned nloc = b.st[0], nx = b.st[1];
        if (nloc == 0u) { xcd_barrier_complete(bar, b.x, nloc, nx); b.st[0] = nloc; b.st[1] = nx; }
        const unsigned old = xb_add(&bar[XB_XSUB(b.x)], 1u);
        const unsigned gen = old / nloc;
        if (old + 1u == (gen + 1u) * nloc) {
            __builtin_amdgcn_fence(__ATOMIC_RELEASE, "agent");
            asm volatile("s_waitcnt vmcnt(0)" ::: "memory");
            const unsigned og = xb_add(&bar[XB_TOP], 1u);
            const unsigned tg = og / nx;
            if (og + 1u == (tg + 1u) * nx) xb_add(&bar[XB_TOPGEN], 1u);
            else XB_SPIN(xb_ld(&bar[XB_TOPGEN]) == tg, bar);
            __builtin_amdgcn_fence(__ATOMIC_ACQUIRE, "agent");
            xb_add(&bar[XB_XGEN(b.x)], 1u);
            asm volatile("s_waitcnt vmcnt(0)" ::: "memory");
        } else {
            XB_SPIN(xb_ld(&bar[XB_XGEN(b.x)]) == gen, bar);
            __builtin_amdgcn_fence(__ATOMIC_ACQUIRE, "agent");
            asm volatile("s_waitcnt vmcnt(0)" ::: "memory");
        }
    }
    __syncthreads();
}

namespace g8 {
constexpr int BM = 256, BK = 64, HALF = 128, HTB = HALF * BK * 2, NXCD = 8, WGM = 8;
__host__ __device__ __forceinline__ int lds_byte(int r, int c) { const int st = (r >> 4) * 2 + (c >> 5), rr = r & 15, cc = c & 31, ob = rr * 64 + cc * 2; return st * 1024 + (ob ^ (((ob >> 9) & 1) << 5)); }
__host__ __device__ __forceinline__ void stage_rc(int b, int& R, int& C) { const int st = b / 1024, sb = b % 1024, swz = sb ^ (((sb >> 9) & 1) << 5); R = (st >> 1) * 16 + swz / 64; C = (st & 1) * 32 + (swz % 64) / 2; }

struct Unit { int pm, pn, e, nt, gm, slot; };
struct GemmP { const bf16* A; int lda; const bf16* Bt; int K; };

struct StaticOrder {
    static constexpr bool GATHER = false;
    int nM, nN, nwg, G, c;
    __device__ void init(int nM_, int nN_, int G_, int c_) { nM = nM_; nN = nN_; nwg = nM * nN; G = G_; c = c_; }
    __device__ __forceinline__ bool next(int i, Unit& u) const {
        const long L = (long)i * G + c; if (L >= nwg) return false;
        int wgid = (int)L; { const int q = nwg / NXCD, r = nwg % NXCD, xcd = wgid % NXCD, off = wgid / NXCD; wgid = (xcd < r ? xcd * (q + 1) : r * (q + 1) + (xcd - r) * q) + off; }
        const int nig = WGM * nN, gid = wgid / nig, fm = gid * WGM, gsz = (nM - fm) < WGM ? (nM - fm) : WGM;
        u.pm = fm + ((wgid % nig) % gsz); u.pn = (wgid % nig) / gsz; u.e = 0; u.nt = u.pn; u.gm = u.pm; u.slot = 0; return true;
    }
    __device__ __forceinline__ int arow(const Unit& u, int r) const { return u.pm * BM + r; }
};
template <bool GATHER_> struct MoeOrder {
    static constexpr bool GATHER = GATHER_;
    const LAS int* tab; const LAS int* idx;
    __device__ __forceinline__ bool next(int i, Unit& u) const {
        if (i >= tab[127]) return false;
        u.gm = tab[128 + 4 * i]; u.pn = tab[129 + 4 * i]; u.e = tab[130 + 4 * i]; u.nt = tab[131 + 4 * i]; u.slot = i; u.pm = u.gm; return true;
    }
    __device__ __forceinline__ int arow(const Unit& u, int r) const {
        if (GATHER_) { const int s = idx[u.slot * 256 + r]; return s < 0 ? 0 : (s >> 2); }
        return u.gm * BM + r;
    }
};

template <class Epi, class Sched>
__device__ __forceinline__ void gemm_phase(LAS unsigned char* lds, const GemmP g, const Sched& S, const Epi& E) {
    const int tid = otid(), wid = __builtin_amdgcn_readfirstlane(tid >> 6), lane = tid & 63, wr = wid >> 2, wc = wid & 3, fr = lane & 15, fq = lane >> 4;
    const int K = g.K, nt = K / BK;
    int RR[2], CC[2]; unsigned voffB[2], voffA[2];
    const unsigned lda2 = (unsigned)g.lda * 2u;
#pragma unroll
    for (int i = 0; i < 2; ++i) { stage_rc(tid * 16 + i * 8192, RR[i], CC[i]); voffB[i] = (unsigned)(RR[i] * K + CC[i]) * 2u; voffA[i] = (unsigned)RR[i] * lda2 + (unsigned)CC[i] * 2u; }
    const size_t hstepA = (size_t)HALF * lda2, tstepA = 2 * hstepA;
    const size_t kstep = (size_t)(BK * 2);
    const size_t hstepB = (size_t)HALF * K * 2;
    const size_t tstepB = 2 * hstepB;
    const unsigned ldsw = (unsigned)wid * 1024u;
    const int aoff = lds_byte(wr * 64 + fr, fq * 8), boff = lds_byte(wc * 32 + fr, fq * 8);
#define G8_SA(b, h) (((b) * 2 + (h)) * HTB)
#define G8_SB(b, h) ((4 + (b) * 2 + (h)) * HTB)
#define G8_STAGE(bufoff, gbase, voff) do { _Pragma("unroll") for (int _i = 0; _i < 2; ++_i) \
        __builtin_amdgcn_global_load_lds((const unsigned*)((const char*)(gbase) + (voff)[_i]), (LAS unsigned*)(lds + (bufoff) + ldsw + _i * 8192), 16, 0, 0); } while (0)
#define G8_LDA(dst, b, h) do { _Pragma("unroll") for (int m = 0; m < 4; ++m) _Pragma("unroll") for (int k = 0; k < 2; ++k) dst[m][k] = *(const LAS bf16x8*)(lds + G8_SA(b, h) + aoff + m * 2048 + k * 1024); } while (0)
#define G8_LDB(dst, b, h) do { _Pragma("unroll") for (int n = 0; n < 2; ++n) _Pragma("unroll") for (int k = 0; k < 2; ++k) dst[n][k] = *(const LAS bf16x8*)(lds + G8_SB(b, h) + boff + n * 2048 + k * 1024); } while (0)
#define G8_MMA(ai, bj, At, Bt) do { __builtin_amdgcn_s_setprio(1); _Pragma("unroll") for (int m = 0; m < 4; ++m) _Pragma("unroll") for (int n = 0; n < 2; ++n) _Pragma("unroll") for (int k = 0; k < 2; ++k) \
        acc[ai][bj][m][n] = __builtin_amdgcn_mfma_f32_16x16x32_bf16(Bt[n][k], At[m][k], acc[ai][bj][m][n], 0, 0, 0); __builtin_amdgcn_s_setprio(0); } while (0)
#define G8_WAIT_V(n) asm volatile("s_waitcnt vmcnt(" #n ")" ::: "memory")
#define G8_WAIT_L(n) asm volatile("s_waitcnt lgkmcnt(" #n ")" ::: "memory")
#define G8_BAR __builtin_amdgcn_s_barrier()
#define G8_SCHED __builtin_amdgcn_sched_barrier(0)
#define G8_MKOFF(u, o) do { if constexpr (Sched::GATHER) { _Pragma("unroll") for (int _i = 0; _i < 2; ++_i) { int _R, _C; stage_rc(tid * 16 + _i * 8192, _R, _C); \
        _Pragma("unroll") for (int _h = 0; _h < 2; ++_h) o[_h][_i] = (unsigned)S.arow(u, _h * HALF + _R) * lda2 + (unsigned)_C * 2u; } } } while (0)
#define G8_STAGE_A(bufoff, kofs, h, usenext) do { if constexpr (Sched::GATHER) { unsigned _o[2]; _o[0] = (usenext) ? no[h][0] : co[h][0]; _o[1] = (usenext) ? no[h][1] : co[h][1]; G8_STAGE(bufoff, Ab + (kofs), _o); } \
        else { const char* _p = ((usenext) ? nAp : cAp) + (size_t)(h) * hstepA + (kofs); G8_STAGE(bufoff, _p, voffA); } } while (0)
    Unit cur, nxt; int ui = 0;
    if (!S.next(0, cur)) return;
    f32x4 acc[2][2][4][2];
#pragma unroll
    for (int a = 0; a < 2; ++a)
#pragma unroll
        for (int b = 0; b < 2; ++b)
#pragma unroll
            for (int m = 0; m < 4; ++m)
#pragma unroll
                for (int n = 0; n < 2; ++n) acc[a][b][m][n] = (f32x4){0.f, 0.f, 0.f, 0.f};
    bf16x8 At[4][2], B0[2][2], B1[2][2];
    unsigned co[2][2], no[2][2];
    G8_MKOFF(cur, co);
    if (Sched::GATHER) { G8_WAIT_L(0); }
    const char* Ab = (const char*)g.A;
    const char* cAp = Ab + (size_t)cur.pm * tstepA; const char* nAp = cAp;
    const char* cB = (const char*)g.Bt + (size_t)cur.pn * tstepB;
    G8_STAGE(G8_SB(0, 0), cB, voffB); G8_STAGE(G8_SB(0, 1), cB + hstepB, voffB); G8_STAGE_A(G8_SA(0, 0), 0, 0, false); G8_STAGE_A(G8_SA(0, 1), 0, 1, false);
    if (wr == 1) G8_BAR;
    G8_WAIT_V(2); G8_BAR;
    G8_STAGE(G8_SB(1, 0), cB + kstep, voffB); G8_STAGE_A(G8_SA(1, 0), kstep, 0, false); G8_STAGE(G8_SB(1, 1), cB + hstepB + kstep, voffB);
    G8_WAIT_V(6); G8_BAR;
    for (;;) {
        const bool has_next = S.next(ui + 1, nxt);
        if (has_next) { G8_MKOFF(nxt, no); if (Sched::GATHER) { G8_WAIT_L(0); } nAp = Ab + (size_t)nxt.pm * tstepA; }
        else {
            nAp = cAp;
            if constexpr (Sched::GATHER) {
#pragma unroll
                for (int h = 0; h < 2; ++h)
#pragma unroll
                    for (int i = 0; i < 2; ++i) no[h][i] = co[h][i];
            }
        }
        G8_SCHED;
        const char* nB = has_next ? (const char*)g.Bt + (size_t)nxt.pn * tstepB : cB;
#pragma unroll 1
        for (int t = 0; t < nt; t += 2) {
            const bool last = (t == nt - 2);
            const size_t k1 = (size_t)(t + 1) * kstep, k2 = last ? 0 : (size_t)(t + 2) * kstep, k3 = k2 + kstep;
            const char* b2 = last ? nB : cB + (size_t)(t + 2) * kstep; const char* b3 = b2 + kstep;
            G8_LDB(B0, 0, 0); G8_LDB(B1, 0, 1); G8_SCHED; G8_LDA(At, 0, 0); G8_STAGE_A(G8_SA(1, 1), k1, 1, false);
            G8_WAIT_V(8); G8_WAIT_L(0); G8_BAR; G8_MMA(0, 0, At, B0); G8_MMA(0, 1, At, B1); G8_BAR; G8_SCHED;
            G8_LDA(At, 0, 1); G8_STAGE(G8_SB(0, 0), b2, voffB); G8_STAGE(G8_SB(0, 1), b2 + hstepB, voffB); G8_STAGE_A(G8_SA(0, 0), k2, 0, last);
            G8_WAIT_V(8); G8_WAIT_L(0); G8_BAR; G8_MMA(1, 0, At, B0); G8_MMA(1, 1, At, B1); G8_BAR; G8_SCHED;
            G8_LDB(B0, 1, 0); G8_LDB(B1, 1, 1); G8_SCHED; G8_LDA(At, 1, 0); G8_STAGE_A(G8_SA(0, 1), k2, 1, last);
            G8_WAIT_V(8); G8_WAIT_L(0); G8_BAR; G8_MMA(0, 0, At, B0); G8_MMA(0, 1, At, B1); G8_BAR; G8_SCHED;
            G8_LDA(At, 1, 1); G8_STAGE(G8_SB(1, 0), b3, voffB); G8_STAGE(G8_SB(1, 1), b3 + hstepB, voffB); G8_STAGE_A(G8_SA(1, 0), k3, 0, last);
            G8_WAIT_V(8); G8_WAIT_L(0); G8_BAR; G8_MMA(1, 0, At, B0); G8_MMA(1, 1, At, B1); G8_BAR; G8_SCHED;
        }
        if (wr == 0) G8_BAR;
        E(acc, cur, wr, wc, fr, fq, lds);
        if (!has_next) break;
#pragma unroll
        for (int a = 0; a < 2; ++a)
#pragma unroll
            for (int b = 0; b < 2; ++b)
#pragma unroll
                for (int m = 0; m < 4; ++m)
#pragma unroll
                    for (int n = 0; n < 2; ++n) acc[a][b][m][n] = (f32x4){0.f, 0.f, 0.f, 0.f};
        cur = nxt; cB = nB; cAp = nAp; ++ui;
        if constexpr (Sched::GATHER) {
#pragma unroll
            for (int h = 0; h < 2; ++h)
#pragma unroll
                for (int i = 0; i < 2; ++i) co[h][i] = no[h][i];
        }
        if (wr == 1) G8_BAR;
    }
    G8_WAIT_V(0);
    G8_BAR;
#undef G8_SA
#undef G8_SB
#undef G8_STAGE
#undef G8_LDA
#undef G8_LDB
#undef G8_MMA
#undef G8_WAIT_V
#undef G8_WAIT_L
#undef G8_BAR
#undef G8_SCHED
#undef G8_MKOFF
#undef G8_STAGE_A
}
}

using g8::Unit;
typedef f32x4 Acc[2][2][4][2];
__device__ __forceinline__ u32x4 pack8(const f32x4 a, const f32x4 b) { u32x4 w; w.x = pk2(a[0], a[1]); w.y = pk2(a[2], a[3]); w.z = pk2(b[0], b[1]); w.w = pk2(b[2], b[3]); return w; }

struct EpiInA {
    bf16 *Qa, *Ka, *Va, *Z; const float *qg, *kg, *cosA, *sinA;
    __device__ __forceinline__ void operator()(const Acc& acc, const Unit& u, int wr, int wc, int fr, int fq, LAS unsigned char*) const {
        const int row0 = u.pm * 256 + wr * 64 + fr, pn = u.pn, a = fq >> 1, b = fq & 1;
        if (pn < 3) {
            const bool isv = (pn == 2 && wc >= 2), isq = pn < 2;
            const int dbase = 32 * a + 8 * b;
            if (isv) {
#pragma unroll
                for (int ai = 0; ai < 2; ++ai)
#pragma unroll
                    for (int m = 0; m < 4; ++m) { const int row = row0 + ai * 128 + m * 16; bf16* o = Va + (size_t)row * 128 + (wc - 2) * 64 + dbase;
#pragma unroll
                        for (int bj = 0; bj < 2; ++bj) *(u32x4*)(o + 16 * bj) = pack8(acc[ai][bj][m][0], acc[ai][bj][m][1]); }
                return;
            }
            const float* g = isq ? qg : kg;
            f32x4 gv[2][2];
#pragma unroll
            for (int bj = 0; bj < 2; ++bj)
#pragma unroll
                for (int n = 0; n < 2; ++n) gv[bj][n] = *(const f32x4*)(g + dbase + 16 * bj + 4 * n);
            const float sc = isq ? QSCALE_A : 1.f;
            bf16* obase = isq ? (Qa + (pn * 4 + wc) * 64 + dbase) : (Ka + wc * 64 + dbase);
            const int opitch = isq ? 512 : 128;
            f32x4 cc[2], sn[2], cn[2], snn[2];
            { const int t = row0 & 4095;
#pragma unroll
              for (int n = 0; n < 2; ++n) { cc[n] = *(const f32x4*)(cosA + t * 32 + 16 * a + 8 * b + 4 * n); sn[n] = *(const f32x4*)(sinA + t * 32 + 16 * a + 8 * b + 4 * n); } }
#pragma unroll
            for (int gidx = 0; gidx < 8; ++gidx) {
                    const int ai = gidx >> 2, m = gidx & 3;
                    const int row = row0 + ai * 128 + m * 16;
                    if (gidx < 7) { const int tn = (row0 + ((gidx + 1) >> 2) * 128 + ((gidx + 1) & 3) * 16) & 4095;
#pragma unroll
                        for (int n = 0; n < 2; ++n) { cn[n] = *(const f32x4*)(cosA + tn * 32 + 16 * a + 8 * b + 4 * n); snn[n] = *(const f32x4*)(sinA + tn * 32 + 16 * a + 8 * b + 4 * n); } }
                    float ss = 0.f;
#pragma unroll
                    for (int bj = 0; bj < 2; ++bj)
#pragma unroll
                        for (int n = 0; n < 2; ++n) { const f32x4 v = acc[ai][bj][m][n]; ss += (v[0] * v[0] + v[1] * v[1]) + (v[2] * v[2] + v[3] * v[3]); }
                    ss += __shfl_xor(ss, 16); ss += __shfl_xor(ss, 32);
                    const float rs = rsqrtf(ss * (1.f / 64.f) + EPS);
                    f32x4 y[2][2];
#pragma unroll
                    for (int bj = 0; bj < 2; ++bj)
#pragma unroll
                        for (int n = 0; n < 2; ++n) y[bj][n] = acc[ai][bj][m][n] * rs * gv[bj][n];
                    if (row < NL) {
#pragma unroll
                        for (int n = 0; n < 2; ++n) { const f32x4 y0 = y[0][n], y1 = y[1][n]; y[0][n] = y0 * cc[n] - y1 * sn[n]; y[1][n] = y1 * cc[n] + y0 * sn[n]; }
                    }
                    bf16* o = obase + (size_t)row * opitch;
#pragma unroll
                    for (int bj = 0; bj < 2; ++bj) *(u32x4*)(o + 16 * bj) = pack8(y[bj][0] * sc, y[bj][1] * sc);
                    asm volatile("" ::: "memory");
#pragma unroll
                    for (int n = 0; n < 2; ++n) { cc[n] = cn[n]; sn[n] = snn[n]; }
            }
        } else {
            const int j0 = 128 * (pn - 3) + 32 * wc + 8 * fq;
#pragma unroll
            for (int ai = 0; ai < 2; ++ai)
#pragma unroll
                for (int m = 0; m < 4; ++m) {
                    const int row = row0 + ai * 128 + m * 16; f32x4 z[2];
#pragma unroll
                    for (int n = 0; n < 2; ++n) { const f32x4 av = acc[ai][0][m][n], gt = acc[ai][1][m][n];
#pragma unroll
                        for (int r = 0; r < 4; ++r) z[n][r] = av[r] * fsigm(gt[r]); }
                    *(u32x4*)(Z + (size_t)row * 512 + j0) = pack8(z[0], z[1]);
                }
        }
    }
};
struct EpiResid {
    float* X; const float* Xlat; const float* Xctx; const float* gmod; float* SSX;
    __device__ __forceinline__ void operator()(const Acc& acc, const Unit& u, int wr, int wc, int fr, int fq, LAS unsigned char*) const {
        const int row0 = u.pm * 256 + wr * 64 + fr; const int mr = u.pm < 64 ? (u.pm >> 4) : 4;
        const float* gp = gmod + (size_t)mr * 6144; const float* src = u.pm < 64 ? Xlat : Xctx - (size_t)NL * D;
        float ssr[2][4];
#pragma unroll
        for (int ai = 0; ai < 2; ++ai)
#pragma unroll
            for (int m = 0; m < 4; ++m) ssr[ai][m] = 0.f;
#pragma unroll
        for (int bj = 0; bj < 2; ++bj) {
            const int c0 = 256 * u.pn + 128 * bj + 32 * wc + 8 * fq;
            const f32x4 g0 = *(const f32x4*)(gp + c0), g1 = *(const f32x4*)(gp + c0 + 4);
#pragma unroll
            for (int ai = 0; ai < 2; ++ai) {
                f32x4 xo[4][2];
#pragma unroll
                for (int m = 0; m < 4; ++m) { const float* xp = src + (size_t)(row0 + ai * 128 + m * 16) * D + c0; xo[m][0] = *(const f32x4*)xp; xo[m][1] = *(const f32x4*)(xp + 4); }
#pragma unroll
                for (int m = 0; m < 4; ++m) { float* op = X + (size_t)(row0 + ai * 128 + m * 16) * D + c0;
                    const f32x4 y0 = xo[m][0] + g0 * acc[ai][bj][m][0], y1 = xo[m][1] + g1 * acc[ai][bj][m][1];
                    *(f32x4*)op = y0; *(f32x4*)(op + 4) = y1;
                    ssr[ai][m] += (y0[0] * y0[0] + y0[1] * y0[1]) + (y0[2] * y0[2] + y0[3] * y0[3]) + (y1[0] * y1[0] + y1[1] * y1[1]) + (y1[2] * y1[2] + y1[3] * y1[3]); }
                asm volatile("" ::: "memory");
            }
        }
#pragma unroll
        for (int ai = 0; ai < 2; ++ai)
#pragma unroll
            for (int m = 0; m < 4; ++m) { float ss = ssr[ai][m]; ss += __shfl_xor(ss, 16); ss += __shfl_xor(ss, 32);
                if (fq == 0) SSX[(size_t)(row0 + ai * 128 + m * 16) * 16 + 4 * u.pn + wc] = ss; }
    }
};
struct EpiBf16 {
    bf16* O; int ldo, ncols;
    __device__ __forceinline__ void operator()(const Acc& acc, const Unit& u, int wr, int wc, int fr, int fq, LAS unsigned char*) const {
        const int row0 = u.pm * 256 + wr * 64 + fr;
#pragma unroll
        for (int bj = 0; bj < 2; ++bj) {
            const int c0 = 256 * u.pn + 128 * bj + 32 * wc + 8 * fq;
            if (c0 < ncols) {
#pragma unroll
                for (int ai = 0; ai < 2; ++ai)
#pragma unroll
                    for (int m = 0; m < 4; ++m) *(u32x4*)(O + (size_t)(row0 + ai * 128 + m * 16) * ldo + c0) = pack8(acc[ai][bj][m][0], acc[ai][bj][m][1]);
            }
        }
    }
};
struct EpiP {
    bf16* P; float* SSP; bf16* Kc; const float* krg; const float* cosC; const float* sinC;
    __device__ __forceinline__ void operator()(const Acc& acc, const Unit& u, int wr, int wc, int fr, int fq, LAS unsigned char*) const {
        const int row0 = u.pm * 256 + wr * 64 + fr;
        if (u.pn < 4) {
#pragma unroll
            for (int ai = 0; ai < 2; ++ai)
#pragma unroll
                for (int m = 0; m < 4; ++m) { const int row = row0 + ai * 128 + m * 16; float ss = 0.f;
#pragma unroll
                    for (int bj = 0; bj < 2; ++bj) { const f32x4 y0 = acc[ai][bj][m][0], y1 = acc[ai][bj][m][1];
                        *(u32x4*)(P + (size_t)row * PP + 256 * u.pn + 128 * bj + 32 * wc + 8 * fq) = pack8(y0, y1);
                        ss += (y0[0] * y0[0] + y0[1] * y0[1]) + (y0[2] * y0[2] + y0[3] * y0[3]) + (y1[0] * y1[0] + y1[1] * y1[1]) + (y1[2] * y1[2] + y1[3] * y1[3]); }
                    ss += __shfl_xor(ss, 16); ss += __shfl_xor(ss, 32);
                    if (fq == 0) SSP[(size_t)row * 16 + 4 * u.pn + wc] = ss; }
        } else if (wc == 0) {
            const f32x4 g0 = *(const f32x4*)(krg + 8 * fq), g1 = *(const f32x4*)(krg + 8 * fq + 4);
#pragma unroll
            for (int ai = 0; ai < 2; ++ai)
#pragma unroll
                for (int m = 0; m < 4; ++m) { const int row = row0 + ai * 128 + m * 16; const f32x4 v0 = acc[ai][0][m][0], v1 = acc[ai][0][m][1];
                    *(u32x4*)(P + (size_t)row * PP + 1024 + 8 * fq) = pack8(v0, v1);
                    float ss = (v0[0] * v0[0] + v0[1] * v0[1]) + (v0[2] * v0[2] + v0[3] * v0[3]) + (v1[0] * v1[0] + v1[1] * v1[1]) + (v1[2] * v1[2] + v1[3] * v1[3]);
                    ss += __shfl_xor(ss, 16); ss += __shfl_xor(ss, 32);
                    const float rk = rsqrtf(ss * (1.f / 32.f) + EPS);
                    f32x4 y0 = v0 * rk * g0, y1 = v1 * rk * g1;
                    const int t = row & 4095, ax = fq >> 1;
                    const f32x4 c0 = *(const f32x4*)(cosC + t * 16 + 8 * ax), c1 = *(const f32x4*)(cosC + t * 16 + 8 * ax + 4), s0 = *(const f32x4*)(sinC + t * 16 + 8 * ax), s1 = *(const f32x4*)(sinC + t * 16 + 8 * ax + 4);
                    f32x4 p0, p1;
#pragma unroll
                    for (int j = 0; j < 4; ++j) { p0[j] = __shfl_xor(y0[j], 16); p1[j] = __shfl_xor(y1[j], 16); }
                    if (row < NL) { if ((fq & 1) == 0) { y0 = y0 * c0 - p0 * s0; y1 = y1 * c1 - p1 * s1; } else { y0 = y0 * c0 + p0 * s0; y1 = y1 * c1 + p1 * s1; } }
                    const u32x4 wv = pack8(y0, y1);
#pragma unroll
                    for (int hd = 0; hd < 16; ++hd) *(u32x4*)(Kc + (size_t)row * 1536 + hd * 96 + 64 + 8 * fq) = wv;
                    asm volatile("" ::: "memory"); }
        }
    }
};
struct EpiKV {
    bf16 *Kc, *Vc; const float* SSP; const float* kg;
    __device__ __forceinline__ void operator()(const Acc& acc, const Unit& u, int wr, int wc, int fr, int fq, LAS unsigned char*) const {
        const int row0 = u.pm * 256 + wr * 64 + fr, head = 2 * u.pn + (wc >> 1), dbase = 32 * (fq >> 1) + 8 * (fq & 1);
        const bool isk = (wc & 1) == 0;
        float rr[2][4];
#pragma unroll
        for (int ai = 0; ai < 2; ++ai)
#pragma unroll
            for (int m = 0; m < 4; ++m) { const f32x4 pq = *(const f32x4*)(SSP + (size_t)(row0 + ai * 128 + m * 16) * 16 + 12); rr[ai][m] = (pq[0] + pq[1]) + (pq[2] + pq[3]); }
        f32x4 gv[2][2];
#pragma unroll
        for (int bj = 0; bj < 2; ++bj)
#pragma unroll
            for (int n = 0; n < 2; ++n) gv[bj][n] = isk ? *(const f32x4*)(kg + dbase + 16 * bj + 4 * n) : (f32x4){1.f, 1.f, 1.f, 1.f};
#pragma unroll
        for (int ai = 0; ai < 2; ++ai)
#pragma unroll
            for (int m = 0; m < 4; ++m) {
                const int row = row0 + ai * 128 + m * 16; const float r = rsqrtf(rr[ai][m] * (1.f / 256.f) + EPS);
                float f = r;
                if (isk) {
                    float ss = 0.f;
#pragma unroll
                    for (int bj = 0; bj < 2; ++bj)
#pragma unroll
                        for (int n = 0; n < 2; ++n) { const f32x4 v = acc[ai][bj][m][n]; ss += (v[0] * v[0] + v[1] * v[1]) + (v[2] * v[2] + v[3] * v[3]); }
                    ss += __shfl_xor(ss, 16); ss += __shfl_xor(ss, 32);
                    f = r * rsqrtf(r * r * ss * (1.f / 64.f) + EPS);
                }
                bf16* o = isk ? (Kc + (size_t)row * 1536 + head * 96 + dbase) : (Vc + (size_t)row * 1024 + head * 64 + dbase);
#pragma unroll
                for (int bj = 0; bj < 2; ++bj) *(u32x4*)(o + 16 * bj) = pack8(acc[ai][bj][m][0] * f * gv[bj][0], acc[ai][bj][m][1] * f * gv[bj][1]);
            }
    }
};
struct EpiGU {
    bf16* ACT; const float* bgu;
    __device__ __forceinline__ void operator()(const Acc& acc, const Unit& u, int wr, int wc, int fr, int fq, LAS unsigned char*) const {
        const int row0 = u.gm * 256 + wr * 64 + fr, j0 = 128 * u.nt + 32 * wc + 8 * fq;
        const float* bp = bgu + (size_t)u.e * 2048;
        f32x4 bg[2], bu[2];
#pragma unroll
        for (int n = 0; n < 2; ++n) { bg[n] = *(const f32x4*)(bp + j0 + 4 * n); bu[n] = *(const f32x4*)(bp + 1024 + j0 + 4 * n); }
#pragma unroll
        for (int ai = 0; ai < 2; ++ai)
#pragma unroll
            for (int m = 0; m < 4; ++m) {
                f32x4 z[2];
#pragma unroll
                for (int n = 0; n < 2; ++n) { const f32x4 gt = acc[ai][0][m][n] + bg[n], up = acc[ai][1][m][n] + bu[n];
#pragma unroll
                    for (int r = 0; r < 4; ++r) { const float gg = fminf(gt[r], 7.f), uu = fminf(fmaxf(up[r], -7.f), 7.f); z[n][r] = (uu + 1.f) * (gg * fsigm(1.702f * gg)); } }
                *(u32x4*)(ACT + (size_t)(row0 + ai * 128 + m * 16) * 1024 + j0) = pack8(z[0], z[1]);
            }
    }
};
struct EpiDown {
    bf16* YB; const float* bdn; const float* gate; const LAS int* idx;
    __device__ __forceinline__ void operator()(const Acc& acc, const Unit& u, int wr, int wc, int fr, int fq, LAS unsigned char*) const {
        const int r0 = wr * 64 + fr; const float* bp = bdn + (size_t)u.e * 1024;
        f32x4 bv[2][2]; int c0[2];
#pragma unroll
        for (int bj = 0; bj < 2; ++bj) { c0[bj] = 256 * u.nt + 128 * bj + 32 * wc + 8 * fq; bv[bj][0] = *(const f32x4*)(bp + c0[bj]); bv[bj][1] = *(const f32x4*)(bp + c0[bj] + 4); }
#pragma unroll
        for (int ai = 0; ai < 2; ++ai)
#pragma unroll
            for (int m = 0; m < 4; ++m) {
                const int slot = idx[u.slot * 256 + r0 + ai * 128 + m * 16];
                if (slot >= 0) {
                    const float gw = gate[slot]; bf16* o = YB + (size_t)slot * 1024;
#pragma unroll
                    for (int bj = 0; bj < 2; ++bj) *(u32x4*)(o + c0[bj]) = pack8((acc[ai][bj][m][0] + bv[bj][0]) * gw, (acc[ai][bj][m][1] + bv[bj][1]) * gw);
                }
            }
    }
};

enum { LAY_STD = 0, LAY_HEAD = 1, LAY_INA = 2, LAY_GU = 3 };
template <int LAY> __device__ __forceinline__ int colmap(int pn, int rho) {
    const int bj = rho >> 7, wc = (rho >> 5) & 3, n = (rho >> 4) & 1, fq = (rho >> 2) & 3, reg = rho & 3;
    const int std_c = 128 * bj + 32 * wc + 8 * fq + 4 * n + reg;
    const int head_c = 64 * wc + 32 * (fq >> 1) + 8 * (fq & 1) + 16 * bj + 4 * n + reg;
    if (LAY == LAY_STD) return 256 * pn + std_c;
    if (LAY == LAY_HEAD) return 256 * pn + head_c;
    if (LAY == LAY_INA) return pn < 3 ? 256 * pn + head_c : 768 + (bj ? 512 : 0) + 128 * (pn - 3) + 32 * wc + 8 * fq + 4 * n + reg;
    return (bj ? 1024 : 0) + 128 * pn + 32 * wc + 8 * fq + 4 * n + reg;
}
template <int LAY>
__device__ __forceinline__ void cvt_matrix(const float* src, size_t mat_stride, int ld, int nvalid, int K, int tiles_per_mat, int ntiles, bf16* dst, const float* kscale,
                                           LAS float* scr, int it_begin, int it_step, int lane, int it_end = 0x7fffffff) {
    const int kblocks = K / 64; int nitems = ntiles * 8 * kblocks; nitems = nitems < it_end ? nitems : it_end;
    const int gw = it_begin, NGW = it_step;
    const int i = lane & 31, kh = lane >> 5;
    float v[32], vn[32];
#define CVT_LOAD(it_, dstv) do { const int _kb = (it_) % kblocks, _tg = (it_) / kblocks, _grp = _tg & 7, _tile = _tg >> 3; \
        const int _mat = _tile / tiles_per_mat, _pn = _tile - _mat * tiles_per_mat; const int _c = colmap<LAY>(_pn, _grp * 32 + i); const bool _ok = _c < nvalid; \
        const float* _s = src + (size_t)_mat * mat_stride + (size_t)(_kb * 64 + kh) * ld + (_ok ? _c : 0); \
        _Pragma("unroll") for (int ii = 0; ii < 32; ++ii) dstv[ii] = _ok ? _s[(size_t)(2 * ii) * ld] : 0.f; } while (0)
    int it = gw;
    if (it < nitems) CVT_LOAD(it, v);
    for (; it < nitems; it += NGW) {
        const int itn = it + NGW;
        if (itn < nitems) CVT_LOAD(itn, vn);
        const int kb = it % kblocks, tg = it / kblocks, grp = tg & 7, tile = tg >> 3;
        if (kscale) {
#pragma unroll
            for (int ii = 0; ii < 32; ++ii) v[ii] *= kscale[kb * 64 + 2 * ii + kh];
        }
#pragma unroll
        for (int ii = 0; ii < 32; ++ii) scr[(2 * ii + kh) * 33 + i] = v[ii];
        LDS_WAIT(); asm volatile("" ::: "memory");
        const int c8 = lane & 7;
#pragma unroll
        for (int j = 0; j < 4; ++j) { const int n = (lane >> 3) + 8 * j; const LAS float* q = scr + (8 * c8) * 33 + n;
            u32x4 o; o.x = pk2(q[0 * 33], q[1 * 33]); o.y = pk2(q[2 * 33], q[3 * 33]); o.z = pk2(q[4 * 33], q[5 * 33]); o.w = pk2(q[6 * 33], q[7 * 33]);
            *(u32x4*)(dst + ((size_t)tile * 256 + grp * 32 + n) * K + kb * 64 + 8 * c8) = o; }
        LDS_WAIT(); asm volatile("" ::: "memory");
#pragma unroll
        for (int ii = 0; ii < 32; ++ii) v[ii] = vn[ii];
    }
#undef CVT_LOAD
}

struct CvtBg {
    const float* wgu; const float* wdn; bf16* dgu; bf16* ddn; LAS float* scr; int cl0, vcu, j, jend, cur; bool have; f32x4 v[8];
    __device__ __forceinline__ void init(const float* wgu_, const float* wdn_, bf16* dgu_, bf16* ddn_, LAS float* scr_, int cl0_, int nlay, int vcu_, int wave) {
        wgu = wgu_; wdn = wdn_; dgu = dgu_; ddn = ddn_; scr = scr_; cl0 = cl0_; vcu = vcu_; j = wave; jend = nlay * 192; cur = 0; have = false;
#pragma unroll
        for (int q = 0; q < 8; ++q) v[q] = (f32x4){0.f, 0.f, 0.f, 0.f}; }
    __device__ __forceinline__ void decode(int jj, bool& isgu, int& cl, int& it) const { cl = cl0 + jj / 192; const int r = jj % 192; isgu = r < 128; it = isgu ? vcu * 128 + r : vcu * 64 + (r - 128); }
    __device__ __forceinline__ void issue(int lane) {
        if (j >= jend) { have = false; return; }
        bool isgu; int cl, it; decode(j, isgu, cl, it);
        const int c4 = lane & 7, kr = lane >> 3, i0 = 16 * (c4 & 1) + 4 * (c4 >> 1);
        const int kb = it & 15, tg = it >> 4, grp = tg & 7, tile = tg >> 3;
        const float* s;
        if (isgu) { const int mat = tile >> 3, pn = tile & 7; s = wgu + ((size_t)(cl * 32 + mat) * 1024 + kb * 64 + kr) * 2048 + colmap<LAY_GU>(pn, grp * 32 + i0); }
        else { const int mat = tile >> 2, pn = tile & 3; s = wdn + ((size_t)(cl * 32 + mat) * 1024 + kb * 64 + kr) * 1024 + colmap<LAY_STD>(pn, grp * 32 + i0); }
        const size_t ld8 = isgu ? 8 * 2048 : 8 * 1024;
#pragma unroll
        for (int q = 0; q < 8; ++q) v[q] = __builtin_nontemporal_load((const f32x4*)(s + q * ld8));
        cur = j; have = true; j += 8;
    }
    __device__ __forceinline__ void finish(int lane) {
        if (!have) return;
        bool isgu; int cl, it; decode(cur, isgu, cl, it);
        const int c4 = lane & 7, kr = lane >> 3, i0 = 16 * (c4 & 1) + 4 * (c4 >> 1);
        const int kb = it & 15, tg = it >> 4, grp = tg & 7, tile = tg >> 3;
#pragma unroll
        for (int q = 0; q < 8; ++q) { const int kk = 8 * q + kr; scr[kk * 33 + i0] = v[q][0]; scr[kk * 33 + i0 + 1] = v[q][1]; scr[kk * 33 + i0 + 2] = v[q][2]; scr[kk * 33 + i0 + 3] = v[q][3]; }
        LDS_WAIT(); asm volatile("" ::: "memory");
        bf16* d = isgu ? dgu + ((size_t)(cl * 256 + tile) * 256 + grp * 32) * 1024 : ddn + ((size_t)(cl * 128 + tile) * 256 + grp * 32) * 1024;
        const int c8 = lane & 7;
#pragma unroll
        for (int jx = 0; jx < 4; ++jx) { const int n = (lane >> 3) + 8 * jx; const LAS float* q_ = scr + (8 * c8) * 33 + n;
            u32x4 o; o.x = pk2(q_[0 * 33], q_[1 * 33]); o.y = pk2(q_[2 * 33], q_[3 * 33]); o.z = pk2(q_[4 * 33], q_[5 * 33]); o.w = pk2(q_[6 * 33], q_[7 * 33]);
            *(u32x4*)(d + (size_t)n * 1024 + kb * 64 + 8 * c8) = o; }
        LDS_WAIT(); asm volatile("" ::: "memory");
        have = false;
    }
};
struct NoBg { __device__ __forceinline__ void issue(int) {} __device__ __forceinline__ void finish(int) {} };

__device__ __forceinline__ void normmod_store(const f32x4 (&v)[4], float rstd, const float* g, const float* mvec  , int sh_off, int sc_off, bf16* orow, int lane) {
#pragma unroll
    for (int j = 0; j < 4; ++j) { const int c = 4 * lane + 256 * j;
        const f32x4 gg = *(const f32x4*)(g + c), sc = *(const f32x4*)(mvec + sc_off + c), sh = *(const f32x4*)(mvec + sh_off + c);
        const f32x4 y = v[j] * rstd * gg * (sc + 1.f) + sh;
        u32x2 w; w.x = pk2(y[0], y[1]); w.y = pk2(y[2], y[3]); *(u32x2*)(orow + c) = w; }
}

template <int DQK> struct AT {
    static constexpr int CK = DQK / 8, RSK = DQK * 2 + 16, RSV = 192, KT = 64 * RSK, VT = 64 * RSV, STG = KT + VT, NKS = DQK / 16;
};
#define MFMA32(a, b, c) __builtin_amdgcn_mfma_f32_32x32x16_bf16((a), (b), (c), 0, 0, 0)
struct TileList { int nloc, row_loc0, kpos_loc0, row_ctx0, ntiles; };
template <int DQK, bool MASK, class Bg, int CAD>
__device__ __forceinline__ void attn_core(LAS unsigned char* lds, const bf16x8 (&qf)[DQK / 16], const TileList tl, const char* Kg, int kpitchB, const char* Vg, int vpitchB,
                                          int qpos, float& m, float& l, f32x16 (&O)[2], Bg& bg) {
    typedef AT<DQK> A;
    const int tid = otid(), lane = tid & 63, h = lane >> 5;
    const int kr0 = tid / A::CK, kc0 = tid % A::CK;
    const int kr1 = (tid + 512) / A::CK, kc1 = (tid + 512) % A::CK;
    const bool has2 = (DQK == 96) && (tid < 256);
    const int vr = tid >> 3, vc = tid & 7;
    const unsigned kfrag = (unsigned)((lane & 31) * A::RSK + 16 * h);
    const unsigned vfrag = (unsigned)((((lane & 15) >> 2) + 4 * h) * A::RSV + (16 * ((lane >> 4) & 1) + 4 * (lane & 3)) * 2);
    u32x4 rk0, rk1, rv;
    rk1 = (u32x4){0u, 0u, 0u, 0u};
#define AT_ROW0(i) ((i) < tl.nloc ? tl.row_loc0 + 64 * (i) : tl.row_ctx0 + 64 * ((i) - tl.nloc))
#define AT_LOAD(i) do { const int _r0 = AT_ROW0(i); \
        rk0 = *(const u32x4*)(Kg + (size_t)(_r0 + kr0) * kpitchB + kc0 * 16); \
        if (has2) rk1 = *(const u32x4*)(Kg + (size_t)(_r0 + kr1) * kpitchB + kc1 * 16); \
        rv = *(const u32x4*)(Vg + (size_t)(_r0 + vr) * vpitchB + vc * 16); } while (0)
#define AT_WRITE(buf) do { LAS unsigned char* _b = lds + (buf) * A::STG; \
        *(LAS u32x4*)(_b + kr0 * A::RSK + kc0 * 16) = rk0; \
        if (has2) *(LAS u32x4*)(_b + kr1 * A::RSK + kc1 * 16) = rk1; \
        *(LAS u32x4*)(_b + A::KT + vr * A::RSV + vc * 16) = rv; } while (0)
    f32x16 zero16;
#pragma unroll
    for (int r = 0; r < 16; ++r) zero16[r] = 0.f;
    AT_LOAD(0); AT_WRITE(0);
    __syncthreads();
    for (int i = 0; i < tl.ntiles; ++i) {
        const bool more = (i + 1 < tl.ntiles);
        if (more) AT_LOAD(i + 1);
        if ((i & (CAD - 1)) == 0) bg.issue(lane);
        const LAS unsigned char* kt = lds + (i & 1) * A::STG; const LAS unsigned char* vt = kt + A::KT;
        constexpr int KH = A::NKS / 2;
        bf16x8 ka[KH][2];
#pragma unroll
        for (int ks = 0; ks < KH; ++ks) { ka[ks][0] = *(const LAS bf16x8*)(kt + kfrag + 32 * ks); ka[ks][1] = *(const LAS bf16x8*)(kt + kfrag + 32 * A::RSK + 32 * ks); }
        __builtin_amdgcn_sched_barrier(0);
        f32x16 s0 = MFMA32(ka[0][0], qf[0], zero16), s1 = MFMA32(ka[0][1], qf[0], zero16);
#pragma unroll
        for (int ks = 1; ks < KH; ++ks) { s0 = MFMA32(ka[ks][0], qf[ks], s0); s1 = MFMA32(ka[ks][1], qf[ks], s1); }
#pragma unroll
        for (int ks = 0; ks < KH; ++ks) { ka[ks][0] = *(const LAS bf16x8*)(kt + kfrag + 32 * (KH + ks)); ka[ks][1] = *(const LAS bf16x8*)(kt + kfrag + 32 * A::RSK + 32 * (KH + ks)); }
        __builtin_amdgcn_sched_barrier(0);
#pragma unroll
        for (int ks = 0; ks < KH; ++ks) { s0 = MFMA32(ka[ks][0], qf[KH + ks], s0); s1 = MFMA32(ka[ks][1], qf[KH + ks], s1); }
        __builtin_amdgcn_sched_barrier(0);
        s16x4 vlo[2][2], vhi[2][2];
#pragma unroll
        for (int sp = 0; sp < 2; ++sp)
#pragma unroll
            for (int dvb = 0; dvb < 2; ++dvb) { const LAS unsigned char* vp = vt + vfrag + (16 * sp) * A::RSV + 64 * dvb;
                vlo[sp][dvb] = __builtin_amdgcn_ds_read_tr16_b64_v4i16((LAS s16x4*)(vp)); vhi[sp][dvb] = __builtin_amdgcn_ds_read_tr16_b64_v4i16((LAS s16x4*)(vp + 8 * A::RSV)); }
        __builtin_amdgcn_sched_barrier(0);
        if (MASK) {
            if (i < tl.nloc) {
                const int kb = tl.kpos_loc0 + 64 * i + 4 * h - qpos;
#pragma unroll
                for (int r = 0; r < 16; ++r) { const int d0 = kb + (r & 3) + 8 * (r >> 2), d1 = d0 + 32;
                    if (d0 > 128 || d0 < -128) s0[r] = -1e30f; if (d1 > 128 || d1 < -128) s1[r] = -1e30f; }
            }
        }
        float tm = fmaxf(fmaxf(s0[0], s1[0]), fmaxf(s0[1], s1[1]));
#pragma unroll
        for (int r = 2; r < 16; r += 2) tm = fmaxf(tm, fmaxf(fmaxf(s0[r], s1[r]), fmaxf(s0[r + 1], s1[r + 1])));
        tm = fmaxf(tm, __shfl_xor(tm, 32)) - m;
        if (__builtin_amdgcn_ballot_w64(tm > 8.f) != 0ull) {
            const float dlt = fmaxf(tm, 0.f), alpha = __builtin_amdgcn_exp2f(-dlt);
            m += dlt; l *= alpha;
#pragma unroll
            for (int r = 0; r < 16; ++r) { O[0][r] *= alpha; O[1][r] *= alpha; }
        }
        if (__builtin_amdgcn_ballot_w64(m != 0.f) != 0ull) {
#pragma unroll
            for (int r = 0; r < 16; ++r) { s0[r] -= m; s1[r] -= m; }
        }
        float ps = 0.f;
#pragma unroll
        for (int r = 0; r < 16; ++r) { s0[r] = __builtin_amdgcn_exp2f(s0[r]); s1[r] = __builtin_amdgcn_exp2f(s1[r]); ps += s0[r] + s1[r]; }
        l += ps;
#pragma unroll
        for (int kh = 0; kh < 2; ++kh) {
            const f32x16& p = kh ? s1 : s0;
#pragma unroll
            for (int sp = 0; sp < 2; ++sp) {
                u32x4 pw; pw.x = pk2(p[8 * sp + 0], p[8 * sp + 1]); pw.y = pk2(p[8 * sp + 2], p[8 * sp + 3]); pw.z = pk2(p[8 * sp + 4], p[8 * sp + 5]); pw.w = pk2(p[8 * sp + 6], p[8 * sp + 7]);
                const bf16x8 pf = __builtin_bit_cast(bf16x8, pw);
#pragma unroll
                for (int dvb = 0; dvb < 2; ++dvb) { const bf16x8 va = __builtin_shufflevector(vlo[sp][dvb], vhi[sp][dvb], 0, 1, 2, 3, 4, 5, 6, 7); O[dvb] = MFMA32(va, pf, O[dvb]); }
            }
            if (kh == 0) {
#pragma unroll
                for (int sp = 0; sp < 2; ++sp)
#pragma unroll
                    for (int dvb = 0; dvb < 2; ++dvb) { const LAS unsigned char* vp = vt + vfrag + (32 + 16 * sp) * A::RSV + 64 * dvb;
                        vlo[sp][dvb] = __builtin_amdgcn_ds_read_tr16_b64_v4i16((LAS s16x4*)(vp)); vhi[sp][dvb] = __builtin_amdgcn_ds_read_tr16_b64_v4i16((LAS s16x4*)(vp + 8 * A::RSV)); }
            }
        }
        if (more) AT_WRITE((i + 1) & 1);
        if ((i & (CAD - 1)) == CAD - 1) bg.finish(lane);
        __syncthreads();
    }
#undef AT_ROW0
#undef AT_LOAD
#undef AT_WRITE
}
__device__ __forceinline__ void attn_store(const f32x16 (&O)[2], float l, bf16* orow, int h) {
    const float lt = l + __shfl_xor(l, 32); const float inv = 1.f / lt;
#pragma unroll
    for (int dvb = 0; dvb < 2; ++dvb)
#pragma unroll
        for (int g4 = 0; g4 < 4; ++g4) { u32x2 w; w.x = pk2(O[dvb][4 * g4] * inv, O[dvb][4 * g4 + 1] * inv); w.y = pk2(O[dvb][4 * g4 + 2] * inv, O[dvb][4 * g4 + 3] * inv);
            *(u32x2*)(orow + 32 * dvb + 8 * g4 + 4 * h) = w; }
}

__device__ __forceinline__ void wattn_unit(LAS unsigned char* lds, int unit, const bf16* Qa, const bf16* Ka, const bf16* Va, const float* sink, bf16* MIX, CvtBg& bg) {
    const int tid = otid(), w = tid >> 6, lane = tid & 63, h = lane >> 5;
    int b, kvh, hp, tq, qpos; TileList tl;
    if (unit < 512) { b = unit >> 7; kvh = (unit >> 6) & 1; const int nb = (unit >> 1) & 31; hp = unit & 1;
        const int t0 = max(0, 128 * nb - 128), t1 = min(4096, 128 * nb + 256);
        tl.nloc = (t1 - t0) >> 6; tl.row_loc0 = b * S + t0; tl.kpos_loc0 = t0; tl.row_ctx0 = NL + b * CL; tl.ntiles = tl.nloc + 4;
        qpos = 128 * nb + (w & 3) * 32 + (lane & 31); tq = b * S + qpos;
    } else { const int u = unit - 512; b = u >> 3; kvh = (u >> 2) & 1; hp = (u >> 1) & 1; const int half = u & 1;
        tl.nloc = 0; tl.row_loc0 = 0; tl.kpos_loc0 = 0; tl.row_ctx0 = NL + b * CL; tl.ntiles = 4;
        qpos = 0; tq = NL + b * CL + half * 128 + (w & 3) * 32 + (lane & 31); }
    const int hq = kvh * 4 + hp * 2 + (w >> 2);
    bf16x8 qf[4];
#pragma unroll
    for (int ks = 0; ks < 4; ++ks) qf[ks] = *(const bf16x8*)(Qa + (size_t)tq * 512 + hq * 64 + 16 * ks + 8 * h);
    float m = 0.f, l = (h == 0) ? __expf(sink[hq]) : 0.f;
    f32x16 O[2];
#pragma unroll
    for (int r = 0; r < 16; ++r) { O[0][r] = 0.f; O[1][r] = 0.f; }
    attn_core<64, true, CvtBg, 2>(lds, qf, tl, (const char*)(Ka + kvh * 64), 256, (const char*)(Va + kvh * 64), 256, qpos, m, l, O, bg);
    bg.finish(lane);
    attn_store(O, l, MIX + (size_t)tq * 1024 + hq * 64, h);
}
__device__ __forceinline__ void mla_unit(LAS unsigned char* lds, int unit, const bf16* Qc, const bf16* Kc, const bf16* Vc, const float* RS, const float* qg,
                                         const float* cosC, const float* sinC, bf16* MIX, CvtBg& bg) {
    const int tid = otid(), w = tid >> 6, lane = tid & 63, h = lane >> 5;
    int b, head, tq; TileList tl; bool lat;
    if (unit < 1024) { b = unit >> 8; head = (unit >> 4) & 15; const int qb = unit & 15; lat = true;
        tl.nloc = 64; tl.row_loc0 = b * S; tl.kpos_loc0 = 0; tl.row_ctx0 = NL + b * CL; tl.ntiles = 68; tq = b * S + qb * 256 + w * 32 + (lane & 31);
    } else { const int u = unit - 1024; b = u >> 4; head = u & 15; lat = false;
        tl.nloc = 0; tl.row_loc0 = 0; tl.kpos_loc0 = 0; tl.row_ctx0 = NL + b * CL; tl.ntiles = 4; tq = NL + b * CL + w * 32 + (lane & 31); }
    float v[6][8]; float ss = 0.f;
    const bf16* qp = Qc + (size_t)tq * 1536 + head * 96 + 8 * h;
#pragma unroll
    for (int ks = 0; ks < 6; ++ks) { const u32x4 raw = *(const u32x4*)(qp + 16 * ks);
        v[ks][0] = bflo(raw.x); v[ks][1] = bfhi(raw.x); v[ks][2] = bflo(raw.y); v[ks][3] = bfhi(raw.y); v[ks][4] = bflo(raw.z); v[ks][5] = bfhi(raw.z); v[ks][6] = bflo(raw.w); v[ks][7] = bfhi(raw.w);
#pragma unroll
        for (int j = 0; j < 8; ++j) ss += v[ks][j] * v[ks][j]; }
    ss += __shfl_xor(ss, 32);
    float r; { const f32x4 p0 = *(const f32x4*)(RS + (size_t)tq * 16), p1 = *(const f32x4*)(RS + (size_t)tq * 16 + 4), p2 = *(const f32x4*)(RS + (size_t)tq * 16 + 8);
      r = rsqrtf((((p0[0] + p0[1]) + (p0[2] + p0[3])) + ((p1[0] + p1[1]) + (p1[2] + p1[3])) + ((p2[0] + p2[1]) + (p2[2] + p2[3]))) * (1.f / 768.f) + EPS); }
    const float inv = r * rsqrtf(r * r * ss * (1.f / 96.f) + EPS);
#pragma unroll
    for (int ks = 0; ks < 6; ++ks) { const f32x4 g0 = *(const f32x4*)(qg + 16 * ks + 8 * h), g1 = *(const f32x4*)(qg + 16 * ks + 8 * h + 4);
#pragma unroll
        for (int j = 0; j < 4; ++j) { v[ks][j] *= inv * g0[j]; v[ks][4 + j] *= inv * g1[j]; } }
    {
        const int t = tq & 4095;
#pragma unroll
        for (int ax = 0; ax < 2; ++ax) {
            const f32x4 c0 = *(const f32x4*)(cosC + t * 16 + 8 * ax), c1 = *(const f32x4*)(cosC + t * 16 + 8 * ax + 4);
            const f32x4 s0 = *(const f32x4*)(sinC + t * 16 + 8 * ax), s1 = *(const f32x4*)(sinC + t * 16 + 8 * ax + 4);
#pragma unroll
            for (int j = 0; j < 8; ++j) { const float y = v[4 + ax][j], po = __shfl_xor(y, 32); const float c = j < 4 ? c0[j & 3] : c1[j & 3], s = j < 4 ? s0[j & 3] : s1[j & 3];
                const float yr = (h == 0) ? (y * c - po * s) : (y * c + po * s); v[4 + ax][j] = lat ? yr : y; }
        }
    }
    bf16x8 qf[6];
#pragma unroll
    for (int ks = 0; ks < 6; ++ks) { u32x4 pw; pw.x = pk2(v[ks][0] * QSCALE_C, v[ks][1] * QSCALE_C); pw.y = pk2(v[ks][2] * QSCALE_C, v[ks][3] * QSCALE_C);
        pw.z = pk2(v[ks][4] * QSCALE_C, v[ks][5] * QSCALE_C); pw.w = pk2(v[ks][6] * QSCALE_C, v[ks][7] * QSCALE_C); qf[ks] = __builtin_bit_cast(bf16x8, pw); }
    float m = 0.f, l = 0.f;
    f32x16 O[2];
#pragma unroll
    for (int rr = 0; rr < 16; ++rr) { O[0][rr] = 0.f; O[1][rr] = 0.f; }
    attn_core<96, false, CvtBg, 4>(lds, qf, tl, (const char*)(Kc + head * 96), 3072, (const char*)(Vc + head * 64), 2048, 0, m, l, O, bg);
    bg.finish(lane);
    attn_store(O, l, MIX + (size_t)tq * 1024 + head * 64, h);
}

template <int NTOK>
__device__ __forceinline__ void conv_strip(LAS unsigned char* lds, int seq0, int len, int t0, const bf16* Z, const float* dw_w, const float* dw_b, const float* ln_g, const float* ln_b, bf16* MIX) {
    const int tid = otid(), w = tid >> 6, lane = tid & 63;
    constexpr int NROW = NTOK + 30, NCH = NROW * 64, NLD = (NCH + NTHR - 1) / NTHR, NSUB = (NTOK + 15) / 16;
    LAS bf16* zt = (LAS bf16*)lds; LAS float* ot = (LAS float*)(lds + 98304);
    u32x4 st[NLD];
#pragma unroll
    for (int i = 0; i < NLD; ++i) { const int q = tid + i * NTHR, r = q >> 6, cc = q & 63, tt = t0 - 15 + r; st[i] = (u32x4){0u, 0u, 0u, 0u};
        if (q < NCH && tt >= 0 && tt < len) st[i] = *(const u32x4*)(Z + (size_t)(seq0 + tt) * 512 + cc * 8); }
    float wt[31];
#pragma unroll
    for (int j = 0; j < 31; ++j) wt[j] = dw_w[j * 512 + tid];
    const float bias = dw_b[tid];
#pragma unroll
    for (int i = 0; i < NLD; ++i) { const int q = tid + i * NTHR; if (q < NCH) *(LAS u32x4*)(zt + (q >> 6) * 512 + (q & 63) * 8) = st[i]; }
    const f32x4 g0 = *(const f32x4*)(ln_g + 8 * lane), g1 = *(const f32x4*)(ln_g + 8 * lane + 4), b0 = *(const f32x4*)(ln_b + 8 * lane), b1 = *(const f32x4*)(ln_b + 8 * lane + 4);
    __syncthreads();
#pragma unroll 1
    for (int sb = 0; sb < NSUB; ++sb) {
        float acc[16];
#pragma unroll
        for (int t = 0; t < 16; ++t) acc[t] = bias;
        const LAS bf16* zp = zt + sb * 16 * 512 + tid;
        constexpr int NR = (NTOK >= 16 ? 16 : NTOK) + 30;
#pragma unroll
        for (int r = 0; r < NR; ++r) { const float zv = bf1(zp[r * 512]);
#pragma unroll
            for (int t = 0; t < 16; ++t) { const int j = r - t; if (j >= 0 && j < 31 && t < NTOK) acc[t] += zv * wt[j]; } }
#pragma unroll
        for (int t = 0; t < 16; ++t) ot[t * 512 + tid] = acc[t];
        __syncthreads();
#pragma unroll
        for (int q = 0; q < 2; ++q) { const int t = 2 * w + q, tok = sb * 16 + t;
            if (tok < NTOK) {
                const f32x4 x0 = *(const LAS f32x4*)(ot + t * 512 + 8 * lane), x1 = *(const LAS f32x4*)(ot + t * 512 + 8 * lane + 4);
                const float mu = wave_sum((x0[0] + x0[1]) + (x0[2] + x0[3]) + (x1[0] + x1[1]) + (x1[2] + x1[3])) * (1.f / 512.f);
                const f32x4 d0 = x0 - mu, d1 = x1 - mu;
                const float var = wave_sum((d0[0] * d0[0] + d0[1] * d0[1]) + (d0[2] * d0[2] + d0[3] * d0[3]) + (d1[0] * d1[0] + d1[1] * d1[1]) + (d1[2] * d1[2] + d1[3] * d1[3])) * (1.f / 512.f);
                const float rstd = rsqrtf(var + EPS);
                f32x4 y0 = d0 * rstd * g0 + b0, y1 = d1 * rstd * g1 + b1;
#pragma unroll
                for (int j = 0; j < 4; ++j) { y0[j] = fsilu(y0[j]); y1[j] = fsilu(y1[j]); }
                *(u32x4*)(MIX + (size_t)(seq0 + t0 + tok) * 1024 + 512 + 8 * lane) = pack8(y0, y1); } }
        __syncthreads();
    }
}

__device__ __forceinline__ void mla_stats_row(int row, int lane, const bf16* P, const float* krg, const float* cosC, const float* sinC, float* RS, bf16* Kc) {
    const bf16* p = P + (size_t)row * PP;
    const u32x4 a = *(const u32x4*)(p + 8 * lane);
    const u32x4 b = *(const u32x4*)(p + 8 * (lane + 64));
    u32x4 c = (u32x4){0u, 0u, 0u, 0u};
    if (lane < 4) c = *(const u32x4*)(p + 8 * (lane + 128));
    auto sq = [](u32x4 u) { float s = 0.f; s += bflo(u.x) * bflo(u.x) + bfhi(u.x) * bfhi(u.x); s += bflo(u.y) * bflo(u.y) + bfhi(u.y) * bfhi(u.y);
                            s += bflo(u.z) * bflo(u.z) + bfhi(u.z) * bfhi(u.z); s += bflo(u.w) * bflo(u.w) + bfhi(u.w) * bfhi(u.w); return s; };
    const float sa = sq(a), sb = sq(b), sc = sq(c);
    const float ssq = wave_sum(sa + (lane < 32 ? sb : 0.f)), skv = wave_sum(lane >= 32 ? sb : 0.f), skr = wave_sum(sc);
    if (lane == 0) { RS[(size_t)row * 2] = rsqrtf(ssq * (1.f / 768.f) + EPS); RS[(size_t)row * 2 + 1] = rsqrtf(skv * (1.f / 256.f) + EPS); }
    const float rk = rsqrtf(skr * (1.f / 32.f) + EPS);
    float y[8]; const int l4 = lane & 3;
    { const f32x4 g0 = *(const f32x4*)(krg + 8 * l4), g1 = *(const f32x4*)(krg + 8 * l4 + 4);
      y[0] = bflo(c.x) * rk * g0[0]; y[1] = bfhi(c.x) * rk * g0[1]; y[2] = bflo(c.y) * rk * g0[2]; y[3] = bfhi(c.y) * rk * g0[3];
      y[4] = bflo(c.z) * rk * g1[0]; y[5] = bfhi(c.z) * rk * g1[1]; y[6] = bflo(c.w) * rk * g1[2]; y[7] = bfhi(c.w) * rk * g1[3]; }
    const int t = row & 4095, ax = l4 >> 1, half = l4 & 1;
    const f32x4 c0 = *(const f32x4*)(cosC + t * 16 + 8 * ax), c1 = *(const f32x4*)(cosC + t * 16 + 8 * ax + 4), s0 = *(const f32x4*)(sinC + t * 16 + 8 * ax), s1 = *(const f32x4*)(sinC + t * 16 + 8 * ax + 4);
    float o[8];
#pragma unroll
    for (int j = 0; j < 8; ++j) { const float po = __shfl_xor(y[j], 1); const float cc = j < 4 ? c0[j & 3] : c1[j & 3], sn = j < 4 ? s0[j & 3] : s1[j & 3];
        const float yr = half == 0 ? (y[j] * cc - po * sn) : (y[j] * cc + po * sn); o[j] = row < NL ? yr : y[j]; }
    if (lane < 4) { u32x4 wv; wv.x = pk2(o[0], o[1]); wv.y = pk2(o[2], o[3]); wv.z = pk2(o[4], o[5]); wv.w = pk2(o[6], o[7]);
#pragma unroll
        for (int hd = 0; hd < 16; ++hd) *(u32x4*)(Kc + (size_t)row * 1536 + hd * 96 + 64 + 8 * lane) = wv; }
}

template <int NT>
__device__ __forceinline__ void moe_setup(LAS unsigned char* lds, const int* cntG, const int* list, int layer, int vcu, int G) {
    LAS int* tab = (LAS int*)(lds + LDS_TAB); LAS int* idx = (LAS int*)(lds + LDS_IDX);
    const int tid = otid(); constexpr int MG = 32 / NT;
    if (tid < 32) tab[tid] = cntG[tid * 64];
    __syncthreads();
    if (tid == 0) { int acc = 0; for (int e = 0; e < 32; ++e) { tab[32 + e] = acc; acc += (tab[e] + 255) >> 8; } tab[64] = acc;
        int n = 0;
        for (int i = 0; i < MAXU; ++i) { const int v = i * G + vcu, gm = (v >> 5) * MG + (v & 31) / NT, nt = v % NT; if (gm >= acc) break;
            int e = 0; while (e < 31 && tab[33 + e] <= gm) ++e;
            tab[128 + 4 * i] = gm; tab[129 + 4 * i] = (layer * 32 + e) * NT + nt; tab[130 + 4 * i] = e; tab[131 + 4 * i] = nt; n = i + 1; }
        tab[127] = n; }
    __syncthreads();
    const int n = tab[127];
    for (int q = tid; q < n * 256; q += NTHR) { const int i = q >> 8, r = q & 255, gm = tab[128 + 4 * i], e = tab[130 + 4 * i], rr = (gm - tab[32 + e]) * 256 + r;
        idx[q] = rr < tab[e] ? list[(size_t)e * T + rr] : -1; }
    __syncthreads();
}

__device__ __forceinline__ void combine_row(int row, int lane, float* X, const bf16* YB, const float* mcur  , const float* gnext, const float* mnext, bf16* H, float* out) {
    const int mr = modrow(row); const float* mv = mcur + (size_t)mr * 6144 + 5120;
    f32x4 v[4]; float ss = 0.f;
#pragma unroll
    for (int j = 0; j < 4; ++j) { const int c = 4 * lane + 256 * j; f32x4 a = (f32x4){0.f, 0.f, 0.f, 0.f};
#pragma unroll
        for (int k = 0; k < 4; ++k) { const u32x2 y = *(const u32x2*)(YB + ((size_t)row * 4 + k) * 1024 + c); a += (f32x4){bflo(y.x), bfhi(y.x), bflo(y.y), bfhi(y.y)}; }
        float* xp = X + (size_t)row * D + c; const f32x4 g = *(const f32x4*)(mv + c);
        v[j] = *(const f32x4*)xp + g * a;
        if (out) *(f32x4*)(out + (size_t)row * D + c) = v[j]; else *(f32x4*)xp = v[j];
        ss += (v[j][0] * v[j][0] + v[j][1] * v[j][1]) + (v[j][2] * v[j][2] + v[j][3] * v[j][3]); }
    if (H) { const float rstd = rsqrtf(wave_sum(ss) * (1.f / D) + EPS); normmod_store(v, rstd, gnext, mnext + (size_t)mr * 6144, 0, 1024, H + (size_t)row * D, lane); }
}


#define MFMA16(a, b, c) __builtin_amdgcn_mfma_f32_16x16x32_bf16((a), (b), (c), 0, 0, 0)
__device__ __forceinline__ void router_load_table(LAS unsigned char* lds, const bf16* Wr, int tid) {
    u32x4 v[16];
#pragma unroll
    for (int i = 0; i < 16; ++i) v[i] = *(const u32x4*)(Wr + (size_t)(tid + i * NTHR) * 8);
#pragma unroll
    for (int i = 0; i < 16; ++i) { const int q = tid + i * NTHR, row = q >> 7, c = q & 127; *(LAS u32x4*)(lds + row * 2048 + ((c ^ (row & 15)) << 4)) = v[i]; }
}
__device__ __forceinline__ void router_group(LAS unsigned char* lds, int g, int w, int lane, const float* X, const float* SSX, const float* gffn, const float* mvec, const float* rb,
                                             bf16* F, float* gate) {
    LAS float* lg = (LAS float*)(lds + LDS_IDX) + w * 512; LAS int* pend = (LAS int*)(lds + LDS_IDX + 10240) + w * 64; LAS int* cntL = (LAS int*)(lds + LDS_TAB);
    const int i = lane & 15, kq = lane >> 4, row = 16 * g + i;
    const float* xr = X + (size_t)row * D + 8 * kq;
    float ss; { const f32x4 pq = *(const f32x4*)(SSX + (size_t)row * 16 + 4 * kq); ss = (pq[0] + pq[1]) + (pq[2] + pq[3]); }
    ss += __shfl_xor(ss, 16); ss += __shfl_xor(ss, 32);
    const float rstd = rsqrtf(ss * (1.f / D) + EPS);
    f32x4 acc[2] = {(f32x4){0.f, 0.f, 0.f, 0.f}, (f32x4){0.f, 0.f, 0.f, 0.f}};
    const LAS unsigned char* tb = lds + i * 2048;
#pragma unroll 8
    for (int s = 0; s < 32; ++s) {
        const int k = 32 * s + 8 * kq;
        const f32x4 a = *(const f32x4*)(xr + 32 * s), b = *(const f32x4*)(xr + 32 * s + 4);
        const f32x4 g0 = *(const f32x4*)(gffn + k), g1 = *(const f32x4*)(gffn + k + 4), c0 = *(const f32x4*)(mvec + 4096 + k), c1 = *(const f32x4*)(mvec + 4096 + k + 4);
        const f32x4 h0 = *(const f32x4*)(mvec + 3072 + k), h1 = *(const f32x4*)(mvec + 3072 + k + 4);
        const f32x4 f0 = a * rstd * g0 * (c0 + 1.f) + h0, f1 = b * rstd * g1 * (c1 + 1.f) + h1;
        u32x4 hi; hi.x = pk2(f0[0], f0[1]); hi.y = pk2(f0[2], f0[3]); hi.z = pk2(f1[0], f1[1]); hi.w = pk2(f1[2], f1[3]);
        *(u32x4*)(F + (size_t)row * D + k) = hi;
        u32x4 lo; lo.x = pk2(f0[0] - bflo(hi.x), f0[1] - bfhi(hi.x)); lo.y = pk2(f0[2] - bflo(hi.y), f0[3] - bfhi(hi.y));
        lo.z = pk2(f1[0] - bflo(hi.z), f1[1] - bfhi(hi.z)); lo.w = pk2(f1[2] - bflo(hi.w), f1[3] - bfhi(hi.w));
        const bf16x8 ah = __builtin_bit_cast(bf16x8, hi), al = __builtin_bit_cast(bf16x8, lo);
        const int cs = ((4 * s + kq) ^ i) << 4;
#pragma unroll
        for (int et = 0; et < 2; ++et) { const bf16x8 bh = *(const LAS bf16x8*)(tb + et * 16 * 2048 + cs), bl = *(const LAS bf16x8*)(tb + (32 + et * 16) * 2048 + cs);
            acc[et] = MFMA16(ah, bh, acc[et]); acc[et] = MFMA16(al, bh, acc[et]); acc[et] = MFMA16(ah, bl, acc[et]); }
    }
#pragma unroll
    for (int et = 0; et < 2; ++et) { const float bias = rb[16 * et + i];
#pragma unroll
        for (int r = 0; r < 4; ++r) lg[(4 * kq + r) * 32 + 16 * et + i] = acc[et][r] + bias; }
    LDS_WAIT(); asm volatile("" ::: "memory");
    if (lane < 16) {
        const LAS float* my = lg + lane * 32; unsigned used = 0u; int bi[4]; float bv[4];
#pragma unroll
        for (int k = 0; k < 4; ++k) { float best = -3.0e38f; int be = 0;
#pragma unroll
            for (int e = 0; e < 32; ++e) { const float v = my[e]; const bool ok = !((used >> e) & 1u) && v > best; best = ok ? v : best; be = ok ? e : be; }
            used |= 1u << be; bi[k] = be; bv[k] = best; }
        float ex[4], sum = 0.f;
#pragma unroll
        for (int k = 0; k < 4; ++k) { ex[k] = __expf(bv[k] - bv[0]); sum += ex[k]; }
        const float inv = 1.f / sum; const int trow = 16 * g + lane;
#pragma unroll
        for (int k = 0; k < 4; ++k) { const int rl = __hip_atomic_fetch_add(cntL + bi[k], 1, __ATOMIC_RELAXED, __HIP_MEMORY_SCOPE_WORKGROUP);
            pend[lane * 4 + k] = (trow * 4 + k) | (bi[k] << 17) | (rl << 22); gate[trow * 4 + k] = ex[k] * inv; }
    }
}

struct Args { const float* in[32]; float* out; unsigned char* ws; int lo, hi, flags, pad; };
constexpr int N_PHASES = 2 + 2 * (7 + 8);

__global__ void __launch_bounds__(NTHR, 2) mega(Args args) {
    extern __shared__ __attribute__((aligned(16))) unsigned char lds_raw[];
    LAS unsigned char* lds = (LAS unsigned char*)lds_raw;
    const int tid = threadIdx.x, lane = tid & 63, wave = __builtin_amdgcn_readfirstlane(tid >> 6);
    constexpr int G = 256;
    const int bx = blockIdx.x & (G - 1), vcu = (bx % 8) * (G / 8) + bx / 8;
    const int gw = vcu * NWAVES + wave, NGW = G * NWAVES;
    unsigned* ctl = (unsigned*)(args.ws + WS_CTL);
#define PH_LOCALS \
    unsigned zsg_; asm volatile("s_mov_b32 %0, 0" : "=s"(zsg_)); unsigned char* ws = args.ws + zsg_;   const int tid = otid(), lane = tid & 63, wave = __builtin_amdgcn_readfirstlane(tid >> 6), gw = vcu * NWAVES + wave; (void)lane; (void)gw; \
    const float* x_in = args.in[0]; const float* c_in = args.in[1]; const float* ctx_in = args.in[2]; const float* cctx_in = args.in[3]; \
    const float* mod_w = args.in[4]; const float* mod_b = args.in[5]; const float* norm_mix_g = args.in[6]; const float* norm_ffn_g = args.in[7]; \
    float* MOD = (float*)(ws + WS_MOD); float* cosA = (float*)(ws + WS_COSA); float* sinA = (float*)(ws + WS_SINA); float* cosC = (float*)(ws + WS_COSC); float* sinC = (float*)(ws + WS_SINC); \
    bf16* WR = (bf16*)(ws + WS_WR); bf16* WINA = (bf16*)(ws + WS_WINA); bf16* WOUTA = (bf16*)(ws + WS_WOUTA); bf16* WINC = (bf16*)(ws + WS_WINC); bf16* WQB = (bf16*)(ws + WS_WQB); \
    bf16* WKVB = (bf16*)(ws + WS_WKVB); bf16* WOUTC = (bf16*)(ws + WS_WOUTC); bf16* WGU = (bf16*)(ws + WS_WGU); bf16* WDN = (bf16*)(ws + WS_WDN); \
    float* X = (float*)(ws + WS_X); bf16* H = (bf16*)(ws + WS_H); bf16* QA = (bf16*)(ws + WS_QA); bf16* KA = (bf16*)(ws + WS_KA); bf16* VA = (bf16*)(ws + WS_VA); bf16* Z = (bf16*)(ws + WS_Z); \
    bf16* P = (bf16*)(ws + WS_P); float* RS = (float*)(ws + WS_RS); bf16* QC = (bf16*)(ws + WS_QC); bf16* KC = (bf16*)(ws + WS_KC); bf16* VC = (bf16*)(ws + WS_VC); \
    bf16* MIX = (bf16*)(ws + WS_MIX); bf16* F = (bf16*)(ws + WS_F); float* GATE = (float*)(ws + WS_GATE); int* LIST = (int*)(ws + WS_LIST); bf16* ACT = (bf16*)(ws + WS_ACT); bf16* YB = (bf16*)(ws + WS_YB); \
    int* CNT = (int*)(ws + WS_CTL) + CW_CNT; float* SSX = (float*)(ws + WS_SSX); float* SSP = (float*)(ws + WS_SSP); (void)SSX; (void)SSP; const float* ML = MOD + (size_t)layer_ * 5 * 6144; \
    (void)x_in; (void)c_in; (void)ctx_in; (void)cctx_in; (void)mod_w; (void)mod_b; (void)norm_mix_g; (void)norm_ffn_g; (void)MOD; (void)cosA; (void)sinA; (void)cosC; (void)sinC; (void)WR; (void)WINA; (void)WOUTA; \
    (void)WINC; (void)WQB; (void)WKVB; (void)WOUTC; (void)WGU; (void)WDN; (void)X; (void)H; (void)QA; (void)KA; (void)VA; (void)Z; (void)P; (void)RS; (void)QC; (void)KC; (void)VC; (void)MIX; (void)F; (void)GATE; \
    (void)LIST; (void)ACT; (void)YB; (void)CNT; (void)ML;
    if (tid < 64) ((LAS unsigned*)(lds + LDS_MISC))[tid] = 0u;
    __syncthreads();
    const int lo = args.lo, hi = args.hi;
    XcdBarrier bar; bar.bar = ctl + CW_BAR; bar.x = 0; bar.st = nullptr;
    if (hi - lo > 1) bar = xcd_barrier_post(ctl + CW_BAR, (volatile LAS unsigned*)(lds + LDS_MISC));
    int ph = 0; int layer_ = 0;
#ifndef MK_EN
#define MK_EN 0xffffffffu
#endif
#ifdef MK_PROBE_PH
#define PFLAG(b) (args.flags & (b))
#else
#define PFLAG(b) 0
#endif
#define EN(k) (((MK_EN) >> (k)) & 1u)
#define PH_ON (ph >= lo && ph < hi)
#define PH_END do { const bool _b = (ph >= lo) && (ph + 1 < hi); ++ph; if (_b) xcd_barrier(bar); } while (0)

    if (EN(0) && PH_ON) { PH_LOCALS
        LAS float* st = (LAS float*)(lds + 73728);
        for (int q = tid; q < 5 * 1024; q += NTHR) { const float v = q < 4096 ? c_in[q] : cctx_in[q - 4096]; st[q] = fsilu(v); }
        __syncthreads();
        if (gw % 5 == 0 && gw / 5 < 384) {
            const int u = gw / 5, l = u / 96, col = (u % 96) * 64 + lane;
            const float* wp = mod_w + (size_t)l * D * 6144 + col; float a0 = 0.f, a1 = 0.f, a2 = 0.f, a3 = 0.f, a4 = 0.f;
            for (int k0 = 0; k0 < D; k0 += 64) { float wv[64];
#pragma unroll
                for (int kk = 0; kk < 64; ++kk) wv[kk] = __builtin_nontemporal_load(wp + (size_t)(k0 + kk) * 6144);
#pragma unroll
                for (int kk = 0; kk < 64; ++kk) { const int k = k0 + kk; a0 += st[k] * wv[kk]; a1 += st[1024 + k] * wv[kk]; a2 += st[2048 + k] * wv[kk]; a3 += st[3072 + k] * wv[kk]; a4 += st[4096 + k] * wv[kk]; } }
            const float bv = mod_b[l * 6144 + col]; float* mo = MOD + (size_t)l * 5 * 6144 + col;
            mo[0] = a0 + bv; mo[6144] = a1 + bv; mo[2 * 6144] = a2 + bv; mo[3 * 6144] = a3 + bv; mo[4 * 6144] = a4 + bv;
        }
        for (int q = gw * 64 + lane; q < 4096 * 32; q += NGW * 64) {
            { const int t = q >> 5, j = q & 31, ax = j >> 4, i = j & 15; const float pos = (float)(ax == 0 ? (t >> 6) : (t & 63)); const float a = pos * powf(10000.f, -((float)i * 2.f) / 32.f); cosA[q] = cosf(a); sinA[q] = sinf(a); }
            if (q < 4096 * 16) { const int t = q >> 4, j = q & 15, ax = j >> 3, i = j & 7; const float pos = (float)(ax == 0 ? (t >> 6) : (t & 63)); const float a = pos * powf(10000.f, -((float)i * 2.f) / 16.f); cosC[q] = cosf(a); sinC[q] = sinf(a); }
        }
        { const float* rw = args.in[26];
          for (int q = gw * 64 + lane; q < 4 * 32 * 1024; q += NGW * 64) { const int l = q >> 15, e = (q >> 10) & 31, k = q & 1023; const float wv = rw[((size_t)l * 1024 + k) * 32 + e];
              const unsigned hb = pk2(wv, 0.f) & 0xffffu; const float hf = __uint_as_float(hb << 16); const unsigned lb = pk2(wv - hf, 0.f) & 0xffffu;
              WR[((size_t)(l * 2 + 0) * 32 + e) * 1024 + k] = (bf16)hb; WR[((size_t)(l * 2 + 1) * 32 + e) * 1024 + k] = (bf16)lb; } }
        LAS float* scr = (LAS float*)(lds + wave * 8448);
        cvt_matrix<LAY_INA>(args.in[8], (size_t)D * 1792, 1792, 1792, 1024, 7, 14, WINA, nullptr, scr, gw, NGW, lane);
        cvt_matrix<LAY_STD>(args.in[9], (size_t)D * 1024, 1024, 1024, 1024, 4, 8, WOUTA, nullptr, scr, gw, NGW, lane);
        cvt_matrix<LAY_STD>(args.in[17], (size_t)D * 1056, 1056, 1056, 1024, 5, 10, WINC, nullptr, scr, gw, NGW, lane);
        cvt_matrix<LAY_STD>(args.in[20], (size_t)768 * 1536, 1536, 1536, 768, 6, 6, WQB, args.in[18], scr, gw, NGW, lane);
        cvt_matrix<LAY_STD>(args.in[20] + (size_t)768 * 1536, 0, 1536, 1536, 768, 6, 6, WQB + (size_t)1536 * 768, args.in[18] + 768, scr, gw, NGW, lane);
        cvt_matrix<LAY_HEAD>(args.in[21], (size_t)256 * 2048, 2048, 2048, 256, 8, 8, WKVB, args.in[19], scr, gw, NGW, lane);
        cvt_matrix<LAY_HEAD>(args.in[21] + (size_t)256 * 2048, 0, 2048, 2048, 256, 8, 8, WKVB + (size_t)2048 * 256, args.in[19] + 256, scr, gw, NGW, lane);
        cvt_matrix<LAY_STD>(args.in[25], (size_t)D * 1024, 1024, 1024, 1024, 4, 8, WOUTC, nullptr, scr, gw, NGW, lane);
        __syncthreads();
    }
    PH_END;
    if (EN(1) && PH_ON) { PH_LOCALS
        for (int row = gw; row < T; row += NGW) { f32x4 v[4]; float ss = 0.f;
            const float* xrow = row < NL ? x_in + (size_t)row * D : ctx_in + (size_t)(row - NL) * D;
#pragma unroll
            for (int j = 0; j < 4; ++j) { v[j] = *(const f32x4*)(xrow + 4 * lane + 256 * j); ss += (v[j][0] * v[j][0] + v[j][1] * v[j][1]) + (v[j][2] * v[j][2] + v[j][3] * v[j][3]); }
            const float rstd = rsqrtf(wave_sum(ss) * (1.f / D) + EPS);
            normmod_store(v, rstd, norm_mix_g, MOD + (size_t)modrow(row) * 6144, 0, 1024, H + (size_t)row * D, lane); }
    }
    PH_END;

    for (int layer = 0; layer < 4; ++layer) {
        const bool keep = layer < 3; const int li = layer >> 1; const int nrt = keep ? 68 : 64;
        layer_ = layer;
        if ((layer & 1) == 0) {
            if (EN(2) && PH_ON) { PH_LOCALS
                g8::GemmP g{H, D, WINA + (size_t)li * 1792 * 1024, 1024}; g8::StaticOrder S_; S_.init(68, 7, G, bx);
                EpiInA E{QA, KA, VA, Z, args.in[10] + li * 64, args.in[11] + li * 64, cosA, sinA};
                g8::gemm_phase(lds, g, S_, E);
            }
            PH_END;
            if (EN(3) && PH_ON) { PH_LOCALS
                const int nau = keep ? 544 : 512;
                if (!(PFLAG(1))) {
                    CvtBg bg; bg.init(args.in[28], args.in[30], WGU, WDN, (LAS float*)(lds + 57344 + wave * 8448), 0, layer == 0 ? 1 : 0, vcu, wave);
                    for (int u = vcu; u < nau; u += G) wattn_unit(lds, u, QA, KA, VA, args.in[12] + li * 8, MIX, bg);
                    while (bg.j < bg.jend) { bg.issue(lane); bg.finish(lane); }
                    __syncthreads();
                }
                if (!(PFLAG(2))) {
                    const float* dww = args.in[13] + (size_t)li * 31 * 512; const float* dwb = args.in[14] + li * 512; const float* lng = args.in[15] + li * 512; const float* lnb = args.in[16] + li * 512;
                    conv_strip<64>(lds, (vcu >> 6) * S, S, (vcu & 63) * 64, Z, dww, dwb, lng, lnb, MIX);
                    if (keep) conv_strip<4>(lds, NL + (vcu >> 6) * CL, CL, (vcu & 63) * 4, Z, dww, dwb, lng, lnb, MIX);
                }
            }
            PH_END;
            if (EN(4) && PH_ON) { PH_LOCALS
                g8::GemmP g{MIX, D, WOUTA + (size_t)li * 1024 * 1024, 1024}; g8::StaticOrder S_; S_.init(nrt, 4, G, bx);
                EpiResid E{X, layer == 0 ? x_in : X, layer == 0 ? ctx_in : X + (size_t)NL * D, ML + 2048, SSX};
                g8::gemm_phase(lds, g, S_, E);
            }
            PH_END;
        } else {
            if (EN(5) && PH_ON) { PH_LOCALS
                g8::GemmP g{H, D, WINC + (size_t)li * 1280 * 1024, 1024}; g8::StaticOrder S_; S_.init(68, 5, G, bx);
                EpiP E{P, SSP, KC, args.in[24] + li * 32, cosC, sinC};
                g8::gemm_phase(lds, g, S_, E);
            }
            PH_END;
            if (EN(7) && PH_ON) { PH_LOCALS
#ifndef MK_O3
#define MK_O3 3
#endif
                if ((MK_O3 & 1) && !(PFLAG(16))) { g8::GemmP g{P, PP, WQB + (size_t)li * 1536 * 768, 768}; g8::StaticOrder S_; S_.init(nrt, 6, G, bx); EpiBf16 E{QC, 1536, 1536}; g8::gemm_phase(lds, g, S_, E); }
                if ((MK_O3 & 2) && !(PFLAG(32))) { g8::GemmP g{P + 768, PP, WKVB + (size_t)li * 2048 * 256, 256}; g8::StaticOrder S_; S_.init(68, 8, G, bx); EpiKV E{KC, VC, SSP, args.in[23] + li * 64}; g8::gemm_phase(lds, g, S_, E); }
            }
            PH_END;
            if (EN(8) && PH_ON) { PH_LOCALS
                const int nau = keep ? 1088 : 1024;
                CvtBg bg; bg.init(args.in[28], args.in[30], WGU, WDN, (LAS float*)(lds + 57344 + wave * 8448), layer, (PFLAG(8)) ? 0 : ((layer == 1) ? 2 : 1), vcu, wave);
                for (int u = vcu; u < nau; u += G) mla_unit(lds, u, QC, KC, VC, SSP, args.in[22] + li * 96, cosC, sinC, MIX, bg);
                while (bg.j < bg.jend) { bg.issue(lane); bg.finish(lane); }
            }
            PH_END;
            if (EN(9) && PH_ON) { PH_LOCALS
                g8::GemmP g{MIX, D, WOUTC + (size_t)li * 1024 * 1024, 1024}; g8::StaticOrder S_; S_.init(nrt, 4, G, bx);
                EpiResid E{X, X, X + (size_t)NL * D, ML + 2048, SSX};
                g8::gemm_phase(lds, g, S_, E);
            }
            PH_END;
        }
        if (EN(10) && PH_ON) { PH_LOCALS
            LAS int* cntL = (LAS int*)(lds + LDS_TAB); LAS int* baseL = cntL + 32; LAS int* pend = (LAS int*)(lds + LDS_IDX + 10240);
            if (tid < 32) cntL[tid] = 0;
            router_load_table(lds, WR + (size_t)layer * 2 * 32 * 1024, tid);
            __syncthreads();
            int g = -1;
            if (wave < 4) g = bx * 4 + wave; else if (wave == 4 && keep && bx < 64) g = 1024 + bx;
            if (g >= 0) router_group(lds, g, wave, lane, X, SSX, norm_ffn_g + layer * D, ML + (size_t)(g < 1024 ? (g >> 8) : 4) * 6144, args.in[27] + layer * 32, F, GATE);
            __syncthreads();
            if (tid < 32) baseL[tid] = (PFLAG(4)) ? 0 : atomicAdd(CNT + (layer * 32 + tid) * 64, cntL[tid])    ;
            __syncthreads();
            if (tid < 320) { const int wv = tid >> 6; const bool has = (wv < 4) || (wv == 4 && keep && bx < 64);
                if (has) { const int pe = pend[tid], slot = pe & 0x1ffff, e = (pe >> 17) & 31, rl = pe >> 22; LIST[(size_t)e * T + baseL[e] + rl] = slot; } }
            __syncthreads();
        }
        PH_END;
        if (EN(11) && PH_ON) { PH_LOCALS
            moe_setup<8>(lds, CNT + layer * 32 * 64, LIST, layer, vcu, G);
            g8::GemmP g{F, D, WGU, 1024}; g8::MoeOrder<true> S_{(const LAS int*)(lds + LDS_TAB), (const LAS int*)(lds + LDS_IDX)};
            EpiGU E{ACT, args.in[29] + (size_t)layer * 32 * 2048};
            g8::gemm_phase(lds, g, S_, E);
        }
        PH_END;
        if (EN(12) && PH_ON) { PH_LOCALS
            moe_setup<4>(lds, CNT + layer * 32 * 64, LIST, layer, vcu, G);
            g8::GemmP g{ACT, 1024, WDN, 1024}; g8::MoeOrder<false> S_{(const LAS int*)(lds + LDS_TAB), (const LAS int*)(lds + LDS_IDX)};
            EpiDown E{YB, args.in[31] + (size_t)layer * 32 * 1024, GATE, (const LAS int*)(lds + LDS_IDX)};
            g8::gemm_phase(lds, g, S_, E);
        }
        PH_END;
        if (EN(13) && PH_ON) { PH_LOCALS
            const int nrows = keep ? T : NL;
            for (int row = gw; row < nrows; row += NGW)
                combine_row(row, lane, X, YB, ML, norm_mix_g + (layer + 1 < 4 ? layer + 1 : 0) * D, MOD + (size_t)(layer + 1 < 4 ? layer + 1 : 0) * 5 * 6144, layer < 3 ? H : nullptr, layer < 3 ? nullptr : args.out);
        }
        PH_END;
    }
#undef PH_ON
#undef PH_END
}
}

#ifndef MK_MULTI
#define MK_MULTI 0
#endif
#ifndef MK_DEBUG
#define MK_DEBUG 0
#endif
#if MK_DEBUG
namespace dbg {
__global__ void k_cmp_bf(const unsigned short* a, int lda, const float* b, int ldb, int rows, int cols, float s, float* acc, int cp) {
    float d2 = 0.f, r2 = 0.f;
    for (size_t i = (size_t)blockIdx.x * blockDim.x + threadIdx.x; i < (size_t)rows * cols; i += (size_t)gridDim.x * blockDim.x) {
        const size_t r = i / cols, c = i % cols; const float av = __uint_as_float(((unsigned)a[r * lda + c]) << 16), bv = s * b[r * ldb + c]; d2 += (av - bv) * (av - bv); r2 += bv * bv; }
    for (int o = 32; o >= 1; o >>= 1) { d2 += __shfl_xor(d2, o); r2 += __shfl_xor(r2, o); }
    if ((threadIdx.x & 63) == 0) { atomicAdd(acc + 2 * cp, d2); atomicAdd(acc + 2 * cp + 1, r2); }
}
__global__ void k_cmp_f(const float* a, const float* b, size_t n, float* acc, int cp) {
    float d2 = 0.f, r2 = 0.f;
    for (size_t i = (size_t)blockIdx.x * blockDim.x + threadIdx.x; i < n; i += (size_t)gridDim.x * blockDim.x) { const float av = a[i], bv = b[i]; d2 += (av - bv) * (av - bv); r2 += bv * bv; }
    for (int o = 32; o >= 1; o >>= 1) { d2 += __shfl_xor(d2, o); r2 += __shfl_xor(r2, o); }
    if ((threadIdx.x & 63) == 0) { atomicAdd(acc + 2 * cp, d2); atomicAdd(acc + 2 * cp + 1, r2); }
}
__global__ void k_report(const float* acc, int ncp, float thr, float* out) {
    if (blockIdx.x == 0 && threadIdx.x == 0) { int bad = -1; for (int i = 0; i < ncp; ++i) { const float d = acc[2 * i], r = acc[2 * i + 1]; if (!(d <= thr * r)) { bad = i; break; } }
        if (bad >= 0) out[0] += 100.f * (float)(bad + 1); }
}
}
#endif

extern "C" void kernel_launch(void* const* d_in, const int* in_sizes, int n_in, void* d_out, int out_size, void* d_ws, size_t ws_size, hipStream_t stream) {
    using namespace mk;
    static int grid = 0;
    if (grid == 0) {
        int dev = 0, cus = 0, per_cu = 0;
        if (hipGetDevice(&dev) != hipSuccess || hipDeviceGetAttribute(&cus, hipDeviceAttributeMultiprocessorCount, dev) != hipSuccess) { fprintf(stderr, "kernel_launch: device query failed\n"); grid = -1; return; }
        if (hipFuncSetAttribute((const void*)mega, hipFuncAttributeMaxDynamicSharedMemorySize, LDS_BYTES) != hipSuccess) { fprintf(stderr, "kernel_launch: hipFuncSetAttribute(%d B LDS) failed\n", LDS_BYTES); grid = -1; return; }
        if (hipOccupancyMaxActiveBlocksPerMultiprocessor(&per_cu, (const void*)mega, NTHR, LDS_BYTES) != hipSuccess || per_cu < 1) fprintf(stderr, "kernel_launch: occupancy query reports %d blocks per CU\n", per_cu);
        (void)hipGetLastError();
        grid = 256;
        if (cus < 256) { fprintf(stderr, "kernel_launch: %d CUs < 256: the persistent grid would not be resident; nothing launched\n", cus); grid = -1; return; }
        if (n_in != 32 || ws_size < WS_END) { fprintf(stderr, "kernel_launch: n_in %d ws %zu (need %zu)\n", n_in, ws_size, (size_t)WS_END); grid = -1; return; }
    }
    if (grid < 0) return;
    (void)hipMemsetAsync((char*)d_ws + WS_CTL, 0, CTL_BYTES, stream);
    Args a{};
    for (int i = 0; i < 32; ++i) a.in[i] = (const float*)d_in[i];
    a.out = (float*)d_out; a.ws = (unsigned char*)d_ws;
#if !MK_DEBUG
#if MK_MULTI
    for (int p = 0; p < N_PHASES; ++p) { a.lo = p; a.hi = p + 1; hipLaunchKernelGGL(mega, dim3(grid), dim3(NTHR), LDS_BYTES, stream, a); }
#else
    a.lo = 0; a.hi = N_PHASES; hipLaunchKernelGGL(mega, dim3(grid), dim3(NTHR), LDS_BYTES, stream, a);
#ifdef MK_PROBE_PH
    for (int r = 0; r < MK_PROBE_N; ++r) { a.lo = MK_PROBE_PH; a.hi = MK_PROBE_PH + 1; a.flags = MK_PROBE_FLAGS; hipLaunchKernelGGL(mega, dim3(grid), dim3(NTHR), LDS_BYTES, stream, a); }
#endif
#endif
    { const hipError_t le = hipPeekAtLastError(); if (le != hipSuccess) fprintf(stderr, "kernel_launch: launch failed: %s\n", hipGetErrorName(le)); }
#else
#endif
}
```

```cpp
#include <hip/hip_runtime.h>
#include <cstdio>
#include <cstdint>
#define MK_MULTI 0
#define MK_DEBUG 0
#define MK_DBG_THR 1e-3f
namespace mk {
#define LAS __attribute__((address_space(3)))
#define GAS __attribute__((address_space(1)))
typedef unsigned short bf16;
typedef short bf16x8 __attribute__((ext_vector_type(8)));
typedef short s16x4 __attribute__((ext_vector_type(4)));
typedef float f32x2 __attribute__((ext_vector_type(2)));
typedef float f32x4 __attribute__((ext_vector_type(4)));
typedef float f32x16 __attribute__((ext_vector_type(16)));
typedef unsigned u32x2 __attribute__((ext_vector_type(2)));
typedef unsigned u32x4 __attribute__((ext_vector_type(4)));

constexpr int D = 1024, NBATCH = 4, S = 4096, CL = 256, NL = NBATCH * S, NC = NBATCH * CL, T = NL + NC;
constexpr int NWAVES = 8, NTHR = 512;
constexpr float EPS = 1e-6f;
constexpr float LOG2E = 1.4426950408889634f;
constexpr float QSCALE_A = 0.125f * LOG2E;
constexpr float QSCALE_C = 0.10206207261596575f * LOG2E;

constexpr size_t al256(size_t x) { return (x + 255) & ~(size_t)255; }
constexpr size_t CTL_BYTES = 65536;
constexpr int CW_BAR = 1024, CW_CNT = 8192;
constexpr size_t WS_CTL = 0;
constexpr size_t WS_MOD = WS_CTL + CTL_BYTES;
constexpr size_t WS_COSA = WS_MOD + al256((size_t)4 * 5 * 6144 * 4);
constexpr size_t WS_SINA = WS_COSA + 4096 * 32 * 4;
constexpr size_t WS_COSC = WS_SINA + 4096 * 32 * 4;
constexpr size_t WS_SINC = WS_COSC + 4096 * 16 * 4;
constexpr size_t WS_WR = WS_SINC + 4096 * 16 * 4;
constexpr size_t WS_WINA = WS_WR + (size_t)4 * 2 * 32 * 1024 * 2;
constexpr size_t WS_WOUTA = WS_WINA + (size_t)2 * 1792 * 1024 * 2;
constexpr size_t WS_WINC = WS_WOUTA + (size_t)2 * 1024 * 1024 * 2;
constexpr size_t WS_WQB = WS_WINC + (size_t)2 * 1280 * 1024 * 2;
constexpr size_t WS_WKVB = WS_WQB + (size_t)2 * 1536 * 768 * 2;
constexpr size_t WS_WOUTC = WS_WKVB + (size_t)2 * 2048 * 256 * 2;
constexpr size_t WS_WGU = WS_WOUTC + (size_t)2 * 1024 * 1024 * 2;
constexpr size_t WS_WDN = WS_WGU + (size_t)128 * 2048 * 1024 * 2;
constexpr size_t WS_X = WS_WDN + (size_t)128 * 1024 * 1024 * 2;
constexpr size_t WS_H = WS_X + (size_t)T * D * 4;
constexpr size_t WS_QA = WS_H + (size_t)T * D * 2;
constexpr size_t WS_KA = WS_QA + (size_t)T * 512 * 2;
constexpr size_t WS_VA = WS_KA + (size_t)T * 128 * 2;
constexpr size_t WS_Z = WS_VA + (size_t)T * 128 * 2;
constexpr size_t WS_P = WS_Z + (size_t)T * 512 * 2;
constexpr int PP = 1056;
constexpr size_t WS_RS = WS_P + (size_t)T * PP * 2;
constexpr size_t WS_QC = WS_RS + (size_t)T * 2 * 4;
constexpr size_t WS_KC = WS_QC + (size_t)T * 1536 * 2;
constexpr size_t WS_VC = WS_KC + (size_t)T * 1536 * 2;
constexpr size_t WS_MIX = WS_VC + (size_t)T * 1024 * 2;
constexpr size_t WS_F = WS_MIX + (size_t)T * 1024 * 2;
constexpr size_t WS_GATE = WS_F + (size_t)T * 1024 * 2;
constexpr size_t WS_LIST = WS_GATE + (size_t)T * 4 * 4;
constexpr int ACT_ROWS = 304 * 256;
constexpr size_t WS_ACT = WS_LIST + (size_t)32 * T * 4;
constexpr size_t WS_YB = WS_ACT + (size_t)ACT_ROWS * 1024 * 2;
constexpr size_t WS_SSX = WS_YB + (size_t)T * 4 * 1024 * 2;
constexpr size_t WS_SSP = WS_SSX + (size_t)T * 16 * 4;
constexpr size_t WS_END = WS_SSP + (size_t)T * 16 * 4;

constexpr int STAGE_BYTES = 131072;
constexpr int LDS_IDX = 131072;
constexpr int MAXU = 12;
constexpr int LDS_TAB = LDS_IDX + MAXU * 1024;
constexpr int LDS_MISC = LDS_TAB + 1024;
constexpr int LDS_BYTES = LDS_MISC + 256;

__device__ __forceinline__ unsigned pk2(float lo, float hi) {
    typedef __bf16 bf2 __attribute__((ext_vector_type(2)));
    return __builtin_bit_cast(unsigned, __builtin_convertvector((f32x2){lo, hi}, bf2));
}
__device__ __forceinline__ float bflo(unsigned u) { return __uint_as_float(u << 16); }
__device__ __forceinline__ float bfhi(unsigned u) { return __uint_as_float(u & 0xffff0000u); }
__device__ __forceinline__ float bf1(bf16 u) { return __uint_as_float(((unsigned)u) << 16); }
__device__ __forceinline__ float fsigm(float v) { return __builtin_amdgcn_rcpf(1.f + __builtin_amdgcn_exp2f(-1.4426950408889634f * v)); }
__device__ __forceinline__ float fsilu(float v) { return v * fsigm(v); }
__device__ __forceinline__ int modrow(int row) { return row < NL ? (row >> 12) : 4; }
#define WS_DPP(v, ctrl) ((v) + __int_as_float(__builtin_amdgcn_update_dpp(0, __float_as_int(v), (ctrl), 0xF, 0xF, false)))
__device__ __forceinline__ float wave_sum(float v) {
    v = WS_DPP(v, 0xB1); v = WS_DPP(v, 0x4E); v = WS_DPP(v, 0x141); v = WS_DPP(v, 0x140);
    v += __shfl_xor(v, 16); v += __shfl_xor(v, 32);
    return v;
}
__device__ __forceinline__ int otid() { int t = threadIdx.x; asm volatile("" : "+v"(t)); return t; }
#define LDS_WAIT() asm volatile("s_waitcnt lgkmcnt(0)" ::: "memory")
#define VM_WAIT() asm volatile("s_waitcnt vmcnt(0)" ::: "memory")

#define XB_TMO      128
#define XB_XCNT(j)  (256  + 64 * (j))
#define XB_XSUB(j)  (1280 + 64 * (j))
#define XB_XGEN(j)  (2304 + 64 * (j))
#define XB_TOP      3328
#define XB_TOPGEN   3392
#define XCD_BAR_WORDS 3456
#define XB_SPIN_CAP (1u << 18)
__device__ __forceinline__ unsigned xb_ld(unsigned* p)              { return __hip_atomic_load(p, __ATOMIC_RELAXED, __HIP_MEMORY_SCOPE_AGENT); }
__device__ __forceinline__ unsigned xb_add(unsigned* p, unsigned v) { return __hip_atomic_fetch_add(p, v, __ATOMIC_RELAXED, __HIP_MEMORY_SCOPE_AGENT); }
__device__ __forceinline__ unsigned xb_xcc_id() { return (unsigned)__builtin_amdgcn_s_getreg((3 << 11) | 20) & 0xFu; }
#define XB_SPIN(cond, bar) do { unsigned _sp = 0; while (cond) { __builtin_amdgcn_s_sleep(1); \
    if ((++_sp & 255u) == 0u) { if (xb_ld(&(bar)[XB_TMO])) break; if (_sp > XB_SPIN_CAP) { atomicAdd(&(bar)[XB_TMO], 1u); break; } } } } while (0)
struct XcdBarrier { unsigned* bar; unsigned x; volatile LAS unsigned* st; };
__device__ __forceinline__ XcdBarrier xcd_barrier_post(unsigned* bar, volatile LAS unsigned* st) {
    XcdBarrier b; b.bar = bar; b.x = xb_xcc_id(); b.st = st;
    if (threadIdx.x == 0) (void)xb_add(&bar[XB_XCNT(b.x)], 1u);
    return b;
}
__device__ __forceinline__ void xcd_barrier_complete(unsigned* bar, unsigned x, unsigned& nloc, unsigned& nx) {
    const unsigned G = gridDim.x * gridDim.y * gridDim.z;
    unsigned sum, cnt, mine, sp = 0u;
    for (;;) {
        sum = 0u; cnt = 0u; mine = 0u;
#pragma unroll
        for (unsigned j = 0; j < 16; ++j) { const unsigned c = xb_ld(&bar[XB_XCNT(j)]); sum += c; cnt += (c > 0u) ? 1u : 0u; mine = (j == x) ? c : mine; }
        if (sum == G) break;
        __builtin_amdgcn_s_sleep(1);
        if ((++sp & 255u) == 0u) { if (xb_ld(&bar[XB_TMO])) break; if (sp > XB_SPIN_CAP) { atomicAdd(&bar[XB_TMO], 1u); break; } }
    }
    nloc = mine > 0u ? mine : 1u; nx = cnt > 0u ? cnt : 1u;
}
__device__ __forceinline__ void xcd_barrier(const XcdBarrier& b) {
    asm volatile("s_waitcnt vmcnt(0)" ::: "memory");
    __syncthreads();
    if (otid() == 0) {
        unsigned* bar = b.bar;
        __builtin_amdgcn_s_waitcnt(0);
        unsigned nloc = b.st[0], nx = b.st[1];
        if (nloc == 0u) { xcd_barrier_complete(bar, b.x, nloc, nx); b.st[0] = nloc; b.st[1] = nx; }
        const unsigned old = xb_add(&bar[XB_XSUB(b.x)], 1u);
        const unsigned gen = old / nloc;
        if (old + 1u == (gen + 1u) * nloc) {
            __builtin_amdgcn_fence(__ATOMIC_RELEASE, "agent");
            asm volatile("s_waitcnt vmcnt(0)" ::: "memory");
            const unsigned og = xb_add(&bar[XB_TOP], 1u);
            const unsigned tg = og / nx;
            if (og + 1u == (tg + 1u) * nx) xb_add(&bar[XB_TOPGEN], 1u);
            else XB_SPIN(xb_ld(&bar[XB_TOPGEN]) == tg, bar);
            __builtin_amdgcn_fence(__ATOMIC_ACQUIRE, "agent");
            xb_add(&bar[XB_XGEN(b.x)], 1u);
            asm volatile("s_waitcnt vmcnt(0)" ::: "memory");
        } else {
            XB_SPIN(xb_ld(&bar[XB_XGEN(b.x)]) == gen, bar);
            __builtin_amdgcn_fence(__ATOMIC_ACQUIRE, "agent");
            asm volatile("s_waitcnt vmcnt(0)" ::: "memory");
        }
    }
    __syncthreads();
}

namespace g8 {
constexpr int BM = 256, BK = 64, HALF = 128, HTB = HALF * BK * 2, NXCD = 8, WGM = 8;
__host__ __device__ __forceinline__ int lds_byte(int r, int c) { const int st = (r >> 4) * 2 + (c >> 5), rr = r & 15, cc = c & 31, ob = rr * 64 + cc * 2; return st * 1024 + (ob ^ (((ob >> 9) & 1) << 5)); }
__host__ __device__ __forceinline__ void stage_rc(int b, int& R, int& C) { const int st = b / 1024, sb = b % 1024, swz = sb ^ (((sb >> 9) & 1) << 5); R = (st >> 1) * 16 + swz / 64; C = (st & 1) * 32 + (swz % 64) / 2; }

struct Unit { int pm, pn, e, nt, gm, slot; };
struct GemmP { const bf16* A; int lda; const bf16* Bt; int K; };

struct StaticOrder {
    static constexpr bool GATHER = false;
    int nM, nN, nwg, G, c;
    __device__ void init(int nM_, int nN_, int G_, int c_) { nM = nM_; nN = nN_; nwg = nM * nN; G = G_; c = c_; }
    __device__ __forceinline__ bool next(int i, Unit& u) const {
        const long L = (long)i * G + c; if (L >= nwg) return false;
        int wgid = (int)L; { const int q = nwg / NXCD, r = nwg % NXCD, xcd = wgid % NXCD, off = wgid / NXCD; wgid = (xcd < r ? xcd * (q + 1) : r * (q + 1) + (xcd - r) * q) + off; }
        const int nig = WGM * nN, gid = wgid / nig, fm = gid * WGM, gsz = (nM - fm) < WGM ? (nM - fm) : WGM;
        u.pm = fm + ((wgid % nig) % gsz); u.pn = (wgid % nig) / gsz; u.e = 0; u.nt = u.pn; u.gm = u.pm; u.slot = 0; return true;
    }
    __device__ __forceinline__ int arow(const Unit& u, int r) const { return u.pm * BM + r; }
};
template <bool GATHER_> struct MoeOrder {
    static constexpr bool GATHER = GATHER_;
    const LAS int* tab; const LAS int* idx;
    __device__ __forceinline__ bool next(int i, Unit& u) const {
        if (i >= tab[127]) return false;
        u.gm = tab[128 + 4 * i]; u.pn = tab[129 + 4 * i]; u.e = tab[130 + 4 * i]; u.nt = tab[131 + 4 * i]; u.slot = i; u.pm = u.gm; return true;
    }
    __device__ __forceinline__ int arow(const Unit& u, int r) const {
        if (GATHER_) { const int s = idx[u.slot * 256 + r]; return s < 0 ? 0 : (s >> 2); }
        return u.gm * BM + r;
    }
};

template <class Epi, class Sched>
__device__ __forceinline__ void gemm_phase(LAS unsigned char* lds, const GemmP g, const Sched& S, const Epi& E) {
    const int tid = otid(), wid = __builtin_amdgcn_readfirstlane(tid >> 6), lane = tid & 63, wr = wid >> 2, wc = wid & 3, fr = lane & 15, fq = lane >> 4;
    const int K = g.K, nt = K / BK;
    int RR[2], CC[2]; unsigned voffB[2], voffA[2];
    const unsigned lda2 = (unsigned)g.lda * 2u;
#pragma unroll
    for (int i = 0; i < 2; ++i) { stage_rc(tid * 16 + i * 8192, RR[i], CC[i]); voffB[i] = (unsigned)(RR[i] * K + CC[i]) * 2u; voffA[i] = (unsigned)RR[i] * lda2 + (unsigned)CC[i] * 2u; }
    const size_t hstepA = (size_t)HALF * lda2, tstepA = 2 * hstepA;
    const size_t kstep = (size_t)(BK * 2);
    const size_t hstepB = (size_t)HALF * K * 2;
    const size_t tstepB = 2 * hstepB;
    const unsigned ldsw = (unsigned)wid * 1024u;
    const int aoff = lds_byte(wr * 64 + fr, fq * 8), boff = lds_byte(wc * 32 + fr, fq * 8);
#define G8_SA(b, h) (((b) * 2 + (h)) * HTB)
#define G8_SB(b, h) ((4 + (b) * 2 + (h)) * HTB)
#define G8_STAGE(bufoff, gbase, voff) do { _Pragma("unroll") for (int _i = 0; _i < 2; ++_i) \
        __builtin_amdgcn_global_load_lds((const unsigned*)((const char*)(gbase) + (voff)[_i]), (LAS unsigned*)(lds + (bufoff) + ldsw + _i * 8192), 16, 0, 0); } while (0)
#define G8_LDA(dst, b, h) do { _Pragma("unroll") for (int m = 0; m < 4; ++m) _Pragma("unroll") for (int k = 0; k < 2; ++k) dst[m][k] = *(const LAS bf16x8*)(lds + G8_SA(b, h) + aoff + m * 2048 + k * 1024); } while (0)
#define G8_LDB(dst, b, h) do { _Pragma("unroll") for (int n = 0; n < 2; ++n) _Pragma("unroll") for (int k = 0; k < 2; ++k) dst[n][k] = *(const LAS bf16x8*)(lds + G8_SB(b, h) + boff + n * 2048 + k * 1024); } while (0)
#define G8_MMA(ai, bj, At, Bt) do { __builtin_amdgcn_s_setprio(1); _Pragma("unroll") for (int m = 0; m < 4; ++m) _Pragma("unroll") for (int n = 0; n < 2; ++n) _Pragma("unroll") for (int k = 0; k < 2; ++k) \
        acc[ai][bj][m][n] = __builtin_amdgcn_mfma_f32_16x16x32_bf16(Bt[n][k], At[m][k], acc[ai][bj][m][n], 0, 0, 0); __builtin_amdgcn_s_setprio(0); } while (0)
#define G8_WAIT_V(n) asm volatile("s_waitcnt vmcnt(" #n ")" ::: "memory")
#define G8_WAIT_L(n) asm volatile("s_waitcnt lgkmcnt(" #n ")" ::: "memory")
#define G8_BAR __builtin_amdgcn_s_barrier()
#define G8_SCHED __builtin_amdgcn_sched_barrier(0)
#define G8_MKOFF(u, o) do { if constexpr (Sched::GATHER) { _Pragma("unroll") for (int _i = 0; _i < 2; ++_i) { int _R, _C; stage_rc(tid * 16 + _i * 8192, _R, _C); \
        _Pragma("unroll") for (int _h = 0; _h < 2; ++_h) o[_h][_i] = (unsigned)S.arow(u, _h * HALF + _R) * lda2 + (unsigned)_C * 2u; } } } while (0)
#define G8_STAGE_A(bufoff, kofs, h, usenext) do { if constexpr (Sched::GATHER) { unsigned _o[2]; _o[0] = (usenext) ? no[h][0] : co[h][0]; _o[1] = (usenext) ? no[h][1] : co[h][1]; G8_STAGE(bufoff, Ab + (kofs), _o); } \
        else { const char* _p = ((usenext) ? nAp : cAp) + (size_t)(h) * hstepA + (kofs); G8_STAGE(bufoff, _p, voffA); } } while (0)
    Unit cur, nxt; int ui = 0;
    if (!S.next(0, cur)) return;
    f32x4 acc[2][2][4][2];
#pragma unroll
    for (int a = 0; a < 2; ++a)
#pragma unroll
        for (int b = 0; b < 2; ++b)
#pragma unroll
            for (int m = 0; m < 4; ++m)
#pragma unroll
                for (int n = 0; n < 2; ++n) acc[a][b][m][n] = (f32x4){0.f, 0.f, 0.f, 0.f};
    bf16x8 At[4][2], B0[2][2], B1[2][2];
    unsigned co[2][2], no[2][2];
    G8_MKOFF(cur, co);
    if (Sched::GATHER) { G8_WAIT_L(0); }
    const char* Ab = (const char*)g.A;
    const char* cAp = Ab + (size_t)cur.pm * tstepA; const char* nAp = cAp;
    const char* cB = (const char*)g.Bt + (size_t)cur.pn * tstepB;
    G8_STAGE(G8_SB(0, 0), cB, voffB); G8_STAGE(G8_SB(0, 1), cB + hstepB, voffB); G8_STAGE_A(G8_SA(0, 0), 0, 0, false); G8_STAGE_A(G8_SA(0, 1), 0, 1, false);
    if (wr == 1) G8_BAR;
    G8_WAIT_V(2); G8_BAR;
    G8_STAGE(G8_SB(1, 0), cB + kstep, voffB); G8_STAGE_A(G8_SA(1, 0), kstep, 0, false); G8_STAGE(G8_SB(1, 1), cB + hstepB + kstep, voffB);
    G8_WAIT_V(6); G8_BAR;
    for (;;) {
        const bool has_next = S.next(ui + 1, nxt);
        if (has_next) { G8_MKOFF(nxt, no); if (Sched::GATHER) { G8_WAIT_L(0); } nAp = Ab + (size_t)nxt.pm * tstepA; }
        else {
            nAp = cAp;
            if constexpr (Sched::GATHER) {
#pragma unroll
                for (int h = 0; h < 2; ++h)
#pragma unroll
                    for (int i = 0; i < 2; ++i) no[h][i] = co[h][i];
            }
        }
        G8_SCHED;
        const char* nB = has_next ? (const char*)g.Bt + (size_t)nxt.pn * tstepB : cB;
#pragma unroll 1
        for (int t = 0; t < nt; t += 2) {
            const bool last = (t == nt - 2);
            const size_t k1 = (size_t)(t + 1) * kstep, k2 = last ? 0 : (size_t)(t + 2) * kstep, k3 = k2 + kstep;
            const char* b2 = last ? nB : cB + (size_t)(t + 2) * kstep; const char* b3 = b2 + kstep;
            G8_LDB(B0, 0, 0); G8_LDB(B1, 0, 1); G8_SCHED; G8_LDA(At, 0, 0); G8_STAGE_A(G8_SA(1, 1), k1, 1, false);
            G8_WAIT_V(8); G8_WAIT_L(0); G8_BAR; G8_MMA(0, 0, At, B0); G8_MMA(0, 1, At, B1); G8_BAR; G8_SCHED;
            G8_LDA(At, 0, 1); G8_STAGE(G8_SB(0, 0), b2, voffB); G8_STAGE(G8_SB(0, 1), b2 + hstepB, voffB); G8_STAGE_A(G8_SA(0, 0), k2, 0, last);
            G8_WAIT_V(8); G8_WAIT_L(0); G8_BAR; G8_MMA(1, 0, At, B0); G8_MMA(1, 1, At, B1); G8_BAR; G8_SCHED;
            G8_LDB(B0, 1, 0); G8_LDB(B1, 1, 1); G8_SCHED; G8_LDA(At, 1, 0); G8_STAGE_A(G8_SA(0, 1), k2, 1, last);
            G8_WAIT_V(8); G8_WAIT_L(0); G8_BAR; G8_MMA(0, 0, At, B0); G8_MMA(0, 1, At, B1); G8_BAR; G8_SCHED;
            G8_LDA(At, 1, 1); G8_STAGE(G8_SB(1, 0), b3, voffB); G8_STAGE(G8_SB(1, 1), b3 + hstepB, voffB); G8_STAGE_A(G8_SA(1, 0), k3, 0, last);
            G8_WAIT_V(8); G8_WAIT_L(0); G8_BAR; G8_MMA(1, 0, At, B0); G8_MMA(1, 1, At, B1); G8_BAR; G8_SCHED;
        }
        if (wr == 0) G8_BAR;
        E(acc, cur, wr, wc, fr, fq, lds);
        if (!has_next) break;
#pragma unroll
        for (int a = 0; a < 2; ++a)
#pragma unroll
            for (int b = 0; b < 2; ++b)
#pragma unroll
                for (int m = 0; m < 4; ++m)
#pragma unroll
                    for (int n = 0; n < 2; ++n) acc[a][b][m][n] = (f32x4){0.f, 0.f, 0.f, 0.f};
        cur = nxt; cB = nB; cAp = nAp; ++ui;
        if constexpr (Sched::GATHER) {
#pragma unroll
            for (int h = 0; h < 2; ++h)
#pragma unroll
                for (int i = 0; i < 2; ++i) co[h][i] = no[h][i];
        }
        if (wr == 1) G8_BAR;
    }
    G8_WAIT_V(0);
    G8_BAR;
#undef G8_SA
#undef G8_SB
#undef G8_STAGE
#undef G8_LDA
#undef G8_LDB
#undef G8_MMA
#undef G8_WAIT_V
#undef G8_WAIT_L
#undef G8_BAR
#undef G8_SCHED
#undef G8_MKOFF
#undef G8_STAGE_A
}
}

using g8::Unit;
typedef f32x4 Acc[2][2][4][2];
__device__ __forceinline__ u32x4 pack8(const f32x4 a, const f32x4 b) { u32x4 w; w.x = pk2(a[0], a[1]); w.y = pk2(a[2], a[3]); w.z = pk2(b[0], b[1]); w.w = pk2(b[2], b[3]); return w; }

struct EpiInA {
    bf16 *Qa, *Ka, *Va, *Z; const float *qg, *kg, *cosA, *sinA;
    __device__ __forceinline__ void operator()(const Acc& acc, const Unit& u, int wr, int wc, int fr, int fq, LAS unsigned char*) const {
        const int row0 = u.pm * 256 + wr * 64 + fr, pn = u.pn, a = fq >> 1, b = fq & 1;
        if (pn < 3) {
            const bool isv = (pn == 2 && wc >= 2), isq = pn < 2;
            const int dbase = 32 * a + 8 * b;
            if (isv) {
#pragma unroll
                for (int ai = 0; ai < 2; ++ai)
#pragma unroll
                    for (int m = 0; m < 4; ++m) { const int row = row0 + ai * 128 + m * 16; bf16* o = Va + (size_t)row * 128 + (wc - 2) * 64 + dbase;
#pragma unroll
                        for (int bj = 0; bj < 2; ++bj) *(u32x4*)(o + 16 * bj) = pack8(acc[ai][bj][m][0], acc[ai][bj][m][1]); }
                return;
            }
            const float* g = isq ? qg : kg;
            f32x4 gv[2][2];
#pragma unroll
            for (int bj = 0; bj < 2; ++bj)
#pragma unroll
                for (int n = 0; n < 2; ++n) gv[bj][n] = *(const f32x4*)(g + dbase + 16 * bj + 4 * n);
            const float sc = isq ? QSCALE_A : 1.f;
            bf16* obase = isq ? (Qa + (pn * 4 + wc) * 64 + dbase) : (Ka + wc * 64 + dbase);
            const int opitch = isq ? 512 : 128;
            f32x4 cc[2], sn[2], cn[2], snn[2];
            { const int t = row0 & 4095;
#pragma unroll
              for (int n = 0; n < 2; ++n) { cc[n] = *(const f32x4*)(cosA + t * 32 + 16 * a + 8 * b + 4 * n); sn[n] = *(const f32x4*)(sinA + t * 32 + 16 * a + 8 * b + 4 * n); } }
#pragma unroll
            for (int gidx = 0; gidx < 8; ++gidx) {
                    const int ai = gidx >> 2, m = gidx & 3;
                    const int row = row0 + ai * 128 + m * 16;
                    if (gidx < 7) { const int tn = (row0 + ((gidx + 1) >> 2) * 128 + ((gidx + 1) & 3) * 16) & 4095;
#pragma unroll
                        for (int n = 0; n < 2; ++n) { cn[n] = *(const f32x4*)(cosA + tn * 32 + 16 * a + 8 * b + 4 * n); snn[n] = *(const f32x4*)(sinA + tn * 32 + 16 * a + 8 * b + 4 * n); } }
                    float ss = 0.f;
#pragma unroll
                    for (int bj = 0; bj < 2; ++bj)
#pragma unroll
                        for (int n = 0; n < 2; ++n) { const f32x4 v = acc[ai][bj][m][n]; ss += (v[0] * v[0] + v[1] * v[1]) + (v[2] * v[2] + v[3] * v[3]); }
                    ss += __shfl_xor(ss, 16); ss += __shfl_xor(ss, 32);
                    const float rs = rsqrtf(ss * (1.f / 64.f) + EPS);
                    f32x4 y[2][2];
#pragma unroll
                    for (int bj = 0; bj < 2; ++bj)
#pragma unroll
                        for (int n = 0; n < 2; ++n) y[bj][n] = acc[ai][bj][m][n] * rs * gv[bj][n];
                    if (row < NL) {
#pragma unroll
                        for (int n = 0; n < 2; ++n) { const f32x4 y0 = y[0][n], y1 = y[1][n]; y[0][n] = y0 * cc[n] - y1 * sn[n]; y[1][n] = y1 * cc[n] + y0 * sn[n]; }
                    }
                    bf16* o = obase + (size_t)row * opitch;
#pragma unroll
                    for (int bj = 0; bj < 2; ++bj) *(u32x4*)(o + 16 * bj) = pack8(y[bj][0] * sc, y[bj][1] * sc);
                    asm volatile("" ::: "memory");
#pragma unroll
                    for (int n = 0; n < 2; ++n) { cc[n] = cn[n]; sn[n] = snn[n]; }
            }
        } else {
            const int j0 = 128 * (pn - 3) + 32 * wc + 8 * fq;
#pragma unroll
            for (int ai = 0; ai < 2; ++ai)
#pragma unroll
                for (int m = 0; m < 4; ++m) {
                    const int row = row0 + ai * 128 + m * 16; f32x4 z[2];
#pragma unroll
                    for (int n = 0; n < 2; ++n) { const f32x4 av = acc[ai][0][m][n], gt = acc[ai][1][m][n];
#pragma unroll
                        for (int r = 0; r < 4; ++r) z[n][r] = av[r] * fsigm(gt[r]); }
                    *(u32x4*)(Z + (size_t)row * 512 + j0) = pack8(z[0], z[1]);
                }
        }
    }
};
struct EpiResid {
    float* X; const float* Xlat; const float* Xctx; const float* gmod; float* SSX;
    __device__ __forceinline__ void operator()(const Acc& acc, const Unit& u, int wr, int wc, int fr, int fq, LAS unsigned char*) const {
        const int row0 = u.pm * 256 + wr * 64 + fr; const int mr = u.pm < 64 ? (u.pm >> 4) : 4;
        const float* gp = gmod + (size_t)mr * 6144; const float* src = u.pm < 64 ? Xlat : Xctx - (size_t)NL * D;
        float ssr[2][4];
#pragma unroll
        for (int ai = 0; ai < 2; ++ai)
#pragma unroll
            for (int m = 0; m < 4; ++m) ssr[ai][m] = 0.f;
#pragma unroll
        for (int bj = 0; bj < 2; ++bj) {
            const int c0 = 256 * u.pn + 128 * bj + 32 * wc + 4 * fq;
            const f32x4 g0 = *(const f32x4*)(gp + c0), g1 = *(const f32x4*)(gp + c0 + 16);
#pragma unroll
            for (int ai = 0; ai < 2; ++ai) {
                f32x4 xo[4][2];
#pragma unroll
                for (int m = 0; m < 4; ++m) { const float* xp = src + (size_t)(row0 + ai * 128 + m * 16) * D + c0; xo[m][0] = *(const f32x4*)xp; xo[m][1] = *(const f32x4*)(xp + 16); }
#pragma unroll
                for (int m = 0; m < 4; ++m) { float* op = X + (size_t)(row0 + ai * 128 + m * 16) * D + c0;
                    const f32x4 y0 = xo[m][0] + g0 * acc[ai][bj][m][0], y1 = xo[m][1] + g1 * acc[ai][bj][m][1];
                    *(f32x4*)op = y0; *(f32x4*)(op + 16) = y1;
                    ssr[ai][m] += (y0[0] * y0[0] + y0[1] * y0[1]) + (y0[2] * y0[2] + y0[3] * y0[3]) + (y1[0] * y1[0] + y1[1] * y1[1]) + (y1[2] * y1[2] + y1[3] * y1[3]); }
                asm volatile("" ::: "memory");
            }
        }
#pragma unroll
        for (int ai = 0; ai < 2; ++ai)
#pragma unroll
            for (int m = 0; m < 4; ++m) { float ss = ssr[ai][m]; ss += __shfl_xor(ss, 16); ss += __shfl_xor(ss, 32);
                if (fq == 0) SSX[(size_t)(row0 + ai * 128 + m * 16) * 16 + 4 * u.pn + wc] = ss; }
    }
};
struct EpiBf16 {
    bf16* O; int ldo, ncols;
    __device__ __forceinline__ void operator()(const Acc& acc, const Unit& u, int wr, int wc, int fr, int fq, LAS unsigned char*) const {
        const int row0 = u.pm * 256 + wr * 64 + fr;
#pragma unroll
        for (int bj = 0; bj < 2; ++bj) {
            const int c0 = 256 * u.pn + 128 * bj + 32 * wc + 8 * fq;
            if (c0 < ncols) {
#pragma unroll
                for (int ai = 0; ai < 2; ++ai)
#pragma unroll
                    for (int m = 0; m < 4; ++m) *(u32x4*)(O + (size_t)(row0 + ai * 128 + m * 16) * ldo + c0) = pack8(acc[ai][bj][m][0], acc[ai][bj][m][1]);
            }
        }
    }
};
struct EpiP {
    bf16* P; float* SSP; bf16* Kc; const float* krg; const float* cosC; const float* sinC;
    __device__ __forceinline__ void operator()(const Acc& acc, const Unit& u, int wr, int wc, int fr, int fq, LAS unsigned char*) const {
        const int row0 = u.pm * 256 + wr * 64 + fr;
        if (u.pn < 4) {
#pragma unroll
            for (int ai = 0; ai < 2; ++ai)
#pragma unroll
                for (int m = 0; m < 4; ++m) { const int row = row0 + ai * 128 + m * 16; float ss = 0.f;
#pragma unroll
                    for (int bj = 0; bj < 2; ++bj) { const f32x4 y0 = acc[ai][bj][m][0], y1 = acc[ai][bj][m][1];
                        *(u32x4*)(P + (size_t)row * PP + 256 * u.pn + 128 * bj + 32 * wc + 8 * fq) = pack8(y0, y1);
                        ss += (y0[0] * y0[0] + y0[1] * y0[1]) + (y0[2] * y0[2] + y0[3] * y0[3]) + (y1[0] * y1[0] + y1[1] * y1[1]) + (y1[2] * y1[2] + y1[3] * y1[3]); }
                    ss += __shfl_xor(ss, 16); ss += __shfl_xor(ss, 32);
                    if (fq == 0) SSP[(size_t)row * 16 + 4 * u.pn + wc] = ss; }
        } else if (wc == 0) {
            const f32x4 g0 = *(const f32x4*)(krg + 8 * fq), g1 = *(const f32x4*)(krg + 8 * fq + 4);
#pragma unroll
            for (int ai = 0; ai < 2; ++ai)
#pragma unroll
                for (int m = 0; m < 4; ++m) { const int row = row0 + ai * 128 + m * 16; const f32x4 v0 = acc[ai][0][m][0], v1 = acc[ai][0][m][1];
                    *(u32x4*)(P + (size_t)row * PP + 1024 + 8 * fq) = pack8(v0, v1);
                    float ss = (v0[0] * v0[0] + v0[1] * v0[1]) + (v0[2] * v0[2] + v0[3] * v0[3]) + (v1[0] * v1[0] + v1[1] * v1[1]) + (v1[2] * v1[2] + v1[3] * v1[3]);
                    ss += __shfl_xor(ss, 16); ss += __shfl_xor(ss, 32);
                    const float rk = rsqrtf(ss * (1.f / 32.f) + EPS);
                    f32x4 y0 = v0 * rk * g0, y1 = v1 * rk * g1;
                    const int t = row & 4095, ax = fq >> 1;
                    const f32x4 c0 = *(const f32x4*)(cosC + t * 16 + 8 * ax), c1 = *(const f32x4*)(cosC + t * 16 + 8 * ax + 4), s0 = *(const f32x4*)(sinC + t * 16 + 8 * ax), s1 = *(const f32x4*)(sinC + t * 16 + 8 * ax + 4);
                    f32x4 p0, p1;
#pragma unroll
                    for (int j = 0; j < 4; ++j) { p0[j] = __shfl_xor(y0[j], 16); p1[j] = __shfl_xor(y1[j], 16); }
                    if (row < NL) { if ((fq & 1) == 0) { y0 = y0 * c0 - p0 * s0; y1 = y1 * c1 - p1 * s1; } else { y0 = y0 * c0 + p0 * s0; y1 = y1 * c1 + p1 * s1; } }
                    const u32x4 wv = pack8(y0, y1);
#pragma unroll
                    for (int hd = 0; hd < 16; ++hd) *(u32x4*)(Kc + (size_t)row * 1536 + hd * 96 + 64 + 8 * fq) = wv;
                    asm volatile("" ::: "memory"); }
        }
    }
};
struct EpiKV {
    bf16 *Kc, *Vc; const float* SSP; const float* kg;
    __device__ __forceinline__ void operator()(const Acc& acc, const Unit& u, int wr, int wc, int fr, int fq, LAS unsigned char*) const {
        const int row0 = u.pm * 256 + wr * 64 + fr, head = 2 * u.pn + (wc >> 1), dbase = 8 * fq;
        const bool isk = (wc & 1) == 0;
        float rr[2][4];
#pragma unroll
        for (int ai = 0; ai < 2; ++ai)
#pragma unroll
            for (int m = 0; m < 4; ++m) { const f32x4 pq = *(const f32x4*)(SSP + (size_t)(row0 + ai * 128 + m * 16) * 16 + 12); rr[ai][m] = (pq[0] + pq[1]) + (pq[2] + pq[3]); }
        f32x4 gv[2][2];
#pragma unroll
        for (int bj = 0; bj < 2; ++bj)
#pragma unroll
            for (int n = 0; n < 2; ++n) gv[bj][n] = isk ? *(const f32x4*)(kg + dbase + 32 * bj + 4 * n) : (f32x4){1.f, 1.f, 1.f, 1.f};
#pragma unroll
        for (int ai = 0; ai < 2; ++ai)
#pragma unroll
            for (int m = 0; m < 4; ++m) {
                const int row = row0 + ai * 128 + m * 16; const float r = rsqrtf(rr[ai][m] * (1.f / 256.f) + EPS);
                float f = r;
                if (isk) {
                    float ss = 0.f;
#pragma unroll
                    for (int bj = 0; bj < 2; ++bj)
#pragma unroll
                        for (int n = 0; n < 2; ++n) { const f32x4 v = acc[ai][bj][m][n]; ss += (v[0] * v[0] + v[1] * v[1]) + (v[2] * v[2] + v[3] * v[3]); }
                    ss += __shfl_xor(ss, 16); ss += __shfl_xor(ss, 32);
                    f = r * rsqrtf(r * r * ss * (1.f / 64.f) + EPS);
                }
                bf16* o = isk ? (Kc + (size_t)row * 1536 + head * 96 + dbase) : (Vc + (size_t)row * 1024 + head * 64 + dbase);
#pragma unroll
                for (int bj = 0; bj < 2; ++bj) *(u32x4*)(o + 32 * bj) = pack8(acc[ai][bj][m][0] * f * gv[bj][0], acc[ai][bj][m][1] * f * gv[bj][1]);
            }
    }
};
struct EpiGU {
    bf16* ACT; const float* bgu;
    __device__ __forceinline__ void operator()(const Acc& acc, const Unit& u, int wr, int wc, int fr, int fq, LAS unsigned char*) const {
        const int row0 = u.gm * 256 + wr * 64 + fr, j0 = 128 * u.nt + 32 * wc + 8 * fq;
        const float* bp = bgu + (size_t)u.e * 2048;
        f32x4 bg[2], bu[2];
#pragma unroll
        for (int n = 0; n < 2; ++n) { bg[n] = *(const f32x4*)(bp + j0 + 4 * n); bu[n] = *(const f32x4*)(bp + 1024 + j0 + 4 * n); }
#pragma unroll
        for (int ai = 0; ai < 2; ++ai)
#pragma unroll
            for (int m = 0; m < 4; ++m) {
                f32x4 z[2];
#pragma unroll
                for (int n = 0; n < 2; ++n) { const f32x4 gt = acc[ai][0][m][n] + bg[n], up = acc[ai][1][m][n] + bu[n];
#pragma unroll
                    for (int r = 0; r < 4; ++r) { const float gg = fminf(gt[r], 7.f), uu = fminf(fmaxf(up[r], -7.f), 7.f); z[n][r] = (uu + 1.f) * (gg * fsigm(1.702f * gg)); } }
                *(u32x4*)(ACT + (size_t)(row0 + ai * 128 + m * 16) * 1024 + j0) = pack8(z[0], z[1]);
            }
    }
};
struct EpiDown {
    bf16* YB; const float* bdn; const float* gate; const LAS int* idx;
    __device__ __forceinline__ void operator()(const Acc& acc, const Unit& u, int wr, int wc, int fr, int fq, LAS unsigned char*) const {
        const int r0 = wr * 64 + fr; const float* bp = bdn + (size_t)u.e * 1024;
        f32x4 bv[2][2]; int c0[2];
#pragma unroll
        for (int bj = 0; bj < 2; ++bj) { c0[bj] = 256 * u.nt + 128 * bj + 32 * wc + 8 * fq; bv[bj][0] = *(const f32x4*)(bp + c0[bj]); bv[bj][1] = *(const f32x4*)(bp + c0[bj] + 4); }
#pragma unroll
        for (int ai = 0; ai < 2; ++ai)
#pragma unroll
            for (int m = 0; m < 4; ++m) {
                const int slot = idx[u.slot * 256 + r0 + ai * 128 + m * 16];
                if (slot >= 0) {
                    const float gw = gate[slot]; bf16* o = YB + (size_t)slot * 1024;
#pragma unroll
                    for (int bj = 0; bj < 2; ++bj) *(u32x4*)(o + c0[bj]) = pack8((acc[ai][bj][m][0] + bv[bj][0]) * gw, (acc[ai][bj][m][1] + bv[bj][1]) * gw);
                }
            }
    }
};

enum { LAY_STD = 0, LAY_HEAD = 1, LAY_INA = 2, LAY_GU = 3, LAY_F32 = 4, LAY_HEAD2 = 5 };
template <int LAY> __device__ __forceinline__ int colmap(int pn, int rho) {
    const int bj = rho >> 7, wc = (rho >> 5) & 3, n = (rho >> 4) & 1, fq = (rho >> 2) & 3, reg = rho & 3;
    const int std_c = 128 * bj + 32 * wc + 8 * fq + 4 * n + reg;
    const int head_c = 64 * wc + 32 * (fq >> 1) + 8 * (fq & 1) + 16 * bj + 4 * n + reg;
    if (LAY == LAY_STD) return 256 * pn + std_c;
    if (LAY == LAY_F32) return 256 * pn + rho;
    if (LAY == LAY_HEAD) return 256 * pn + head_c;
    if (LAY == LAY_HEAD2) return 256 * pn + 64 * wc + 32 * bj + 8 * fq + 4 * n + reg;
    if (LAY == LAY_INA) return pn < 3 ? 256 * pn + head_c : 768 + (bj ? 512 : 0) + 128 * (pn - 3) + 32 * wc + 8 * fq + 4 * n + reg;
    return (bj ? 1024 : 0) + 128 * pn + 32 * wc + 8 * fq + 4 * n + reg;
}
template <int LAY>
__device__ __forceinline__ void cvt_matrix(const float* src, size_t mat_stride, int ld, int nvalid, int K, int tiles_per_mat, int ntiles, bf16* dst, const float* kscale,
                                           LAS float* scr, int it_begin, int it_step, int lane, int it_end = 0x7fffffff) {
    const int kblocks = K / 64; int nitems = ntiles * 8 * kblocks; nitems = nitems < it_end ? nitems : it_end;
    const int gw = it_begin, NGW = it_step;
    const int i = lane & 31, kh = lane >> 5;
    float v[32], vn[32];
#define CVT_LOAD(it_, dstv) do { const int _kb = (it_) % kblocks, _tg = (it_) / kblocks, _grp = _tg & 7, _tile = _tg >> 3; \
        const int _mat = _tile / tiles_per_mat, _pn = _tile - _mat * tiles_per_mat; const int _c = colmap<LAY>(_pn, _grp * 32 + i); const bool _ok = _c < nvalid; \
        const float* _s = src + (size_t)_mat * mat_stride + (size_t)(_kb * 64 + kh) * ld + (_ok ? _c : 0); \
        _Pragma("unroll") for (int ii = 0; ii < 32; ++ii) dstv[ii] = _ok ? _s[(size_t)(2 * ii) * ld] : 0.f; } while (0)
    int it = gw;
    if (it < nitems) CVT_LOAD(it, v);
    for (; it < nitems; it += NGW) {
        const int itn = it + NGW;
        if (itn < nitems) CVT_LOAD(itn, vn);
        const int kb = it % kblocks, tg = it / kblocks, grp = tg & 7, tile = tg >> 3;
        if (kscale) {
#pragma unroll
            for (int ii = 0; ii < 32; ++ii) v[ii] *= kscale[kb * 64 + 2 * ii + kh];
        }
#pragma unroll
        for (int ii = 0; ii < 32; ++ii) scr[(2 * ii + kh) * 33 + i] = v[ii];
        LDS_WAIT(); asm volatile("" ::: "memory");
        const int c8 = lane & 7;
#pragma unroll
        for (int j = 0; j < 4; ++j) { const int n = (lane >> 3) + 8 * j; const LAS float* q = scr + (8 * c8) * 33 + n;
            u32x4 o; o.x = pk2(q[0 * 33], q[1 * 33]); o.y = pk2(q[2 * 33], q[3 * 33]); o.z = pk2(q[4 * 33], q[5 * 33]); o.w = pk2(q[6 * 33], q[7 * 33]);
            *(u32x4*)(dst + ((size_t)tile * 256 + grp * 32 + n) * K + kb * 64 + 8 * c8) = o; }
        LDS_WAIT(); asm volatile("" ::: "memory");
#pragma unroll
        for (int ii = 0; ii < 32; ++ii) v[ii] = vn[ii];
    }
#undef CVT_LOAD
}

struct CvtBg {
    const float* wgu; const float* wdn; bf16* dgu; bf16* ddn; LAS float* scr; int cl0, vcu, j, jend, cur; bool have; f32x4 v[8];
    __device__ __forceinline__ void init(const float* wgu_, const float* wdn_, bf16* dgu_, bf16* ddn_, LAS float* scr_, int cl0_, int nlay, int vcu_, int wave) {
        wgu = wgu_; wdn = wdn_; dgu = dgu_; ddn = ddn_; scr = scr_; cl0 = cl0_; vcu = vcu_; j = wave; jend = nlay * 192; cur = 0; have = false;
#pragma unroll
        for (int q = 0; q < 8; ++q) v[q] = (f32x4){0.f, 0.f, 0.f, 0.f}; }
    __device__ __forceinline__ void decode(int jj, bool& isgu, int& cl, int& it) const { cl = cl0 + jj / 192; const int r = jj % 192; isgu = r < 128; it = isgu ? vcu * 128 + r : vcu * 64 + (r - 128); }
    __device__ __forceinline__ void issue(int lane) {
        if (j >= jend) { have = false; return; }
        bool isgu; int cl, it; decode(j, isgu, cl, it);
        const int c4 = lane & 7, kr = lane >> 3, i0 = 16 * (c4 & 1) + 4 * (c4 >> 1);
        const int kb = it & 15, tg = it >> 4, grp = tg & 7, tile = tg >> 3;
        const float* s;
        if (isgu) { const int mat = tile >> 3, pn = tile & 7; s = wgu + ((size_t)(cl * 32 + mat) * 1024 + kb * 64 + kr) * 2048 + colmap<LAY_GU>(pn, grp * 32 + i0); }
        else { const int mat = tile >> 2, pn = tile & 3; s = wdn + ((size_t)(cl * 32 + mat) * 1024 + kb * 64 + kr) * 1024 + colmap<LAY_STD>(pn, grp * 32 + i0); }
        const size_t ld8 = isgu ? 8 * 2048 : 8 * 1024;
#pragma unroll
        for (int q = 0; q < 8; ++q) v[q] = __builtin_nontemporal_load((const f32x4*)(s + q * ld8));
        cur = j; have = true; j += 8;
    }
    __device__ __forceinline__ void finish(int lane) {
        if (!have) return;
        bool isgu; int cl, it; decode(cur, isgu, cl, it);
        const int c4 = lane & 7, kr = lane >> 3, i0 = 16 * (c4 & 1) + 4 * (c4 >> 1);
        const int kb = it & 15, tg = it >> 4, grp = tg & 7, tile = tg >> 3;
#pragma unroll
        for (int q = 0; q < 8; ++q) { const int kk = 8 * q + kr; scr[kk * 33 + i0] = v[q][0]; scr[kk * 33 + i0 + 1] = v[q][1]; scr[kk * 33 + i0 + 2] = v[q][2]; scr[kk * 33 + i0 + 3] = v[q][3]; }
        LDS_WAIT(); asm volatile("" ::: "memory");
        bf16* d = isgu ? dgu + ((size_t)(cl * 256 + tile) * 256 + grp * 32) * 1024 : ddn + ((size_t)(cl * 128 + tile) * 256 + grp * 32) * 1024;
        const int c8 = lane & 7;
#pragma unroll
        for (int jx = 0; jx < 4; ++jx) { const int n = (lane >> 3) + 8 * jx; const LAS float* q_ = scr + (8 * c8) * 33 + n;
            u32x4 o; o.x = pk2(q_[0 * 33], q_[1 * 33]); o.y = pk2(q_[2 * 33], q_[3 * 33]); o.z = pk2(q_[4 * 33], q_[5 * 33]); o.w = pk2(q_[6 * 33], q_[7 * 33]);
            *(u32x4*)(d + (size_t)n * 1024 + kb * 64 + 8 * c8) = o; }
        LDS_WAIT(); asm volatile("" ::: "memory");
        have = false;
    }
};
struct NoBg { __device__ __forceinline__ void issue(int) {} __device__ __forceinline__ void finish(int) {} };

__device__ __forceinline__ void normmod_store(const f32x4 (&v)[4], float rstd, const float* g, const float* mvec  , int sh_off, int sc_off, bf16* orow, int lane) {
#pragma unroll
    for (int j = 0; j < 4; ++j) { const int c = 4 * lane + 256 * j;
        const f32x4 gg = *(const f32x4*)(g + c), sc = *(const f32x4*)(mvec + sc_off + c), sh = *(const f32x4*)(mvec + sh_off + c);
        const f32x4 y = v[j] * rstd * gg * (sc + 1.f) + sh;
        u32x2 w; w.x = pk2(y[0], y[1]); w.y = pk2(y[2], y[3]); *(u32x2*)(orow + c) = w; }
}

template <int DQK> struct AT {
    static constexpr int CK = DQK / 8, RSK = DQK * 2 + 16, RSV = 192, KT = 64 * RSK, VT = 64 * RSV, STG = KT + VT, NKS = DQK / 16;
};
#define MFMA32(a, b, c) __builtin_amdgcn_mfma_f32_32x32x16_bf16((a), (b), (c), 0, 0, 0)
struct TileList { int nloc, row_loc0, kpos_loc0, row_ctx0, ntiles; };
template <int DQK, bool MASK, class Bg, int CAD>
__device__ __forceinline__ void attn_core(LAS unsigned char* lds, const bf16x8 (&qf)[DQK / 16], const TileList tl, const char* Kg, int kpitchB, const char* Vg, int vpitchB,
                                          int qpos, float& m, float& l, f32x16 (&O)[2], Bg& bg) {
    typedef AT<DQK> A;
    const int tid = otid(), lane = tid & 63, h = lane >> 5;
    const int kr0 = tid / A::CK, kc0 = tid % A::CK;
    const int kr1 = (tid + 512) / A::CK, kc1 = (tid + 512) % A::CK;
    const bool has2 = (DQK == 96) && (tid < 256);
    const int vr = tid >> 3, vc = tid & 7;
    const unsigned kfrag = (unsigned)((lane & 31) * A::RSK + 16 * h);
    const unsigned vfrag = (unsigned)((((lane & 15) >> 2) + 4 * h) * A::RSV + (16 * ((lane >> 4) & 1) + 4 * (lane & 3)) * 2);
    u32x4 rk0, rk1, rv;
    rk1 = (u32x4){0u, 0u, 0u, 0u};
#define AT_ROW0(i) ((i) < tl.nloc ? tl.row_loc0 + 64 * (i) : tl.row_ctx0 + 64 * ((i) - tl.nloc))
#define AT_LOAD(i) do { const int _r0 = AT_ROW0(i); \
        rk0 = *(const u32x4*)(Kg + (size_t)(_r0 + kr0) * kpitchB + kc0 * 16); \
        if (has2) rk1 = *(const u32x4*)(Kg + (size_t)(_r0 + kr1) * kpitchB + kc1 * 16); \
        rv = *(const u32x4*)(Vg + (size_t)(_r0 + vr) * vpitchB + vc * 16); } while (0)
#define AT_WRITE(buf) do { LAS unsigned char* _b = lds + (buf) * A::STG; \
        *(LAS u32x4*)(_b + kr0 * A::RSK + kc0 * 16) = rk0; \
        if (has2) *(LAS u32x4*)(_b + kr1 * A::RSK + kc1 * 16) = rk1; \
        *(LAS u32x4*)(_b + A::KT + vr * A::RSV + vc * 16) = rv; } while (0)
    f32x16 zero16;
#pragma unroll
    for (int r = 0; r < 16; ++r) zero16[r] = 0.f;
    AT_LOAD(0); AT_WRITE(0);
    __syncthreads();
    for (int i = 0; i < tl.ntiles; ++i) {
        const bool more = (i + 1 < tl.ntiles);
        if (more) AT_LOAD(i + 1);
        if ((i & (CAD - 1)) == 0) bg.issue(lane);
        const LAS unsigned char* kt = lds + (i & 1) * A::STG; const LAS unsigned char* vt = kt + A::KT;
        constexpr int KH = A::NKS / 2;
        bf16x8 ka[KH][2];
#pragma unroll
        for (int ks = 0; ks < KH; ++ks) { ka[ks][0] = *(const LAS bf16x8*)(kt + kfrag + 32 * ks); ka[ks][1] = *(const LAS bf16x8*)(kt + kfrag + 32 * A::RSK + 32 * ks); }
        __builtin_amdgcn_sched_barrier(0);
        f32x16 s0 = MFMA32(ka[0][0], qf[0], zero16), s1 = MFMA32(ka[0][1], qf[0], zero16);
#pragma unroll
        for (int ks = 1; ks < KH; ++ks) { s0 = MFMA32(ka[ks][0], qf[ks], s0); s1 = MFMA32(ka[ks][1], qf[ks], s1); }
#pragma unroll
        for (int ks = 0; ks < KH; ++ks) { ka[ks][0] = *(const LAS bf16x8*)(kt + kfrag + 32 * (KH + ks)); ka[ks][1] = *(const LAS bf16x8*)(kt + kfrag + 32 * A::RSK + 32 * (KH + ks)); }
        __builtin_amdgcn_sched_barrier(0);
#pragma unroll
        for (int ks = 0; ks < KH; ++ks) { s0 = MFMA32(ka[ks][0], qf[KH + ks], s0); s1 = MFMA32(ka[ks][1], qf[KH + ks], s1); }
        __builtin_amdgcn_sched_barrier(0);
        s16x4 vlo[2][2], vhi[2][2];
#pragma unroll
        for (int sp = 0; sp < 2; ++sp)
#pragma unroll
            for (int dvb = 0; dvb < 2; ++dvb) { const LAS unsigned char* vp = vt + vfrag + (16 * sp) * A::RSV + 64 * dvb;
                vlo[sp][dvb] = __builtin_amdgcn_ds_read_tr16_b64_v4i16((LAS s16x4*)(vp)); vhi[sp][dvb] = __builtin_amdgcn_ds_read_tr16_b64_v4i16((LAS s16x4*)(vp + 8 * A::RSV)); }
        __builtin_amdgcn_sched_barrier(0);
        if (MASK) {
            if (i < tl.nloc) {
                const int kb = tl.kpos_loc0 + 64 * i + 4 * h - qpos;
#pragma unroll
                for (int r = 0; r < 16; ++r) { const int d0 = kb + (r & 3) + 8 * (r >> 2), d1 = d0 + 32;
                    if (d0 > 128 || d0 < -128) s0[r] = -1e30f; if (d1 > 128 || d1 < -128) s1[r] = -1e30f; }
            }
        }
        float tm = fmaxf(fmaxf(s0[0], s1[0]), fmaxf(s0[1], s1[1]));
#pragma unroll
        for (int r = 2; r < 16; r += 2) tm = fmaxf(tm, fmaxf(fmaxf(s0[r], s1[r]), fmaxf(s0[r + 1], s1[r + 1])));
        tm = fmaxf(tm, __shfl_xor(tm, 32)) - m;
        if (__builtin_amdgcn_ballot_w64(tm > 8.f) != 0ull) {
            const float dlt = fmaxf(tm, 0.f), alpha = __builtin_amdgcn_exp2f(-dlt);
            m += dlt; l *= alpha;
#pragma unroll
            for (int r = 0; r < 16; ++r) { O[0][r] *= alpha; O[1][r] *= alpha; }
        }
        if (__builtin_amdgcn_ballot_w64(m != 0.f) != 0ull) {
#pragma unroll
            for (int r = 0; r < 16; ++r) { s0[r] -= m; s1[r] -= m; }
        }
        float ps = 0.f;
#pragma unroll
        for (int r = 0; r < 16; ++r) { s0[r] = __builtin_amdgcn_exp2f(s0[r]); s1[r] = __builtin_amdgcn_exp2f(s1[r]); ps += s0[r] + s1[r]; }
        l += ps;
#pragma unroll
        for (int kh = 0; kh < 2; ++kh) {
            const f32x16& p = kh ? s1 : s0;
#pragma unroll
            for (int sp = 0; sp < 2; ++sp) {
                u32x4 pw; pw.x = pk2(p[8 * sp + 0], p[8 * sp + 1]); pw.y = pk2(p[8 * sp + 2], p[8 * sp + 3]); pw.z = pk2(p[8 * sp + 4], p[8 * sp + 5]); pw.w = pk2(p[8 * sp + 6], p[8 * sp + 7]);
                const bf16x8 pf = __builtin_bit_cast(bf16x8, pw);
#pragma unroll
                for (int dvb = 0; dvb < 2; ++dvb) { const bf16x8 va = __builtin_shufflevector(vlo[sp][dvb], vhi[sp][dvb], 0, 1, 2, 3, 4, 5, 6, 7); O[dvb] = MFMA32(va, pf, O[dvb]); }
            }
            if (kh == 0) {
#pragma unroll
                for (int sp = 0; sp < 2; ++sp)
#pragma unroll
                    for (int dvb = 0; dvb < 2; ++dvb) { const LAS unsigned char* vp = vt + vfrag + (32 + 16 * sp) * A::RSV + 64 * dvb;
                        vlo[sp][dvb] = __builtin_amdgcn_ds_read_tr16_b64_v4i16((LAS s16x4*)(vp)); vhi[sp][dvb] = __builtin_amdgcn_ds_read_tr16_b64_v4i16((LAS s16x4*)(vp + 8 * A::RSV)); }
            }
        }
        if (more) AT_WRITE((i + 1) & 1);
        if ((i & (CAD - 1)) == CAD - 1) bg.finish(lane);
        __syncthreads();
    }
#undef AT_ROW0
#undef AT_LOAD
#undef AT_WRITE
}
__device__ __forceinline__ void attn_store(const f32x16 (&O)[2], float l, bf16* orow, int h) {
    const float lt = l + __shfl_xor(l, 32); const float inv = 1.f / lt;
#pragma unroll
    for (int dvb = 0; dvb < 2; ++dvb)
#pragma unroll
        for (int g4 = 0; g4 < 4; ++g4) { u32x2 w; w.x = pk2(O[dvb][4 * g4] * inv, O[dvb][4 * g4 + 1] * inv); w.y = pk2(O[dvb][4 * g4 + 2] * inv, O[dvb][4 * g4 + 3] * inv);
            *(u32x2*)(orow + 32 * dvb + 8 * g4 + 4 * h) = w; }
}

__device__ __forceinline__ void wattn_unit(LAS unsigned char* lds, int unit, const bf16* Qa, const bf16* Ka, const bf16* Va, const float* sink, bf16* MIX, CvtBg& bg) {
    const int tid = otid(), w = tid >> 6, lane = tid & 63, h = lane >> 5;
    int b, kvh, hp, tq, qpos; TileList tl;
    if (unit < 512) { b = unit >> 7; kvh = (unit >> 6) & 1; const int nb = (unit >> 1) & 31; hp = unit & 1;
        const int t0 = max(0, 128 * nb - 128), t1 = min(4096, 128 * nb + 256);
        tl.nloc = (t1 - t0) >> 6; tl.row_loc0 = b * S + t0; tl.kpos_loc0 = t0; tl.row_ctx0 = NL + b * CL; tl.ntiles = tl.nloc + 4;
        qpos = 128 * nb + (w & 3) * 32 + (lane & 31); tq = b * S + qpos;
    } else { const int u = unit - 512; b = u >> 3; kvh = (u >> 2) & 1; hp = (u >> 1) & 1; const int half = u & 1;
        tl.nloc = 0; tl.row_loc0 = 0; tl.kpos_loc0 = 0; tl.row_ctx0 = NL + b * CL; tl.ntiles = 4;
        qpos = 0; tq = NL + b * CL + half * 128 + (w & 3) * 32 + (lane & 31); }
    const int hq = kvh * 4 + hp * 2 + (w >> 2);
    bf16x8 qf[4];
#pragma unroll
    for (int ks = 0; ks < 4; ++ks) qf[ks] = *(const bf16x8*)(Qa + (size_t)tq * 512 + hq * 64 + 16 * ks + 8 * h);
    float m = 0.f, l = (h == 0) ? __expf(sink[hq]) : 0.f;
    f32x16 O[2];
#pragma unroll
    for (int r = 0; r < 16; ++r) { O[0][r] = 0.f; O[1][r] = 0.f; }
    attn_core<64, true, CvtBg, 2>(lds, qf, tl, (const char*)(Ka + kvh * 64), 256, (const char*)(Va + kvh * 64), 256, qpos, m, l, O, bg);
    bg.finish(lane);
    attn_store(O, l, MIX + (size_t)tq * 1024 + hq * 64, h);
}
__device__ __forceinline__ void mla_unit(LAS unsigned char* lds, int unit, const bf16* Qc, const bf16* Kc, const bf16* Vc, const float* RS, const float* qg,
                                         const float* cosC, const float* sinC, bf16* MIX, CvtBg& bg) {
    const int tid = otid(), w = tid >> 6, lane = tid & 63, h = lane >> 5;
    int b, head, tq; TileList tl; bool lat;
    if (unit < 1024) { b = unit >> 8; head = (unit >> 4) & 15; const int qb = unit & 15; lat = true;
        tl.nloc = 64; tl.row_loc0 = b * S; tl.kpos_loc0 = 0; tl.row_ctx0 = NL + b * CL; tl.ntiles = 68; tq = b * S + qb * 256 + w * 32 + (lane & 31);
    } else { const int u = unit - 1024; b = u >> 4; head = u & 15; lat = false;
        tl.nloc = 0; tl.row_loc0 = 0; tl.kpos_loc0 = 0; tl.row_ctx0 = NL + b * CL; tl.ntiles = 4; tq = NL + b * CL + w * 32 + (lane & 31); }
    float v[6][8]; float ss = 0.f;
    const bf16* qp = Qc + (size_t)tq * 1536 + head * 96 + 8 * h;
#pragma unroll
    for (int ks = 0; ks < 6; ++ks) { const u32x4 raw = *(const u32x4*)(qp + 16 * ks);
        v[ks][0] = bflo(raw.x); v[ks][1] = bfhi(raw.x); v[ks][2] = bflo(raw.y); v[ks][3] = bfhi(raw.y); v[ks][4] = bflo(raw.z); v[ks][5] = bfhi(raw.z); v[ks][6] = bflo(raw.w); v[ks][7] = bfhi(raw.w);
#pragma unroll
        for (int j = 0; j < 8; ++j) ss += v[ks][j] * v[ks][j]; }
    ss += __shfl_xor(ss, 32);
    float r; { const f32x4 p0 = *(const f32x4*)(RS + (size_t)tq * 16), p1 = *(const f32x4*)(RS + (size_t)tq * 16 + 4), p2 = *(const f32x4*)(RS + (size_t)tq * 16 + 8);
      r = rsqrtf((((p0[0] + p0[1]) + (p0[2] + p0[3])) + ((p1[0] + p1[1]) + (p1[2] + p1[3])) + ((p2[0] + p2[1]) + (p2[2] + p2[3]))) * (1.f / 768.f) + EPS); }
    const float inv = r * rsqrtf(r * r * ss * (1.f / 96.f) + EPS);
#pragma unroll
    for (int ks = 0; ks < 6; ++ks) { const f32x4 g0 = *(const f32x4*)(qg + 16 * ks + 8 * h), g1 = *(const f32x4*)(qg + 16 * ks + 8 * h + 4);
#pragma unroll
        for (int j = 0; j < 4; ++j) { v[ks][j] *= inv * g0[j]; v[ks][4 + j] *= inv * g1[j]; } }
    {
        const int t = tq & 4095;
#pragma unroll
        for (int ax = 0; ax < 2; ++ax) {
            const f32x4 c0 = *(const f32x4*)(cosC + t * 16 + 8 * ax), c1 = *(const f32x4*)(cosC + t * 16 + 8 * ax + 4);
            const f32x4 s0 = *(const f32x4*)(sinC + t * 16 + 8 * ax), s1 = *(const f32x4*)(sinC + t * 16 + 8 * ax + 4);
#pragma unroll
            for (int j = 0; j < 8; ++j) { const float y = v[4 + ax][j], po = __shfl_xor(y, 32); const float c = j < 4 ? c0[j & 3] : c1[j & 3], s = j < 4 ? s0[j & 3] : s1[j & 3];
                const float yr = (h == 0) ? (y * c - po * s) : (y * c + po * s); v[4 + ax][j] = lat ? yr : y; }
        }
    }
    bf16x8 qf[6];
#pragma unroll
    for (int ks = 0; ks < 6; ++ks) { u32x4 pw; pw.x = pk2(v[ks][0] * QSCALE_C, v[ks][1] * QSCALE_C); pw.y = pk2(v[ks][2] * QSCALE_C, v[ks][3] * QSCALE_C);
        pw.z = pk2(v[ks][4] * QSCALE_C, v[ks][5] * QSCALE_C); pw.w = pk2(v[ks][6] * QSCALE_C, v[ks][7] * QSCALE_C); qf[ks] = __builtin_bit_cast(bf16x8, pw); }
    float m = 0.f, l = 0.f;
    f32x16 O[2];
#pragma unroll
    for (int rr = 0; rr < 16; ++rr) { O[0][rr] = 0.f; O[1][rr] = 0.f; }
    attn_core<96, false, CvtBg, 4>(lds, qf, tl, (const char*)(Kc + head * 96), 3072, (const char*)(Vc + head * 64), 2048, 0, m, l, O, bg);
    bg.finish(lane);
    attn_store(O, l, MIX + (size_t)tq * 1024 + head * 64, h);
}

template <int NTOK>
__device__ __forceinline__ void conv_strip(LAS unsigned char* lds, int seq0, int len, int t0, const bf16* Z, const float* dw_w, const float* dw_b, const float* ln_g, const float* ln_b, bf16* MIX) {
    const int tid = otid(), w = tid >> 6, lane = tid & 63;
    constexpr int NROW = NTOK + 30, NCH = NROW * 64, NLD = (NCH + NTHR - 1) / NTHR, NSUB = (NTOK + 15) / 16;
    LAS bf16* zt = (LAS bf16*)lds; LAS float* ot = (LAS float*)(lds + 98304);
    u32x4 st[NLD];
#pragma unroll
    for (int i = 0; i < NLD; ++i) { const int q = tid + i * NTHR, r = q >> 6, cc = q & 63, tt = t0 - 15 + r; st[i] = (u32x4){0u, 0u, 0u, 0u};
        if (q < NCH && tt >= 0 && tt < len) st[i] = *(const u32x4*)(Z + (size_t)(seq0 + tt) * 512 + cc * 8); }
    float wt[31];
#pragma unroll
    for (int j = 0; j < 31; ++j) wt[j] = dw_w[j * 512 + tid];
    const float bias = dw_b[tid];
#pragma unroll
    for (int i = 0; i < NLD; ++i) { const int q = tid + i * NTHR; if (q < NCH) *(LAS u32x4*)(zt + (q >> 6) * 512 + (q & 63) * 8) = st[i]; }
    const f32x4 g0 = *(const f32x4*)(ln_g + 8 * lane), g1 = *(const f32x4*)(ln_g + 8 * lane + 4), b0 = *(const f32x4*)(ln_b + 8 * lane), b1 = *(const f32x4*)(ln_b + 8 * lane + 4);
    __syncthreads();
#pragma unroll 1
    for (int sb = 0; sb < NSUB; ++sb) {
        float acc[16];
#pragma unroll
        for (int t = 0; t < 16; ++t) acc[t] = bias;
        const LAS bf16* zp = zt + sb * 16 * 512 + tid;
        constexpr int NR = (NTOK >= 16 ? 16 : NTOK) + 30;
#pragma unroll
        for (int r = 0; r < NR; ++r) { const float zv = bf1(zp[r * 512]);
#pragma unroll
            for (int t = 0; t < 16; ++t) { const int j = r - t; if (j >= 0 && j < 31 && t < NTOK) acc[t] += zv * wt[j]; } }
#pragma unroll
        for (int t = 0; t < 16; ++t) ot[t * 512 + tid] = acc[t];
        __syncthreads();
#pragma unroll
        for (int q = 0; q < 2; ++q) { const int t = 2 * w + q, tok = sb * 16 + t;
            if (tok < NTOK) {
                const f32x4 x0 = *(const LAS f32x4*)(ot + t * 512 + 8 * lane), x1 = *(const LAS f32x4*)(ot + t * 512 + 8 * lane + 4);
                const float mu = wave_sum((x0[0] + x0[1]) + (x0[2] + x0[3]) + (x1[0] + x1[1]) + (x1[2] + x1[3])) * (1.f / 512.f);
                const f32x4 d0 = x0 - mu, d1 = x1 - mu;
                const float var = wave_sum((d0[0] * d0[0] + d0[1] * d0[1]) + (d0[2] * d0[2] + d0[3] * d0[3]) + (d1[0] * d1[0] + d1[1] * d1[1]) + (d1[2] * d1[2] + d1[3] * d1[3])) * (1.f / 512.f);
                const float rstd = rsqrtf(var + EPS);
                f32x4 y0 = d0 * rstd * g0 + b0, y1 = d1 * rstd * g1 + b1;
#pragma unroll
                for (int j = 0; j < 4; ++j) { y0[j] = fsilu(y0[j]); y1[j] = fsilu(y1[j]); }
                *(u32x4*)(MIX + (size_t)(seq0 + t0 + tok) * 1024 + 512 + 8 * lane) = pack8(y0, y1); } }
        __syncthreads();
    }
}

__device__ __forceinline__ void mla_stats_row(int row, int lane, const bf16* P, const float* krg, const float* cosC, const float* sinC, float* RS, bf16* Kc) {
    const bf16* p = P + (size_t)row * PP;
    const u32x4 a = *(const u32x4*)(p + 8 * lane);
    const u32x4 b = *(const u32x4*)(p + 8 * (lane + 64));
    u32x4 c = (u32x4){0u, 0u, 0u, 0u};
    if (lane < 4) c = *(const u32x4*)(p + 8 * (lane + 128));
    auto sq = [](u32x4 u) { float s = 0.f; s += bflo(u.x) * bflo(u.x) + bfhi(u.x) * bfhi(u.x); s += bflo(u.y) * bflo(u.y) + bfhi(u.y) * bfhi(u.y);
                            s += bflo(u.z) * bflo(u.z) + bfhi(u.z) * bfhi(u.z); s += bflo(u.w) * bflo(u.w) + bfhi(u.w) * bfhi(u.w); return s; };
    const float sa = sq(a), sb = sq(b), sc = sq(c);
    const float ssq = wave_sum(sa + (lane < 32 ? sb : 0.f)), skv = wave_sum(lane >= 32 ? sb : 0.f), skr = wave_sum(sc);
    if (lane == 0) { RS[(size_t)row * 2] = rsqrtf(ssq * (1.f / 768.f) + EPS); RS[(size_t)row * 2 + 1] = rsqrtf(skv * (1.f / 256.f) + EPS); }
    const float rk = rsqrtf(skr * (1.f / 32.f) + EPS);
    float y[8]; const int l4 = lane & 3;
    { const f32x4 g0 = *(const f32x4*)(krg + 8 * l4), g1 = *(const f32x4*)(krg + 8 * l4 + 4);
      y[0] = bflo(c.x) * rk * g0[0]; y[1] = bfhi(c.x) * rk * g0[1]; y[2] = bflo(c.y) * rk * g0[2]; y[3] = bfhi(c.y) * rk * g0[3];
      y[4] = bflo(c.z) * rk * g1[0]; y[5] = bfhi(c.z) * rk * g1[1]; y[6] = bflo(c.w) * rk * g1[2]; y[7] = bfhi(c.w) * rk * g1[3]; }
    const int t = row & 4095, ax = l4 >> 1, half = l4 & 1;
    const f32x4 c0 = *(const f32x4*)(cosC + t * 16 + 8 * ax), c1 = *(const f32x4*)(cosC + t * 16 + 8 * ax + 4), s0 = *(const f32x4*)(sinC + t * 16 + 8 * ax), s1 = *(const f32x4*)(sinC + t * 16 + 8 * ax + 4);
    float o[8];
#pragma unroll
    for (int j = 0; j < 8; ++j) { const float po = __shfl_xor(y[j], 1); const float cc = j < 4 ? c0[j & 3] : c1[j & 3], sn = j < 4 ? s0[j & 3] : s1[j & 3];
        const float yr = half == 0 ? (y[j] * cc - po * sn) : (y[j] * cc + po * sn); o[j] = row < NL ? yr : y[j]; }
    if (lane < 4) { u32x4 wv; wv.x = pk2(o[0], o[1]); wv.y = pk2(o[2], o[3]); wv.z = pk2(o[4], o[5]); wv.w = pk2(o[6], o[7]);
#pragma unroll
        for (int hd = 0; hd < 16; ++hd) *(u32x4*)(Kc + (size_t)row * 1536 + hd * 96 + 64 + 8 * lane) = wv; }
}

template <int NT>
__device__ __forceinline__ void moe_setup(LAS unsigned char* lds, const int* cntG, const int* list, int layer, int vcu, int G) {
    LAS int* tab = (LAS int*)(lds + LDS_TAB); LAS int* idx = (LAS int*)(lds + LDS_IDX);
    const int tid = otid(); constexpr int MG = 32 / NT;
    if (tid < 32) tab[tid] = cntG[tid * 64];
    __syncthreads();
    if (tid == 0) { int acc = 0; for (int e = 0; e < 32; ++e) { tab[32 + e] = acc; acc += (tab[e] + 255) >> 8; } tab[64] = acc;
        int n = 0;
        for (int i = 0; i < MAXU; ++i) { const int v = i * G + vcu, gm = (v >> 5) * MG + (v & 31) / NT, nt = v % NT; if (gm >= acc) break;
            int e = 0; while (e < 31 && tab[33 + e] <= gm) ++e;
            tab[128 + 4 * i] = gm; tab[129 + 4 * i] = (layer * 32 + e) * NT + nt; tab[130 + 4 * i] = e; tab[131 + 4 * i] = nt; n = i + 1; }
        tab[127] = n; }
    __syncthreads();
    const int n = tab[127];
    for (int q = tid; q < n * 256; q += NTHR) { const int i = q >> 8, r = q & 255, gm = tab[128 + 4 * i], e = tab[130 + 4 * i], rr = (gm - tab[32 + e]) * 256 + r;
        idx[q] = rr < tab[e] ? list[(size_t)e * T + rr] : -1; }
    __syncthreads();
}

__device__ __forceinline__ void combine_row(int row, int lane, float* X, const bf16* YB, const float* mcur  , const float* gnext, const float* mnext, bf16* H, float* out) {
    const int mr = modrow(row); const float* mv = mcur + (size_t)mr * 6144 + 5120;
    f32x4 v[2][2]; float ss = 0.f;
    u32x4 y[2][4];
#pragma unroll
    for (int j = 0; j < 2; ++j)
#pragma unroll
        for (int k = 0; k < 4; ++k) y[j][k] = *(const u32x4*)(YB + ((size_t)row * 4 + k) * 1024 + 8 * lane + 512 * j);
#pragma unroll
    for (int j = 0; j < 2; ++j) { const int c = 8 * lane + 512 * j; f32x4 a0 = (f32x4){0.f, 0.f, 0.f, 0.f}, a1 = a0;
#pragma unroll
        for (int k = 0; k < 4; ++k) { a0 += (f32x4){bflo(y[j][k].x), bfhi(y[j][k].x), bflo(y[j][k].y), bfhi(y[j][k].y)}; a1 += (f32x4){bflo(y[j][k].z), bfhi(y[j][k].z), bflo(y[j][k].w), bfhi(y[j][k].w)}; }
        float* xp = X + (size_t)row * D + c; const f32x4 g0 = *(const f32x4*)(mv + c), g1 = *(const f32x4*)(mv + c + 4);
        v[j][0] = *(const f32x4*)xp + g0 * a0; v[j][1] = *(const f32x4*)(xp + 4) + g1 * a1;
        float* op = out ? out + (size_t)row * D + c : xp;
        *(f32x4*)op = v[j][0]; *(f32x4*)(op + 4) = v[j][1];
#pragma unroll
        for (int q = 0; q < 2; ++q) ss += (v[j][q][0] * v[j][q][0] + v[j][q][1] * v[j][q][1]) + (v[j][q][2] * v[j][q][2] + v[j][q][3] * v[j][q][3]); }
    if (H) { const float rstd = rsqrtf(wave_sum(ss) * (1.f / D) + EPS); const float* mn = mnext + (size_t)mr * 6144;
#pragma unroll
        for (int j = 0; j < 2; ++j) { const int c = 8 * lane + 512 * j; f32x4 o[2];
#pragma unroll
            for (int q = 0; q < 2; ++q) { const f32x4 gg = *(const f32x4*)(gnext + c + 4 * q), sc = *(const f32x4*)(mn + 1024 + c + 4 * q), sh = *(const f32x4*)(mn + c + 4 * q); o[q] = v[j][q] * rstd * gg * (sc + 1.f) + sh; }
            *(u32x4*)(H + (size_t)row * D + c) = pack8(o[0], o[1]); } }
}

#define MFMA16(a, b, c) __builtin_amdgcn_mfma_f32_16x16x32_bf16((a), (b), (c), 0, 0, 0)
__device__ __forceinline__ void router_load_table(LAS unsigned char* lds, const bf16* Wr, int tid) {
    u32x4 v[16];
#pragma unroll
    for (int i = 0; i < 16; ++i) v[i] = *(const u32x4*)(Wr + (size_t)(tid + i * NTHR) * 8);
#pragma unroll
    for (int i = 0; i < 16; ++i) { const int q = tid + i * NTHR, row = q >> 7, c = q & 127; *(LAS u32x4*)(lds + row * 2048 + ((c ^ (row & 15)) << 4)) = v[i]; }
}
__device__ __forceinline__ void router_group(LAS unsigned char* lds, int g, int w, int lane, const float* X, const float* SSX, const float* gffn, const float* mvec, const float* rb,
                                             bf16* F, float* gate) {
    LAS float* lg = (LAS float*)(lds + LDS_IDX) + w * 512; LAS int* pend = (LAS int*)(lds + LDS_IDX + 10240) + w * 64; LAS int* cntL = (LAS int*)(lds + LDS_TAB);
    const int i = lane & 15, kq = lane >> 4, row = 16 * g + i;
    const float* xr = X + (size_t)row * D + 8 * kq;
    float ss; { const f32x4 pq = *(const f32x4*)(SSX + (size_t)row * 16 + 4 * kq); ss = (pq[0] + pq[1]) + (pq[2] + pq[3]); }
    ss += __shfl_xor(ss, 16); ss += __shfl_xor(ss, 32);
    const float rstd = rsqrtf(ss * (1.f / D) + EPS);
    f32x4 acc[2] = {(f32x4){0.f, 0.f, 0.f, 0.f}, (f32x4){0.f, 0.f, 0.f, 0.f}};
    const LAS unsigned char* tb = lds + i * 2048;
#pragma unroll 8
    for (int s = 0; s < 32; ++s) {
        const int k = 32 * s + 8 * kq;
        const f32x4 a = *(const f32x4*)(xr + 32 * s), b = *(const f32x4*)(xr + 32 * s + 4);
        const f32x4 g0 = *(const f32x4*)(gffn + k), g1 = *(const f32x4*)(gffn + k + 4), c0 = *(const f32x4*)(mvec + 4096 + k), c1 = *(const f32x4*)(mvec + 4096 + k + 4);
        const f32x4 h0 = *(const f32x4*)(mvec + 3072 + k), h1 = *(const f32x4*)(mvec + 3072 + k + 4);
        const f32x4 f0 = a * rstd * g0 * (c0 + 1.f) + h0, f1 = b * rstd * g1 * (c1 + 1.f) + h1;
        u32x4 hi; hi.x = pk2(f0[0], f0[1]); hi.y = pk2(f0[2], f0[3]); hi.z = pk2(f1[0], f1[1]); hi.w = pk2(f1[2], f1[3]);
        *(u32x4*)(F + (size_t)row * D + k) = hi;
        u32x4 lo; lo.x = pk2(f0[0] - bflo(hi.x), f0[1] - bfhi(hi.x)); lo.y = pk2(f0[2] - bflo(hi.y), f0[3] - bfhi(hi.y));
        lo.z = pk2(f1[0] - bflo(hi.z), f1[1] - bfhi(hi.z)); lo.w = pk2(f1[2] - bflo(hi.w), f1[3] - bfhi(hi.w));
        const bf16x8 ah = __builtin_bit_cast(bf16x8, hi), al = __builtin_bit_cast(bf16x8, lo);
        const int cs = ((4 * s + kq) ^ i) << 4;
#pragma unroll
        for (int et = 0; et < 2; ++et) { const bf16x8 bh = *(const LAS bf16x8*)(tb + et * 16 * 2048 + cs), bl = *(const LAS bf16x8*)(tb + (32 + et * 16) * 2048 + cs);
            acc[et] = MFMA16(ah, bh, acc[et]); acc[et] = MFMA16(al, bh, acc[et]); acc[et] = MFMA16(ah, bl, acc[et]); }
    }
#pragma unroll
    for (int et = 0; et < 2; ++et) { const float bias = rb[16 * et + i];
#pragma unroll
        for (int r = 0; r < 4; ++r) lg[(4 * kq + r) * 32 + 16 * et + i] = acc[et][r] + bias; }
    LDS_WAIT(); asm volatile("" ::: "memory");
    if (lane < 16) {
        const LAS float* my = lg + lane * 32; unsigned used = 0u; int bi[4]; float bv[4];
#pragma unroll
        for (int k = 0; k < 4; ++k) { float best = -3.0e38f; int be = 0;
#pragma unroll
            for (int e = 0; e < 32; ++e) { const float v = my[e]; const bool ok = !((used >> e) & 1u) && v > best; best = ok ? v : best; be = ok ? e : be; }
            used |= 1u << be; bi[k] = be; bv[k] = best; }
        float ex[4], sum = 0.f;
#pragma unroll
        for (int k = 0; k < 4; ++k) { ex[k] = __expf(bv[k] - bv[0]); sum += ex[k]; }
        const float inv = 1.f / sum; const int trow = 16 * g + lane;
#pragma unroll
        for (int k = 0; k < 4; ++k) { const int rl = __hip_atomic_fetch_add(cntL + bi[k], 1, __ATOMIC_RELAXED, __HIP_MEMORY_SCOPE_WORKGROUP);
            pend[lane * 4 + k] = (trow * 4 + k) | (bi[k] << 17) | (rl << 22); gate[trow * 4 + k] = ex[k] * inv; }
    }
}

struct Args { const float* in[32]; float* out; unsigned char* ws; int lo, hi, flags, pad; };
constexpr int N_PHASES = 2 + 2 * (7 + 8);

__global__ void __launch_bounds__(NTHR, 2) mega(Args args) {
    extern __shared__ __attribute__((aligned(16))) unsigned char lds_raw[];
    LAS unsigned char* lds = (LAS unsigned char*)lds_raw;
    const int tid = threadIdx.x, lane = tid & 63, wave = __builtin_amdgcn_readfirstlane(tid >> 6);
    constexpr int G = 256;
    const int bx = blockIdx.x & (G - 1), vcu = (bx % 8) * (G / 8) + bx / 8;
    const int gw = vcu * NWAVES + wave, NGW = G * NWAVES;
    unsigned* ctl = (unsigned*)(args.ws + WS_CTL);
#define PH_LOCALS \
    unsigned zsg_; asm volatile("s_mov_b32 %0, 0" : "=s"(zsg_)); unsigned char* ws = args.ws + zsg_;   const int tid = otid(), lane = tid & 63, wave = __builtin_amdgcn_readfirstlane(tid >> 6), gw = vcu * NWAVES + wave; (void)lane; (void)gw; \
    const float* x_in = args.in[0]; const float* c_in = args.in[1]; const float* ctx_in = args.in[2]; const float* cctx_in = args.in[3]; \
    const float* mod_w = args.in[4]; const float* mod_b = args.in[5]; const float* norm_mix_g = args.in[6]; const float* norm_ffn_g = args.in[7]; \
    float* MOD = (float*)(ws + WS_MOD); float* cosA = (float*)(ws + WS_COSA); float* sinA = (float*)(ws + WS_SINA); float* cosC = (float*)(ws + WS_COSC); float* sinC = (float*)(ws + WS_SINC); \
    bf16* WR = (bf16*)(ws + WS_WR); bf16* WINA = (bf16*)(ws + WS_WINA); bf16* WOUTA = (bf16*)(ws + WS_WOUTA); bf16* WINC = (bf16*)(ws + WS_WINC); bf16* WQB = (bf16*)(ws + WS_WQB); \
    bf16* WKVB = (bf16*)(ws + WS_WKVB); bf16* WOUTC = (bf16*)(ws + WS_WOUTC); bf16* WGU = (bf16*)(ws + WS_WGU); bf16* WDN = (bf16*)(ws + WS_WDN); \
    float* X = (float*)(ws + WS_X); bf16* H = (bf16*)(ws + WS_H); bf16* QA = (bf16*)(ws + WS_QA); bf16* KA = (bf16*)(ws + WS_KA); bf16* VA = (bf16*)(ws + WS_VA); bf16* Z = (bf16*)(ws + WS_Z); \
    bf16* P = (bf16*)(ws + WS_P); float* RS = (float*)(ws + WS_RS); bf16* QC = (bf16*)(ws + WS_QC); bf16* KC = (bf16*)(ws + WS_KC); bf16* VC = (bf16*)(ws + WS_VC); \
    bf16* MIX = (bf16*)(ws + WS_MIX); bf16* F = (bf16*)(ws + WS_F); float* GATE = (float*)(ws + WS_GATE); int* LIST = (int*)(ws + WS_LIST); bf16* ACT = (bf16*)(ws + WS_ACT); bf16* YB = (bf16*)(ws + WS_YB); \
    int* CNT = (int*)(ws + WS_CTL) + CW_CNT; float* SSX = (float*)(ws + WS_SSX); float* SSP = (float*)(ws + WS_SSP); (void)SSX; (void)SSP; const float* ML = MOD + (size_t)layer_ * 5 * 6144; \
    (void)x_in; (void)c_in; (void)ctx_in; (void)cctx_in; (void)mod_w; (void)mod_b; (void)norm_mix_g; (void)norm_ffn_g; (void)MOD; (void)cosA; (void)sinA; (void)cosC; (void)sinC; (void)WR; (void)WINA; (void)WOUTA; \
    (void)WINC; (void)WQB; (void)WKVB; (void)WOUTC; (void)WGU; (void)WDN; (void)X; (void)H; (void)QA; (void)KA; (void)VA; (void)Z; (void)P; (void)RS; (void)QC; (void)KC; (void)VC; (void)MIX; (void)F; (void)GATE; \
    (void)LIST; (void)ACT; (void)YB; (void)CNT; (void)ML;
    if (tid < 64) ((LAS unsigned*)(lds + LDS_MISC))[tid] = 0u;
    __syncthreads();
    const int lo = args.lo, hi = args.hi;
    XcdBarrier bar; bar.bar = ctl + CW_BAR; bar.x = 0; bar.st = nullptr;
    if (hi - lo > 1) bar = xcd_barrier_post(ctl + CW_BAR, (volatile LAS unsigned*)(lds + LDS_MISC));
    int ph = 0; int layer_ = 0;
#ifndef MK_EN
#define MK_EN 0xffffffffu
#endif
#ifdef MK_PROBE_PH
#define PFLAG(b) (args.flags & (b))
#else
#define PFLAG(b) 0
#endif
#define EN(k) (((MK_EN) >> (k)) & 1u)
#define PH_ON (ph >= lo && ph < hi)
#define PH_END do { const bool _b = (ph >= lo) && (ph + 1 < hi); ++ph; if (_b) xcd_barrier(bar); } while (0)

    if (EN(0) && PH_ON) { PH_LOCALS
        LAS float* st = (LAS float*)(lds + 73728);
        for (int q = tid; q < 5 * 1024; q += NTHR) { const float v = q < 4096 ? c_in[q] : cctx_in[q - 4096]; st[q] = fsilu(v); }
        __syncthreads();
        if (gw % 5 == 0 && gw / 5 < 384) {
            const int u = gw / 5, l = u / 96, col = (u % 96) * 64 + lane;
            const float* wp = mod_w + (size_t)l * D * 6144 + col; float a0 = 0.f, a1 = 0.f, a2 = 0.f, a3 = 0.f, a4 = 0.f;
            for (int k0 = 0; k0 < D; k0 += 64) { float wv[64];
#pragma unroll
                for (int kk = 0; kk < 64; ++kk) wv[kk] = __builtin_nontemporal_load(wp + (size_t)(k0 + kk) * 6144);
#pragma unroll
                for (int kk = 0; kk < 64; ++kk) { const int k = k0 + kk; a0 += st[k] * wv[kk]; a1 += st[1024 + k] * wv[kk]; a2 += st[2048 + k] * wv[kk]; a3 += st[3072 + k] * wv[kk]; a4 += st[4096 + k] * wv[kk]; } }
            const float bv = mod_b[l * 6144 + col]; float* mo = MOD + (size_t)l * 5 * 6144 + col;
            mo[0] = a0 + bv; mo[6144] = a1 + bv; mo[2 * 6144] = a2 + bv; mo[3 * 6144] = a3 + bv; mo[4 * 6144] = a4 + bv;
        }
        for (int q = gw * 64 + lane; q < 4096 * 32; q += NGW * 64) {
            { const int t = q >> 5, j = q & 31, ax = j >> 4, i = j & 15; const float pos = (float)(ax == 0 ? (t >> 6) : (t & 63)); const float a = pos * powf(10000.f, -((float)i * 2.f) / 32.f); cosA[q] = cosf(a); sinA[q] = sinf(a); }
            if (q < 4096 * 16) { const int t = q >> 4, j = q & 15, ax = j >> 3, i = j & 7; const float pos = (float)(ax == 0 ? (t >> 6) : (t & 63)); const float a = pos * powf(10000.f, -((float)i * 2.f) / 16.f); cosC[q] = cosf(a); sinC[q] = sinf(a); }
        }
        { const float* rw = args.in[26];
          for (int q = gw * 64 + lane; q < 4 * 32 * 1024; q += NGW * 64) { const int l = q >> 15, e = (q >> 10) & 31, k = q & 1023; const float wv = rw[((size_t)l * 1024 + k) * 32 + e];
              const unsigned hb = pk2(wv, 0.f) & 0xffffu; const float hf = __uint_as_float(hb << 16); const unsigned lb = pk2(wv - hf, 0.f) & 0xffffu;
              WR[((size_t)(l * 2 + 0) * 32 + e) * 1024 + k] = (bf16)hb; WR[((size_t)(l * 2 + 1) * 32 + e) * 1024 + k] = (bf16)lb; } }
        LAS float* scr = (LAS float*)(lds + wave * 8448);
        cvt_matrix<LAY_INA>(args.in[8], (size_t)D * 1792, 1792, 1792, 1024, 7, 14, WINA, nullptr, scr, gw, NGW, lane);
        cvt_matrix<LAY_F32>(args.in[9], (size_t)D * 1024, 1024, 1024, 1024, 4, 8, WOUTA, nullptr, scr, gw, NGW, lane);
        cvt_matrix<LAY_STD>(args.in[17], (size_t)D * 1056, 1056, 1056, 1024, 5, 10, WINC, nullptr, scr, gw, NGW, lane);
        cvt_matrix<LAY_STD>(args.in[20], (size_t)768 * 1536, 1536, 1536, 768, 6, 6, WQB, args.in[18], scr, gw, NGW, lane);
        cvt_matrix<LAY_STD>(args.in[20] + (size_t)768 * 1536, 0, 1536, 1536, 768, 6, 6, WQB + (size_t)1536 * 768, args.in[18] + 768, scr, gw, NGW, lane);
        cvt_matrix<LAY_HEAD2>(args.in[21], (size_t)256 * 2048, 2048, 2048, 256, 8, 8, WKVB, args.in[19], scr, gw, NGW, lane);
        cvt_matrix<LAY_HEAD2>(args.in[21] + (size_t)256 * 2048, 0, 2048, 2048, 256, 8, 8, WKVB + (size_t)2048 * 256, args.in[19] + 256, scr, gw, NGW, lane);
        cvt_matrix<LAY_F32>(args.in[25], (size_t)D * 1024, 1024, 1024, 1024, 4, 8, WOUTC, nullptr, scr, gw, NGW, lane);
        __syncthreads();
    }
    PH_END;
    if (EN(1) && PH_ON) { PH_LOCALS
        for (int row = gw; row < T; row += NGW) {
            const float* xrow = row < NL ? x_in + (size_t)row * D : ctx_in + (size_t)(row - NL) * D; const float* mn = MOD + (size_t)modrow(row) * 6144;
            f32x4 v[2][2]; float ss = 0.f;
#pragma unroll
            for (int j = 0; j < 2; ++j)
#pragma unroll
                for (int q = 0; q < 2; ++q) { v[j][q] = *(const f32x4*)(xrow + 8 * lane + 512 * j + 4 * q); ss += (v[j][q][0] * v[j][q][0] + v[j][q][1] * v[j][q][1]) + (v[j][q][2] * v[j][q][2] + v[j][q][3] * v[j][q][3]); }
            const float rstd = rsqrtf(wave_sum(ss) * (1.f / D) + EPS);
#pragma unroll
            for (int j = 0; j < 2; ++j) { const int c = 8 * lane + 512 * j; f32x4 o[2];
#pragma unroll
                for (int q = 0; q < 2; ++q) { const f32x4 gg = *(const f32x4*)(norm_mix_g + c + 4 * q), sc = *(const f32x4*)(mn + 1024 + c + 4 * q), sh = *(const f32x4*)(mn + c + 4 * q); o[q] = v[j][q] * rstd * gg * (sc + 1.f) + sh; }
                *(u32x4*)(H + (size_t)row * D + c) = pack8(o[0], o[1]); }
        }
    }
    PH_END;

    for (int layer = 0; layer < 4; ++layer) {
        const bool keep = layer < 3; const int li = layer >> 1; const int nrt = keep ? 68 : 64;
        layer_ = layer;
        if ((layer & 1) == 0) {
            if (EN(2) && PH_ON) { PH_LOCALS
                g8::GemmP g{H, D, WINA + (size_t)li * 1792 * 1024, 1024}; g8::StaticOrder S_; S_.init(68, 7, G, bx);
                EpiInA E{QA, KA, VA, Z, args.in[10] + li * 64, args.in[11] + li * 64, cosA, sinA};
                g8::gemm_phase(lds, g, S_, E);
            }
            PH_END;
            if (EN(3) && PH_ON) { PH_LOCALS
                const int nau = keep ? 544 : 512;
                if (!(PFLAG(1))) {
                    CvtBg bg; bg.init(args.in[28], args.in[30], WGU, WDN, (LAS float*)(lds + 57344 + wave * 8448), 0, layer == 0 ? 1 : 0, vcu, wave);
                    for (int u = vcu; u < nau; u += G) wattn_unit(lds, u, QA, KA, VA, args.in[12] + li * 8, MIX, bg);
                    while (bg.j < bg.jend) { bg.issue(lane); bg.finish(lane); }
                    __syncthreads();
                }
                if (!(PFLAG(2))) {
                    const float* dww = args.in[13] + (size_t)li * 31 * 512; const float* dwb = args.in[14] + li * 512; const float* lng = args.in[15] + li * 512; const float* lnb = args.in[16] + li * 512;
                    conv_strip<64>(lds, (vcu >> 6) * S, S, (vcu & 63) * 64, Z, dww, dwb, lng, lnb, MIX);
                    if (keep) conv_strip<4>(lds, NL + (vcu >> 6) * CL, CL, (vcu & 63) * 4, Z, dww, dwb, lng, lnb, MIX);
                }
            }
            PH_END;
            if (EN(4) && PH_ON) { PH_LOCALS
                g8::GemmP g{MIX, D, WOUTA + (size_t)li * 1024 * 1024, 1024}; g8::StaticOrder S_; S_.init(nrt, 4, G, bx);
                EpiResid E{X, layer == 0 ? x_in : X, layer == 0 ? ctx_in : X + (size_t)NL * D, ML + 2048, SSX};
                g8::gemm_phase(lds, g, S_, E);
            }
            PH_END;
        } else {
            if (EN(5) && PH_ON) { PH_LOCALS
                g8::GemmP g{H, D, WINC + (size_t)li * 1280 * 1024, 1024}; g8::StaticOrder S_; S_.init(68, 5, G, bx);
                EpiP E{P, SSP, KC, args.in[24] + li * 32, cosC, sinC};
                g8::gemm_phase(lds, g, S_, E);
            }
            PH_END;
            if (EN(7) && PH_ON) { PH_LOCALS
#ifndef MK_O3
#define MK_O3 3
#endif
                if ((MK_O3 & 1) && !(PFLAG(16))) { g8::GemmP g{P, PP, WQB + (size_t)li * 1536 * 768, 768}; g8::StaticOrder S_; S_.init(nrt, 6, G, bx); EpiBf16 E{QC, 1536, 1536}; g8::gemm_phase(lds, g, S_, E); }
                if ((MK_O3 & 2) && !(PFLAG(32))) { g8::GemmP g{P + 768, PP, WKVB + (size_t)li * 2048 * 256, 256}; g8::StaticOrder S_; S_.init(68, 8, G, bx); EpiKV E{KC, VC, SSP, args.in[23] + li * 64}; g8::gemm_phase(lds, g, S_, E); }
            }
            PH_END;
            if (EN(8) && PH_ON) { PH_LOCALS
                const int nau = keep ? 1088 : 1024;
                CvtBg bg; bg.init(args.in[28], args.in[30], WGU, WDN, (LAS float*)(lds + 57344 + wave * 8448), layer, (PFLAG(8)) ? 0 : ((layer == 1) ? 2 : 1), vcu, wave);
                for (int u = vcu; u < nau; u += G) mla_unit(lds, u, QC, KC, VC, SSP, args.in[22] + li * 96, cosC, sinC, MIX, bg);
                while (bg.j < bg.jend) { bg.issue(lane); bg.finish(lane); }
            }
            PH_END;
            if (EN(9) && PH_ON) { PH_LOCALS
                g8::GemmP g{MIX, D, WOUTC + (size_t)li * 1024 * 1024, 1024}; g8::StaticOrder S_; S_.init(nrt, 4, G, bx);
                EpiResid E{X, X, X + (size_t)NL * D, ML + 2048, SSX};
                g8::gemm_phase(lds, g, S_, E);
            }
            PH_END;
        }
        if (EN(10) && PH_ON) { PH_LOCALS
            LAS int* cntL = (LAS int*)(lds + LDS_TAB); LAS int* baseL = cntL + 32; LAS int* pend = (LAS int*)(lds + LDS_IDX + 10240);
            if (tid < 32) cntL[tid] = 0;
            router_load_table(lds, WR + (size_t)layer * 2 * 32 * 1024, tid);
            __syncthreads();
            int g = -1;
            if (wave < 4) g = bx * 4 + wave; else if (wave == 4 && keep && bx < 64) g = 1024 + bx;
            if (g >= 0) router_group(lds, g, wave, lane, X, SSX, norm_ffn_g + layer * D, ML + (size_t)(g < 1024 ? (g >> 8) : 4) * 6144, args.in[27] + layer * 32, F, GATE);
            __syncthreads();
            if (tid < 32) baseL[tid] = (PFLAG(4)) ? 0 : atomicAdd(CNT + (layer * 32 + tid) * 64, cntL[tid])    ;
            __syncthreads();
            if (tid < 320) { const int wv = tid >> 6; const bool has = (wv < 4) || (wv == 4 && keep && bx < 64);
                if (has) { const int pe = pend[tid], slot = pe & 0x1ffff, e = (pe >> 17) & 31, rl = pe >> 22; LIST[(size_t)e * T + baseL[e] + rl] = slot; } }
            __syncthreads();
        }
        PH_END;
        if (EN(11) && PH_ON) { PH_LOCALS
            moe_setup<8>(lds, CNT + layer * 32 * 64, LIST, layer, vcu, G);
            g8::GemmP g{F, D, WGU, 1024}; g8::MoeOrder<true> S_{(const LAS int*)(lds + LDS_TAB), (const LAS int*)(lds + LDS_IDX)};
            EpiGU E{ACT, args.in[29] + (size_t)layer * 32 * 2048};
            g8::gemm_phase(lds, g, S_, E);
        }
        PH_END;
        if (EN(12) && PH_ON) { PH_LOCALS
            moe_setup<4>(lds, CNT + layer * 32 * 64, LIST, layer, vcu, G);
            g8::GemmP g{ACT, 1024, WDN, 1024}; g8::MoeOrder<false> S_{(const LAS int*)(lds + LDS_TAB), (const LAS int*)(lds + LDS_IDX)};
            EpiDown E{YB, args.in[31] + (size_t)layer * 32 * 1024, GATE, (const LAS int*)(lds + LDS_IDX)};
            g8::gemm_phase(lds, g, S_, E);
        }
        PH_END;
        if (EN(13) && PH_ON) { PH_LOCALS
            const int nrows = keep ? T : NL;
            for (int row = gw; row < nrows; row += NGW)
                combine_row(row, lane, X, YB, ML, norm_mix_g + (layer + 1 < 4 ? layer + 1 : 0) * D, MOD + (size_t)(layer + 1 < 4 ? layer + 1 : 0) * 5 * 6144, layer < 3 ? H : nullptr, layer < 3 ? nullptr : args.out);
        }
        PH_END;
    }
#undef PH_ON
#undef PH_END
}
}

#ifndef MK_MULTI
#define MK_MULTI 0
#endif
#ifndef MK_DEBUG
#define MK_DEBUG 0
#endif
#if MK_DEBUG
namespace dbg {
__global__ void k_cmp_bf(const unsigned short* a, int lda, const float* b, int ldb, int rows, int cols, float s, float* acc, int cp) {
    float d2 = 0.f, r2 = 0.f;
    for (size_t i = (size_t)blockIdx.x * blockDim.x + threadIdx.x; i < (size_t)rows * cols; i += (size_t)gridDim.x * blockDim.x) {
        const size_t r = i / cols, c = i % cols; const float av = __uint_as_float(((unsigned)a[r * lda + c]) << 16), bv = s * b[r * ldb + c]; d2 += (av - bv) * (av - bv); r2 += bv * bv; }
    for (int o = 32; o >= 1; o >>= 1) { d2 += __shfl_xor(d2, o); r2 += __shfl_xor(r2, o); }
    if ((threadIdx.x & 63) == 0) { atomicAdd(acc + 2 * cp, d2); atomicAdd(acc + 2 * cp + 1, r2); }
}
__global__ void k_cmp_f(const float* a, const float* b, size_t n, float* acc, int cp) {
    float d2 = 0.f, r2 = 0.f;
    for (size_t i = (size_t)blockIdx.x * blockDim.x + threadIdx.x; i < n; i += (size_t)gridDim.x * blockDim.x) { const float av = a[i], bv = b[i]; d2 += (av - bv) * (av - bv); r2 += bv * bv; }
    for (int o = 32; o >= 1; o >>= 1) { d2 += __shfl_xor(d2, o); r2 += __shfl_xor(r2, o); }
    if ((threadIdx.x & 63) == 0) { atomicAdd(acc + 2 * cp, d2); atomicAdd(acc + 2 * cp + 1, r2); }
}
__global__ void k_report(const float* acc, int ncp, float thr, float* out) {
    if (blockIdx.x == 0 && threadIdx.x == 0) { int bad = -1; for (int i = 0; i < ncp; ++i) { const float d = acc[2 * i], r = acc[2 * i + 1]; if (!(d <= thr * r)) { bad = i; break; } }
        if (bad >= 0) out[0] += 100.f * (float)(bad + 1); }
}
}
#endif

extern "C" void kernel_launch(void* const* d_in, const int* in_sizes, int n_in, void* d_out, int out_size, void* d_ws, size_t ws_size, hipStream_t stream) {
    using namespace mk;
    static int grid = 0;
    if (grid == 0) {
        int dev = 0, cus = 0, per_cu = 0;
        if (hipGetDevice(&dev) != hipSuccess || hipDeviceGetAttribute(&cus, hipDeviceAttributeMultiprocessorCount, dev) != hipSuccess) { fprintf(stderr, "kernel_launch: device query failed\n"); grid = -1; return; }
        if (hipFuncSetAttribute((const void*)mega, hipFuncAttributeMaxDynamicSharedMemorySize, LDS_BYTES) != hipSuccess) { fprintf(stderr, "kernel_launch: hipFuncSetAttribute(%d B LDS) failed\n", LDS_BYTES); grid = -1; return; }
        if (hipOccupancyMaxActiveBlocksPerMultiprocessor(&per_cu, (const void*)mega, NTHR, LDS_BYTES) != hipSuccess || per_cu < 1) fprintf(stderr, "kernel_launch: occupancy query reports %d blocks per CU\n", per_cu);
        (void)hipGetLastError();
        grid = 256;
        if (cus < 256) { fprintf(stderr, "kernel_launch: %d CUs < 256: the persistent grid would not be resident; nothing launched\n", cus); grid = -1; return; }
        if (n_in != 32 || ws_size < WS_END) { fprintf(stderr, "kernel_launch: n_in %d ws %zu (need %zu)\n", n_in, ws_size, (size_t)WS_END); grid = -1; return; }
    }
    if (grid < 0) return;
    (void)hipMemsetAsync((char*)d_ws + WS_CTL, 0, CTL_BYTES, stream);
    Args a{};
    for (int i = 0; i < 32; ++i) a.in[i] = (const float*)d_in[i];
    a.out = (float*)d_out; a.ws = (unsigned char*)d_ws;
#if !MK_DEBUG
#if MK_MULTI
    for (int p = 0; p < N_PHASES; ++p) { a.lo = p; a.hi = p + 1; hipLaunchKernelGGL(mega, dim3(grid), dim3(NTHR), LDS_BYTES, stream, a); }
#else
    a.lo = 0; a.hi = N_PHASES; hipLaunchKernelGGL(mega, dim3(grid), dim3(NTHR), LDS_BYTES, stream, a);
#ifdef MK_PROBE_PH
    for (int r = 0; r < MK_PROBE_N; ++r) { a.lo = MK_PROBE_PH; a.hi = MK_PROBE_PH + 1; a.flags = MK_PROBE_FLAGS; hipLaunchKernelGGL(mega, dim3(grid), dim3(NTHR), LDS_BYTES, stream, a); }
#endif
#endif
    { const hipError_t le = hipPeekAtLastError(); if (le != hipSuccess) fprintf(stderr, "kernel_launch: launch failed: %s\n", hipGetErrorName(le)); }
#else
#endif
}
```

```cpp
#include <hip/hip_runtime.h>
#include <cstdio>
#include <cstdint>
#define MK_MULTI 0
#define MK_DEBUG 0
#define MK_DBG_THR 1e-3f
namespace mk {
#define LAS __attribute__((address_space(3)))
#define GAS __attribute__((address_space(1)))
typedef unsigned short bf16;
typedef short bf16x8 __attribute__((ext_vector_type(8)));
typedef short s16x4 __attribute__((ext_vector_type(4)));
typedef float f32x2 __attribute__((ext_vector_type(2)));
typedef float f32x4 __attribute__((ext_vector_type(4)));
typedef float f32x16 __attribute__((ext_vector_type(16)));
typedef unsigned u32x2 __attribute__((ext_vector_type(2)));
typedef unsigned u32x4 __attribute__((ext_vector_type(4)));

constexpr int D = 1024, NBATCH = 4, S = 4096, CL = 256, NL = NBATCH * S, NC = NBATCH * CL, T = NL + NC;
constexpr int NWAVES = 8, NTHR = 512;
constexpr float EPS = 1e-6f;
constexpr float LOG2E = 1.4426950408889634f;
constexpr float QSCALE_A = 0.125f * LOG2E;
constexpr float QSCALE_C = 0.10206207261596575f * LOG2E;

constexpr size_t al256(size_t x) { return (x + 255) & ~(size_t)255; }
constexpr size_t CTL_BYTES = 65536;
constexpr int CW_BAR = 1024, CW_CNT = 8192;
constexpr size_t WS_CTL = 0;
constexpr size_t WS_MOD = WS_CTL + CTL_BYTES;
constexpr size_t WS_COSA = WS_MOD + al256((size_t)4 * 5 * 6144 * 4);
constexpr size_t WS_SINA = WS_COSA + 4096 * 32 * 4;
constexpr size_t WS_COSC = WS_SINA + 4096 * 32 * 4;
constexpr size_t WS_SINC = WS_COSC + 4096 * 16 * 4;
constexpr size_t WS_WR = WS_SINC + 4096 * 16 * 4;
constexpr size_t WS_WINA = WS_WR + (size_t)4 * 2 * 32 * 1024 * 2;
constexpr size_t WS_WOUTA = WS_WINA + (size_t)2 * 1792 * 1024 * 2;
constexpr size_t WS_WINC = WS_WOUTA + (size_t)2 * 1024 * 1024 * 2;
constexpr size_t WS_WQB = WS_WINC + (size_t)2 * 1280 * 1024 * 2;
constexpr size_t WS_WKVB = WS_WQB + (size_t)2 * 1536 * 768 * 2;
constexpr size_t WS_WOUTC = WS_WKVB + (size_t)2 * 2048 * 256 * 2;
constexpr size_t WS_WGU = WS_WOUTC + (size_t)2 * 1024 * 1024 * 2;
constexpr size_t WS_WDN = WS_WGU + (size_t)128 * 2048 * 1024 * 2;
constexpr size_t WS_X = WS_WDN + (size_t)128 * 1024 * 1024 * 2;
constexpr size_t WS_H = WS_X + (size_t)T * D * 4;
constexpr size_t WS_QA = WS_H + (size_t)T * D * 2;
constexpr size_t WS_KA = WS_QA + (size_t)T * 512 * 2;
constexpr size_t WS_VA = WS_KA + (size_t)T * 128 * 2;
constexpr size_t WS_Z = WS_VA + (size_t)T * 128 * 2;
constexpr size_t WS_P = WS_Z + (size_t)T * 512 * 2;
constexpr int PP = 1056;
constexpr size_t WS_RS = WS_P + (size_t)T * PP * 2;
constexpr size_t WS_QC = WS_RS + (size_t)T * 2 * 4;
constexpr size_t WS_KC = WS_QC + (size_t)T * 1536 * 2;
constexpr size_t WS_VC = WS_KC + (size_t)T * 1536 * 2;
constexpr size_t WS_MIX = WS_VC + (size_t)T * 1024 * 2;
constexpr size_t WS_F = WS_MIX + (size_t)T * 1024 * 2;
constexpr size_t WS_GATE = WS_F + (size_t)T * 1024 * 2;
constexpr size_t WS_LIST = WS_GATE + (size_t)T * 4 * 4;
constexpr int ACT_ROWS = 304 * 256;
constexpr size_t WS_ACT = WS_LIST + (size_t)32 * T * 4;
constexpr size_t WS_YB = WS_ACT + (size_t)ACT_ROWS * 1024 * 2;
constexpr size_t WS_SSX = WS_YB + (size_t)T * 4 * 1024 * 2;
constexpr size_t WS_SSP = WS_SSX + (size_t)T * 16 * 4;
constexpr size_t WS_END = WS_SSP + (size_t)T * 16 * 4;

constexpr int STAGE_BYTES = 131072;
constexpr int LDS_IDX = 131072;
constexpr int MAXU = 12;
constexpr int LDS_TAB = LDS_IDX + MAXU * 1024;
constexpr int LDS_MISC = LDS_TAB + 1024;
constexpr int LDS_BYTES = LDS_MISC + 256;

__device__ __forceinline__ unsigned pk2(float lo, float hi) {
    typedef __bf16 bf2 __attribute__((ext_vector_type(2)));
    return __builtin_bit_cast(unsigned, __builtin_convertvector((f32x2){lo, hi}, bf2));
}
__device__ __forceinline__ float bflo(unsigned u) { return __uint_as_float(u << 16); }
__device__ __forceinline__ float bfhi(unsigned u) { return __uint_as_float(u & 0xffff0000u); }
__device__ __forceinline__ float bf1(bf16 u) { return __uint_as_float(((unsigned)u) << 16); }
__device__ __forceinline__ float fsigm(float v) { return __builtin_amdgcn_rcpf(1.f + __builtin_amdgcn_exp2f(-1.4426950408889634f * v)); }
__device__ __forceinline__ float fsilu(float v) { return v * fsigm(v); }
__device__ __forceinline__ int modrow(int row) { return row < NL ? (row >> 12) : 4; }
#define WS_DPP(v, ctrl) ((v) + __int_as_float(__builtin_amdgcn_update_dpp(0, __float_as_int(v), (ctrl), 0xF, 0xF, false)))
__device__ __forceinline__ float wave_sum(float v) {
    v = WS_DPP(v, 0xB1); v = WS_DPP(v, 0x4E); v = WS_DPP(v, 0x141); v = WS_DPP(v, 0x140);
    v += __shfl_xor(v, 16); v += __shfl_xor(v, 32);
    return v;
}
__device__ __forceinline__ int otid() { int t = threadIdx.x; asm volatile("" : "+v"(t)); return t; }
#define LDS_WAIT() asm volatile("s_waitcnt lgkmcnt(0)" ::: "memory")
#define VM_WAIT() asm volatile("s_waitcnt vmcnt(0)" ::: "memory")

#define XB_TMO      128
#define XB_XCNT(j)  (256  + 64 * (j))
#define XB_XSUB(j)  (1280 + 64 * (j))
#define XB_XGEN(j)  (2304 + 64 * (j))
#define XB_TOP      3328
#define XB_TOPGEN   3392
#define XCD_BAR_WORDS 3456
#define XB_SPIN_CAP (1u << 18)
__device__ __forceinline__ unsigned xb_ld(unsigned* p)              { return __hip_atomic_load(p, __ATOMIC_RELAXED, __HIP_MEMORY_SCOPE_AGENT); }
__device__ __forceinline__ unsigned xb_add(unsigned* p, unsigned v) { return __hip_atomic_fetch_add(p, v, __ATOMIC_RELAXED, __HIP_MEMORY_SCOPE_AGENT); }
__device__ __forceinline__ unsigned xb_xcc_id() { return (unsigned)__builtin_amdgcn_s_getreg((3 << 11) | 20) & 0xFu; }
#define XB_SPIN(cond, bar) do { unsigned _sp = 0; while (cond) { __builtin_amdgcn_s_sleep(1); \
    if ((++_sp & 255u) == 0u) { if (xb_ld(&(bar)[XB_TMO])) break; if (_sp > XB_SPIN_CAP) { atomicAdd(&(bar)[XB_TMO], 1u); break; } } } } while (0)
struct XcdBarrier { unsigned* bar; unsigned x; volatile LAS unsigned* st; };
__device__ __forceinline__ XcdBarrier xcd_barrier_post(unsigned* bar, volatile LAS unsigned* st) {
    XcdBarrier b; b.bar = bar; b.x = xb_xcc_id(); b.st = st;
    if (threadIdx.x == 0) (void)xb_add(&bar[XB_XCNT(b.x)], 1u);
    return b;
}
__device__ __forceinline__ void xcd_barrier_complete(unsigned* bar, unsigned x, unsigned& nloc, unsigned& nx) {
    const unsigned G = gridDim.x * gridDim.y * gridDim.z;
    unsigned sum, cnt, mine, sp = 0u;
    for (;;) {
        sum = 0u; cnt = 0u; mine = 0u;
#pragma unroll
        for (unsigned j = 0; j < 16; ++j) { const unsigned c = xb_ld(&bar[XB_XCNT(j)]); sum += c; cnt += (c > 0u) ? 1u : 0u; mine = (j == x) ? c : mine; }
        if (sum == G) break;
        __builtin_amdgcn_s_sleep(1);
        if ((++sp & 255u) == 0u) { if (xb_ld(&bar[XB_TMO])) break; if (sp > XB_SPIN_CAP) { atomicAdd(&bar[XB_TMO], 1u); break; } }
    }
    nloc = mine > 0u ? mine : 1u; nx = cnt > 0u ? cnt : 1u;
}
__device__ __forceinline__ void xcd_barrier(const XcdBarrier& b) {
    asm volatile("s_waitcnt vmcnt(0)" ::: "memory");
    __syncthreads();
    if (otid() == 0) {
        unsigned* bar = b.bar;
        __builtin_amdgcn_s_waitcnt(0);
        unsigned nloc = b.st[0], nx = b.st[1];
        if (nloc == 0u) { xcd_barrier_complete(bar, b.x, nloc, nx); b.st[0] = nloc; b.st[1] = nx; }
        const unsigned old = xb_add(&bar[XB_XSUB(b.x)], 1u);
        const unsigned gen = old / nloc;
        if (old + 1u == (gen + 1u) * nloc) {
            __builtin_amdgcn_fence(__ATOMIC_RELEASE, "agent");
            asm volatile("s_waitcnt vmcnt(0)" ::: "memory");
            const unsigned og = xb_add(&bar[XB_TOP], 1u);
            const unsigned tg = og / nx;
            if (og + 1u == (tg + 1u) * nx) xb_add(&bar[XB_TOPGEN], 1u);
            else XB_SPIN(xb_ld(&bar[XB_TOPGEN]) == tg, bar);
            __builtin_amdgcn_fence(__ATOMIC_ACQUIRE, "agent");
            xb_add(&bar[XB_XGEN(b.x)], 1u);
            asm volatile("s_waitcnt vmcnt(0)" ::: "memory");
        } else {
            XB_SPIN(xb_ld(&bar[XB_XGEN(b.x)]) == gen, bar);
            __builtin_amdgcn_fence(__ATOMIC_ACQUIRE, "agent");
            asm volatile("s_waitcnt vmcnt(0)" ::: "memory");
        }
    }
    __syncthreads();
}

namespace g8 {
constexpr int BM = 256, BK = 64, HALF = 128, HTB = HALF * BK * 2, NXCD = 8, WGM = 8;
__host__ __device__ __forceinline__ int lds_byte(int r, int c) { const int st = (r >> 4) * 2 + (c >> 5), rr = r & 15, cc = c & 31, ob = rr * 64 + cc * 2; return st * 1024 + (ob ^ (((ob >> 9) & 1) << 5)); }
__host__ __device__ __forceinline__ void stage_rc(int b, int& R, int& C) { const int st = b / 1024, sb = b % 1024, swz = sb ^ (((sb >> 9) & 1) << 5); R = (st >> 1) * 16 + swz / 64; C = (st & 1) * 32 + (swz % 64) / 2; }

struct Unit { int pm, pn, e, nt, gm, slot; };
struct GemmP { const bf16* A; int lda; const bf16* Bt; int K; };

struct StaticOrder {
    static constexpr bool GATHER = false;
    int nM, nN, nwg, G, c;
    __device__ void init(int nM_, int nN_, int G_, int c_) { nM = nM_; nN = nN_; nwg = nM * nN; G = G_; c = c_; }
    __device__ __forceinline__ bool next(int i, Unit& u) const {
        const long L = (long)i * G + c; if (L >= nwg) return false;
        int wgid = (int)L; { const int q = nwg / NXCD, r = nwg % NXCD, xcd = wgid % NXCD, off = wgid / NXCD; wgid = (xcd < r ? xcd * (q + 1) : r * (q + 1) + (xcd - r) * q) + off; }
        const int nig = WGM * nN, gid = wgid / nig, fm = gid * WGM, gsz = (nM - fm) < WGM ? (nM - fm) : WGM;
        u.pm = fm + ((wgid % nig) % gsz); u.pn = (wgid % nig) / gsz; u.e = 0; u.nt = u.pn; u.gm = u.pm; u.slot = 0; return true;
    }
    __device__ __forceinline__ int arow(const Unit& u, int r) const { return u.pm * BM + r; }
};
template <bool GATHER_> struct MoeOrder {
    static constexpr bool GATHER = GATHER_;
    const LAS int* tab; const LAS int* idx;
    __device__ __forceinline__ bool next(int i, Unit& u) const {
        if (i >= tab[127]) return false;
        u.gm = tab[128 + 4 * i]; u.pn = tab[129 + 4 * i]; u.e = tab[130 + 4 * i]; u.nt = tab[131 + 4 * i]; u.slot = i; u.pm = u.gm; return true;
    }
    __device__ __forceinline__ int arow(const Unit& u, int r) const {
        if (GATHER_) { const int s = idx[u.slot * 256 + r]; return s < 0 ? 0 : (s >> 2); }
        return u.gm * BM + r;
    }
};

template <class Epi, class Sched>
__device__ __forceinline__ void gemm_phase(LAS unsigned char* lds, const GemmP g, const Sched& S, const Epi& E) {
    const int tid = otid(), wid = __builtin_amdgcn_readfirstlane(tid >> 6), lane = tid & 63, wr = wid >> 2, wc = wid & 3, fr = lane & 15, fq = lane >> 4;
    const int K = g.K, nt = K / BK;
    int RR[2], CC[2]; unsigned voffB[2], voffA[2];
    const unsigned lda2 = (unsigned)g.lda * 2u;
#pragma unroll
    for (int i = 0; i < 2; ++i) { stage_rc(tid * 16 + i * 8192, RR[i], CC[i]); voffB[i] = (unsigned)(RR[i] * K + CC[i]) * 2u; voffA[i] = (unsigned)RR[i] * lda2 + (unsigned)CC[i] * 2u; }
    const size_t hstepA = (size_t)HALF * lda2, tstepA = 2 * hstepA;
    const size_t kstep = (size_t)(BK * 2);
    const size_t hstepB = (size_t)HALF * K * 2;
    const size_t tstepB = 2 * hstepB;
    const unsigned ldsw = (unsigned)wid * 1024u;
    const int aoff = lds_byte(wr * 64 + fr, fq * 8), boff = lds_byte(wc * 32 + fr, fq * 8);
#define G8_SA(b, h) (((b) * 2 + (h)) * HTB)
#define G8_SB(b, h) ((4 + (b) * 2 + (h)) * HTB)
#define G8_STAGE(bufoff, gbase, voff) do { _Pragma("unroll") for (int _i = 0; _i < 2; ++_i) \
        __builtin_amdgcn_global_load_lds((const unsigned*)((const char*)(gbase) + (voff)[_i]), (LAS unsigned*)(lds + (bufoff) + ldsw + _i * 8192), 16, 0, 0); } while (0)
#define G8_LDA(dst, b, h) do { _Pragma("unroll") for (int m = 0; m < 4; ++m) _Pragma("unroll") for (int k = 0; k < 2; ++k) dst[m][k] = *(const LAS bf16x8*)(lds + G8_SA(b, h) + aoff + m * 2048 + k * 1024); } while (0)
#define G8_LDB(dst, b, h) do { _Pragma("unroll") for (int n = 0; n < 2; ++n) _Pragma("unroll") for (int k = 0; k < 2; ++k) dst[n][k] = *(const LAS bf16x8*)(lds + G8_SB(b, h) + boff + n * 2048 + k * 1024); } while (0)
#define G8_MMA(ai, bj, At, Bt) do { __builtin_amdgcn_s_setprio(1); _Pragma("unroll") for (int m = 0; m < 4; ++m) _Pragma("unroll") for (int n = 0; n < 2; ++n) _Pragma("unroll") for (int k = 0; k < 2; ++k) \
        acc[ai][bj][m][n] = __builtin_amdgcn_mfma_f32_16x16x32_bf16(Bt[n][k], At[m][k], acc[ai][bj][m][n], 0, 0, 0); __builtin_amdgcn_s_setprio(0); } while (0)
#define G8_WAIT_V(n) asm volatile("s_waitcnt vmcnt(" #n ")" ::: "memory")
#define G8_WAIT_L(n) asm volatile("s_waitcnt lgkmcnt(" #n ")" ::: "memory")
#define G8_BAR __builtin_amdgcn_s_barrier()
#define G8_SCHED __builtin_amdgcn_sched_barrier(0)
#define G8_MKOFF(u, o) do { if constexpr (Sched::GATHER) { _Pragma("unroll") for (int _i = 0; _i < 2; ++_i) { int _R, _C; stage_rc(tid * 16 + _i * 8192, _R, _C); \
        _Pragma("unroll") for (int _h = 0; _h < 2; ++_h) o[_h][_i] = (unsigned)S.arow(u, _h * HALF + _R) * lda2 + (unsigned)_C * 2u; } } } while (0)
#define G8_STAGE_A(bufoff, kofs, h, usenext) do { if constexpr (Sched::GATHER) { unsigned _o[2]; _o[0] = (usenext) ? no[h][0] : co[h][0]; _o[1] = (usenext) ? no[h][1] : co[h][1]; G8_STAGE(bufoff, Ab + (kofs), _o); } \
        else { const char* _p = ((usenext) ? nAp : cAp) + (size_t)(h) * hstepA + (kofs); G8_STAGE(bufoff, _p, voffA); } } while (0)
    Unit cur, nxt; int ui = 0;
    if (!S.next(0, cur)) return;
    f32x4 acc[2][2][4][2];
#pragma unroll
    for (int a = 0; a < 2; ++a)
#pragma unroll
        for (int b = 0; b < 2; ++b)
#pragma unroll
            for (int m = 0; m < 4; ++m)
#pragma unroll
                for (int n = 0; n < 2; ++n) acc[a][b][m][n] = (f32x4){0.f, 0.f, 0.f, 0.f};
    bf16x8 At[4][2], B0[2][2], B1[2][2];
    unsigned co[2][2], no[2][2];
    G8_MKOFF(cur, co);
    if (Sched::GATHER) { G8_WAIT_L(0); }
    const char* Ab = (const char*)g.A;
    const char* cAp = Ab + (size_t)cur.pm * tstepA; const char* nAp = cAp;
    const char* cB = (const char*)g.Bt + (size_t)cur.pn * tstepB;
    G8_STAGE(G8_SB(0, 0), cB, voffB); G8_STAGE(G8_SB(0, 1), cB + hstepB, voffB); G8_STAGE_A(G8_SA(0, 0), 0, 0, false); G8_STAGE_A(G8_SA(0, 1), 0, 1, false);
    if (wr == 1) G8_BAR;
    G8_WAIT_V(2); G8_BAR;
    G8_STAGE(G8_SB(1, 0), cB + kstep, voffB); G8_STAGE_A(G8_SA(1, 0), kstep, 0, false); G8_STAGE(G8_SB(1, 1), cB + hstepB + kstep, voffB);
    G8_WAIT_V(6); G8_BAR;
    for (;;) {
        const bool has_next = S.next(ui + 1, nxt);
        if (has_next) { G8_MKOFF(nxt, no); if (Sched::GATHER) { G8_WAIT_L(0); } nAp = Ab + (size_t)nxt.pm * tstepA; }
        else {
            nAp = cAp;
            if constexpr (Sched::GATHER) {
#pragma unroll
                for (int h = 0; h < 2; ++h)
#pragma unroll
                    for (int i = 0; i < 2; ++i) no[h][i] = co[h][i];
            }
        }
        G8_SCHED;
        const char* nB = has_next ? (const char*)g.Bt + (size_t)nxt.pn * tstepB : cB;
#pragma unroll 1
        for (int t = 0; t < nt; t += 2) {
            const bool last = (t == nt - 2);
            const size_t k1 = (size_t)(t + 1) * kstep, k2 = last ? 0 : (size_t)(t + 2) * kstep, k3 = k2 + kstep;
            const char* b2 = last ? nB : cB + (size_t)(t + 2) * kstep; const char* b3 = b2 + kstep;
            G8_LDB(B0, 0, 0); G8_LDB(B1, 0, 1); G8_SCHED; G8_LDA(At, 0, 0); G8_STAGE_A(G8_SA(1, 1), k1, 1, false);
            G8_WAIT_V(8); G8_WAIT_L(0); G8_BAR; G8_MMA(0, 0, At, B0); G8_MMA(0, 1, At, B1); G8_BAR; G8_SCHED;
            G8_LDA(At, 0, 1); G8_STAGE(G8_SB(0, 0), b2, voffB); G8_STAGE(G8_SB(0, 1), b2 + hstepB, voffB); G8_STAGE_A(G8_SA(0, 0), k2, 0, last);
            G8_WAIT_V(8); G8_WAIT_L(0); G8_BAR; G8_MMA(1, 0, At, B0); G8_MMA(1, 1, At, B1); G8_BAR; G8_SCHED;
            G8_LDB(B0, 1, 0); G8_LDB(B1, 1, 1); G8_SCHED; G8_LDA(At, 1, 0); G8_STAGE_A(G8_SA(0, 1), k2, 1, last);
            G8_WAIT_V(8); G8_WAIT_L(0); G8_BAR; G8_MMA(0, 0, At, B0); G8_MMA(0, 1, At, B1); G8_BAR; G8_SCHED;
            G8_LDA(At, 1, 1); G8_STAGE(G8_SB(1, 0), b3, voffB); G8_STAGE(G8_SB(1, 1), b3 + hstepB, voffB); G8_STAGE_A(G8_SA(1, 0), k3, 0, last);
            G8_WAIT_V(8); G8_WAIT_L(0); G8_BAR; G8_MMA(1, 0, At, B0); G8_MMA(1, 1, At, B1); G8_BAR; G8_SCHED;
        }
        if (wr == 0) G8_BAR;
        E(acc, cur, wr, wc, fr, fq, lds);
        if (!has_next) break;
#pragma unroll
        for (int a = 0; a < 2; ++a)
#pragma unroll
            for (int b = 0; b < 2; ++b)
#pragma unroll
                for (int m = 0; m < 4; ++m)
#pragma unroll
                    for (int n = 0; n < 2; ++n) acc[a][b][m][n] = (f32x4){0.f, 0.f, 0.f, 0.f};
        cur = nxt; cB = nB; cAp = nAp; ++ui;
        if constexpr (Sched::GATHER) {
#pragma unroll
            for (int h = 0; h < 2; ++h)
#pragma unroll
                for (int i = 0; i < 2; ++i) co[h][i] = no[h][i];
        }
        if (wr == 1) G8_BAR;
    }
    G8_WAIT_V(0);
    G8_BAR;
#undef G8_SA
#undef G8_SB
#undef G8_STAGE
#undef G8_LDA
#undef G8_LDB
#undef G8_MMA
#undef G8_WAIT_V
#undef G8_WAIT_L
#undef G8_BAR
#undef G8_SCHED
#undef G8_MKOFF
#undef G8_STAGE_A
}
}

using g8::Unit;
typedef f32x4 Acc[2][2][4][2];
__device__ __forceinline__ u32x4 pack8(const f32x4 a, const f32x4 b) { u32x4 w; w.x = pk2(a[0], a[1]); w.y = pk2(a[2], a[3]); w.z = pk2(b[0], b[1]); w.w = pk2(b[2], b[3]); return w; }

struct EpiInA {
    bf16 *Qa, *Ka, *Va, *Z; const float *qg, *kg, *cosA, *sinA;
    __device__ __forceinline__ void operator()(const Acc& acc, const Unit& u, int wr, int wc, int fr, int fq, LAS unsigned char*) const {
        const int row0 = u.pm * 256 + wr * 64 + fr, pn = u.pn, a = fq >> 1, b = fq & 1;
        if (pn < 3) {
            const bool isv = (pn == 2 && wc >= 2), isq = pn < 2;
            const int dbase = 32 * a + 8 * b;
            if (isv) {
#pragma unroll
                for (int ai = 0; ai < 2; ++ai)
#pragma unroll
                    for (int m = 0; m < 4; ++m) { const int row = row0 + ai * 128 + m * 16; bf16* o = Va + (size_t)row * 128 + (wc - 2) * 64 + dbase;
#pragma unroll
                        for (int bj = 0; bj < 2; ++bj) *(u32x4*)(o + 16 * bj) = pack8(acc[ai][bj][m][0], acc[ai][bj][m][1]); }
                return;
            }
            const float* g = isq ? qg : kg;
            f32x4 gv[2][2];
#pragma unroll
            for (int bj = 0; bj < 2; ++bj)
#pragma unroll
                for (int n = 0; n < 2; ++n) gv[bj][n] = *(const f32x4*)(g + dbase + 16 * bj + 4 * n);
            const float sc = isq ? QSCALE_A : 1.f;
            bf16* obase = isq ? (Qa + (pn * 4 + wc) * 64 + dbase) : (Ka + wc * 64 + dbase);
            const int opitch = isq ? 512 : 128;
            f32x4 cc[2], sn[2], cn[2], snn[2];
            { const int t = row0 & 4095;
#pragma unroll
              for (int n = 0; n < 2; ++n) { cc[n] = *(const f32x4*)(cosA + t * 32 + 16 * a + 8 * b + 4 * n); sn[n] = *(const f32x4*)(sinA + t * 32 + 16 * a + 8 * b + 4 * n); } }
#pragma unroll
            for (int gidx = 0; gidx < 8; ++gidx) {
                    const int ai = gidx >> 2, m = gidx & 3;
                    const int row = row0 + ai * 128 + m * 16;
                    if (gidx < 7) { const int tn = (row0 + ((gidx + 1) >> 2) * 128 + ((gidx + 1) & 3) * 16) & 4095;
#pragma unroll
                        for (int n = 0; n < 2; ++n) { cn[n] = *(const f32x4*)(cosA + tn * 32 + 16 * a + 8 * b + 4 * n); snn[n] = *(const f32x4*)(sinA + tn * 32 + 16 * a + 8 * b + 4 * n); } }
                    float ss = 0.f;
#pragma unroll
                    for (int bj = 0; bj < 2; ++bj)
#pragma unroll
                        for (int n = 0; n < 2; ++n) { const f32x4 v = acc[ai][bj][m][n]; ss += (v[0] * v[0] + v[1] * v[1]) + (v[2] * v[2] + v[3] * v[3]); }
                    ss += __shfl_xor(ss, 16); ss += __shfl_xor(ss, 32);
                    const float rs = rsqrtf(ss * (1.f / 64.f) + EPS);
                    f32x4 y[2][2];
#pragma unroll
                    for (int bj = 0; bj < 2; ++bj)
#pragma unroll
                        for (int n = 0; n < 2; ++n) y[bj][n] = acc[ai][bj][m][n] * rs * gv[bj][n];
                    if (row < NL) {
#pragma unroll
                        for (int n = 0; n < 2; ++n) { const f32x4 y0 = y[0][n], y1 = y[1][n]; y[0][n] = y0 * cc[n] - y1 * sn[n]; y[1][n] = y1 * cc[n] + y0 * sn[n]; }
                    }
                    bf16* o = obase + (size_t)row * opitch;
#pragma unroll
                    for (int bj = 0; bj < 2; ++bj) *(u32x4*)(o + 16 * bj) = pack8(y[bj][0] * sc, y[bj][1] * sc);
                    asm volatile("" ::: "memory");
#pragma unroll
                    for (int n = 0; n < 2; ++n) { cc[n] = cn[n]; sn[n] = snn[n]; }
            }
        } else {
            const int j0 = 128 * (pn - 3) + 32 * wc + 8 * fq;
#pragma unroll
            for (int ai = 0; ai < 2; ++ai)
#pragma unroll
                for (int m = 0; m < 4; ++m) {
                    const int row = row0 + ai * 128 + m * 16; f32x4 z[2];
#pragma unroll
                    for (int n = 0; n < 2; ++n) { const f32x4 av = acc[ai][0][m][n], gt = acc[ai][1][m][n];
#pragma unroll
                        for (int r = 0; r < 4; ++r) z[n][r] = av[r] * fsigm(gt[r]); }
                    *(u32x4*)(Z + (size_t)row * 512 + j0) = pack8(z[0], z[1]);
                }
        }
    }
};
struct EpiResid {
    float* X; const float* Xlat; const float* Xctx; const float* gmod; float* SSX;
    __device__ __forceinline__ void operator()(const Acc& acc, const Unit& u, int wr, int wc, int fr, int fq, LAS unsigned char*) const {
        const int row0 = u.pm * 256 + wr * 64 + fr; const int mr = u.pm < 64 ? (u.pm >> 4) : 4;
        const float* gp = gmod + (size_t)mr * 6144; const float* src = u.pm < 64 ? Xlat : Xctx - (size_t)NL * D;
        float ssr[2][4];
#pragma unroll
        for (int ai = 0; ai < 2; ++ai)
#pragma unroll
            for (int m = 0; m < 4; ++m) ssr[ai][m] = 0.f;
#pragma unroll
        for (int bj = 0; bj < 2; ++bj) {
            const int c0 = 256 * u.pn + 128 * bj + 32 * wc + 4 * fq;
            const f32x4 g0 = *(const f32x4*)(gp + c0), g1 = *(const f32x4*)(gp + c0 + 16);
#pragma unroll
            for (int ai = 0; ai < 2; ++ai) {
                f32x4 xo[4][2];
#pragma unroll
                for (int m = 0; m < 4; ++m) { const float* xp = src + (size_t)(row0 + ai * 128 + m * 16) * D + c0; xo[m][0] = *(const f32x4*)xp; xo[m][1] = *(const f32x4*)(xp + 16); }
#pragma unroll
                for (int m = 0; m < 4; ++m) { float* op = X + (size_t)(row0 + ai * 128 + m * 16) * D + c0;
                    const f32x4 y0 = xo[m][0] + g0 * acc[ai][bj][m][0], y1 = xo[m][1] + g1 * acc[ai][bj][m][1];
                    *(f32x4*)op = y0; *(f32x4*)(op + 16) = y1;
                    ssr[ai][m] += (y0[0] * y0[0] + y0[1] * y0[1]) + (y0[2] * y0[2] + y0[3] * y0[3]) + (y1[0] * y1[0] + y1[1] * y1[1]) + (y1[2] * y1[2] + y1[3] * y1[3]); }
                asm volatile("" ::: "memory");
            }
        }
#pragma unroll
        for (int ai = 0; ai < 2; ++ai)
#pragma unroll
            for (int m = 0; m < 4; ++m) { float ss = ssr[ai][m]; ss += __shfl_xor(ss, 16); ss += __shfl_xor(ss, 32);
                if (fq == 0) SSX[(size_t)(row0 + ai * 128 + m * 16) * 16 + 4 * u.pn + wc] = ss; }
    }
};
struct EpiBf16 {
    bf16* O; int ldo, ncols;
    __device__ __forceinline__ void operator()(const Acc& acc, const Unit& u, int wr, int wc, int fr, int fq, LAS unsigned char*) const {
        const int row0 = u.pm * 256 + wr * 64 + fr;
#pragma unroll
        for (int bj = 0; bj < 2; ++bj) {
            const int c0 = 256 * u.pn + 128 * bj + 32 * wc + 8 * fq;
            if (c0 < ncols) {
#pragma unroll
                for (int ai = 0; ai < 2; ++ai)
#pragma unroll
                    for (int m = 0; m < 4; ++m) *(u32x4*)(O + (size_t)(row0 + ai * 128 + m * 16) * ldo + c0) = pack8(acc[ai][bj][m][0], acc[ai][bj][m][1]);
            }
        }
    }
};
struct EpiP {
    bf16* P; float* SSP; bf16* Kc; const float* krg; const float* cosC; const float* sinC;
    __device__ __forceinline__ void operator()(const Acc& acc, const Unit& u, int wr, int wc, int fr, int fq, LAS unsigned char*) const {
        const int row0 = u.pm * 256 + wr * 64 + fr;
        if (u.pn < 4) {
#pragma unroll
            for (int ai = 0; ai < 2; ++ai)
#pragma unroll
                for (int m = 0; m < 4; ++m) { const int row = row0 + ai * 128 + m * 16; float ss = 0.f;
#pragma unroll
                    for (int bj = 0; bj < 2; ++bj) { const f32x4 y0 = acc[ai][bj][m][0], y1 = acc[ai][bj][m][1];
                        *(u32x4*)(P + (size_t)row * PP + 256 * u.pn + 128 * bj + 32 * wc + 8 * fq) = pack8(y0, y1);
                        ss += (y0[0] * y0[0] + y0[1] * y0[1]) + (y0[2] * y0[2] + y0[3] * y0[3]) + (y1[0] * y1[0] + y1[1] * y1[1]) + (y1[2] * y1[2] + y1[3] * y1[3]); }
                    ss += __shfl_xor(ss, 16); ss += __shfl_xor(ss, 32);
                    if (fq == 0) SSP[(size_t)row * 16 + 4 * u.pn + wc] = ss; }
        } else if (wc == 0) {
            const f32x4 g0 = *(const f32x4*)(krg + 8 * fq), g1 = *(const f32x4*)(krg + 8 * fq + 4);
#pragma unroll
            for (int ai = 0; ai < 2; ++ai)
#pragma unroll
                for (int m = 0; m < 4; ++m) { const int row = row0 + ai * 128 + m * 16; const f32x4 v0 = acc[ai][0][m][0], v1 = acc[ai][0][m][1];
                    *(u32x4*)(P + (size_t)row * PP + 1024 + 8 * fq) = pack8(v0, v1);
                    float ss = (v0[0] * v0[0] + v0[1] * v0[1]) + (v0[2] * v0[2] + v0[3] * v0[3]) + (v1[0] * v1[0] + v1[1] * v1[1]) + (v1[2] * v1[2] + v1[3] * v1[3]);
                    ss += __shfl_xor(ss, 16); ss += __shfl_xor(ss, 32);
                    const float rk = rsqrtf(ss * (1.f / 32.f) + EPS);
                    f32x4 y0 = v0 * rk * g0, y1 = v1 * rk * g1;
                    const int t = row & 4095, ax = fq >> 1;
                    const f32x4 c0 = *(const f32x4*)(cosC + t * 16 + 8 * ax), c1 = *(const f32x4*)(cosC + t * 16 + 8 * ax + 4), s0 = *(const f32x4*)(sinC + t * 16 + 8 * ax), s1 = *(const f32x4*)(sinC + t * 16 + 8 * ax + 4);
                    f32x4 p0, p1;
#pragma unroll
                    for (int j = 0; j < 4; ++j) { p0[j] = __shfl_xor(y0[j], 16); p1[j] = __shfl_xor(y1[j], 16); }
                    if (row < NL) { if ((fq & 1) == 0) { y0 = y0 * c0 - p0 * s0; y1 = y1 * c1 - p1 * s1; } else { y0 = y0 * c0 + p0 * s0; y1 = y1 * c1 + p1 * s1; } }
                    const u32x4 wv = pack8(y0, y1);
#pragma unroll
                    for (int hd = 0; hd < 16; ++hd) *(u32x4*)(Kc + (size_t)row * 1536 + hd * 96 + 64 + 8 * fq) = wv;
                    asm volatile("" ::: "memory"); }
        }
    }
};
struct EpiKV {
    bf16 *Kc, *Vc; const float* SSP; const float* kg;
    __device__ __forceinline__ void operator()(const Acc& acc, const Unit& u, int wr, int wc, int fr, int fq, LAS unsigned char*) const {
        const int row0 = u.pm * 256 + wr * 64 + fr, head = 2 * u.pn + (wc >> 1), dbase = 8 * fq;
        const bool isk = (wc & 1) == 0;
        float rr[2][4];
#pragma unroll
        for (int ai = 0; ai < 2; ++ai)
#pragma unroll
            for (int m = 0; m < 4; ++m) { const f32x4 pq = *(const f32x4*)(SSP + (size_t)(row0 + ai * 128 + m * 16) * 16 + 12); rr[ai][m] = (pq[0] + pq[1]) + (pq[2] + pq[3]); }
        f32x4 gv[2][2];
#pragma unroll
        for (int bj = 0; bj < 2; ++bj)
#pragma unroll
            for (int n = 0; n < 2; ++n) gv[bj][n] = isk ? *(const f32x4*)(kg + dbase + 32 * bj + 4 * n) : (f32x4){1.f, 1.f, 1.f, 1.f};
#pragma unroll
        for (int ai = 0; ai < 2; ++ai)
#pragma unroll
            for (int m = 0; m < 4; ++m) {
                const int row = row0 + ai * 128 + m * 16; const float r = rsqrtf(rr[ai][m] * (1.f / 256.f) + EPS);
                float f = r;
                if (isk) {
                    float ss = 0.f;
#pragma unroll
                    for (int bj = 0; bj < 2; ++bj)
#pragma unroll
                        for (int n = 0; n < 2; ++n) { const f32x4 v = acc[ai][bj][m][n]; ss += (v[0] * v[0] + v[1] * v[1]) + (v[2] * v[2] + v[3] * v[3]); }
                    ss += __shfl_xor(ss, 16); ss += __shfl_xor(ss, 32);
                    f = r * rsqrtf(r * r * ss * (1.f / 64.f) + EPS);
                }
                bf16* o = isk ? (Kc + (size_t)row * 1536 + head * 96 + dbase) : (Vc + (size_t)row * 1024 + head * 64 + dbase);
#pragma unroll
                for (int bj = 0; bj < 2; ++bj) *(u32x4*)(o + 32 * bj) = pack8(acc[ai][bj][m][0] * f * gv[bj][0], acc[ai][bj][m][1] * f * gv[bj][1]);
            }
    }
};
struct EpiGU {
    bf16* ACT; const float* bgu;
    __device__ __forceinline__ void operator()(const Acc& acc, const Unit& u, int wr, int wc, int fr, int fq, LAS unsigned char*) const {
        const int row0 = u.gm * 256 + wr * 64 + fr, j0 = 128 * u.nt + 32 * wc + 8 * fq;
        const float* bp = bgu + (size_t)u.e * 2048;
        f32x4 bg[2], bu[2];
#pragma unroll
        for (int n = 0; n < 2; ++n) { bg[n] = *(const f32x4*)(bp + j0 + 4 * n); bu[n] = *(const f32x4*)(bp + 1024 + j0 + 4 * n); }
#pragma unroll
        for (int ai = 0; ai < 2; ++ai)
#pragma unroll
            for (int m = 0; m < 4; ++m) {
                f32x4 z[2];
#pragma unroll
                for (int n = 0; n < 2; ++n) { const f32x4 gt = acc[ai][0][m][n] + bg[n], up = acc[ai][1][m][n] + bu[n];
#pragma unroll
                    for (int r = 0; r < 4; ++r) { const float gg = fminf(gt[r], 7.f), uu = fminf(fmaxf(up[r], -7.f), 7.f); z[n][r] = (uu + 1.f) * (gg * fsigm(1.702f * gg)); } }
                *(u32x4*)(ACT + (size_t)(row0 + ai * 128 + m * 16) * 1024 + j0) = pack8(z[0], z[1]);
            }
    }
};
struct EpiDown {
    bf16* YB; const float* bdn; const float* gate; const LAS int* idx;
    __device__ __forceinline__ void operator()(const Acc& acc, const Unit& u, int wr, int wc, int fr, int fq, LAS unsigned char*) const {
        const int r0 = wr * 64 + fr; const float* bp = bdn + (size_t)u.e * 1024;
        f32x4 bv[2][2]; int c0[2];
#pragma unroll
        for (int bj = 0; bj < 2; ++bj) { c0[bj] = 256 * u.nt + 128 * bj + 32 * wc + 8 * fq; bv[bj][0] = *(const f32x4*)(bp + c0[bj]); bv[bj][1] = *(const f32x4*)(bp + c0[bj] + 4); }
#pragma unroll
        for (int ai = 0; ai < 2; ++ai)
#pragma unroll
            for (int m = 0; m < 4; ++m) {
                const int slot = idx[u.slot * 256 + r0 + ai * 128 + m * 16];
                if (slot >= 0) {
                    const float gw = gate[slot]; bf16* o = YB + (size_t)slot * 1024;
#pragma unroll
                    for (int bj = 0; bj < 2; ++bj) *(u32x4*)(o + c0[bj]) = pack8((acc[ai][bj][m][0] + bv[bj][0]) * gw, (acc[ai][bj][m][1] + bv[bj][1]) * gw);
                }
            }
    }
};

enum { LAY_STD = 0, LAY_HEAD = 1, LAY_INA = 2, LAY_GU = 3, LAY_F32 = 4, LAY_HEAD2 = 5 };
template <int LAY> __device__ __forceinline__ int colmap(int pn, int rho) {
    const int bj = rho >> 7, wc = (rho >> 5) & 3, n = (rho >> 4) & 1, fq = (rho >> 2) & 3, reg = rho & 3;
    const int std_c = 128 * bj + 32 * wc + 8 * fq + 4 * n + reg;
    const int head_c = 64 * wc + 32 * (fq >> 1) + 8 * (fq & 1) + 16 * bj + 4 * n + reg;
    if (LAY == LAY_STD) return 256 * pn + std_c;
    if (LAY == LAY_F32) return 256 * pn + rho;
    if (LAY == LAY_HEAD) return 256 * pn + head_c;
    if (LAY == LAY_HEAD2) return 256 * pn + 64 * wc + 32 * bj + 8 * fq + 4 * n + reg;
    if (LAY == LAY_INA) return pn < 3 ? 256 * pn + head_c : 768 + (bj ? 512 : 0) + 128 * (pn - 3) + 32 * wc + 8 * fq + 4 * n + reg;
    return (bj ? 1024 : 0) + 128 * pn + 32 * wc + 8 * fq + 4 * n + reg;
}
template <int LAY>
__device__ __forceinline__ void cvt_matrix(const float* src, size_t mat_stride, int ld, int nvalid, int K, int tiles_per_mat, int ntiles, bf16* dst, const float* kscale,
                                           LAS float* scr, int it_begin, int it_step, int lane, int it_end = 0x7fffffff) {
    const int kblocks = K / 64; int nitems = ntiles * 8 * kblocks; nitems = nitems < it_end ? nitems : it_end;
    const int gw = it_begin, NGW = it_step;
    const int i = lane & 31, kh = lane >> 5;
    float v[32], vn[32];
#define CVT_LOAD(it_, dstv) do { const int _kb = (it_) % kblocks, _tg = (it_) / kblocks, _grp = _tg & 7, _tile = _tg >> 3; \
        const int _mat = _tile / tiles_per_mat, _pn = _tile - _mat * tiles_per_mat; const int _c = colmap<LAY>(_pn, _grp * 32 + i); const bool _ok = _c < nvalid; \
        const float* _s = src + (size_t)_mat * mat_stride + (size_t)(_kb * 64 + kh) * ld + (_ok ? _c : 0); \
        _Pragma("unroll") for (int ii = 0; ii < 32; ++ii) dstv[ii] = _ok ? _s[(size_t)(2 * ii) * ld] : 0.f; } while (0)
    int it = gw;
    if (it < nitems) CVT_LOAD(it, v);
    for (; it < nitems; it += NGW) {
        const int itn = it + NGW;
        if (itn < nitems) CVT_LOAD(itn, vn);
        const int kb = it % kblocks, tg = it / kblocks, grp = tg & 7, tile = tg >> 3;
        if (kscale) {
#pragma unroll
            for (int ii = 0; ii < 32; ++ii) v[ii] *= kscale[kb * 64 + 2 * ii + kh];
        }
#pragma unroll
        for (int ii = 0; ii < 32; ++ii) scr[(2 * ii + kh) * 33 + i] = v[ii];
        LDS_WAIT(); asm volatile("" ::: "memory");
        const int c8 = lane & 7;
#pragma unroll
        for (int j = 0; j < 4; ++j) { const int n = (lane >> 3) + 8 * j; const LAS float* q = scr + (8 * c8) * 33 + n;
            u32x4 o; o.x = pk2(q[0 * 33], q[1 * 33]); o.y = pk2(q[2 * 33], q[3 * 33]); o.z = pk2(q[4 * 33], q[5 * 33]); o.w = pk2(q[6 * 33], q[7 * 33]);
            *(u32x4*)(dst + ((size_t)tile * 256 + grp * 32 + n) * K + kb * 64 + 8 * c8) = o; }
        LDS_WAIT(); asm volatile("" ::: "memory");
#pragma unroll
        for (int ii = 0; ii < 32; ++ii) v[ii] = vn[ii];
    }
#undef CVT_LOAD
}

struct CvtBg {
    const float* wgu; const float* wdn; bf16* dgu; bf16* ddn; LAS float* scr; int cl0, vcu, j, jend, cur; bool have; f32x4 v[8];
    __device__ __forceinline__ void init(const float* wgu_, const float* wdn_, bf16* dgu_, bf16* ddn_, LAS float* scr_, int cl0_, int nlay, int vcu_, int wave) {
        wgu = wgu_; wdn = wdn_; dgu = dgu_; ddn = ddn_; scr = scr_; cl0 = cl0_; vcu = vcu_; j = wave; jend = nlay * 192; cur = 0; have = false;
#pragma unroll
        for (int q = 0; q < 8; ++q) v[q] = (f32x4){0.f, 0.f, 0.f, 0.f}; }
    __device__ __forceinline__ void decode(int jj, bool& isgu, int& cl, int& it) const { cl = cl0 + jj / 192; const int r = jj % 192; isgu = r < 128; it = isgu ? vcu * 128 + r : vcu * 64 + (r - 128); }
    __device__ __forceinline__ void issue(int lane) {
        if (j >= jend) { have = false; return; }
        bool isgu; int cl, it; decode(j, isgu, cl, it);
        const int c4 = lane & 7, kr = lane >> 3, i0 = 16 * (c4 & 1) + 4 * (c4 >> 1);
        const int kb = it & 15, tg = it >> 4, grp = tg & 7, tile = tg >> 3;
        const float* s;
        if (isgu) { const int mat = tile >> 3, pn = tile & 7; s = wgu + ((size_t)(cl * 32 + mat) * 1024 + kb * 64 + kr) * 2048 + colmap<LAY_GU>(pn, grp * 32 + i0); }
        else { const int mat = tile >> 2, pn = tile & 3; s = wdn + ((size_t)(cl * 32 + mat) * 1024 + kb * 64 + kr) * 1024 + colmap<LAY_STD>(pn, grp * 32 + i0); }
        const size_t ld8 = isgu ? 8 * 2048 : 8 * 1024;
#pragma unroll
        for (int q = 0; q < 8; ++q) v[q] = __builtin_nontemporal_load((const f32x4*)(s + q * ld8));
        cur = j; have = true; j += 8;
    }
    __device__ __forceinline__ void finish(int lane) {
        if (!have) return;
        bool isgu; int cl, it; decode(cur, isgu, cl, it);
        const int c4 = lane & 7, kr = lane >> 3, i0 = 16 * (c4 & 1) + 4 * (c4 >> 1);
        const int kb = it & 15, tg = it >> 4, grp = tg & 7, tile = tg >> 3;
#pragma unroll
        for (int q = 0; q < 8; ++q) { const int kk = 8 * q + kr; scr[kk * 33 + i0] = v[q][0]; scr[kk * 33 + i0 + 1] = v[q][1]; scr[kk * 33 + i0 + 2] = v[q][2]; scr[kk * 33 + i0 + 3] = v[q][3]; }
        LDS_WAIT(); asm volatile("" ::: "memory");
        bf16* d = isgu ? dgu + ((size_t)(cl * 256 + tile) * 256 + grp * 32) * 1024 : ddn + ((size_t)(cl * 128 + tile) * 256 + grp * 32) * 1024;
        const int c8 = lane & 7;
#pragma unroll
        for (int jx = 0; jx < 4; ++jx) { const int n = (lane >> 3) + 8 * jx; const LAS float* q_ = scr + (8 * c8) * 33 + n;
            u32x4 o; o.x = pk2(q_[0 * 33], q_[1 * 33]); o.y = pk2(q_[2 * 33], q_[3 * 33]); o.z = pk2(q_[4 * 33], q_[5 * 33]); o.w = pk2(q_[6 * 33], q_[7 * 33]);
            *(u32x4*)(d + (size_t)n * 1024 + kb * 64 + 8 * c8) = o; }
        LDS_WAIT(); asm volatile("" ::: "memory");
        have = false;
    }
};
struct NoBg { __device__ __forceinline__ void issue(int) {} __device__ __forceinline__ void finish(int) {} };

__device__ __forceinline__ void normmod_store(const f32x4 (&v)[4], float rstd, const float* g, const float* mvec  , int sh_off, int sc_off, bf16* orow, int lane) {
#pragma unroll
    for (int j = 0; j < 4; ++j) { const int c = 4 * lane + 256 * j;
        const f32x4 gg = *(const f32x4*)(g + c), sc = *(const f32x4*)(mvec + sc_off + c), sh = *(const f32x4*)(mvec + sh_off + c);
        const f32x4 y = v[j] * rstd * gg * (sc + 1.f) + sh;
        u32x2 w; w.x = pk2(y[0], y[1]); w.y = pk2(y[2], y[3]); *(u32x2*)(orow + c) = w; }
}

template <int DQK> struct AT {
    static constexpr int CK = DQK / 8, RSK = DQK * 2 + 16, RSV = 192, KT = 64 * RSK, VT = 64 * RSV, STG = KT + VT, NKS = DQK / 16;
};
#define MFMA32(a, b, c) __builtin_amdgcn_mfma_f32_32x32x16_bf16((a), (b), (c), 0, 0, 0)
struct TileList { int nloc, row_loc0, kpos_loc0, row_ctx0, ntiles; };
template <int DQK, bool MASK, class Bg, int CAD>
__device__ __forceinline__ void attn_core(LAS unsigned char* lds, const bf16x8 (&qf)[DQK / 16], const TileList tl, const char* Kg, int kpitchB, const char* Vg, int vpitchB,
                                          int qpos, float& m, float& l, f32x16 (&O)[2], Bg& bg) {
    typedef AT<DQK> A;
    const int tid = otid(), lane = tid & 63, h = lane >> 5;
    const int kr0 = tid / A::CK, kc0 = tid % A::CK;
    const int kr1 = (tid + 512) / A::CK, kc1 = (tid + 512) % A::CK;
    const bool has2 = (DQK == 96) && (tid < 256);
    const int vr = tid >> 3, vc = tid & 7;
    const unsigned kfrag = (unsigned)((lane & 31) * A::RSK + 16 * h);
    const unsigned vfrag = (unsigned)((((lane & 15) >> 2) + 4 * h) * A::RSV + (16 * ((lane >> 4) & 1) + 4 * (lane & 3)) * 2);
    u32x4 rk0, rk1, rv;
    rk1 = (u32x4){0u, 0u, 0u, 0u};
#define AT_ROW0(i) ((i) < tl.nloc ? tl.row_loc0 + 64 * (i) : tl.row_ctx0 + 64 * ((i) - tl.nloc))
#define AT_LOAD(i) do { const int _r0 = AT_ROW0(i); \
        rk0 = *(const u32x4*)(Kg + (size_t)(_r0 + kr0) * kpitchB + kc0 * 16); \
        if (has2) rk1 = *(const u32x4*)(Kg + (size_t)(_r0 + kr1) * kpitchB + kc1 * 16); \
        rv = *(const u32x4*)(Vg + (size_t)(_r0 + vr) * vpitchB + vc * 16); } while (0)
#define AT_WRITE(buf) do { LAS unsigned char* _b = lds + (buf) * A::STG; \
        *(LAS u32x4*)(_b + kr0 * A::RSK + kc0 * 16) = rk0; \
        if (has2) *(LAS u32x4*)(_b + kr1 * A::RSK + kc1 * 16) = rk1; \
        *(LAS u32x4*)(_b + A::KT + vr * A::RSV + vc * 16) = rv; } while (0)
    f32x16 zero16;
#pragma unroll
    for (int r = 0; r < 16; ++r) zero16[r] = 0.f;
    AT_LOAD(0); AT_WRITE(0);
    __syncthreads();
    for (int i = 0; i < tl.ntiles; ++i) {
        const bool more = (i + 1 < tl.ntiles);
        if (more) AT_LOAD(i + 1);
        if ((i & (CAD - 1)) == 0) bg.issue(lane);
        const LAS unsigned char* kt = lds + (i & 1) * A::STG; const LAS unsigned char* vt = kt + A::KT;
        constexpr int KH = A::NKS / 2;
        bf16x8 ka[KH][2];
#pragma unroll
        for (int ks = 0; ks < KH; ++ks) { ka[ks][0] = *(const LAS bf16x8*)(kt + kfrag + 32 * ks); ka[ks][1] = *(const LAS bf16x8*)(kt + kfrag + 32 * A::RSK + 32 * ks); }
        __builtin_amdgcn_sched_barrier(0);
        f32x16 s0 = MFMA32(ka[0][0], qf[0], zero16), s1 = MFMA32(ka[0][1], qf[0], zero16);
#pragma unroll
        for (int ks = 1; ks < KH; ++ks) { s0 = MFMA32(ka[ks][0], qf[ks], s0); s1 = MFMA32(ka[ks][1], qf[ks], s1); }
#pragma unroll
        for (int ks = 0; ks < KH; ++ks) { ka[ks][0] = *(const LAS bf16x8*)(kt + kfrag + 32 * (KH + ks)); ka[ks][1] = *(const LAS bf16x8*)(kt + kfrag + 32 * A::RSK + 32 * (KH + ks)); }
        __builtin_amdgcn_sched_barrier(0);
#pragma unroll
        for (int ks = 0; ks < KH; ++ks) { s0 = MFMA32(ka[ks][0], qf[KH + ks], s0); s1 = MFMA32(ka[ks][1], qf[KH + ks], s1); }
        __builtin_amdgcn_sched_barrier(0);
        s16x4 vlo[2][2], vhi[2][2];
#pragma unroll
        for (int sp = 0; sp < 2; ++sp)
#pragma unroll
            for (int dvb = 0; dvb < 2; ++dvb) { const LAS unsigned char* vp = vt + vfrag + (16 * sp) * A::RSV + 64 * dvb;
                vlo[sp][dvb] = __builtin_amdgcn_ds_read_tr16_b64_v4i16((LAS s16x4*)(vp)); vhi[sp][dvb] = __builtin_amdgcn_ds_read_tr16_b64_v4i16((LAS s16x4*)(vp + 8 * A::RSV)); }
        __builtin_amdgcn_sched_barrier(0);
        if (MASK) {
            if (i < tl.nloc) {
                const int kb = tl.kpos_loc0 + 64 * i + 4 * h - qpos;
#pragma unroll
                for (int r = 0; r < 16; ++r) { const int d0 = kb + (r & 3) + 8 * (r >> 2), d1 = d0 + 32;
                    if (d0 > 128 || d0 < -128) s0[r] = -1e30f; if (d1 > 128 || d1 < -128) s1[r] = -1e30f; }
            }
        }
        float tm = fmaxf(fmaxf(s0[0], s1[0]), fmaxf(s0[1], s1[1]));
#pragma unroll
        for (int r = 2; r < 16; r += 2) tm = fmaxf(tm, fmaxf(fmaxf(s0[r], s1[r]), fmaxf(s0[r + 1], s1[r + 1])));
        tm = fmaxf(tm, __shfl_xor(tm, 32)) - m;
        if (__builtin_amdgcn_ballot_w64(tm > 8.f) != 0ull) {
            const float dlt = fmaxf(tm, 0.f), alpha = __builtin_amdgcn_exp2f(-dlt);
            m += dlt; l *= alpha;
#pragma unroll
            for (int r = 0; r < 16; ++r) { O[0][r] *= alpha; O[1][r] *= alpha; }
        }
        if (__builtin_amdgcn_ballot_w64(m != 0.f) != 0ull) {
#pragma unroll
            for (int r = 0; r < 16; ++r) { s0[r] -= m; s1[r] -= m; }
        }
        float ps = 0.f;
#pragma unroll
        for (int r = 0; r < 16; ++r) { s0[r] = __builtin_amdgcn_exp2f(s0[r]); s1[r] = __builtin_amdgcn_exp2f(s1[r]); ps += s0[r] + s1[r]; }
        l += ps;
#pragma unroll
        for (int kh = 0; kh < 2; ++kh) {
            const f32x16& p = kh ? s1 : s0;
#pragma unroll
            for (int sp = 0; sp < 2; ++sp) {
                u32x4 pw; pw.x = pk2(p[8 * sp + 0], p[8 * sp + 1]); pw.y = pk2(p[8 * sp + 2], p[8 * sp + 3]); pw.z = pk2(p[8 * sp + 4], p[8 * sp + 5]); pw.w = pk2(p[8 * sp + 6], p[8 * sp + 7]);
                const bf16x8 pf = __builtin_bit_cast(bf16x8, pw);
#pragma unroll
                for (int dvb = 0; dvb < 2; ++dvb) { const bf16x8 va = __builtin_shufflevector(vlo[sp][dvb], vhi[sp][dvb], 0, 1, 2, 3, 4, 5, 6, 7); O[dvb] = MFMA32(va, pf, O[dvb]); }
            }
            if (kh == 0) {
#pragma unroll
                for (int sp = 0; sp < 2; ++sp)
#pragma unroll
                    for (int dvb = 0; dvb < 2; ++dvb) { const LAS unsigned char* vp = vt + vfrag + (32 + 16 * sp) * A::RSV + 64 * dvb;
                        vlo[sp][dvb] = __builtin_amdgcn_ds_read_tr16_b64_v4i16((LAS s16x4*)(vp)); vhi[sp][dvb] = __builtin_amdgcn_ds_read_tr16_b64_v4i16((LAS s16x4*)(vp + 8 * A::RSV)); }
            }
        }
        if (more) AT_WRITE((i + 1) & 1);
        if ((i & (CAD - 1)) == CAD - 1) bg.finish(lane);
        __syncthreads();
    }
#undef AT_ROW0
#undef AT_LOAD
#undef AT_WRITE
}
__device__ __forceinline__ void attn_store(const f32x16 (&O)[2], float l, bf16* orow, int h) {
    const float lt = l + __shfl_xor(l, 32); const float inv = 1.f / lt;
#pragma unroll
    for (int dvb = 0; dvb < 2; ++dvb)
#pragma unroll
        for (int g4 = 0; g4 < 4; ++g4) { u32x2 w; w.x = pk2(O[dvb][4 * g4] * inv, O[dvb][4 * g4 + 1] * inv); w.y = pk2(O[dvb][4 * g4 + 2] * inv, O[dvb][4 * g4 + 3] * inv);
            *(u32x2*)(orow + 32 * dvb + 8 * g4 + 4 * h) = w; }
}

__device__ __forceinline__ void wattn_unit(LAS unsigned char* lds, int unit, const bf16* Qa, const bf16* Ka, const bf16* Va, const float* sink, bf16* MIX, CvtBg& bg) {
    const int tid = otid(), w = tid >> 6, lane = tid & 63, h = lane >> 5;
    int b, kvh, hp, tq, qpos; TileList tl;
    if (unit < 512) { b = unit >> 7; kvh = (unit >> 6) & 1; const int nb = (unit >> 1) & 31; hp = unit & 1;
        const int t0 = max(0, 128 * nb - 128), t1 = min(4096, 128 * nb + 256);
        tl.nloc = (t1 - t0) >> 6; tl.row_loc0 = b * S + t0; tl.kpos_loc0 = t0; tl.row_ctx0 = NL + b * CL; tl.ntiles = tl.nloc + 4;
        qpos = 128 * nb + (w & 3) * 32 + (lane & 31); tq = b * S + qpos;
    } else { const int u = unit - 512; b = u >> 3; kvh = (u >> 2) & 1; hp = (u >> 1) & 1; const int half = u & 1;
        tl.nloc = 0; tl.row_loc0 = 0; tl.kpos_loc0 = 0; tl.row_ctx0 = NL + b * CL; tl.ntiles = 4;
        qpos = 0; tq = NL + b * CL + half * 128 + (w & 3) * 32 + (lane & 31); }
    const int hq = kvh * 4 + hp * 2 + (w >> 2);
    bf16x8 qf[4];
#pragma unroll
    for (int ks = 0; ks < 4; ++ks) qf[ks] = *(const bf16x8*)(Qa + (size_t)tq * 512 + hq * 64 + 16 * ks + 8 * h);
    float m = 0.f, l = (h == 0) ? __expf(sink[hq]) : 0.f;
    f32x16 O[2];
#pragma unroll
    for (int r = 0; r < 16; ++r) { O[0][r] = 0.f; O[1][r] = 0.f; }
    attn_core<64, true, CvtBg, 2>(lds, qf, tl, (const char*)(Ka + kvh * 64), 256, (const char*)(Va + kvh * 64), 256, qpos, m, l, O, bg);
    bg.finish(lane);
    attn_store(O, l, MIX + (size_t)tq * 1024 + hq * 64, h);
}
__device__ __forceinline__ void mla_unit(LAS unsigned char* lds, int unit, const bf16* Qc, const bf16* Kc, const bf16* Vc, const float* RS, const float* qg,
                                         const float* cosC, const float* sinC, bf16* MIX, CvtBg& bg) {
    const int tid = otid(), w = tid >> 6, lane = tid & 63, h = lane >> 5;
    int b, head, tq; TileList tl; bool lat;
    if (unit < 1024) { b = unit >> 8; head = (unit >> 4) & 15; const int qb = unit & 15; lat = true;
        tl.nloc = 64; tl.row_loc0 = b * S; tl.kpos_loc0 = 0; tl.row_ctx0 = NL + b * CL; tl.ntiles = 68; tq = b * S + qb * 256 + w * 32 + (lane & 31);
    } else { const int u = unit - 1024; b = u >> 4; head = u & 15; lat = false;
        tl.nloc = 0; tl.row_loc0 = 0; tl.kpos_loc0 = 0; tl.row_ctx0 = NL + b * CL; tl.ntiles = 4; tq = NL + b * CL + w * 32 + (lane & 31); }
    float v[6][8]; float ss = 0.f;
    const bf16* qp = Qc + (size_t)tq * 1536 + head * 96 + 8 * h;
#pragma unroll
    for (int ks = 0; ks < 6; ++ks) { const u32x4 raw = *(const u32x4*)(qp + 16 * ks);
        v[ks][0] = bflo(raw.x); v[ks][1] = bfhi(raw.x); v[ks][2] = bflo(raw.y); v[ks][3] = bfhi(raw.y); v[ks][4] = bflo(raw.z); v[ks][5] = bfhi(raw.z); v[ks][6] = bflo(raw.w); v[ks][7] = bfhi(raw.w);
#pragma unroll
        for (int j = 0; j < 8; ++j) ss += v[ks][j] * v[ks][j]; }
    ss += __shfl_xor(ss, 32);
    float r; { const f32x4 p0 = *(const f32x4*)(RS + (size_t)tq * 16), p1 = *(const f32x4*)(RS + (size_t)tq * 16 + 4), p2 = *(const f32x4*)(RS + (size_t)tq * 16 + 8);
      r = rsqrtf((((p0[0] + p0[1]) + (p0[2] + p0[3])) + ((p1[0] + p1[1]) + (p1[2] + p1[3])) + ((p2[0] + p2[1]) + (p2[2] + p2[3]))) * (1.f / 768.f) + EPS); }
    const float inv = r * rsqrtf(r * r * ss * (1.f / 96.f) + EPS);
#pragma unroll
    for (int ks = 0; ks < 6; ++ks) { const f32x4 g0 = *(const f32x4*)(qg + 16 * ks + 8 * h), g1 = *(const f32x4*)(qg + 16 * ks + 8 * h + 4);
#pragma unroll
        for (int j = 0; j < 4; ++j) { v[ks][j] *= inv * g0[j]; v[ks][4 + j] *= inv * g1[j]; } }
    {
        const int t = tq & 4095;
#pragma unroll
        for (int ax = 0; ax < 2; ++ax) {
            const f32x4 c0 = *(const f32x4*)(cosC + t * 16 + 8 * ax), c1 = *(const f32x4*)(cosC + t * 16 + 8 * ax + 4);
            const f32x4 s0 = *(const f32x4*)(sinC + t * 16 + 8 * ax), s1 = *(const f32x4*)(sinC + t * 16 + 8 * ax + 4);
#pragma unroll
            for (int j = 0; j < 8; ++j) { const float y = v[4 + ax][j], po = __shfl_xor(y, 32); const float c = j < 4 ? c0[j & 3] : c1[j & 3], s = j < 4 ? s0[j & 3] : s1[j & 3];
                const float yr = (h == 0) ? (y * c - po * s) : (y * c + po * s); v[4 + ax][j] = lat ? yr : y; }
        }
    }
    bf16x8 qf[6];
#pragma unroll
    for (int ks = 0; ks < 6; ++ks) { u32x4 pw; pw.x = pk2(v[ks][0] * QSCALE_C, v[ks][1] * QSCALE_C); pw.y = pk2(v[ks][2] * QSCALE_C, v[ks][3] * QSCALE_C);
        pw.z = pk2(v[ks][4] * QSCALE_C, v[ks][5] * QSCALE_C); pw.w = pk2(v[ks][6] * QSCALE_C, v[ks][7] * QSCALE_C); qf[ks] = __builtin_bit_cast(bf16x8, pw); }
    float m = 0.f, l = 0.f;
    f32x16 O[2];
#pragma unroll
    for (int rr = 0; rr < 16; ++rr) { O[0][rr] = 0.f; O[1][rr] = 0.f; }
    attn_core<96, false, CvtBg, 4>(lds, qf, tl, (const char*)(Kc + head * 96), 3072, (const char*)(Vc + head * 64), 2048, 0, m, l, O, bg);
    bg.finish(lane);
    attn_store(O, l, MIX + (size_t)tq * 1024 + head * 64, h);
}

template <int NTOK>
__device__ __forceinline__ void conv_strip(LAS unsigned char* lds, int seq0, int len, int t0, const bf16* Z, const float* dw_w, const float* dw_b, const float* ln_g, const float* ln_b, bf16* MIX) {
    const int tid = otid(), w = tid >> 6, lane = tid & 63;
    constexpr int NROW = NTOK + 30, NCH = NROW * 64, NLD = (NCH + NTHR - 1) / NTHR, NSUB = (NTOK + 15) / 16;
    LAS bf16* zt = (LAS bf16*)lds; LAS float* ot = (LAS float*)(lds + 98304);
    u32x4 st[NLD];
#pragma unroll
    for (int i = 0; i < NLD; ++i) { const int q = tid + i * NTHR, r = q >> 6, cc = q & 63, tt = t0 - 15 + r; st[i] = (u32x4){0u, 0u, 0u, 0u};
        if (q < NCH && tt >= 0 && tt < len) st[i] = *(const u32x4*)(Z + (size_t)(seq0 + tt) * 512 + cc * 8); }
    float wt[31];
#pragma unroll
    for (int j = 0; j < 31; ++j) wt[j] = dw_w[j * 512 + tid];
    const float bias = dw_b[tid];
#pragma unroll
    for (int i = 0; i < NLD; ++i) { const int q = tid + i * NTHR; if (q < NCH) *(LAS u32x4*)(zt + (q >> 6) * 512 + (q & 63) * 8) = st[i]; }
    const f32x4 g0 = *(const f32x4*)(ln_g + 8 * lane), g1 = *(const f32x4*)(ln_g + 8 * lane + 4), b0 = *(const f32x4*)(ln_b + 8 * lane), b1 = *(const f32x4*)(ln_b + 8 * lane + 4);
    __syncthreads();
#pragma unroll 1
    for (int sb = 0; sb < NSUB; ++sb) {
        float acc[16];
#pragma unroll
        for (int t = 0; t < 16; ++t) acc[t] = bias;
        const LAS bf16* zp = zt + sb * 16 * 512 + tid;
        constexpr int NR = (NTOK >= 16 ? 16 : NTOK) + 30;
#pragma unroll
        for (int r = 0; r < NR; ++r) { const float zv = bf1(zp[r * 512]);
#pragma unroll
            for (int t = 0; t < 16; ++t) { const int j = r - t; if (j >= 0 && j < 31 && t < NTOK) acc[t] += zv * wt[j]; } }
#pragma unroll
        for (int t = 0; t < 16; ++t) ot[t * 512 + tid] = acc[t];
        __syncthreads();
#pragma unroll
        for (int q = 0; q < 2; ++q) { const int t = 2 * w + q, tok = sb * 16 + t;
            if (tok < NTOK) {
                const f32x4 x0 = *(const LAS f32x4*)(ot + t * 512 + 8 * lane), x1 = *(const LAS f32x4*)(ot + t * 512 + 8 * lane + 4);
                const float mu = wave_sum((x0[0] + x0[1]) + (x0[2] + x0[3]) + (x1[0] + x1[1]) + (x1[2] + x1[3])) * (1.f / 512.f);
                const f32x4 d0 = x0 - mu, d1 = x1 - mu;
                const float var = wave_sum((d0[0] * d0[0] + d0[1] * d0[1]) + (d0[2] * d0[2] + d0[3] * d0[3]) + (d1[0] * d1[0] + d1[1] * d1[1]) + (d1[2] * d1[2] + d1[3] * d1[3])) * (1.f / 512.f);
                const float rstd = rsqrtf(var + EPS);
                f32x4 y0 = d0 * rstd * g0 + b0, y1 = d1 * rstd * g1 + b1;
#pragma unroll
                for (int j = 0; j < 4; ++j) { y0[j] = fsilu(y0[j]); y1[j] = fsilu(y1[j]); }
                *(u32x4*)(MIX + (size_t)(seq0 + t0 + tok) * 1024 + 512 + 8 * lane) = pack8(y0, y1); } }
        __syncthreads();
    }
}

__device__ __forceinline__ void mla_stats_row(int row, int lane, const bf16* P, const float* krg, const float* cosC, const float* sinC, float* RS, bf16* Kc) {
    const bf16* p = P + (size_t)row * PP;
    const u32x4 a = *(const u32x4*)(p + 8 * lane);
    const u32x4 b = *(const u32x4*)(p + 8 * (lane + 64));
    u32x4 c = (u32x4){0u, 0u, 0u, 0u};
    if (lane < 4) c = *(const u32x4*)(p + 8 * (lane + 128));
    auto sq = [](u32x4 u) { float s = 0.f; s += bflo(u.x) * bflo(u.x) + bfhi(u.x) * bfhi(u.x); s += bflo(u.y) * bflo(u.y) + bfhi(u.y) * bfhi(u.y);
                            s += bflo(u.z) * bflo(u.z) + bfhi(u.z) * bfhi(u.z); s += bflo(u.w) * bflo(u.w) + bfhi(u.w) * bfhi(u.w); return s; };
    const float sa = sq(a), sb = sq(b), sc = sq(c);
    const float ssq = wave_sum(sa + (lane < 32 ? sb : 0.f)), skv = wave_sum(lane >= 32 ? sb : 0.f), skr = wave_sum(sc);
    if (lane == 0) { RS[(size_t)row * 2] = rsqrtf(ssq * (1.f / 768.f) + EPS); RS[(size_t)row * 2 + 1] = rsqrtf(skv * (1.f / 256.f) + EPS); }
    const float rk = rsqrtf(skr * (1.f / 32.f) + EPS);
    float y[8]; const int l4 = lane & 3;
    { const f32x4 g0 = *(const f32x4*)(krg + 8 * l4), g1 = *(const f32x4*)(krg + 8 * l4 + 4);
      y[0] = bflo(c.x) * rk * g0[0]; y[1] = bfhi(c.x) * rk * g0[1]; y[2] = bflo(c.y) * rk * g0[2]; y[3] = bfhi(c.y) * rk * g0[3];
      y[4] = bflo(c.z) * rk * g1[0]; y[5] = bfhi(c.z) * rk * g1[1]; y[6] = bflo(c.w) * rk * g1[2]; y[7] = bfhi(c.w) * rk * g1[3]; }
    const int t = row & 4095, ax = l4 >> 1, half = l4 & 1;
    const f32x4 c0 = *(const f32x4*)(cosC + t * 16 + 8 * ax), c1 = *(const f32x4*)(cosC + t * 16 + 8 * ax + 4), s0 = *(const f32x4*)(sinC + t * 16 + 8 * ax), s1 = *(const f32x4*)(sinC + t * 16 + 8 * ax + 4);
    float o[8];
#pragma unroll
    for (int j = 0; j < 8; ++j) { const float po = __shfl_xor(y[j], 1); const float cc = j < 4 ? c0[j & 3] : c1[j & 3], sn = j < 4 ? s0[j & 3] : s1[j & 3];
        const float yr = half == 0 ? (y[j] * cc - po * sn) : (y[j] * cc + po * sn); o[j] = row < NL ? yr : y[j]; }
    if (lane < 4) { u32x4 wv; wv.x = pk2(o[0], o[1]); wv.y = pk2(o[2], o[3]); wv.z = pk2(o[4], o[5]); wv.w = pk2(o[6], o[7]);
#pragma unroll
        for (int hd = 0; hd < 16; ++hd) *(u32x4*)(Kc + (size_t)row * 1536 + hd * 96 + 64 + 8 * lane) = wv; }
}

template <int NT>
__device__ __forceinline__ void moe_setup(LAS unsigned char* lds, const int* cntG, const int* list, int layer, int vcu, int G) {
    LAS int* tab = (LAS int*)(lds + LDS_TAB); LAS int* idx = (LAS int*)(lds + LDS_IDX);
    const int tid = otid(); constexpr int MG = 32 / NT;
    if (tid < 32) tab[tid] = cntG[tid * 64];
    __syncthreads();
    if (tid == 0) { int acc = 0; for (int e = 0; e < 32; ++e) { tab[32 + e] = acc; acc += (tab[e] + 255) >> 8; } tab[64] = acc;
        int n = 0;
        for (int i = 0; i < MAXU; ++i) { const int v = i * G + vcu, gm = (v >> 5) * MG + (v & 31) / NT, nt = v % NT; if (gm >= acc) break;
            int e = 0; while (e < 31 && tab[33 + e] <= gm) ++e;
            tab[128 + 4 * i] = gm; tab[129 + 4 * i] = (layer * 32 + e) * NT + nt; tab[130 + 4 * i] = e; tab[131 + 4 * i] = nt; n = i + 1; }
        tab[127] = n; }
    __syncthreads();
    const int n = tab[127];
    for (int q = tid; q < n * 256; q += NTHR) { const int i = q >> 8, r = q & 255, gm = tab[128 + 4 * i], e = tab[130 + 4 * i], rr = (gm - tab[32 + e]) * 256 + r;
        idx[q] = rr < tab[e] ? list[(size_t)e * T + rr] : -1; }
    __syncthreads();
}

__device__ __forceinline__ void combine_row(int row, int lane, float* X, const bf16* YB, const float* mcur  , const float* gnext, const float* mnext, bf16* H, float* out) {
    const int mr = modrow(row); const float* mv = mcur + (size_t)mr * 6144 + 5120;
    f32x4 v[2][2]; float ss = 0.f;
    u32x4 y[2][4];
#pragma unroll
    for (int j = 0; j < 2; ++j)
#pragma unroll
        for (int k = 0; k < 4; ++k) y[j][k] = *(const u32x4*)(YB + ((size_t)row * 4 + k) * 1024 + 8 * lane + 512 * j);
#pragma unroll
    for (int j = 0; j < 2; ++j) { const int c = 8 * lane + 512 * j; f32x4 a0 = (f32x4){0.f, 0.f, 0.f, 0.f}, a1 = a0;
#pragma unroll
        for (int k = 0; k < 4; ++k) { a0 += (f32x4){bflo(y[j][k].x), bfhi(y[j][k].x), bflo(y[j][k].y), bfhi(y[j][k].y)}; a1 += (f32x4){bflo(y[j][k].z), bfhi(y[j][k].z), bflo(y[j][k].w), bfhi(y[j][k].w)}; }
        float* xp = X + (size_t)row * D + c; const f32x4 g0 = *(const f32x4*)(mv + c), g1 = *(const f32x4*)(mv + c + 4);
        v[j][0] = *(const f32x4*)xp + g0 * a0; v[j][1] = *(const f32x4*)(xp + 4) + g1 * a1;
        float* op = out ? out + (size_t)row * D + c : xp;
        *(f32x4*)op = v[j][0]; *(f32x4*)(op + 4) = v[j][1];
#pragma unroll
        for (int q = 0; q < 2; ++q) ss += (v[j][q][0] * v[j][q][0] + v[j][q][1] * v[j][q][1]) + (v[j][q][2] * v[j][q][2] + v[j][q][3] * v[j][q][3]); }
    if (H) { const float rstd = rsqrtf(wave_sum(ss) * (1.f / D) + EPS); const float* mn = mnext + (size_t)mr * 6144;
#pragma unroll
        for (int j = 0; j < 2; ++j) { const int c = 8 * lane + 512 * j; f32x4 o[2];
#pragma unroll
            for (int q = 0; q < 2; ++q) { const f32x4 gg = *(const f32x4*)(gnext + c + 4 * q), sc = *(const f32x4*)(mn + 1024 + c + 4 * q), sh = *(const f32x4*)(mn + c + 4 * q); o[q] = v[j][q] * rstd * gg * (sc + 1.f) + sh; }
            *(u32x4*)(H + (size_t)row * D + c) = pack8(o[0], o[1]); } }
}

#define MFMA16(a, b, c) __builtin_amdgcn_mfma_f32_16x16x32_bf16((a), (b), (c), 0, 0, 0)
__device__ __forceinline__ void router_load_table(LAS unsigned char* lds, const bf16* Wr, int tid) {
    u32x4 v[16];
#pragma unroll
    for (int i = 0; i < 16; ++i) v[i] = *(const u32x4*)(Wr + (size_t)(tid + i * NTHR) * 8);
#pragma unroll
    for (int i = 0; i < 16; ++i) { const int q = tid + i * NTHR, row = q >> 7, c = q & 127; *(LAS u32x4*)(lds + row * 2048 + ((c ^ (row & 15)) << 4)) = v[i]; }
}
__device__ __forceinline__ void router_group(LAS unsigned char* lds, int g, int w, int lane, const float* X, const float* SSX, const float* gffn, const float* mvec, const float* rb,
                                             bf16* F, float* gate) {
    LAS float* lg = (LAS float*)(lds + LDS_IDX) + w * 512; LAS int* pend = (LAS int*)(lds + LDS_IDX + 10240) + w * 64; LAS int* cntL = (LAS int*)(lds + LDS_TAB);
    const int i = lane & 15, kq = lane >> 4, row = 16 * g + i;
    const float* xr = X + (size_t)row * D + 8 * kq;
    float ss; { const f32x4 pq = *(const f32x4*)(SSX + (size_t)row * 16 + 4 * kq); ss = (pq[0] + pq[1]) + (pq[2] + pq[3]); }
    ss += __shfl_xor(ss, 16); ss += __shfl_xor(ss, 32);
    const float rstd = rsqrtf(ss * (1.f / D) + EPS);
    f32x4 acc[2] = {(f32x4){0.f, 0.f, 0.f, 0.f}, (f32x4){0.f, 0.f, 0.f, 0.f}};
    const LAS unsigned char* tb = lds + i * 2048;
#pragma unroll 8
    for (int s = 0; s < 32; ++s) {
        const int k = 32 * s + 8 * kq;
        const f32x4 a = *(const f32x4*)(xr + 32 * s), b = *(const f32x4*)(xr + 32 * s + 4);
        const f32x4 g0 = *(const f32x4*)(gffn + k), g1 = *(const f32x4*)(gffn + k + 4), c0 = *(const f32x4*)(mvec + 4096 + k), c1 = *(const f32x4*)(mvec + 4096 + k + 4);
        const f32x4 h0 = *(const f32x4*)(mvec + 3072 + k), h1 = *(const f32x4*)(mvec + 3072 + k + 4);
        const f32x4 f0 = a * rstd * g0 * (c0 + 1.f) + h0, f1 = b * rstd * g1 * (c1 + 1.f) + h1;
        u32x4 hi; hi.x = pk2(f0[0], f0[1]); hi.y = pk2(f0[2], f0[3]); hi.z = pk2(f1[0], f1[1]); hi.w = pk2(f1[2], f1[3]);
        *(u32x4*)(F + (size_t)row * D + k) = hi;
        u32x4 lo; lo.x = pk2(f0[0] - bflo(hi.x), f0[1] - bfhi(hi.x)); lo.y = pk2(f0[2] - bflo(hi.y), f0[3] - bfhi(hi.y));
        lo.z = pk2(f1[0] - bflo(hi.z), f1[1] - bfhi(hi.z)); lo.w = pk2(f1[2] - bflo(hi.w), f1[3] - bfhi(hi.w));
        const bf16x8 ah = __builtin_bit_cast(bf16x8, hi), al = __builtin_bit_cast(bf16x8, lo);
        const int cs = ((4 * s + kq) ^ i) << 4;
#pragma unroll
        for (int et = 0; et < 2; ++et) { const bf16x8 bh = *(const LAS bf16x8*)(tb + et * 16 * 2048 + cs), bl = *(const LAS bf16x8*)(tb + (32 + et * 16) * 2048 + cs);
            acc[et] = MFMA16(ah, bh, acc[et]); acc[et] = MFMA16(al, bh, acc[et]); acc[et] = MFMA16(ah, bl, acc[et]); }
    }
#pragma unroll
    for (int et = 0; et < 2; ++et) { const float bias = rb[16 * et + i];
#pragma unroll
        for (int r = 0; r < 4; ++r) lg[(4 * kq + r) * 32 + 16 * et + i] = acc[et][r] + bias; }
    LDS_WAIT(); asm volatile("" ::: "memory");
    if (lane < 16) {
        const LAS float* my = lg + lane * 32; unsigned used = 0u; int bi[4]; float bv[4];
#pragma unroll
        for (int k = 0; k < 4; ++k) { float best = -3.0e38f; int be = 0;
#pragma unroll
            for (int e = 0; e < 32; ++e) { const float v = my[e]; const bool ok = !((used >> e) & 1u) && v > best; best = ok ? v : best; be = ok ? e : be; }
            used |= 1u << be; bi[k] = be; bv[k] = best; }
        float ex[4], sum = 0.f;
#pragma unroll
        for (int k = 0; k < 4; ++k) { ex[k] = __expf(bv[k] - bv[0]); sum += ex[k]; }
        const float inv = 1.f / sum; const int trow = 16 * g + lane;
#pragma unroll
        for (int k = 0; k < 4; ++k) { const int rl = __hip_atomic_fetch_add(cntL + bi[k], 1, __ATOMIC_RELAXED, __HIP_MEMORY_SCOPE_WORKGROUP);
            pend[lane * 4 + k] = (trow * 4 + k) | (bi[k] << 17) | (rl << 22); gate[trow * 4 + k] = ex[k] * inv; }
    }
}

struct Args { const float* in[32]; float* out; unsigned char* ws; int lo, hi, flags, pad; };
constexpr int N_PHASES = 2 + 2 * (7 + 8);

__global__ void __launch_bounds__(NTHR, 2) mega(Args args) {
    extern __shared__ __attribute__((aligned(16))) unsigned char lds_raw[];
    LAS unsigned char* lds = (LAS unsigned char*)lds_raw;
    const int tid = threadIdx.x, lane = tid & 63, wave = __builtin_amdgcn_readfirstlane(tid >> 6);
    constexpr int G = 256;
    const int bx = blockIdx.x & (G - 1), vcu = (bx % 8) * (G / 8) + bx / 8;
    const int gw = vcu * NWAVES + wave, NGW = G * NWAVES;
    unsigned* ctl = (unsigned*)(args.ws + WS_CTL);
#define PH_LOCALS \
    unsigned zsg_; asm volatile("s_mov_b32 %0, 0" : "=s"(zsg_)); unsigned char* ws = args.ws + zsg_;   const int tid = otid(), lane = tid & 63, wave = __builtin_amdgcn_readfirstlane(tid >> 6), gw = vcu * NWAVES + wave; (void)lane; (void)gw; \
    const float* x_in = args.in[0]; const float* c_in = args.in[1]; const float* ctx_in = args.in[2]; const float* cctx_in = args.in[3]; \
    const float* mod_w = args.in[4]; const float* mod_b = args.in[5]; const float* norm_mix_g = args.in[6]; const float* norm_ffn_g = args.in[7]; \
    float* MOD = (float*)(ws + WS_MOD); float* cosA = (float*)(ws + WS_COSA); float* sinA = (float*)(ws + WS_SINA); float* cosC = (float*)(ws + WS_COSC); float* sinC = (float*)(ws + WS_SINC); \
    bf16* WR = (bf16*)(ws + WS_WR); bf16* WINA = (bf16*)(ws + WS_WINA); bf16* WOUTA = (bf16*)(ws + WS_WOUTA); bf16* WINC = (bf16*)(ws + WS_WINC); bf16* WQB = (bf16*)(ws + WS_WQB); \
    bf16* WKVB = (bf16*)(ws + WS_WKVB); bf16* WOUTC = (bf16*)(ws + WS_WOUTC); bf16* WGU = (bf16*)(ws + WS_WGU); bf16* WDN = (bf16*)(ws + WS_WDN); \
    float* X = (float*)(ws + WS_X); bf16* H = (bf16*)(ws + WS_H); bf16* QA = (bf16*)(ws + WS_QA); bf16* KA = (bf16*)(ws + WS_KA); bf16* VA = (bf16*)(ws + WS_VA); bf16* Z = (bf16*)(ws + WS_Z); \
    bf16* P = (bf16*)(ws + WS_P); float* RS = (float*)(ws + WS_RS); bf16* QC = (bf16*)(ws + WS_QC); bf16* KC = (bf16*)(ws + WS_KC); bf16* VC = (bf16*)(ws + WS_VC); \
    bf16* MIX = (bf16*)(ws + WS_MIX); bf16* F = (bf16*)(ws + WS_F); float* GATE = (float*)(ws + WS_GATE); int* LIST = (int*)(ws + WS_LIST); bf16* ACT = (bf16*)(ws + WS_ACT); bf16* YB = (bf16*)(ws + WS_YB); \
    int* CNT = (int*)(ws + WS_CTL) + CW_CNT; float* SSX = (float*)(ws + WS_SSX); float* SSP = (float*)(ws + WS_SSP); (void)SSX; (void)SSP; const float* ML = MOD + (size_t)layer_ * 5 * 6144; \
    (void)x_in; (void)c_in; (void)ctx_in; (void)cctx_in; (void)mod_w; (void)mod_b; (void)norm_mix_g; (void)norm_ffn_g; (void)MOD; (void)cosA; (void)sinA; (void)cosC; (void)sinC; (void)WR; (void)WINA; (void)WOUTA; \
    (void)WINC; (void)WQB; (void)WKVB; (void)WOUTC; (void)WGU; (void)WDN; (void)X; (void)H; (void)QA; (void)KA; (void)VA; (void)Z; (void)P; (void)RS; (void)QC; (void)KC; (void)VC; (void)MIX; (void)F; (void)GATE; \
    (void)LIST; (void)ACT; (void)YB; (void)CNT; (void)ML;
    if (tid < 64) ((LAS unsigned*)(lds + LDS_MISC))[tid] = 0u;
    __syncthreads();
    const int lo = args.lo, hi = args.hi;
    XcdBarrier bar; bar.bar = ctl + CW_BAR; bar.x = 0; bar.st = nullptr;
    if (hi - lo > 1) bar = xcd_barrier_post(ctl + CW_BAR, (volatile LAS unsigned*)(lds + LDS_MISC));
    int ph = 0; int layer_ = 0;
#ifndef MK_EN
#define MK_EN 0xffffffffu
#endif
#ifdef MK_PROBE_PH
#define PFLAG(b) (args.flags & (b))
#else
#define PFLAG(b) 0
#endif
#define EN(k) (((MK_EN) >> (k)) & 1u)
#define PH_ON (ph >= lo && ph < hi)
#define PH_END do { const bool _b = (ph >= lo) && (ph + 1 < hi); ++ph; if (_b) xcd_barrier(bar); } while (0)

    if (EN(0) && PH_ON) { PH_LOCALS
        LAS float* st = (LAS float*)(lds + 73728);
        for (int q = tid; q < 5 * 1024; q += NTHR) { const float v = q < 4096 ? c_in[q] : cctx_in[q - 4096]; st[q] = fsilu(v); }
        __syncthreads();
        for (int u = vcu; u < 384; u += G) {
            const int l = u / 96, col = (u % 96) * 64 + lane;
            const float* wp = mod_w + ((size_t)l * D + 128 * wave) * 6144 + col; float a0 = 0.f, a1 = 0.f, a2 = 0.f, a3 = 0.f, a4 = 0.f;
#pragma unroll 1
            for (int k0 = 0; k0 < 128; k0 += 64) { float wv[64];
#pragma unroll
                for (int kk = 0; kk < 64; ++kk) wv[kk] = __builtin_nontemporal_load(wp + (size_t)(k0 + kk) * 6144);
#pragma unroll
                for (int kk = 0; kk < 64; ++kk) { const int k = 128 * wave + k0 + kk; a0 += st[k] * wv[kk]; a1 += st[1024 + k] * wv[kk]; a2 += st[2048 + k] * wv[kk]; a3 += st[3072 + k] * wv[kk]; a4 += st[4096 + k] * wv[kk]; } }
            LAS float* part = (LAS float*)(lds + 98304);
            part[(wave * 5 + 0) * 64 + lane] = a0; part[(wave * 5 + 1) * 64 + lane] = a1; part[(wave * 5 + 2) * 64 + lane] = a2; part[(wave * 5 + 3) * 64 + lane] = a3; part[(wave * 5 + 4) * 64 + lane] = a4;
            __syncthreads();
            if (wave < 5) { float s = mod_b[l * 6144 + col];
#pragma unroll
                for (int w8 = 0; w8 < 8; ++w8) s += part[(w8 * 5 + wave) * 64 + lane];
                MOD[((size_t)l * 5 + wave) * 6144 + col] = s; }
            __syncthreads();
        }
        for (int q = gw * 64 + lane; q < 4096 * 32; q += NGW * 64) {
            { const int t = q >> 5, j = q & 31, ax = j >> 4, i = j & 15; const float pos = (float)(ax == 0 ? (t >> 6) : (t & 63)); const float a = pos * powf(10000.f, -((float)i * 2.f) / 32.f); cosA[q] = cosf(a); sinA[q] = sinf(a); }
            if (q < 4096 * 16) { const int t = q >> 4, j = q & 15, ax = j >> 3, i = j & 7; const float pos = (float)(ax == 0 ? (t >> 6) : (t & 63)); const float a = pos * powf(10000.f, -((float)i * 2.f) / 16.f); cosC[q] = cosf(a); sinC[q] = sinf(a); }
        }
        { const float* rw = args.in[26];
          for (int q = gw * 64 + lane; q < 4 * 32 * 1024; q += NGW * 64) { const int l = q >> 15, e = (q >> 10) & 31, k = q & 1023; const float wv = rw[((size_t)l * 1024 + k) * 32 + e];
              const unsigned hb = pk2(wv, 0.f) & 0xffffu; const float hf = __uint_as_float(hb << 16); const unsigned lb = pk2(wv - hf, 0.f) & 0xffffu;
              WR[((size_t)(l * 2 + 0) * 32 + e) * 1024 + k] = (bf16)hb; WR[((size_t)(l * 2 + 1) * 32 + e) * 1024 + k] = (bf16)lb; } }
        LAS float* scr = (LAS float*)(lds + wave * 8448);
        cvt_matrix<LAY_INA>(args.in[8], (size_t)D * 1792, 1792, 1792, 1024, 7, 14, WINA, nullptr, scr, gw, NGW, lane);
        cvt_matrix<LAY_F32>(args.in[9], (size_t)D * 1024, 1024, 1024, 1024, 4, 8, WOUTA, nullptr, scr, gw, NGW, lane);
        cvt_matrix<LAY_STD>(args.in[17], (size_t)D * 1056, 1056, 1056, 1024, 5, 10, WINC, nullptr, scr, gw, NGW, lane);
        cvt_matrix<LAY_STD>(args.in[20], (size_t)768 * 1536, 1536, 1536, 768, 6, 6, WQB, args.in[18], scr, gw, NGW, lane);
        cvt_matrix<LAY_STD>(args.in[20] + (size_t)768 * 1536, 0, 1536, 1536, 768, 6, 6, WQB + (size_t)1536 * 768, args.in[18] + 768, scr, gw, NGW, lane);
        cvt_matrix<LAY_HEAD2>(args.in[21], (size_t)256 * 2048, 2048, 2048, 256, 8, 8, WKVB, args.in[19], scr, gw, NGW, lane);
        cvt_matrix<LAY_HEAD2>(args.in[21] + (size_t)256 * 2048, 0, 2048, 2048, 256, 8, 8, WKVB + (size_t)2048 * 256, args.in[19] + 256, scr, gw, NGW, lane);
        cvt_matrix<LAY_F32>(args.in[25], (size_t)D * 1024, 1024, 1024, 1024, 4, 8, WOUTC, nullptr, scr, gw, NGW, lane);
        __syncthreads();
    }
    PH_END;
    if (EN(1) && PH_ON) { PH_LOCALS
        for (int row = gw; row < T; row += NGW) {
            const float* xrow = row < NL ? x_in + (size_t)row * D : ctx_in + (size_t)(row - NL) * D; const float* mn = MOD + (size_t)modrow(row) * 6144;
            f32x4 v[2][2]; float ss = 0.f;
#pragma unroll
            for (int j = 0; j < 2; ++j)
#pragma unroll
                for (int q = 0; q < 2; ++q) { v[j][q] = *(const f32x4*)(xrow + 8 * lane + 512 * j + 4 * q); ss += (v[j][q][0] * v[j][q][0] + v[j][q][1] * v[j][q][1]) + (v[j][q][2] * v[j][q][2] + v[j][q][3] * v[j][q][3]); }
            const float rstd = rsqrtf(wave_sum(ss) * (1.f / D) + EPS);
#pragma unroll
            for (int j = 0; j < 2; ++j) { const int c = 8 * lane + 512 * j; f32x4 o[2];
#pragma unroll
                for (int q = 0; q < 2; ++q) { const f32x4 gg = *(const f32x4*)(norm_mix_g + c + 4 * q), sc = *(const f32x4*)(mn + 1024 + c + 4 * q), sh = *(const f32x4*)(mn + c + 4 * q); o[q] = v[j][q] * rstd * gg * (sc + 1.f) + sh; }
                *(u32x4*)(H + (size_t)row * D + c) = pack8(o[0], o[1]); }
        }
    }
    PH_END;

    for (int layer = 0; layer < 4; ++layer) {
        const bool keep = layer < 3; const int li = layer >> 1; const int nrt = keep ? 68 : 64;
        layer_ = layer;
        if ((layer & 1) == 0) {
            if (EN(2) && PH_ON) { PH_LOCALS
                g8::GemmP g{H, D, WINA + (size_t)li * 1792 * 1024, 1024}; g8::StaticOrder S_; S_.init(68, 7, G, bx);
                EpiInA E{QA, KA, VA, Z, args.in[10] + li * 64, args.in[11] + li * 64, cosA, sinA};
                g8::gemm_phase(lds, g, S_, E);
            }
            PH_END;
            if (EN(3) && PH_ON) { PH_LOCALS
                const int nau = keep ? 544 : 512;
                if (!(PFLAG(1))) {
                    CvtBg bg; bg.init(args.in[28], args.in[30], WGU, WDN, (LAS float*)(lds + 57344 + wave * 8448), 0, layer == 0 ? 1 : 0, vcu, wave);
                    for (int u = vcu; u < nau; u += G) wattn_unit(lds, u, QA, KA, VA, args.in[12] + li * 8, MIX, bg);
                    while (bg.j < bg.jend) { bg.issue(lane); bg.finish(lane); }
                    __syncthreads();
                }
                if (!(PFLAG(2))) {
                    const float* dww = args.in[13] + (size_t)li * 31 * 512; const float* dwb = args.in[14] + li * 512; const float* lng = args.in[15] + li * 512; const float* lnb = args.in[16] + li * 512;
                    conv_strip<64>(lds, (vcu >> 6) * S, S, (vcu & 63) * 64, Z, dww, dwb, lng, lnb, MIX);
                    if (keep) conv_strip<4>(lds, NL + (vcu >> 6) * CL, CL, (vcu & 63) * 4, Z, dww, dwb, lng, lnb, MIX);
                }
            }
            PH_END;
            if (EN(4) && PH_ON) { PH_LOCALS
                g8::GemmP g{MIX, D, WOUTA + (size_t)li * 1024 * 1024, 1024}; g8::StaticOrder S_; S_.init(nrt, 4, G, bx);
                EpiResid E{X, layer == 0 ? x_in : X, layer == 0 ? ctx_in : X + (size_t)NL * D, ML + 2048, SSX};
                g8::gemm_phase(lds, g, S_, E);
            }
            PH_END;
        } else {
            if (EN(5) && PH_ON) { PH_LOCALS
                g8::GemmP g{H, D, WINC + (size_t)li * 1280 * 1024, 1024}; g8::StaticOrder S_; S_.init(68, 5, G, bx);
                EpiP E{P, SSP, KC, args.in[24] + li * 32, cosC, sinC};
                g8::gemm_phase(lds, g, S_, E);
            }
            PH_END;
            if (EN(7) && PH_ON) { PH_LOCALS
#ifndef MK_O3
#define MK_O3 3
#endif
                if ((MK_O3 & 1) && !(PFLAG(16))) { g8::GemmP g{P, PP, WQB + (size_t)li * 1536 * 768, 768}; g8::StaticOrder S_; S_.init(nrt, 6, G, bx); EpiBf16 E{QC, 1536, 1536}; g8::gemm_phase(lds, g, S_, E); }
                if ((MK_O3 & 2) && !(PFLAG(32))) { g8::GemmP g{P + 768, PP, WKVB + (size_t)li * 2048 * 256, 256}; g8::StaticOrder S_; S_.init(68, 8, G, bx); EpiKV E{KC, VC, SSP, args.in[23] + li * 64}; g8::gemm_phase(lds, g, S_, E); }
            }
            PH_END;
            if (EN(8) && PH_ON) { PH_LOCALS
                const int nau = keep ? 1088 : 1024;
                CvtBg bg; bg.init(args.in[28], args.in[30], WGU, WDN, (LAS float*)(lds + 57344 + wave * 8448), layer, (PFLAG(8)) ? 0 : ((layer == 1) ? 2 : 1), vcu, wave);
                for (int u = vcu; u < nau; u += G) mla_unit(lds, u, QC, KC, VC, SSP, args.in[22] + li * 96, cosC, sinC, MIX, bg);
                while (bg.j < bg.jend) { bg.issue(lane); bg.finish(lane); }
            }
            PH_END;
            if (EN(9) && PH_ON) { PH_LOCALS
                g8::GemmP g{MIX, D, WOUTC + (size_t)li * 1024 * 1024, 1024}; g8::StaticOrder S_; S_.init(nrt, 4, G, bx);
                EpiResid E{X, X, X + (size_t)NL * D, ML + 2048, SSX};
                g8::gemm_phase(lds, g, S_, E);
            }
            PH_END;
        }
        if (EN(10) && PH_ON) { PH_LOCALS
            LAS int* cntL = (LAS int*)(lds + LDS_TAB); LAS int* baseL = cntL + 32; LAS int* pend = (LAS int*)(lds + LDS_IDX + 10240);
            if (tid < 32) cntL[tid] = 0;
            router_load_table(lds, WR + (size_t)layer * 2 * 32 * 1024, tid);
            __syncthreads();
            int g = -1;
            if (wave < 4) g = bx * 4 + wave; else if (wave == 4 && keep && bx < 64) g = 1024 + bx;
            if (g >= 0) router_group(lds, g, wave, lane, X, SSX, norm_ffn_g + layer * D, ML + (size_t)(g < 1024 ? (g >> 8) : 4) * 6144, args.in[27] + layer * 32, F, GATE);
            __syncthreads();
            if (tid < 32) baseL[tid] = (PFLAG(4)) ? 0 : atomicAdd(CNT + (layer * 32 + tid) * 64, cntL[tid])    ;
            __syncthreads();
            if (tid < 320) { const int wv = tid >> 6; const bool has = (wv < 4) || (wv == 4 && keep && bx < 64);
                if (has) { const int pe = pend[tid], slot = pe & 0x1ffff, e = (pe >> 17) & 31, rl = pe >> 22; LIST[(size_t)e * T + baseL[e] + rl] = slot; } }
            __syncthreads();
        }
        PH_END;
        if (EN(11) && PH_ON) { PH_LOCALS
            moe_setup<8>(lds, CNT + layer * 32 * 64, LIST, layer, vcu, G);
            g8::GemmP g{F, D, WGU, 1024}; g8::MoeOrder<true> S_{(const LAS int*)(lds + LDS_TAB), (const LAS int*)(lds + LDS_IDX)};
            EpiGU E{ACT, args.in[29] + (size_t)layer * 32 * 2048};
            g8::gemm_phase(lds, g, S_, E);
        }
        PH_END;
        if (EN(12) && PH_ON) { PH_LOCALS
            moe_setup<4>(lds, CNT + layer * 32 * 64, LIST, layer, vcu, G);
            g8::GemmP g{ACT, 1024, WDN, 1024}; g8::MoeOrder<false> S_{(const LAS int*)(lds + LDS_TAB), (const LAS int*)(lds + LDS_IDX)};
            EpiDown E{YB, args.in[31] + (size_t)layer * 32 * 1024, GATE, (const LAS int*)(lds + LDS_IDX)};
            g8::gemm_phase(lds, g, S_, E);
        }
        PH_END;
        if (EN(13) && PH_ON) { PH_LOCALS
            const int nrows = keep ? T : NL;
            for (int row = gw; row < nrows; row += NGW)
                combine_row(row, lane, X, YB, ML, norm_mix_g + (layer + 1 < 4 ? layer + 1 : 0) * D, MOD + (size_t)(layer + 1 < 4 ? layer + 1 : 0) * 5 * 6144, layer < 3 ? H : nullptr, layer < 3 ? nullptr : args.out);
        }
        PH_END;
    }
#undef PH_ON
#undef PH_END
}
}

#ifndef MK_MULTI
#define MK_MULTI 0
#endif
#ifndef MK_DEBUG
#define MK_DEBUG 0
#endif
#if MK_DEBUG
namespace dbg {
__global__ void k_cmp_bf(const unsigned short* a, int lda, const float* b, int ldb, int rows, int cols, float s, float* acc, int cp) {
    float d2 = 0.f, r2 = 0.f;
    for (size_t i = (size_t)blockIdx.x * blockDim.x + threadIdx.x; i < (size_t)rows * cols; i += (size_t)gridDim.x * blockDim.x) {
        const size_t r = i / cols, c = i % cols; const float av = __uint_as_float(((unsigned)a[r * lda + c]) << 16), bv = s * b[r * ldb + c]; d2 += (av - bv) * (av - bv); r2 += bv * bv; }
    for (int o = 32; o >= 1; o >>= 1) { d2 += __shfl_xor(d2, o); r2 += __shfl_xor(r2, o); }
    if ((threadIdx.x & 63) == 0) { atomicAdd(acc + 2 * cp, d2); atomicAdd(acc + 2 * cp + 1, r2); }
}
__global__ void k_cmp_f(const float* a, const float* b, size_t n, float* acc, int cp) {
    float d2 = 0.f, r2 = 0.f;
    for (size_t i = (size_t)blockIdx.x * blockDim.x + threadIdx.x; i < n; i += (size_t)gridDim.x * blockDim.x) { const float av = a[i], bv = b[i]; d2 += (av - bv) * (av - bv); r2 += bv * bv; }
    for (int o = 32; o >= 1; o >>= 1) { d2 += __shfl_xor(d2, o); r2 += __shfl_xor(r2, o); }
    if ((threadIdx.x & 63) == 0) { atomicAdd(acc + 2 * cp, d2); atomicAdd(acc + 2 * cp + 1, r2); }
}
__global__ void k_report(const float* acc, int ncp, float thr, float* out) {
    if (blockIdx.x == 0 && threadIdx.x == 0) { int bad = -1; for (int i = 0; i < ncp; ++i) { const float d = acc[2 * i], r = acc[2 * i + 1]; if (!(d <= thr * r)) { bad = i; break; } }
        if (bad >= 0) out[0] += 100.f * (float)(bad + 1); }
}
}
#endif

extern "C" void kernel_launch(void* const* d_in, const int* in_sizes, int n_in, void* d_out, int out_size, void* d_ws, size_t ws_size, hipStream_t stream) {
    using namespace mk;
    static int grid = 0;
    if (grid == 0) {
        int dev = 0, cus = 0, per_cu = 0;
        if (hipGetDevice(&dev) != hipSuccess || hipDeviceGetAttribute(&cus, hipDeviceAttributeMultiprocessorCount, dev) != hipSuccess) { fprintf(stderr, "kernel_launch: device query failed\n"); grid = -1; return; }
        if (hipFuncSetAttribute((const void*)mega, hipFuncAttributeMaxDynamicSharedMemorySize, LDS_BYTES) != hipSuccess) { fprintf(stderr, "kernel_launch: hipFuncSetAttribute(%d B LDS) failed\n", LDS_BYTES); grid = -1; return; }
        if (hipOccupancyMaxActiveBlocksPerMultiprocessor(&per_cu, (const void*)mega, NTHR, LDS_BYTES) != hipSuccess || per_cu < 1) fprintf(stderr, "kernel_launch: occupancy query reports %d blocks per CU\n", per_cu);
        (void)hipGetLastError();
        grid = 256;
        if (cus < 256) { fprintf(stderr, "kernel_launch: %d CUs < 256: the persistent grid would not be resident; nothing launched\n", cus); grid = -1; return; }
        if (n_in != 32 || ws_size < WS_END) { fprintf(stderr, "kernel_launch: n_in %d ws %zu (need %zu)\n", n_in, ws_size, (size_t)WS_END); grid = -1; return; }
    }
    if (grid < 0) return;
    (void)hipMemsetAsync((char*)d_ws + WS_CTL, 0, CTL_BYTES, stream);
    Args a{};
    for (int i = 0; i < 32; ++i) a.in[i] = (const float*)d_in[i];
    a.out = (float*)d_out; a.ws = (unsigned char*)d_ws;
#if !MK_DEBUG
#if MK_MULTI
    for (int p = 0; p < N_PHASES; ++p) { a.lo = p; a.hi = p + 1; hipLaunchKernelGGL(mega, dim3(grid), dim3(NTHR), LDS_BYTES, stream, a); }
#else
    a.lo = 0; a.hi = N_PHASES; hipLaunchKernelGGL(mega, dim3(grid), dim3(NTHR), LDS_BYTES, stream, a);
#ifdef MK_PROBE_PH
    for (int r = 0; r < MK_PROBE_N; ++r) { a.lo = MK_PROBE_PH; a.hi = MK_PROBE_PH + 1; a.flags = MK_PROBE_FLAGS; hipLaunchKernelGGL(mega, dim3(grid), dim3(NTHR), LDS_BYTES, stream, a); }
#endif
#endif
    { const hipError_t le = hipPeekAtLastError(); if (le != hipSuccess) fprintf(stderr, "kernel_launch: launch failed: %s\n", hipGetErrorName(le)); }
#else
#endif
}
```

```cpp
#include <hip/hip_runtime.h>
#include <cstdio>
#include <cstdint>
#define MK_MULTI 0
#define MK_DEBUG 0
#define MK_DBG_THR 1e-3f
namespace mk {
#define LAS __attribute__((address_space(3)))
#define GAS __attribute__((address_space(1)))
typedef unsigned short bf16;
typedef short bf16x8 __attribute__((ext_vector_type(8)));
typedef short s16x4 __attribute__((ext_vector_type(4)));
typedef float f32x2 __attribute__((ext_vector_type(2)));
typedef float f32x4 __attribute__((ext_vector_type(4)));
typedef float f32x16 __attribute__((ext_vector_type(16)));
typedef unsigned u32x2 __attribute__((ext_vector_type(2)));
typedef unsigned u32x4 __attribute__((ext_vector_type(4)));

constexpr int D = 1024, NBATCH = 4, S = 4096, CL = 256, NL = NBATCH * S, NC = NBATCH * CL, T = NL + NC;
constexpr int NWAVES = 8, NTHR = 512;
constexpr float EPS = 1e-6f;
constexpr float LOG2E = 1.4426950408889634f;
constexpr float QSCALE_A = 0.125f * LOG2E;
constexpr float QSCALE_C = 0.10206207261596575f * LOG2E;

constexpr size_t al256(size_t x) { return (x + 255) & ~(size_t)255; }
constexpr size_t CTL_BYTES = 65536;
constexpr int CW_BAR = 1024, CW_CNT = 8192;
constexpr size_t WS_CTL = 0;
constexpr size_t WS_MOD = WS_CTL + CTL_BYTES;
constexpr size_t WS_COSA = WS_MOD + al256((size_t)4 * 5 * 6144 * 4);
constexpr size_t WS_SINA = WS_COSA + 4096 * 32 * 4;
constexpr size_t WS_COSC = WS_SINA + 4096 * 32 * 4;
constexpr size_t WS_SINC = WS_COSC + 4096 * 16 * 4;
constexpr size_t WS_WR = WS_SINC + 4096 * 16 * 4;
constexpr size_t WS_WINA = WS_WR + (size_t)4 * 2 * 32 * 1024 * 2;
constexpr size_t WS_WOUTA = WS_WINA + (size_t)2 * 1792 * 1024 * 2;
constexpr size_t WS_WINC = WS_WOUTA + (size_t)2 * 1024 * 1024 * 2;
constexpr size_t WS_WQB = WS_WINC + (size_t)2 * 1280 * 1024 * 2;
constexpr size_t WS_WKVB = WS_WQB + (size_t)2 * 1536 * 768 * 2;
constexpr size_t WS_WOUTC = WS_WKVB + (size_t)2 * 2048 * 256 * 2;
constexpr size_t WS_WGU = WS_WOUTC + (size_t)2 * 1024 * 1024 * 2;
constexpr size_t WS_WDN = WS_WGU + (size_t)128 * 2048 * 1024 * 2;
constexpr size_t WS_X = WS_WDN + (size_t)128 * 1024 * 1024 * 2;
constexpr size_t WS_H = WS_X + (size_t)T * D * 4;
constexpr size_t WS_QA = WS_H + (size_t)T * D * 2;
constexpr size_t WS_KA = WS_QA + (size_t)T * 512 * 2;
constexpr size_t WS_VA = WS_KA + (size_t)T * 128 * 2;
constexpr size_t WS_Z = WS_VA + (size_t)T * 128 * 2;
constexpr size_t WS_P = WS_Z + (size_t)T * 512 * 2;
constexpr int PP = 1056;
constexpr size_t WS_RS = WS_P + (size_t)T * PP * 2;
constexpr size_t WS_QC = WS_RS + (size_t)T * 2 * 4;
constexpr size_t WS_KC = WS_QC + (size_t)T * 1536 * 2;
constexpr size_t WS_VC = WS_KC + (size_t)T * 1536 * 2;
constexpr size_t WS_MIX = WS_VC + (size_t)T * 1024 * 2;
constexpr size_t WS_F = WS_MIX + (size_t)T * 1024 * 2;
constexpr size_t WS_GATE = WS_F + (size_t)T * 1024 * 2;
constexpr size_t WS_LIST = WS_GATE + (size_t)T * 4 * 4;
constexpr int ACT_ROWS = 304 * 256;
constexpr size_t WS_ACT = WS_LIST + (size_t)32 * T * 4;
constexpr size_t WS_YB = WS_ACT + (size_t)ACT_ROWS * 1024 * 2;
constexpr size_t WS_SSX = WS_YB + (size_t)T * 4 * 1024 * 2;
constexpr size_t WS_SSP = WS_SSX + (size_t)T * 16 * 4;
constexpr size_t WS_END = WS_SSP + (size_t)T * 16 * 4;

constexpr int STAGE_BYTES = 131072;
constexpr int LDS_IDX = 131072;
constexpr int MAXU = 12;
constexpr int LDS_TAB = LDS_IDX + MAXU * 1024;
constexpr int LDS_MISC = LDS_TAB + 1024;
constexpr int LDS_BYTES = LDS_MISC + 256;
constexpr int CV_HDR = 56320, CV_BUF = 57344;

__device__ __forceinline__ unsigned pk2(float lo, float hi) {
    typedef __bf16 bf2 __attribute__((ext_vector_type(2)));
    return __builtin_bit_cast(unsigned, __builtin_convertvector((f32x2){lo, hi}, bf2));
}
__device__ __forceinline__ float bflo(unsigned u) { return __uint_as_float(u << 16); }
__device__ __forceinline__ float bfhi(unsigned u) { return __uint_as_float(u & 0xffff0000u); }
__device__ __forceinline__ float bf1(bf16 u) { return __uint_as_float(((unsigned)u) << 16); }
__device__ __forceinline__ float fsigm(float v) { return __builtin_amdgcn_rcpf(1.f + __builtin_amdgcn_exp2f(-1.4426950408889634f * v)); }
__device__ __forceinline__ float fsilu(float v) { return v * fsigm(v); }
__device__ __forceinline__ int modrow(int row) { return row < NL ? (row >> 12) : 4; }
#define WS_DPP(v, ctrl) ((v) + __int_as_float(__builtin_amdgcn_update_dpp(0, __float_as_int(v), (ctrl), 0xF, 0xF, false)))
__device__ __forceinline__ float wave_sum(float v) {
    v = WS_DPP(v, 0xB1); v = WS_DPP(v, 0x4E); v = WS_DPP(v, 0x141); v = WS_DPP(v, 0x140);
    v += __shfl_xor(v, 16); v += __shfl_xor(v, 32);
    return v;
}
__device__ __forceinline__ int otid() { int t = threadIdx.x; asm volatile("" : "+v"(t)); return t; }
#define LDS_WAIT() asm volatile("s_waitcnt lgkmcnt(0)" ::: "memory")
#define VM_WAIT() asm volatile("s_waitcnt vmcnt(0)" ::: "memory")

#define XB_TMO      128
#define XB_XCNT(j)  (256  + 64 * (j))
#define XB_XSUB(j)  (1280 + 64 * (j))
#define XB_XGEN(j)  (2304 + 64 * (j))
#define XB_TOP      3328
#define XB_TOPGEN   3392
#define XCD_BAR_WORDS 3456
#define XB_SPIN_CAP (1u << 18)
__device__ __forceinline__ unsigned xb_ld(unsigned* p)              { return __hip_atomic_load(p, __ATOMIC_RELAXED, __HIP_MEMORY_SCOPE_AGENT); }
__device__ __forceinline__ unsigned xb_add(unsigned* p, unsigned v) { return __hip_atomic_fetch_add(p, v, __ATOMIC_RELAXED, __HIP_MEMORY_SCOPE_AGENT); }
__device__ __forceinline__ unsigned xb_xcc_id() { return (unsigned)__builtin_amdgcn_s_getreg((3 << 11) | 20) & 0xFu; }
#define XB_SPIN(cond, bar) do { unsigned _sp = 0; while (cond) { __builtin_amdgcn_s_sleep(1); \
    if ((++_sp & 255u) == 0u) { if (xb_ld(&(bar)[XB_TMO])) break; if (_sp > XB_SPIN_CAP) { atomicAdd(&(bar)[XB_TMO], 1u); break; } } } } while (0)
struct XcdBarrier { unsigned* bar; unsigned x; volatile LAS unsigned* st; };
__device__ __forceinline__ XcdBarrier xcd_barrier_post(unsigned* bar, volatile LAS unsigned* st) {
    XcdBarrier b; b.bar = bar; b.x = xb_xcc_id(); b.st = st;
    if (threadIdx.x == 0) (void)xb_add(&bar[XB_XCNT(b.x)], 1u);
    return b;
}
__device__ __forceinline__ void xcd_barrier_complete(unsigned* bar, unsigned x, unsigned& nloc, unsigned& nx) {
    const unsigned G = gridDim.x * gridDim.y * gridDim.z;
    unsigned sum, cnt, mine, sp = 0u;
    for (;;) {
        sum = 0u; cnt = 0u; mine = 0u;
#pragma unroll
        for (unsigned j = 0; j < 16; ++j) { const unsigned c = xb_ld(&bar[XB_XCNT(j)]); sum += c; cnt += (c > 0u) ? 1u : 0u; mine = (j == x) ? c : mine; }
        if (sum == G) break;
        __builtin_amdgcn_s_sleep(1);
        if ((++sp & 255u) == 0u) { if (xb_ld(&bar[XB_TMO])) break; if (sp > XB_SPIN_CAP) { atomicAdd(&bar[XB_TMO], 1u); break; } }
    }
    nloc = mine > 0u ? mine : 1u; nx = cnt > 0u ? cnt : 1u;
}
__device__ __forceinline__ void xcd_barrier(const XcdBarrier& b) {
    asm volatile("s_waitcnt vmcnt(0)" ::: "memory");
    __syncthreads();
    if (otid() == 0) {
        unsigned* bar = b.bar;
        __builtin_amdgcn_s_waitcnt(0);
        unsigned nloc = b.st[0], nx = b.st[1];
        if (nloc == 0u) { xcd_barrier_complete(bar, b.x, nloc, nx); b.st[0] = nloc; b.st[1] = nx; }
        const unsigned old = xb_add(&bar[XB_XSUB(b.x)], 1u);
        const unsigned gen = old / nloc;
        if (old + 1u == (gen + 1u) * nloc) {
            __builtin_amdgcn_fence(__ATOMIC_RELEASE, "agent");
            asm volatile("s_waitcnt vmcnt(0)" ::: "memory");
            const unsigned og = xb_add(&bar[XB_TOP], 1u);
            const unsigned tg = og / nx;
            if (og + 1u == (tg + 1u) * nx) xb_add(&bar[XB_TOPGEN], 1u);
            else XB_SPIN(xb_ld(&bar[XB_TOPGEN]) == tg, bar);
            __builtin_amdgcn_fence(__ATOMIC_ACQUIRE, "agent");
            xb_add(&bar[XB_XGEN(b.x)], 1u);
            asm volatile("s_waitcnt vmcnt(0)" ::: "memory");
        } else {
            XB_SPIN(xb_ld(&bar[XB_XGEN(b.x)]) == gen, bar);
            __builtin_amdgcn_fence(__ATOMIC_ACQUIRE, "agent");
            asm volatile("s_waitcnt vmcnt(0)" ::: "memory");
        }
    }
    __syncthreads();
}

namespace g8 {
constexpr int BM = 256, BK = 64, HALF = 128, HTB = HALF * BK * 2, NXCD = 8, WGM = 8;
__host__ __device__ __forceinline__ int lds_byte(int r, int c) { const int st = (r >> 4) * 2 + (c >> 5), rr = r & 15, cc = c & 31, ob = rr * 64 + cc * 2; return st * 1024 + (ob ^ (((ob >> 9) & 1) << 5)); }
__host__ __device__ __forceinline__ void stage_rc(int b, int& R, int& C) { const int st = b / 1024, sb = b % 1024, swz = sb ^ (((sb >> 9) & 1) << 5); R = (st >> 1) * 16 + swz / 64; C = (st & 1) * 32 + (swz % 64) / 2; }

struct Unit { int pm, pn, e, nt, gm, slot; };
struct GemmP { const bf16* A; int lda; const bf16* Bt; int K; };

struct StaticOrder {
    static constexpr bool GATHER = false;
    int nM, nN, nwg, G, c;
    __device__ void init(int nM_, int nN_, int G_, int c_) { nM = nM_; nN = nN_; nwg = nM * nN; G = G_; c = c_; }
    __device__ __forceinline__ bool next(int i, Unit& u) const {
        const long L = (long)i * G + c; if (L >= nwg) return false;
        int wgid = (int)L; { const int q = nwg / NXCD, r = nwg % NXCD, xcd = wgid % NXCD, off = wgid / NXCD; wgid = (xcd < r ? xcd * (q + 1) : r * (q + 1) + (xcd - r) * q) + off; }
        const int nig = WGM * nN, gid = wgid / nig, fm = gid * WGM, gsz = (nM - fm) < WGM ? (nM - fm) : WGM;
        u.pm = fm + ((wgid % nig) % gsz); u.pn = (wgid % nig) / gsz; u.e = 0; u.nt = u.pn; u.gm = u.pm; u.slot = 0; return true;
    }
    __device__ __forceinline__ int arow(const Unit& u, int r) const { return u.pm * BM + r; }
};
template <bool GATHER_> struct MoeOrder {
    static constexpr bool GATHER = GATHER_;
    const LAS int* tab; const LAS int* idx;
    __device__ __forceinline__ bool next(int i, Unit& u) const {
        if (i >= tab[127]) return false;
        u.gm = tab[128 + 4 * i]; u.pn = tab[129 + 4 * i]; u.e = tab[130 + 4 * i]; u.nt = tab[131 + 4 * i]; u.slot = i; u.pm = u.gm; return true;
    }
    __device__ __forceinline__ int arow(const Unit& u, int r) const {
        if (GATHER_) { const int s = idx[u.slot * 256 + r]; return s < 0 ? 0 : (s >> 2); }
        return u.gm * BM + r;
    }
};

template <class Epi, class Sched>
__device__ __forceinline__ void gemm_phase(LAS unsigned char* lds, const GemmP g, const Sched& S, const Epi& E) {
    const int tid = otid(), wid = __builtin_amdgcn_readfirstlane(tid >> 6), lane = tid & 63, wr = wid >> 2, wc = wid & 3, fr = lane & 15, fq = lane >> 4;
    const int K = g.K, nt = K / BK;
    int RR[2], CC[2]; unsigned voffB[2], voffA[2];
    const unsigned lda2 = (unsigned)g.lda * 2u;
#pragma unroll
    for (int i = 0; i < 2; ++i) { stage_rc(tid * 16 + i * 8192, RR[i], CC[i]); voffB[i] = (unsigned)(RR[i] * K + CC[i]) * 2u; voffA[i] = (unsigned)RR[i] * lda2 + (unsigned)CC[i] * 2u; }
    const size_t hstepA = (size_t)HALF * lda2, tstepA = 2 * hstepA;
    const size_t kstep = (size_t)(BK * 2);
    const size_t hstepB = (size_t)HALF * K * 2;
    const size_t tstepB = 2 * hstepB;
    const unsigned ldsw = (unsigned)wid * 1024u;
    const int aoff = lds_byte(wr * 64 + fr, fq * 8), boff = lds_byte(wc * 32 + fr, fq * 8);
#define G8_SA(b, h) (((b) * 2 + (h)) * HTB)
#define G8_SB(b, h) ((4 + (b) * 2 + (h)) * HTB)
#define G8_STAGE(bufoff, gbase, voff) do { _Pragma("unroll") for (int _i = 0; _i < 2; ++_i) \
        __builtin_amdgcn_global_load_lds((const unsigned*)((const char*)(gbase) + (voff)[_i]), (LAS unsigned*)(lds + (bufoff) + ldsw + _i * 8192), 16, 0, 0); } while (0)
#define G8_LDA(dst, b, h) do { _Pragma("unroll") for (int m = 0; m < 4; ++m) _Pragma("unroll") for (int k = 0; k < 2; ++k) dst[m][k] = *(const LAS bf16x8*)(lds + G8_SA(b, h) + aoff + m * 2048 + k * 1024); } while (0)
#define G8_LDB(dst, b, h) do { _Pragma("unroll") for (int n = 0; n < 2; ++n) _Pragma("unroll") for (int k = 0; k < 2; ++k) dst[n][k] = *(const LAS bf16x8*)(lds + G8_SB(b, h) + boff + n * 2048 + k * 1024); } while (0)
#define G8_MMA(ai, bj, At, Bt) do { __builtin_amdgcn_s_setprio(1); _Pragma("unroll") for (int m = 0; m < 4; ++m) _Pragma("unroll") for (int n = 0; n < 2; ++n) _Pragma("unroll") for (int k = 0; k < 2; ++k) \
        acc[ai][bj][m][n] = __builtin_amdgcn_mfma_f32_16x16x32_bf16(Bt[n][k], At[m][k], acc[ai][bj][m][n], 0, 0, 0); __builtin_amdgcn_s_setprio(0); } while (0)
#define G8_WAIT_V(n) asm volatile("s_waitcnt vmcnt(" #n ")" ::: "memory")
#define G8_WAIT_L(n) asm volatile("s_waitcnt lgkmcnt(" #n ")" ::: "memory")
#define G8_BAR __builtin_amdgcn_s_barrier()
#define G8_SCHED __builtin_amdgcn_sched_barrier(0)
#define G8_MKOFF(u, o) do { if constexpr (Sched::GATHER) { _Pragma("unroll") for (int _i = 0; _i < 2; ++_i) { int _R, _C; stage_rc(tid * 16 + _i * 8192, _R, _C); \
        _Pragma("unroll") for (int _h = 0; _h < 2; ++_h) o[_h][_i] = (unsigned)S.arow(u, _h * HALF + _R) * lda2 + (unsigned)_C * 2u; } } } while (0)
#define G8_STAGE_A(bufoff, kofs, h, usenext) do { if constexpr (Sched::GATHER) { unsigned _o[2]; _o[0] = (usenext) ? no[h][0] : co[h][0]; _o[1] = (usenext) ? no[h][1] : co[h][1]; G8_STAGE(bufoff, Ab + (kofs), _o); } \
        else { const char* _p = ((usenext) ? nAp : cAp) + (size_t)(h) * hstepA + (kofs); G8_STAGE(bufoff, _p, voffA); } } while (0)
    Unit cur, nxt; int ui = 0;
    if (!S.next(0, cur)) return;
    f32x4 acc[2][2][4][2];
#pragma unroll
    for (int a = 0; a < 2; ++a)
#pragma unroll
        for (int b = 0; b < 2; ++b)
#pragma unroll
            for (int m = 0; m < 4; ++m)
#pragma unroll
                for (int n = 0; n < 2; ++n) acc[a][b][m][n] = (f32x4){0.f, 0.f, 0.f, 0.f};
    bf16x8 At[4][2], B0[2][2], B1[2][2];
    unsigned co[2][2], no[2][2];
    G8_MKOFF(cur, co);
    if (Sched::GATHER) { G8_WAIT_L(0); }
    const char* Ab = (const char*)g.A;
    const char* cAp = Ab + (size_t)cur.pm * tstepA; const char* nAp = cAp;
    const char* cB = (const char*)g.Bt + (size_t)cur.pn * tstepB;
    G8_STAGE(G8_SB(0, 0), cB, voffB); G8_STAGE(G8_SB(0, 1), cB + hstepB, voffB); G8_STAGE_A(G8_SA(0, 0), 0, 0, false); G8_STAGE_A(G8_SA(0, 1), 0, 1, false);
    if (wr == 1) G8_BAR;
    G8_WAIT_V(2); G8_BAR;
    G8_STAGE(G8_SB(1, 0), cB + kstep, voffB); G8_STAGE_A(G8_SA(1, 0), kstep, 0, false); G8_STAGE(G8_SB(1, 1), cB + hstepB + kstep, voffB);
    G8_WAIT_V(6); G8_BAR;
    for (;;) {
        const bool has_next = S.next(ui + 1, nxt);
        if (has_next) { G8_MKOFF(nxt, no); if (Sched::GATHER) { G8_WAIT_L(0); } nAp = Ab + (size_t)nxt.pm * tstepA; }
        else {
            nAp = cAp;
            if constexpr (Sched::GATHER) {
#pragma unroll
                for (int h = 0; h < 2; ++h)
#pragma unroll
                    for (int i = 0; i < 2; ++i) no[h][i] = co[h][i];
            }
        }
        G8_SCHED;
        const char* nB = has_next ? (const char*)g.Bt + (size_t)nxt.pn * tstepB : cB;
#pragma unroll 1
        for (int t = 0; t < nt; t += 2) {
            const bool last = (t == nt - 2);
            const size_t k1 = (size_t)(t + 1) * kstep, k2 = last ? 0 : (size_t)(t + 2) * kstep, k3 = k2 + kstep;
            const char* b2 = last ? nB : cB + (size_t)(t + 2) * kstep; const char* b3 = b2 + kstep;
            G8_LDB(B0, 0, 0); G8_LDB(B1, 0, 1); G8_SCHED; G8_LDA(At, 0, 0); G8_STAGE_A(G8_SA(1, 1), k1, 1, false);
            G8_WAIT_V(8); G8_WAIT_L(0); G8_BAR; G8_MMA(0, 0, At, B0); G8_MMA(0, 1, At, B1); G8_BAR; G8_SCHED;
            G8_LDA(At, 0, 1); G8_STAGE(G8_SB(0, 0), b2, voffB); G8_STAGE(G8_SB(0, 1), b2 + hstepB, voffB); G8_STAGE_A(G8_SA(0, 0), k2, 0, last);
            G8_WAIT_V(8); G8_WAIT_L(0); G8_BAR; G8_MMA(1, 0, At, B0); G8_MMA(1, 1, At, B1); G8_BAR; G8_SCHED;
            G8_LDB(B0, 1, 0); G8_LDB(B1, 1, 1); G8_SCHED; G8_LDA(At, 1, 0); G8_STAGE_A(G8_SA(0, 1), k2, 1, last);
            G8_WAIT_V(8); G8_WAIT_L(0); G8_BAR; G8_MMA(0, 0, At, B0); G8_MMA(0, 1, At, B1); G8_BAR; G8_SCHED;
            G8_LDA(At, 1, 1); G8_STAGE(G8_SB(1, 0), b3, voffB); G8_STAGE(G8_SB(1, 1), b3 + hstepB, voffB); G8_STAGE_A(G8_SA(1, 0), k3, 0, last);
            G8_WAIT_V(8); G8_WAIT_L(0); G8_BAR; G8_MMA(1, 0, At, B0); G8_MMA(1, 1, At, B1); G8_BAR; G8_SCHED;
        }
        if (wr == 0) G8_BAR;
        E(acc, cur, wr, wc, fr, fq, lds);
        if (!has_next) break;
#pragma unroll
        for (int a = 0; a < 2; ++a)
#pragma unroll
            for (int b = 0; b < 2; ++b)
#pragma unroll
                for (int m = 0; m < 4; ++m)
#pragma unroll
                    for (int n = 0; n < 2; ++n) acc[a][b][m][n] = (f32x4){0.f, 0.f, 0.f, 0.f};
        cur = nxt; cB = nB; cAp = nAp; ++ui;
        if constexpr (Sched::GATHER) {
#pragma unroll
            for (int h = 0; h < 2; ++h)
#pragma unroll
                for (int i = 0; i < 2; ++i) co[h][i] = no[h][i];
        }
        if (wr == 1) G8_BAR;
    }
    G8_WAIT_V(0);
    G8_BAR;
#undef G8_SA
#undef G8_SB
#undef G8_STAGE
#undef G8_LDA
#undef G8_LDB
#undef G8_MMA
#undef G8_WAIT_V
#undef G8_WAIT_L
#undef G8_BAR
#undef G8_SCHED
#undef G8_MKOFF
#undef G8_STAGE_A
}
}

using g8::Unit;
typedef f32x4 Acc[2][2][4][2];
__device__ __forceinline__ u32x4 pack8(const f32x4 a, const f32x4 b) { u32x4 w; w.x = pk2(a[0], a[1]); w.y = pk2(a[2], a[3]); w.z = pk2(b[0], b[1]); w.w = pk2(b[2], b[3]); return w; }

struct EpiInA {
    bf16 *Qa, *Ka, *Va, *Z; const float *qg, *kg, *cosA, *sinA;
    __device__ __forceinline__ void operator()(const Acc& acc, const Unit& u, int wr, int wc, int fr, int fq, LAS unsigned char*) const {
        const int row0 = u.pm * 256 + wr * 64 + fr, pn = u.pn, a = fq >> 1, b = fq & 1;
        if (pn < 3) {
            const bool isv = (pn == 2 && wc >= 2), isq = pn < 2;
            const int dbase = 32 * a + 8 * b;
            if (isv) {
#pragma unroll
                for (int ai = 0; ai < 2; ++ai)
#pragma unroll
                    for (int m = 0; m < 4; ++m) { const int row = row0 + ai * 128 + m * 16; bf16* o = Va + (size_t)row * 128 + (wc - 2) * 64 + dbase;
#pragma unroll
                        for (int bj = 0; bj < 2; ++bj) *(u32x4*)(o + 16 * bj) = pack8(acc[ai][bj][m][0], acc[ai][bj][m][1]); }
                return;
            }
            const float* g = isq ? qg : kg;
            f32x4 gv[2][2];
#pragma unroll
            for (int bj = 0; bj < 2; ++bj)
#pragma unroll
                for (int n = 0; n < 2; ++n) gv[bj][n] = *(const f32x4*)(g + dbase + 16 * bj + 4 * n);
            const float sc = isq ? QSCALE_A : 1.f;
            bf16* obase = isq ? (Qa + (pn * 4 + wc) * 64 + dbase) : (Ka + wc * 64 + dbase);
            const int opitch = isq ? 512 : 128;
            f32x4 cc[2], sn[2], cn[2], snn[2];
            { const int t = row0 & 4095;
#pragma unroll
              for (int n = 0; n < 2; ++n) { cc[n] = *(const f32x4*)(cosA + t * 32 + 16 * a + 8 * b + 4 * n); sn[n] = *(const f32x4*)(sinA + t * 32 + 16 * a + 8 * b + 4 * n); } }
#pragma unroll
            for (int gidx = 0; gidx < 8; ++gidx) {
                    const int ai = gidx >> 2, m = gidx & 3;
                    const int row = row0 + ai * 128 + m * 16;
                    if (gidx < 7) { const int tn = (row0 + ((gidx + 1) >> 2) * 128 + ((gidx + 1) & 3) * 16) & 4095;
#pragma unroll
                        for (int n = 0; n < 2; ++n) { cn[n] = *(const f32x4*)(cosA + tn * 32 + 16 * a + 8 * b + 4 * n); snn[n] = *(const f32x4*)(sinA + tn * 32 + 16 * a + 8 * b + 4 * n); } }
                    float ss = 0.f;
#pragma unroll
                    for (int bj = 0; bj < 2; ++bj)
#pragma unroll
                        for (int n = 0; n < 2; ++n) { const f32x4 v = acc[ai][bj][m][n]; ss += (v[0] * v[0] + v[1] * v[1]) + (v[2] * v[2] + v[3] * v[3]); }
                    ss += __shfl_xor(ss, 16); ss += __shfl_xor(ss, 32);
                    const float rs = rsqrtf(ss * (1.f / 64.f) + EPS);
                    f32x4 y[2][2];
#pragma unroll
                    for (int bj = 0; bj < 2; ++bj)
#pragma unroll
                        for (int n = 0; n < 2; ++n) y[bj][n] = acc[ai][bj][m][n] * rs * gv[bj][n];
                    if (row < NL) {
#pragma unroll
                        for (int n = 0; n < 2; ++n) { const f32x4 y0 = y[0][n], y1 = y[1][n]; y[0][n] = y0 * cc[n] - y1 * sn[n]; y[1][n] = y1 * cc[n] + y0 * sn[n]; }
                    }
                    bf16* o = obase + (size_t)row * opitch;
#pragma unroll
                    for (int bj = 0; bj < 2; ++bj) *(u32x4*)(o + 16 * bj) = pack8(y[bj][0] * sc, y[bj][1] * sc);
                    asm volatile("" ::: "memory");
#pragma unroll
                    for (int n = 0; n < 2; ++n) { cc[n] = cn[n]; sn[n] = snn[n]; }
            }
        } else {
            const int j0 = 128 * (pn - 3) + 32 * wc + 8 * fq;
#pragma unroll
            for (int ai = 0; ai < 2; ++ai)
#pragma unroll
                for (int m = 0; m < 4; ++m) {
                    const int row = row0 + ai * 128 + m * 16; f32x4 z[2];
#pragma unroll
                    for (int n = 0; n < 2; ++n) { const f32x4 av = acc[ai][0][m][n], gt = acc[ai][1][m][n];
#pragma unroll
                        for (int r = 0; r < 4; ++r) z[n][r] = av[r] * fsigm(gt[r]); }
                    *(u32x4*)(Z + (size_t)row * 512 + j0) = pack8(z[0], z[1]);
                }
        }
    }
};
struct EpiResid {
    float* X; const float* Xlat; const float* Xctx; const float* gmod; float* SSX;
    __device__ __forceinline__ void operator()(const Acc& acc, const Unit& u, int wr, int wc, int fr, int fq, LAS unsigned char*) const {
        const int row0 = u.pm * 256 + wr * 64 + fr; const int mr = u.pm < 64 ? (u.pm >> 4) : 4;
        const float* gp = gmod + (size_t)mr * 6144; const float* src = u.pm < 64 ? Xlat : Xctx - (size_t)NL * D;
        float ssr[2][4];
#pragma unroll
        for (int ai = 0; ai < 2; ++ai)
#pragma unroll
            for (int m = 0; m < 4; ++m) ssr[ai][m] = 0.f;
#pragma unroll
        for (int bj = 0; bj < 2; ++bj) {
            const int c0 = 256 * u.pn + 128 * bj + 32 * wc + 4 * fq;
            const f32x4 g0 = *(const f32x4*)(gp + c0), g1 = *(const f32x4*)(gp + c0 + 16);
#pragma unroll
            for (int ai = 0; ai < 2; ++ai) {
                f32x4 xo[4][2];
#pragma unroll
                for (int m = 0; m < 4; ++m) { const float* xp = src + (size_t)(row0 + ai * 128 + m * 16) * D + c0; xo[m][0] = *(const f32x4*)xp; xo[m][1] = *(const f32x4*)(xp + 16); }
#pragma unroll
                for (int m = 0; m < 4; ++m) { float* op = X + (size_t)(row0 + ai * 128 + m * 16) * D + c0;
                    const f32x4 y0 = xo[m][0] + g0 * acc[ai][bj][m][0], y1 = xo[m][1] + g1 * acc[ai][bj][m][1];
                    *(f32x4*)op = y0; *(f32x4*)(op + 16) = y1;
                    ssr[ai][m] += (y0[0] * y0[0] + y0[1] * y0[1]) + (y0[2] * y0[2] + y0[3] * y0[3]) + (y1[0] * y1[0] + y1[1] * y1[1]) + (y1[2] * y1[2] + y1[3] * y1[3]); }
                asm volatile("" ::: "memory");
            }
        }
#pragma unroll
        for (int ai = 0; ai < 2; ++ai)
#pragma unroll
            for (int m = 0; m < 4; ++m) { float ss = ssr[ai][m]; ss += __shfl_xor(ss, 16); ss += __shfl_xor(ss, 32);
                if (fq == 0) SSX[(size_t)(row0 + ai * 128 + m * 16) * 16 + 4 * u.pn + wc] = ss; }
    }
};
struct EpiBf16 {
    bf16* O; int ldo, ncols;
    __device__ __forceinline__ void operator()(const Acc& acc, const Unit& u, int wr, int wc, int fr, int fq, LAS unsigned char*) const {
        const int row0 = u.pm * 256 + wr * 64 + fr;
#pragma unroll
        for (int bj = 0; bj < 2; ++bj) {
            const int c0 = 256 * u.pn + 128 * bj + 32 * wc + 8 * fq;
            if (c0 < ncols) {
#pragma unroll
                for (int ai = 0; ai < 2; ++ai)
#pragma unroll
                    for (int m = 0; m < 4; ++m) *(u32x4*)(O + (size_t)(row0 + ai * 128 + m * 16) * ldo + c0) = pack8(acc[ai][bj][m][0], acc[ai][bj][m][1]);
            }
        }
    }
};
struct EpiP {
    bf16* P; float* SSP; bf16* Kc; const float* krg; const float* cosC; const float* sinC;
    __device__ __forceinline__ void operator()(const Acc& acc, const Unit& u, int wr, int wc, int fr, int fq, LAS unsigned char*) const {
        const int row0 = u.pm * 256 + wr * 64 + fr;
        if (u.pn < 4) {
#pragma unroll
            for (int ai = 0; ai < 2; ++ai)
#pragma unroll
                for (int m = 0; m < 4; ++m) { const int row = row0 + ai * 128 + m * 16; float ss = 0.f;
#pragma unroll
                    for (int bj = 0; bj < 2; ++bj) { const f32x4 y0 = acc[ai][bj][m][0], y1 = acc[ai][bj][m][1];
                        *(u32x4*)(P + (size_t)row * PP + 256 * u.pn + 128 * bj + 32 * wc + 8 * fq) = pack8(y0, y1);
                        ss += (y0[0] * y0[0] + y0[1] * y0[1]) + (y0[2] * y0[2] + y0[3] * y0[3]) + (y1[0] * y1[0] + y1[1] * y1[1]) + (y1[2] * y1[2] + y1[3] * y1[3]); }
                    ss += __shfl_xor(ss, 16); ss += __shfl_xor(ss, 32);
                    if (fq == 0) SSP[(size_t)row * 16 + 4 * u.pn + wc] = ss; }
        } else if (wc == 0) {
            const f32x4 g0 = *(const f32x4*)(krg + 8 * fq), g1 = *(const f32x4*)(krg + 8 * fq + 4);
#pragma unroll
            for (int ai = 0; ai < 2; ++ai)
#pragma unroll
                for (int m = 0; m < 4; ++m) { const int row = row0 + ai * 128 + m * 16; const f32x4 v0 = acc[ai][0][m][0], v1 = acc[ai][0][m][1];
                    *(u32x4*)(P + (size_t)row * PP + 1024 + 8 * fq) = pack8(v0, v1);
                    float ss = (v0[0] * v0[0] + v0[1] * v0[1]) + (v0[2] * v0[2] + v0[3] * v0[3]) + (v1[0] * v1[0] + v1[1] * v1[1]) + (v1[2] * v1[2] + v1[3] * v1[3]);
                    ss += __shfl_xor(ss, 16); ss += __shfl_xor(ss, 32);
                    const float rk = rsqrtf(ss * (1.f / 32.f) + EPS);
                    f32x4 y0 = v0 * rk * g0, y1 = v1 * rk * g1;
                    const int t = row & 4095, ax = fq >> 1;
                    const f32x4 c0 = *(const f32x4*)(cosC + t * 16 + 8 * ax), c1 = *(const f32x4*)(cosC + t * 16 + 8 * ax + 4), s0 = *(const f32x4*)(sinC + t * 16 + 8 * ax), s1 = *(const f32x4*)(sinC + t * 16 + 8 * ax + 4);
                    f32x4 p0, p1;
#pragma unroll
                    for (int j = 0; j < 4; ++j) { p0[j] = __shfl_xor(y0[j], 16); p1[j] = __shfl_xor(y1[j], 16); }
                    if (row < NL) { if ((fq & 1) == 0) { y0 = y0 * c0 - p0 * s0; y1 = y1 * c1 - p1 * s1; } else { y0 = y0 * c0 + p0 * s0; y1 = y1 * c1 + p1 * s1; } }
                    const u32x4 wv = pack8(y0, y1);
#pragma unroll
                    for (int hd = 0; hd < 16; ++hd) *(u32x4*)(Kc + (size_t)row * 1536 + hd * 96 + 64 + 8 * fq) = wv;
                    asm volatile("" ::: "memory"); }
        }
    }
};
struct EpiKV {
    bf16 *Kc, *Vc; const float* SSP; const float* kg;
    __device__ __forceinline__ void operator()(const Acc& acc, const Unit& u, int wr, int wc, int fr, int fq, LAS unsigned char*) const {
        const int row0 = u.pm * 256 + wr * 64 + fr, head = 2 * u.pn + (wc >> 1), dbase = 8 * fq;
        const bool isk = (wc & 1) == 0;
        float rr[2][4];
#pragma unroll
        for (int ai = 0; ai < 2; ++ai)
#pragma unroll
            for (int m = 0; m < 4; ++m) { const f32x4 pq = *(const f32x4*)(SSP + (size_t)(row0 + ai * 128 + m * 16) * 16 + 12); rr[ai][m] = (pq[0] + pq[1]) + (pq[2] + pq[3]); }
        f32x4 gv[2][2];
#pragma unroll
        for (int bj = 0; bj < 2; ++bj)
#pragma unroll
            for (int n = 0; n < 2; ++n) gv[bj][n] = isk ? *(const f32x4*)(kg + dbase + 32 * bj + 4 * n) : (f32x4){1.f, 1.f, 1.f, 1.f};
#pragma unroll
        for (int ai = 0; ai < 2; ++ai)
#pragma unroll
            for (int m = 0; m < 4; ++m) {
                const int row = row0 + ai * 128 + m * 16; const float r = rsqrtf(rr[ai][m] * (1.f / 256.f) + EPS);
                float f = r;
                if (isk) {
                    float ss = 0.f;
#pragma unroll
                    for (int bj = 0; bj < 2; ++bj)
#pragma unroll
                        for (int n = 0; n < 2; ++n) { const f32x4 v = acc[ai][bj][m][n]; ss += (v[0] * v[0] + v[1] * v[1]) + (v[2] * v[2] + v[3] * v[3]); }
                    ss += __shfl_xor(ss, 16); ss += __shfl_xor(ss, 32);
                    f = r * rsqrtf(r * r * ss * (1.f / 64.f) + EPS);
                }
                bf16* o = isk ? (Kc + (size_t)row * 1536 + head * 96 + dbase) : (Vc + (size_t)row * 1024 + head * 64 + dbase);
#pragma unroll
                for (int bj = 0; bj < 2; ++bj) *(u32x4*)(o + 32 * bj) = pack8(acc[ai][bj][m][0] * f * gv[bj][0], acc[ai][bj][m][1] * f * gv[bj][1]);
            }
    }
};
struct EpiGU {
    bf16* ACT; const float* bgu;
    __device__ __forceinline__ void operator()(const Acc& acc, const Unit& u, int wr, int wc, int fr, int fq, LAS unsigned char*) const {
        const int row0 = u.gm * 256 + wr * 64 + fr, j0 = 128 * u.nt + 32 * wc + 8 * fq;
        const float* bp = bgu + (size_t)u.e * 2048;
        f32x4 bg[2], bu[2];
#pragma unroll
        for (int n = 0; n < 2; ++n) { bg[n] = *(const f32x4*)(bp + j0 + 4 * n); bu[n] = *(const f32x4*)(bp + 1024 + j0 + 4 * n); }
#pragma unroll
        for (int ai = 0; ai < 2; ++ai)
#pragma unroll
            for (int m = 0; m < 4; ++m) {
                f32x4 z[2];
#pragma unroll
                for (int n = 0; n < 2; ++n) { const f32x4 gt = acc[ai][0][m][n] + bg[n], up = acc[ai][1][m][n] + bu[n];
#pragma unroll
                    for (int r = 0; r < 4; ++r) { const float gg = fminf(gt[r], 7.f), uu = fminf(fmaxf(up[r], -7.f), 7.f); z[n][r] = (uu + 1.f) * (gg * fsigm(1.702f * gg)); } }
                *(u32x4*)(ACT + (size_t)(row0 + ai * 128 + m * 16) * 1024 + j0) = pack8(z[0], z[1]);
            }
    }
};
struct EpiDown {
    bf16* YB; const float* bdn; const float* gate; const LAS int* idx;
    __device__ __forceinline__ void operator()(const Acc& acc, const Unit& u, int wr, int wc, int fr, int fq, LAS unsigned char*) const {
        const int r0 = wr * 64 + fr; const float* bp = bdn + (size_t)u.e * 1024;
        f32x4 bv[2][2]; int c0[2];
#pragma unroll
        for (int bj = 0; bj < 2; ++bj) { c0[bj] = 256 * u.nt + 128 * bj + 32 * wc + 8 * fq; bv[bj][0] = *(const f32x4*)(bp + c0[bj]); bv[bj][1] = *(const f32x4*)(bp + c0[bj] + 4); }
#pragma unroll
        for (int ai = 0; ai < 2; ++ai)
#pragma unroll
            for (int m = 0; m < 4; ++m) {
                const int slot = idx[u.slot * 256 + r0 + ai * 128 + m * 16];
                if (slot >= 0) {
                    const float gw = gate[slot]; bf16* o = YB + (size_t)slot * 1024;
#pragma unroll
                    for (int bj = 0; bj < 2; ++bj) *(u32x4*)(o + c0[bj]) = pack8((acc[ai][bj][m][0] + bv[bj][0]) * gw, (acc[ai][bj][m][1] + bv[bj][1]) * gw);
                }
            }
    }
};

enum { LAY_STD = 0, LAY_HEAD = 1, LAY_INA = 2, LAY_GU = 3, LAY_F32 = 4, LAY_HEAD2 = 5 };
template <int LAY> __device__ __forceinline__ int colmap(int pn, int rho) {
    const int bj = rho >> 7, wc = (rho >> 5) & 3, n = (rho >> 4) & 1, fq = (rho >> 2) & 3, reg = rho & 3;
    const int std_c = 128 * bj + 32 * wc + 8 * fq + 4 * n + reg;
    const int head_c = 64 * wc + 32 * (fq >> 1) + 8 * (fq & 1) + 16 * bj + 4 * n + reg;
    if (LAY == LAY_STD) return 256 * pn + std_c;
    if (LAY == LAY_F32) return 256 * pn + rho;
    if (LAY == LAY_HEAD) return 256 * pn + head_c;
    if (LAY == LAY_HEAD2) return 256 * pn + 64 * wc + 32 * bj + 8 * fq + 4 * n + reg;
    if (LAY == LAY_INA) return pn < 3 ? 256 * pn + head_c : 768 + (bj ? 512 : 0) + 128 * (pn - 3) + 32 * wc + 8 * fq + 4 * n + reg;
    return (bj ? 1024 : 0) + 128 * pn + 32 * wc + 8 * fq + 4 * n + reg;
}
template <int LAY>
__device__ __forceinline__ void cvt_matrix(const float* src, size_t mat_stride, int ld, int nvalid, int K, int tiles_per_mat, int ntiles, bf16* dst, const float* kscale,
                                           LAS float* scr, int it_begin, int it_step, int lane, int it_end = 0x7fffffff) {
    const int kblocks = K / 64; int nitems = ntiles * 8 * kblocks; nitems = nitems < it_end ? nitems : it_end;
    const int gw = it_begin, NGW = it_step;
    const int i = lane & 31, kh = lane >> 5;
    float v[32], vn[32];
#define CVT_LOAD(it_, dstv) do { const int _kb = (it_) % kblocks, _tg = (it_) / kblocks, _grp = _tg & 7, _tile = _tg >> 3; \
        const int _mat = _tile / tiles_per_mat, _pn = _tile - _mat * tiles_per_mat; const int _c = colmap<LAY>(_pn, _grp * 32 + i); const bool _ok = _c < nvalid; \
        const float* _s = src + (size_t)_mat * mat_stride + (size_t)(_kb * 64 + kh) * ld + (_ok ? _c : 0); \
        _Pragma("unroll") for (int ii = 0; ii < 32; ++ii) dstv[ii] = _ok ? _s[(size_t)(2 * ii) * ld] : 0.f; } while (0)
    int it = gw;
    if (it < nitems) CVT_LOAD(it, v);
    for (; it < nitems; it += NGW) {
        const int itn = it + NGW;
        if (itn < nitems) CVT_LOAD(itn, vn);
        const int kb = it % kblocks, tg = it / kblocks, grp = tg & 7, tile = tg >> 3;
        if (kscale) {
#pragma unroll
            for (int ii = 0; ii < 32; ++ii) v[ii] *= kscale[kb * 64 + 2 * ii + kh];
        }
#pragma unroll
        for (int ii = 0; ii < 32; ++ii) scr[(2 * ii + kh) * 33 + i] = v[ii];
        LDS_WAIT(); asm volatile("" ::: "memory");
        const int c8 = lane & 7;
#pragma unroll
        for (int j = 0; j < 4; ++j) { const int n = (lane >> 3) + 8 * j; const LAS float* q = scr + (8 * c8) * 33 + n;
            u32x4 o; o.x = pk2(q[0 * 33], q[1 * 33]); o.y = pk2(q[2 * 33], q[3 * 33]); o.z = pk2(q[4 * 33], q[5 * 33]); o.w = pk2(q[6 * 33], q[7 * 33]);
            *(u32x4*)(dst + ((size_t)tile * 256 + grp * 32 + n) * K + kb * 64 + 8 * c8) = o; }
        LDS_WAIT(); asm volatile("" ::: "memory");
#pragma unroll
        for (int ii = 0; ii < 32; ++ii) v[ii] = vn[ii];
    }
#undef CVT_LOAD
}

struct CvtBg {
    const float* wgu; const float* wdn; bf16* dgu; bf16* ddn; LAS float* scr; int cl0, vcu, j, jend, step, cur, tick; bool have; f32x4 v[8];
    __device__ __forceinline__ void init(const float* wgu_, const float* wdn_, bf16* dgu_, bf16* ddn_, LAS float* scr_, int cl0_, int nlay, int vcu_, int j0, int step_) {
        wgu = wgu_; wdn = wdn_; dgu = dgu_; ddn = ddn_; scr = scr_; cl0 = cl0_; vcu = vcu_; j = j0; step = step_; jend = nlay * 192; cur = 0; tick = 0; have = false;
#pragma unroll
        for (int q = 0; q < 8; ++q) v[q] = (f32x4){0.f, 0.f, 0.f, 0.f}; }
    __device__ __forceinline__ void decode(int jj, bool& isgu, int& cl, int& it) const { cl = cl0 + jj / 192; const int r = jj % 192; isgu = r < 128; it = isgu ? vcu * 128 + r : vcu * 64 + (r - 128); }
    __device__ __forceinline__ void issue_to(int lane, f32x4* r) {
        if (j >= jend) { have = false; return; }
        bool isgu; int cl, it; decode(j, isgu, cl, it);
        const int c4 = lane & 7, kr = lane >> 3, i0 = 16 * (c4 & 1) + 4 * (c4 >> 1);
        const int kb = it & 15, tg = it >> 4, grp = tg & 7, tile = tg >> 3;
        const float* s;
        if (isgu) { const int mat = tile >> 3, pn = tile & 7; s = wgu + ((size_t)(cl * 32 + mat) * 1024 + kb * 64 + kr) * 2048 + colmap<LAY_GU>(pn, grp * 32 + i0); }
        else { const int mat = tile >> 2, pn = tile & 3; s = wdn + ((size_t)(cl * 32 + mat) * 1024 + kb * 64 + kr) * 1024 + colmap<LAY_STD>(pn, grp * 32 + i0); }
        const size_t ld8 = isgu ? 8 * 2048 : 8 * 1024;
#pragma unroll
        for (int q = 0; q < 8; ++q) r[q] = __builtin_nontemporal_load((const f32x4*)(s + q * ld8));
        cur = j; have = true; j += step;
    }
    __device__ __forceinline__ void issue(int lane) { issue_to(lane, v); }
    __device__ __forceinline__ bf16* dstptr(int jj, int& kb) const { bool isgu; int cl, it; decode(jj, isgu, cl, it); kb = it & 15; const int tg = it >> 4, grp = tg & 7, tile = tg >> 3;
        return isgu ? dgu + ((size_t)(cl * 256 + tile) * 256 + grp * 32) * 1024 : ddn + ((size_t)(cl * 128 + tile) * 256 + grp * 32) * 1024; }
    __device__ __forceinline__ void finish(int lane) {
        if (!have) return;
        const int c4 = lane & 7, kr = lane >> 3, i0 = 16 * (c4 & 1) + 4 * (c4 >> 1);
#pragma unroll
        for (int q = 0; q < 8; ++q) { const int kk = 8 * q + kr; scr[kk * 33 + i0] = v[q][0]; scr[kk * 33 + i0 + 1] = v[q][1]; scr[kk * 33 + i0 + 2] = v[q][2]; scr[kk * 33 + i0 + 3] = v[q][3]; }
        LDS_WAIT(); asm volatile("" ::: "memory");
        int kb; bf16* d = dstptr(cur, kb);
        const int c8 = lane & 7;
#pragma unroll
        for (int jx = 0; jx < 4; ++jx) { const int n = (lane >> 3) + 8 * jx; const LAS float* q_ = scr + (8 * c8) * 33 + n;
            u32x4 o; o.x = pk2(q_[0 * 33], q_[1 * 33]); o.y = pk2(q_[2 * 33], q_[3 * 33]); o.z = pk2(q_[4 * 33], q_[5 * 33]); o.w = pk2(q_[6 * 33], q_[7 * 33]);
            *(u32x4*)(d + (size_t)n * 1024 + kb * 64 + 8 * c8) = o; }
        LDS_WAIT(); asm volatile("" ::: "memory");
        have = false;
    }
    __device__ __forceinline__ void carrier_put(int lane, const f32x4* r, LAS unsigned char* buf, LAS int* hdr, bool reissue, f32x4* rnext) {
        if (have) { const int c4 = lane & 7, kr = lane >> 3, cq = 4 * (c4 & 1) + (c4 >> 1);
#pragma unroll
            for (int q = 0; q < 8; ++q) *(LAS f32x4*)(buf + (8 * q + kr) * 128 + ((cq ^ q) << 4)) = r[q]; }
        if (lane == 0) *hdr = have ? cur : -1;
        have = false;
        if (reissue) issue_to(lane, rnext);
    }
    __device__ __forceinline__ void cv_process(int tid, const LAS unsigned char* cvb, const LAS int* hdr) const {
#pragma unroll
        for (int hf = 0; hf < 2; ++hf) { const int id = tid + 512 * hf, c = id >> 8, jj = hdr[c];
            if (jj >= 0) { const int n = (id >> 3) & 31, o = id & 7; const LAS float* b = (const LAS float*)(cvb + c * 8192 + (8 * o) * 128 + (((n >> 2) ^ o) << 4)) + (n & 3);
                int kb; bf16* d = dstptr(jj, kb);
                u32x4 w; w.x = pk2(b[0], b[32]); w.y = pk2(b[64], b[96]); w.z = pk2(b[128], b[160]); w.w = pk2(b[192], b[224]);
                *(u32x4*)(d + (size_t)n * 1024 + kb * 64 + 8 * o) = w; } }
    }
};
struct NoBg { __device__ __forceinline__ void issue(int) {} __device__ __forceinline__ void finish(int) {} };

__device__ __forceinline__ void normmod_store(const f32x4 (&v)[4], float rstd, const float* g, const float* mvec  , int sh_off, int sc_off, bf16* orow, int lane) {
#pragma unroll
    for (int j = 0; j < 4; ++j) { const int c = 4 * lane + 256 * j;
        const f32x4 gg = *(const f32x4*)(g + c), sc = *(const f32x4*)(mvec + sc_off + c), sh = *(const f32x4*)(mvec + sh_off + c);
        const f32x4 y = v[j] * rstd * gg * (sc + 1.f) + sh;
        u32x2 w; w.x = pk2(y[0], y[1]); w.y = pk2(y[2], y[3]); *(u32x2*)(orow + c) = w; }
}

template <int DQK> struct AT {
    static constexpr int CK = DQK / 8, RSK = DQK * 2 + 16, RSV = 192, KT = 64 * RSK, VT = 64 * RSV, STG = KT + VT, NKS = DQK / 16;
};
#define MFMA32(a, b, c) __builtin_amdgcn_mfma_f32_32x32x16_bf16((a), (b), (c), 0, 0, 0)
struct TileList { int nloc, row_loc0, kpos_loc0, row_ctx0, ntiles; };
template <int DQK, bool MASK, class Bg, int CAD>
__device__ __forceinline__ void attn_core(LAS unsigned char* lds, const bf16x8 (&qf)[DQK / 16], const TileList tl, const char* Kg, int kpitchB, const char* Vg, int vpitchB,
                                          int qpos, float& m, float& l, f32x16 (&O)[2], Bg& bg) {
    typedef AT<DQK> A;
    const int tid = otid(), lane = tid & 63, h = lane >> 5;
    const bool stager = tid < 256;
    constexpr int NKCH = 64 * A::CK, NCH = NKCH + 512, NQ = NCH / 256;
    const unsigned kfrag = (unsigned)((lane & 31) * A::RSK + 16 * h);
    const unsigned vfrag = (unsigned)((((lane & 15) >> 2) + 4 * h) * A::RSV + (16 * ((lane >> 4) & 1) + 4 * (lane & 3)) * 2);
    f32x4 (&R)[8] = bg.v;
    LAS unsigned char* cvb = lds + CV_BUF; LAS int* cvh = (LAS int*)(lds + CV_HDR);
    const int cw = (tid >> 6) & 3;
#define AT_ROW0(i) ((i) < tl.nloc ? tl.row_loc0 + 64 * (i) : tl.row_ctx0 + 64 * ((i) - tl.nloc))
#define AT_LOAD(i) do { if (stager) { const int _r0 = AT_ROW0(i); \
        _Pragma("unroll") for (int q = 0; q < NQ; ++q) { const int c = tid + 256 * q; \
            if (c < NKCH) R[q] = *(const f32x4*)(Kg + (size_t)(_r0 + c / A::CK) * kpitchB + (c % A::CK) * 16); \
            else { const int v_ = c - NKCH; R[q] = *(const f32x4*)(Vg + (size_t)(_r0 + (v_ >> 3)) * vpitchB + (v_ & 7) * 16); } } } } while (0)
#define AT_WRITE(buf) do { if (stager) { LAS unsigned char* _b = lds + (buf) * A::STG; \
        _Pragma("unroll") for (int q = 0; q < NQ; ++q) { const int c = tid + 256 * q; \
            if (c < NKCH) *(LAS f32x4*)(_b + (c / A::CK) * A::RSK + (c % A::CK) * 16) = R[q]; \
            else { const int v_ = c - NKCH; *(LAS f32x4*)(_b + A::KT + (v_ >> 3) * A::RSV + (v_ & 7) * 16) = R[q]; } } } } while (0)
    f32x16 zero16;
#pragma unroll
    for (int r = 0; r < 16; ++r) zero16[r] = 0.f;
    AT_LOAD(0); AT_WRITE(0);
    __syncthreads();
    for (int i = 0; i < tl.ntiles; ++i) {
        const bool more = (i + 1 < tl.ntiles);
        if (more) AT_LOAD(i + 1);
        if ((bg.tick & 1) == 0) { if (!stager) bg.carrier_put(lane, R, cvb + cw * 8192, cvh + cw, true, R); }
        else bg.cv_process(tid, cvb, cvh);
        const LAS unsigned char* kt = lds + (i & 1) * A::STG; const LAS unsigned char* vt = kt + A::KT;
        constexpr int KH = A::NKS / 2;
        bf16x8 ka[KH][2];
#pragma unroll
        for (int ks = 0; ks < KH; ++ks) { ka[ks][0] = *(const LAS bf16x8*)(kt + kfrag + 32 * ks); ka[ks][1] = *(const LAS bf16x8*)(kt + kfrag + 32 * A::RSK + 32 * ks); }
        __builtin_amdgcn_sched_barrier(0);
        f32x16 s0 = MFMA32(ka[0][0], qf[0], zero16), s1 = MFMA32(ka[0][1], qf[0], zero16);
#pragma unroll
        for (int ks = 1; ks < KH; ++ks) { s0 = MFMA32(ka[ks][0], qf[ks], s0); s1 = MFMA32(ka[ks][1], qf[ks], s1); }
#pragma unroll
        for (int ks = 0; ks < KH; ++ks) { ka[ks][0] = *(const LAS bf16x8*)(kt + kfrag + 32 * (KH + ks)); ka[ks][1] = *(const LAS bf16x8*)(kt + kfrag + 32 * A::RSK + 32 * (KH + ks)); }
        __builtin_amdgcn_sched_barrier(0);
#pragma unroll
        for (int ks = 0; ks < KH; ++ks) { s0 = MFMA32(ka[ks][0], qf[KH + ks], s0); s1 = MFMA32(ka[ks][1], qf[KH + ks], s1); }
        __builtin_amdgcn_sched_barrier(0);
        s16x4 vlo[2][2], vhi[2][2];
#pragma unroll
        for (int sp = 0; sp < 2; ++sp)
#pragma unroll
            for (int dvb = 0; dvb < 2; ++dvb) { const LAS unsigned char* vp = vt + vfrag + (16 * sp) * A::RSV + 64 * dvb;
                vlo[sp][dvb] = __builtin_amdgcn_ds_read_tr16_b64_v4i16((LAS s16x4*)(vp)); vhi[sp][dvb] = __builtin_amdgcn_ds_read_tr16_b64_v4i16((LAS s16x4*)(vp + 8 * A::RSV)); }
        __builtin_amdgcn_sched_barrier(0);
        if (MASK) {
            if (i < tl.nloc) {
                const int kb = tl.kpos_loc0 + 64 * i + 4 * h - qpos;
#pragma unroll
                for (int r = 0; r < 16; ++r) { const int d0 = kb + (r & 3) + 8 * (r >> 2), d1 = d0 + 32;
                    if (d0 > 128 || d0 < -128) s0[r] = -1e30f; if (d1 > 128 || d1 < -128) s1[r] = -1e30f; }
            }
        }
        float tm = fmaxf(fmaxf(s0[0], s1[0]), fmaxf(s0[1], s1[1]));
#pragma unroll
        for (int r = 2; r < 16; r += 2) tm = fmaxf(tm, fmaxf(fmaxf(s0[r], s1[r]), fmaxf(s0[r + 1], s1[r + 1])));
        tm = fmaxf(tm, __shfl_xor(tm, 32)) - m;
        if (__builtin_amdgcn_ballot_w64(tm > 8.f) != 0ull) {
            const float dlt = fmaxf(tm, 0.f), alpha = __builtin_amdgcn_exp2f(-dlt);
            m += dlt; l *= alpha;
#pragma unroll
            for (int r = 0; r < 16; ++r) { O[0][r] *= alpha; O[1][r] *= alpha; }
        }
        if (__builtin_amdgcn_ballot_w64(m != 0.f) != 0ull) {
#pragma unroll
            for (int r = 0; r < 16; ++r) { s0[r] -= m; s1[r] -= m; }
        }
        float ps = 0.f;
#pragma unroll
        for (int r = 0; r < 16; ++r) { s0[r] = __builtin_amdgcn_exp2f(s0[r]); s1[r] = __builtin_amdgcn_exp2f(s1[r]); ps += s0[r] + s1[r]; }
        l += ps;
#pragma unroll
        for (int kh = 0; kh < 2; ++kh) {
            const f32x16& p = kh ? s1 : s0;
#pragma unroll
            for (int sp = 0; sp < 2; ++sp) {
                u32x4 pw; pw.x = pk2(p[8 * sp + 0], p[8 * sp + 1]); pw.y = pk2(p[8 * sp + 2], p[8 * sp + 3]); pw.z = pk2(p[8 * sp + 4], p[8 * sp + 5]); pw.w = pk2(p[8 * sp + 6], p[8 * sp + 7]);
                const bf16x8 pf = __builtin_bit_cast(bf16x8, pw);
#pragma unroll
                for (int dvb = 0; dvb < 2; ++dvb) { const bf16x8 va = __builtin_shufflevector(vlo[sp][dvb], vhi[sp][dvb], 0, 1, 2, 3, 4, 5, 6, 7); O[dvb] = MFMA32(va, pf, O[dvb]); }
            }
            if (kh == 0) {
#pragma unroll
                for (int sp = 0; sp < 2; ++sp)
#pragma unroll
                    for (int dvb = 0; dvb < 2; ++dvb) { const LAS unsigned char* vp = vt + vfrag + (32 + 16 * sp) * A::RSV + 64 * dvb;
                        vlo[sp][dvb] = __builtin_amdgcn_ds_read_tr16_b64_v4i16((LAS s16x4*)(vp)); vhi[sp][dvb] = __builtin_amdgcn_ds_read_tr16_b64_v4i16((LAS s16x4*)(vp + 8 * A::RSV)); }
            }
        }
        if (more) AT_WRITE((i + 1) & 1);
        ++bg.tick;
        __syncthreads();
    }
#undef AT_ROW0
#undef AT_LOAD
#undef AT_WRITE
}
__device__ __forceinline__ void attn_store(const f32x16 (&O)[2], float l, bf16* orow, int h) {
    const float lt = l + __shfl_xor(l, 32); const float inv = 1.f / lt;
#pragma unroll
    for (int dvb = 0; dvb < 2; ++dvb)
#pragma unroll
        for (int g4 = 0; g4 < 4; ++g4) { u32x2 w; w.x = pk2(O[dvb][4 * g4] * inv, O[dvb][4 * g4 + 1] * inv); w.y = pk2(O[dvb][4 * g4 + 2] * inv, O[dvb][4 * g4 + 3] * inv);
            *(u32x2*)(orow + 32 * dvb + 8 * g4 + 4 * h) = w; }
}

__device__ __forceinline__ void wattn_unit(LAS unsigned char* lds, int unit, const bf16* Qa, const bf16* Ka, const bf16* Va, const float* sink, bf16* MIX, CvtBg& bg) {
    const int tid = otid(), w = tid >> 6, lane = tid & 63, h = lane >> 5;
    int b, kvh, hp, tq, qpos; TileList tl;
    if (unit < 512) { b = unit >> 7; kvh = (unit >> 6) & 1; const int nb = (unit >> 1) & 31; hp = unit & 1;
        const int t0 = max(0, 128 * nb - 128), t1 = min(4096, 128 * nb + 256);
        tl.nloc = (t1 - t0) >> 6; tl.row_loc0 = b * S + t0; tl.kpos_loc0 = t0; tl.row_ctx0 = NL + b * CL; tl.ntiles = tl.nloc + 4;
        qpos = 128 * nb + (w & 3) * 32 + (lane & 31); tq = b * S + qpos;
    } else { const int u = unit - 512; b = u >> 3; kvh = (u >> 2) & 1; hp = (u >> 1) & 1; const int half = u & 1;
        tl.nloc = 0; tl.row_loc0 = 0; tl.kpos_loc0 = 0; tl.row_ctx0 = NL + b * CL; tl.ntiles = 4;
        qpos = 0; tq = NL + b * CL + half * 128 + (w & 3) * 32 + (lane & 31); }
    const int hq = kvh * 4 + hp * 2 + (w >> 2);
    bf16x8 qf[4];
#pragma unroll
    for (int ks = 0; ks < 4; ++ks) qf[ks] = *(const bf16x8*)(Qa + (size_t)tq * 512 + hq * 64 + 16 * ks + 8 * h);
    float m = 0.f, l = (h == 0) ? __expf(sink[hq]) : 0.f;
    f32x16 O[2];
#pragma unroll
    for (int r = 0; r < 16; ++r) { O[0][r] = 0.f; O[1][r] = 0.f; }
    attn_core<64, true, CvtBg, 2>(lds, qf, tl, (const char*)(Ka + kvh * 64), 256, (const char*)(Va + kvh * 64), 256, qpos, m, l, O, bg);
    attn_store(O, l, MIX + (size_t)tq * 1024 + hq * 64, h);
}
__device__ __forceinline__ void mla_unit(LAS unsigned char* lds, int unit, const bf16* Qc, const bf16* Kc, const bf16* Vc, const float* RS, const float* qg,
                                         const float* cosC, const float* sinC, bf16* MIX, CvtBg& bg) {
    const int tid = otid(), w = tid >> 6, lane = tid & 63, h = lane >> 5;
    int b, head, tq; TileList tl; bool lat;
    if (unit < 1024) { b = unit >> 8; head = (unit >> 4) & 15; const int qb = unit & 15; lat = true;
        tl.nloc = 64; tl.row_loc0 = b * S; tl.kpos_loc0 = 0; tl.row_ctx0 = NL + b * CL; tl.ntiles = 68; tq = b * S + qb * 256 + w * 32 + (lane & 31);
    } else { const int u = unit - 1024; b = u >> 4; head = u & 15; lat = false;
        tl.nloc = 0; tl.row_loc0 = 0; tl.kpos_loc0 = 0; tl.row_ctx0 = NL + b * CL; tl.ntiles = 4; tq = NL + b * CL + w * 32 + (lane & 31); }
    float v[6][8]; float ss = 0.f;
    const bf16* qp = Qc + (size_t)tq * 1536 + head * 96 + 8 * h;
#pragma unroll
    for (int ks = 0; ks < 6; ++ks) { const u32x4 raw = *(const u32x4*)(qp + 16 * ks);
        v[ks][0] = bflo(raw.x); v[ks][1] = bfhi(raw.x); v[ks][2] = bflo(raw.y); v[ks][3] = bfhi(raw.y); v[ks][4] = bflo(raw.z); v[ks][5] = bfhi(raw.z); v[ks][6] = bflo(raw.w); v[ks][7] = bfhi(raw.w);
#pragma unroll
        for (int j = 0; j < 8; ++j) ss += v[ks][j] * v[ks][j]; }
    ss += __shfl_xor(ss, 32);
    float r; { const f32x4 p0 = *(const f32x4*)(RS + (size_t)tq * 16), p1 = *(const f32x4*)(RS + (size_t)tq * 16 + 4), p2 = *(const f32x4*)(RS + (size_t)tq * 16 + 8);
      r = rsqrtf((((p0[0] + p0[1]) + (p0[2] + p0[3])) + ((p1[0] + p1[1]) + (p1[2] + p1[3])) + ((p2[0] + p2[1]) + (p2[2] + p2[3]))) * (1.f / 768.f) + EPS); }
    const float inv = r * rsqrtf(r * r * ss * (1.f / 96.f) + EPS);
#pragma unroll
    for (int ks = 0; ks < 6; ++ks) { const f32x4 g0 = *(const f32x4*)(qg + 16 * ks + 8 * h), g1 = *(const f32x4*)(qg + 16 * ks + 8 * h + 4);
#pragma unroll
        for (int j = 0; j < 4; ++j) { v[ks][j] *= inv * g0[j]; v[ks][4 + j] *= inv * g1[j]; } }
    {
        const int t = tq & 4095;
#pragma unroll
        for (int ax = 0; ax < 2; ++ax) {
            const f32x4 c0 = *(const f32x4*)(cosC + t * 16 + 8 * ax), c1 = *(const f32x4*)(cosC + t * 16 + 8 * ax + 4);
            const f32x4 s0 = *(const f32x4*)(sinC + t * 16 + 8 * ax), s1 = *(const f32x4*)(sinC + t * 16 + 8 * ax + 4);
#pragma unroll
            for (int j = 0; j < 8; ++j) { const float y = v[4 + ax][j], po = __shfl_xor(y, 32); const float c = j < 4 ? c0[j & 3] : c1[j & 3], s = j < 4 ? s0[j & 3] : s1[j & 3];
                const float yr = (h == 0) ? (y * c - po * s) : (y * c + po * s); v[4 + ax][j] = lat ? yr : y; }
        }
    }
    bf16x8 qf[6];
#pragma unroll
    for (int ks = 0; ks < 6; ++ks) { u32x4 pw; pw.x = pk2(v[ks][0] * QSCALE_C, v[ks][1] * QSCALE_C); pw.y = pk2(v[ks][2] * QSCALE_C, v[ks][3] * QSCALE_C);
        pw.z = pk2(v[ks][4] * QSCALE_C, v[ks][5] * QSCALE_C); pw.w = pk2(v[ks][6] * QSCALE_C, v[ks][7] * QSCALE_C); qf[ks] = __builtin_bit_cast(bf16x8, pw); }
    float m = 0.f, l = 0.f;
    f32x16 O[2];
#pragma unroll
    for (int rr = 0; rr < 16; ++rr) { O[0][rr] = 0.f; O[1][rr] = 0.f; }
    attn_core<96, false, CvtBg, 4>(lds, qf, tl, (const char*)(Kc + head * 96), 3072, (const char*)(Vc + head * 64), 2048, 0, m, l, O, bg);
    attn_store(O, l, MIX + (size_t)tq * 1024 + head * 64, h);
}

template <int NTOK>
__device__ __forceinline__ void conv_strip(LAS unsigned char* lds, int seq0, int len, int t0, const bf16* Z, const float* dw_w, const float* dw_b, const float* ln_g, const float* ln_b, bf16* MIX) {
    const int tid = otid(), w = tid >> 6, lane = tid & 63;
    constexpr int NROW = NTOK + 30, NCH = NROW * 64, NLD = (NCH + NTHR - 1) / NTHR, NSUB = (NTOK + 15) / 16;
    LAS bf16* zt = (LAS bf16*)lds; LAS float* ot = (LAS float*)(lds + 98304);
    u32x4 st[NLD];
#pragma unroll
    for (int i = 0; i < NLD; ++i) { const int q = tid + i * NTHR, r = q >> 6, cc = q & 63, tt = t0 - 15 + r; st[i] = (u32x4){0u, 0u, 0u, 0u};
        if (q < NCH && tt >= 0 && tt < len) st[i] = *(const u32x4*)(Z + (size_t)(seq0 + tt) * 512 + cc * 8); }
    float wt[31];
#pragma unroll
    for (int j = 0; j < 31; ++j) wt[j] = dw_w[j * 512 + tid];
    const float bias = dw_b[tid];
#pragma unroll
    for (int i = 0; i < NLD; ++i) { const int q = tid + i * NTHR; if (q < NCH) *(LAS u32x4*)(zt + (q >> 6) * 512 + (q & 63) * 8) = st[i]; }
    const f32x4 g0 = *(const f32x4*)(ln_g + 8 * lane), g1 = *(const f32x4*)(ln_g + 8 * lane + 4), b0 = *(const f32x4*)(ln_b + 8 * lane), b1 = *(const f32x4*)(ln_b + 8 * lane + 4);
    __syncthreads();
#pragma unroll 1
    for (int sb = 0; sb < NSUB; ++sb) {
        float acc[16];
#pragma unroll
        for (int t = 0; t < 16; ++t) acc[t] = bias;
        const LAS bf16* zp = zt + sb * 16 * 512 + tid;
        constexpr int NR = (NTOK >= 16 ? 16 : NTOK) + 30;
#pragma unroll
        for (int r = 0; r < NR; ++r) { const float zv = bf1(zp[r * 512]);
#pragma unroll
            for (int t = 0; t < 16; ++t) { const int j = r - t; if (j >= 0 && j < 31 && t < NTOK) acc[t] += zv * wt[j]; } }
#pragma unroll
        for (int t = 0; t < 16; ++t) ot[t * 512 + tid] = acc[t];
        __syncthreads();
#pragma unroll
        for (int q = 0; q < 2; ++q) { const int t = 2 * w + q, tok = sb * 16 + t;
            if (tok < NTOK) {
                const f32x4 x0 = *(const LAS f32x4*)(ot + t * 512 + 8 * lane), x1 = *(const LAS f32x4*)(ot + t * 512 + 8 * lane + 4);
                const float mu = wave_sum((x0[0] + x0[1]) + (x0[2] + x0[3]) + (x1[0] + x1[1]) + (x1[2] + x1[3])) * (1.f / 512.f);
                const f32x4 d0 = x0 - mu, d1 = x1 - mu;
                const float var = wave_sum((d0[0] * d0[0] + d0[1] * d0[1]) + (d0[2] * d0[2] + d0[3] * d0[3]) + (d1[0] * d1[0] + d1[1] * d1[1]) + (d1[2] * d1[2] + d1[3] * d1[3])) * (1.f / 512.f);
                const float rstd = rsqrtf(var + EPS);
                f32x4 y0 = d0 * rstd * g0 + b0, y1 = d1 * rstd * g1 + b1;
#pragma unroll
                for (int j = 0; j < 4; ++j) { y0[j] = fsilu(y0[j]); y1[j] = fsilu(y1[j]); }
                *(u32x4*)(MIX + (size_t)(seq0 + t0 + tok) * 1024 + 512 + 8 * lane) = pack8(y0, y1); } }
        __syncthreads();
    }
}

__device__ __forceinline__ void mla_stats_row(int row, int lane, const bf16* P, const float* krg, const float* cosC, const float* sinC, float* RS, bf16* Kc) {
    const bf16* p = P + (size_t)row * PP;
    const u32x4 a = *(const u32x4*)(p + 8 * lane);
    const u32x4 b = *(const u32x4*)(p + 8 * (lane + 64));
    u32x4 c = (u32x4){0u, 0u, 0u, 0u};
    if (lane < 4) c = *(const u32x4*)(p + 8 * (lane + 128));
    auto sq = [](u32x4 u) { float s = 0.f; s += bflo(u.x) * bflo(u.x) + bfhi(u.x) * bfhi(u.x); s += bflo(u.y) * bflo(u.y) + bfhi(u.y) * bfhi(u.y);
                            s += bflo(u.z) * bflo(u.z) + bfhi(u.z) * bfhi(u.z); s += bflo(u.w) * bflo(u.w) + bfhi(u.w) * bfhi(u.w); return s; };
    const float sa = sq(a), sb = sq(b), sc = sq(c);
    const float ssq = wave_sum(sa + (lane < 32 ? sb : 0.f)), skv = wave_sum(lane >= 32 ? sb : 0.f), skr = wave_sum(sc);
    if (lane == 0) { RS[(size_t)row * 2] = rsqrtf(ssq * (1.f / 768.f) + EPS); RS[(size_t)row * 2 + 1] = rsqrtf(skv * (1.f / 256.f) + EPS); }
    const float rk = rsqrtf(skr * (1.f / 32.f) + EPS);
    float y[8]; const int l4 = lane & 3;
    { const f32x4 g0 = *(const f32x4*)(krg + 8 * l4), g1 = *(const f32x4*)(krg + 8 * l4 + 4);
      y[0] = bflo(c.x) * rk * g0[0]; y[1] = bfhi(c.x) * rk * g0[1]; y[2] = bflo(c.y) * rk * g0[2]; y[3] = bfhi(c.y) * rk * g0[3];
      y[4] = bflo(c.z) * rk * g1[0]; y[5] = bfhi(c.z) * rk * g1[1]; y[6] = bflo(c.w) * rk * g1[2]; y[7] = bfhi(c.w) * rk * g1[3]; }
    const int t = row & 4095, ax = l4 >> 1, half = l4 & 1;
    const f32x4 c0 = *(const f32x4*)(cosC + t * 16 + 8 * ax), c1 = *(const f32x4*)(cosC + t * 16 + 8 * ax + 4), s0 = *(const f32x4*)(sinC + t * 16 + 8 * ax), s1 = *(const f32x4*)(sinC + t * 16 + 8 * ax + 4);
    float o[8];
#pragma unroll
    for (int j = 0; j < 8; ++j) { const float po = __shfl_xor(y[j], 1); const float cc = j < 4 ? c0[j & 3] : c1[j & 3], sn = j < 4 ? s0[j & 3] : s1[j & 3];
        const float yr = half == 0 ? (y[j] * cc - po * sn) : (y[j] * cc + po * sn); o[j] = row < NL ? yr : y[j]; }
    if (lane < 4) { u32x4 wv; wv.x = pk2(o[0], o[1]); wv.y = pk2(o[2], o[3]); wv.z = pk2(o[4], o[5]); wv.w = pk2(o[6], o[7]);
#pragma unroll
        for (int hd = 0; hd < 16; ++hd) *(u32x4*)(Kc + (size_t)row * 1536 + hd * 96 + 64 + 8 * lane) = wv; }
}

template <int NT>
__device__ __forceinline__ void moe_setup(LAS unsigned char* lds, const int* cntG, const int* list, int layer, int vcu, int G) {
    LAS int* tab = (LAS int*)(lds + LDS_TAB); LAS int* idx = (LAS int*)(lds + LDS_IDX);
    const int tid = otid(); constexpr int MG = 32 / NT;
    if (tid < 32) tab[tid] = cntG[tid * 64];
    __syncthreads();
    if (tid == 0) { int acc = 0; for (int e = 0; e < 32; ++e) { tab[32 + e] = acc; acc += (tab[e] + 255) >> 8; } tab[64] = acc;
        int n = 0;
        for (int i = 0; i < MAXU; ++i) { const int v = i * G + vcu, gm = (v >> 5) * MG + (v & 31) / NT, nt = v % NT; if (gm >= acc) break;
            int e = 0; while (e < 31 && tab[33 + e] <= gm) ++e;
            tab[128 + 4 * i] = gm; tab[129 + 4 * i] = (layer * 32 + e) * NT + nt; tab[130 + 4 * i] = e; tab[131 + 4 * i] = nt; n = i + 1; }
        tab[127] = n; }
    __syncthreads();
    const int n = tab[127];
    for (int q = tid; q < n * 256; q += NTHR) { const int i = q >> 8, r = q & 255, gm = tab[128 + 4 * i], e = tab[130 + 4 * i], rr = (gm - tab[32 + e]) * 256 + r;
        idx[q] = rr < tab[e] ? list[(size_t)e * T + rr] : -1; }
    __syncthreads();
}

__device__ __forceinline__ void combine_row(int row, int lane, float* X, const bf16* YB, const float* mcur  , const float* gnext, const float* mnext, bf16* H, float* out) {
    const int mr = modrow(row); const float* mv = mcur + (size_t)mr * 6144 + 5120;
    f32x4 v[2][2]; float ss = 0.f;
    u32x4 y[2][4];
#pragma unroll
    for (int j = 0; j < 2; ++j)
#pragma unroll
        for (int k = 0; k < 4; ++k) y[j][k] = *(const u32x4*)(YB + ((size_t)row * 4 + k) * 1024 + 8 * lane + 512 * j);
#pragma unroll
    for (int j = 0; j < 2; ++j) { const int c = 8 * lane + 512 * j; f32x4 a0 = (f32x4){0.f, 0.f, 0.f, 0.f}, a1 = a0;
#pragma unroll
        for (int k = 0; k < 4; ++k) { a0 += (f32x4){bflo(y[j][k].x), bfhi(y[j][k].x), bflo(y[j][k].y), bfhi(y[j][k].y)}; a1 += (f32x4){bflo(y[j][k].z), bfhi(y[j][k].z), bflo(y[j][k].w), bfhi(y[j][k].w)}; }
        float* xp = X + (size_t)row * D + c; const f32x4 g0 = *(const f32x4*)(mv + c), g1 = *(const f32x4*)(mv + c + 4);
        v[j][0] = *(const f32x4*)xp + g0 * a0; v[j][1] = *(const f32x4*)(xp + 4) + g1 * a1;
        float* op = out ? out + (size_t)row * D + c : xp;
        *(f32x4*)op = v[j][0]; *(f32x4*)(op + 4) = v[j][1];
#pragma unroll
        for (int q = 0; q < 2; ++q) ss += (v[j][q][0] * v[j][q][0] + v[j][q][1] * v[j][q][1]) + (v[j][q][2] * v[j][q][2] + v[j][q][3] * v[j][q][3]); }
    if (H) { const float rstd = rsqrtf(wave_sum(ss) * (1.f / D) + EPS); const float* mn = mnext + (size_t)mr * 6144;
#pragma unroll
        for (int j = 0; j < 2; ++j) { const int c = 8 * lane + 512 * j; f32x4 o[2];
#pragma unroll
            for (int q = 0; q < 2; ++q) { const f32x4 gg = *(const f32x4*)(gnext + c + 4 * q), sc = *(const f32x4*)(mn + 1024 + c + 4 * q), sh = *(const f32x4*)(mn + c + 4 * q); o[q] = v[j][q] * rstd * gg * (sc + 1.f) + sh; }
            *(u32x4*)(H + (size_t)row * D + c) = pack8(o[0], o[1]); } }
}

#define MFMA16(a, b, c) __builtin_amdgcn_mfma_f32_16x16x32_bf16((a), (b), (c), 0, 0, 0)
__device__ __forceinline__ void router_load_table(LAS unsigned char* lds, const bf16* Wr, int tid) {
    u32x4 v[16];
#pragma unroll
    for (int i = 0; i < 16; ++i) v[i] = *(const u32x4*)(Wr + (size_t)(tid + i * NTHR) * 8);
#pragma unroll
    for (int i = 0; i < 16; ++i) { const int q = tid + i * NTHR, row = q >> 7, c = q & 127; *(LAS u32x4*)(lds + row * 2048 + ((c ^ (row & 15)) << 4)) = v[i]; }
}
__device__ __forceinline__ void router_group(LAS unsigned char* lds, int g, int w, int lane, const float* X, const float* SSX, const float* gffn, const float* mvec, const float* rb,
                                             bf16* F, float* gate) {
    LAS float* lg = (LAS float*)(lds + LDS_IDX) + w * 512; LAS int* pend = (LAS int*)(lds + LDS_IDX + 10240) + w * 64; LAS int* cntL = (LAS int*)(lds + LDS_TAB);
    const int i = lane & 15, kq = lane >> 4, row = 16 * g + i;
    const float* xr = X + (size_t)row * D + 8 * kq;
    float ss; { const f32x4 pq = *(const f32x4*)(SSX + (size_t)row * 16 + 4 * kq); ss = (pq[0] + pq[1]) + (pq[2] + pq[3]); }
    ss += __shfl_xor(ss, 16); ss += __shfl_xor(ss, 32);
    const float rstd = rsqrtf(ss * (1.f / D) + EPS);
    f32x4 acc[2] = {(f32x4){0.f, 0.f, 0.f, 0.f}, (f32x4){0.f, 0.f, 0.f, 0.f}};
    const LAS unsigned char* tb = lds + i * 2048;
#pragma unroll 8
    for (int s = 0; s < 32; ++s) {
        const int k = 32 * s + 8 * kq;
        const f32x4 a = *(const f32x4*)(xr + 32 * s), b = *(const f32x4*)(xr + 32 * s + 4);
        const f32x4 g0 = *(const f32x4*)(gffn + k), g1 = *(const f32x4*)(gffn + k + 4), c0 = *(const f32x4*)(mvec + 4096 + k), c1 = *(const f32x4*)(mvec + 4096 + k + 4);
        const f32x4 h0 = *(const f32x4*)(mvec + 3072 + k), h1 = *(const f32x4*)(mvec + 3072 + k + 4);
        const f32x4 f0 = a * rstd * g0 * (c0 + 1.f) + h0, f1 = b * rstd * g1 * (c1 + 1.f) + h1;
        u32x4 hi; hi.x = pk2(f0[0], f0[1]); hi.y = pk2(f0[2], f0[3]); hi.z = pk2(f1[0], f1[1]); hi.w = pk2(f1[2], f1[3]);
        *(u32x4*)(F + (size_t)row * D + k) = hi;
        u32x4 lo; lo.x = pk2(f0[0] - bflo(hi.x), f0[1] - bfhi(hi.x)); lo.y = pk2(f0[2] - bflo(hi.y), f0[3] - bfhi(hi.y));
        lo.z = pk2(f1[0] - bflo(hi.z), f1[1] - bfhi(hi.z)); lo.w = pk2(f1[2] - bflo(hi.w), f1[3] - bfhi(hi.w));
        const bf16x8 ah = __builtin_bit_cast(bf16x8, hi), al = __builtin_bit_cast(bf16x8, lo);
        const int cs = ((4 * s + kq) ^ i) << 4;
#pragma unroll
        for (int et = 0; et < 2; ++et) { const bf16x8 bh = *(const LAS bf16x8*)(tb + et * 16 * 2048 + cs), bl = *(const LAS bf16x8*)(tb + (32 + et * 16) * 2048 + cs);
            acc[et] = MFMA16(ah, bh, acc[et]); acc[et] = MFMA16(al, bh, acc[et]); acc[et] = MFMA16(ah, bl, acc[et]); }
    }
#pragma unroll
    for (int et = 0; et < 2; ++et) { const float bias = rb[16 * et + i];
#pragma unroll
        for (int r = 0; r < 4; ++r) lg[(4 * kq + r) * 32 + 16 * et + i] = acc[et][r] + bias; }
    LDS_WAIT(); asm volatile("" ::: "memory");
    if (lane < 16) {
        const LAS float* my = lg + lane * 32; unsigned used = 0u; int bi[4]; float bv[4];
#pragma unroll
        for (int k = 0; k < 4; ++k) { float best = -3.0e38f; int be = 0;
#pragma unroll
            for (int e = 0; e < 32; ++e) { const float v = my[e]; const bool ok = !((used >> e) & 1u) && v > best; best = ok ? v : best; be = ok ? e : be; }
            used |= 1u << be; bi[k] = be; bv[k] = best; }
        float ex[4], sum = 0.f;
#pragma unroll
        for (int k = 0; k < 4; ++k) { ex[k] = __expf(bv[k] - bv[0]); sum += ex[k]; }
        const float inv = 1.f / sum; const int trow = 16 * g + lane;
#pragma unroll
        for (int k = 0; k < 4; ++k) { const int rl = __hip_atomic_fetch_add(cntL + bi[k], 1, __ATOMIC_RELAXED, __HIP_MEMORY_SCOPE_WORKGROUP);
            pend[lane * 4 + k] = (trow * 4 + k) | (bi[k] << 17) | (rl << 22); gate[trow * 4 + k] = ex[k] * inv; }
    }
}

struct Args { const float* in[32]; float* out; unsigned char* ws; int lo, hi, flags, pad; };
constexpr int N_PHASES = 2 + 2 * (7 + 8);

__global__ void __launch_bounds__(NTHR, 2) mega(Args args) {
    extern __shared__ __attribute__((aligned(16))) unsigned char lds_raw[];
    LAS unsigned char* lds = (LAS unsigned char*)lds_raw;
    const int tid = threadIdx.x, lane = tid & 63, wave = __builtin_amdgcn_readfirstlane(tid >> 6);
    constexpr int G = 256;
    const int bx = blockIdx.x & (G - 1), vcu = (bx % 8) * (G / 8) + bx / 8;
    const int gw = vcu * NWAVES + wave, NGW = G * NWAVES;
    unsigned* ctl = (unsigned*)(args.ws + WS_CTL);
#define PH_LOCALS \
    unsigned zsg_; asm volatile("s_mov_b32 %0, 0" : "=s"(zsg_)); unsigned char* ws = args.ws + zsg_;   const int tid = otid(), lane = tid & 63, wave = __builtin_amdgcn_readfirstlane(tid >> 6), gw = vcu * NWAVES + wave; (void)lane; (void)gw; \
    const float* x_in = args.in[0]; const float* c_in = args.in[1]; const float* ctx_in = args.in[2]; const float* cctx_in = args.in[3]; \
    const float* mod_w = args.in[4]; const float* mod_b = args.in[5]; const float* norm_mix_g = args.in[6]; const float* norm_ffn_g = args.in[7]; \
    float* MOD = (float*)(ws + WS_MOD); float* cosA = (float*)(ws + WS_COSA); float* sinA = (float*)(ws + WS_SINA); float* cosC = (float*)(ws + WS_COSC); float* sinC = (float*)(ws + WS_SINC); \
    bf16* WR = (bf16*)(ws + WS_WR); bf16* WINA = (bf16*)(ws + WS_WINA); bf16* WOUTA = (bf16*)(ws + WS_WOUTA); bf16* WINC = (bf16*)(ws + WS_WINC); bf16* WQB = (bf16*)(ws + WS_WQB); \
    bf16* WKVB = (bf16*)(ws + WS_WKVB); bf16* WOUTC = (bf16*)(ws + WS_WOUTC); bf16* WGU = (bf16*)(ws + WS_WGU); bf16* WDN = (bf16*)(ws + WS_WDN); \
    float* X = (float*)(ws + WS_X); bf16* H = (bf16*)(ws + WS_H); bf16* QA = (bf16*)(ws + WS_QA); bf16* KA = (bf16*)(ws + WS_KA); bf16* VA = (bf16*)(ws + WS_VA); bf16* Z = (bf16*)(ws + WS_Z); \
    bf16* P = (bf16*)(ws + WS_P); float* RS = (float*)(ws + WS_RS); bf16* QC = (bf16*)(ws + WS_QC); bf16* KC = (bf16*)(ws + WS_KC); bf16* VC = (bf16*)(ws + WS_VC); \
    bf16* MIX = (bf16*)(ws + WS_MIX); bf16* F = (bf16*)(ws + WS_F); float* GATE = (float*)(ws + WS_GATE); int* LIST = (int*)(ws + WS_LIST); bf16* ACT = (bf16*)(ws + WS_ACT); bf16* YB = (bf16*)(ws + WS_YB); \
    int* CNT = (int*)(ws + WS_CTL) + CW_CNT; float* SSX = (float*)(ws + WS_SSX); float* SSP = (float*)(ws + WS_SSP); (void)SSX; (void)SSP; const float* ML = MOD + (size_t)layer_ * 5 * 6144; \
    (void)x_in; (void)c_in; (void)ctx_in; (void)cctx_in; (void)mod_w; (void)mod_b; (void)norm_mix_g; (void)norm_ffn_g; (void)MOD; (void)cosA; (void)sinA; (void)cosC; (void)sinC; (void)WR; (void)WINA; (void)WOUTA; \
    (void)WINC; (void)WQB; (void)WKVB; (void)WOUTC; (void)WGU; (void)WDN; (void)X; (void)H; (void)QA; (void)KA; (void)VA; (void)Z; (void)P; (void)RS; (void)QC; (void)KC; (void)VC; (void)MIX; (void)F; (void)GATE; \
    (void)LIST; (void)ACT; (void)YB; (void)CNT; (void)ML;
    if (tid < 64) ((LAS unsigned*)(lds + LDS_MISC))[tid] = 0u;
    __syncthreads();
    const int lo = args.lo, hi = args.hi;
    XcdBarrier bar; bar.bar = ctl + CW_BAR; bar.x = 0; bar.st = nullptr;
    if (hi - lo > 1) bar = xcd_barrier_post(ctl + CW_BAR, (volatile LAS unsigned*)(lds + LDS_MISC));
    int ph = 0; int layer_ = 0;
#ifndef MK_EN
#define MK_EN 0xffffffffu
#endif
#ifdef MK_PROBE_PH
#define PFLAG(b) (args.flags & (b))
#else
#define PFLAG(b) 0
#endif
#define EN(k) (((MK_EN) >> (k)) & 1u)
#define PH_ON (ph >= lo && ph < hi)
#define CVT_TAIL(bg) do { LAS int* _jn = (LAS int*)(lds + CV_HDR + 64); if (wave >= 4 && lane == 0) _jn[wave - 4] = bg.j; __syncthreads(); \
        if (bg.tick & 1) bg.cv_process(tid, lds + CV_BUF, (const LAS int*)(lds + CV_HDR)); __syncthreads(); \
        bg.finish(lane); \
        { const int _j = _jn[wave & 3]; bg.j = _j + (wave < 4 ? 4 : 0); bg.step = 8; } while (bg.j < bg.jend) { bg.issue(lane); bg.finish(lane); } __syncthreads(); } while (0)
#define PH_END do { const bool _b = (ph >= lo) && (ph + 1 < hi); ++ph; if (_b) xcd_barrier(bar); } while (0)

    if (EN(0) && PH_ON) { PH_LOCALS
        LAS float* st = (LAS float*)(lds + 73728);
        for (int q = tid; q < 5 * 1024; q += NTHR) { const float v = q < 4096 ? c_in[q] : cctx_in[q - 4096]; st[q] = fsilu(v); }
        __syncthreads();
        for (int u = vcu; u < 384; u += G) {
            const int l = u / 96, col = (u % 96) * 64 + lane;
            const float* wp = mod_w + ((size_t)l * D + 128 * wave) * 6144 + col; float a0 = 0.f, a1 = 0.f, a2 = 0.f, a3 = 0.f, a4 = 0.f;
#pragma unroll 1
            for (int k0 = 0; k0 < 128; k0 += 64) { float wv[64];
#pragma unroll
                for (int kk = 0; kk < 64; ++kk) wv[kk] = __builtin_nontemporal_load(wp + (size_t)(k0 + kk) * 6144);
#pragma unroll
                for (int kk = 0; kk < 64; ++kk) { const int k = 128 * wave + k0 + kk; a0 += st[k] * wv[kk]; a1 += st[1024 + k] * wv[kk]; a2 += st[2048 + k] * wv[kk]; a3 += st[3072 + k] * wv[kk]; a4 += st[4096 + k] * wv[kk]; } }
            LAS float* part = (LAS float*)(lds + 98304);
            part[(wave * 5 + 0) * 64 + lane] = a0; part[(wave * 5 + 1) * 64 + lane] = a1; part[(wave * 5 + 2) * 64 + lane] = a2; part[(wave * 5 + 3) * 64 + lane] = a3; part[(wave * 5 + 4) * 64 + lane] = a4;
            __syncthreads();
            if (wave < 5) { float s = mod_b[l * 6144 + col];
#pragma unroll
                for (int w8 = 0; w8 < 8; ++w8) s += part[(w8 * 5 + wave) * 64 + lane];
                MOD[((size_t)l * 5 + wave) * 6144 + col] = s; }
            __syncthreads();
        }
        for (int q = gw * 64 + lane; q < 4096 * 32; q += NGW * 64) {
            { const int t = q >> 5, j = q & 31, ax = j >> 4, i = j & 15; const float pos = (float)(ax == 0 ? (t >> 6) : (t & 63)); const float a = pos * powf(10000.f, -((float)i * 2.f) / 32.f); cosA[q] = cosf(a); sinA[q] = sinf(a); }
            if (q < 4096 * 16) { const int t = q >> 4, j = q & 15, ax = j >> 3, i = j & 7; const float pos = (float)(ax == 0 ? (t >> 6) : (t & 63)); const float a = pos * powf(10000.f, -((float)i * 2.f) / 16.f); cosC[q] = cosf(a); sinC[q] = sinf(a); }
        }
        { const float* rw = args.in[26];
          for (int q = gw * 64 + lane; q < 4 * 32 * 1024; q += NGW * 64) { const int l = q >> 15, e = (q >> 10) & 31, k = q & 1023; const float wv = rw[((size_t)l * 1024 + k) * 32 + e];
              const unsigned hb = pk2(wv, 0.f) & 0xffffu; const float hf = __uint_as_float(hb << 16); const unsigned lb = pk2(wv - hf, 0.f) & 0xffffu;
              WR[((size_t)(l * 2 + 0) * 32 + e) * 1024 + k] = (bf16)hb; WR[((size_t)(l * 2 + 1) * 32 + e) * 1024 + k] = (bf16)lb; } }
        LAS float* scr = (LAS float*)(lds + wave * 8448);
        cvt_matrix<LAY_INA>(args.in[8], (size_t)D * 1792, 1792, 1792, 1024, 7, 14, WINA, nullptr, scr, gw, NGW, lane);
        cvt_matrix<LAY_F32>(args.in[9], (size_t)D * 1024, 1024, 1024, 1024, 4, 8, WOUTA, nullptr, scr, gw, NGW, lane);
        cvt_matrix<LAY_STD>(args.in[17], (size_t)D * 1056, 1056, 1056, 1024, 5, 10, WINC, nullptr, scr, gw, NGW, lane);
        cvt_matrix<LAY_STD>(args.in[20], (size_t)768 * 1536, 1536, 1536, 768, 6, 6, WQB, args.in[18], scr, gw, NGW, lane);
        cvt_matrix<LAY_STD>(args.in[20] + (size_t)768 * 1536, 0, 1536, 1536, 768, 6, 6, WQB + (size_t)1536 * 768, args.in[18] + 768, scr, gw, NGW, lane);
        cvt_matrix<LAY_HEAD2>(args.in[21], (size_t)256 * 2048, 2048, 2048, 256, 8, 8, WKVB, args.in[19], scr, gw, NGW, lane);
        cvt_matrix<LAY_HEAD2>(args.in[21] + (size_t)256 * 2048, 0, 2048, 2048, 256, 8, 8, WKVB + (size_t)2048 * 256, args.in[19] + 256, scr, gw, NGW, lane);
        cvt_matrix<LAY_F32>(args.in[25], (size_t)D * 1024, 1024, 1024, 1024, 4, 8, WOUTC, nullptr, scr, gw, NGW, lane);
        __syncthreads();
    }
    PH_END;
    if (EN(1) && PH_ON) { PH_LOCALS
        for (int row = gw; row < T; row += NGW) {
            const float* xrow = row < NL ? x_in + (size_t)row * D : ctx_in + (size_t)(row - NL) * D; const float* mn = MOD + (size_t)modrow(row) * 6144;
            f32x4 v[2][2]; float ss = 0.f;
#pragma unroll
            for (int j = 0; j < 2; ++j)
#pragma unroll
                for (int q = 0; q < 2; ++q) { v[j][q] = *(const f32x4*)(xrow + 8 * lane + 512 * j + 4 * q); ss += (v[j][q][0] * v[j][q][0] + v[j][q][1] * v[j][q][1]) + (v[j][q][2] * v[j][q][2] + v[j][q][3] * v[j][q][3]); }
            const float rstd = rsqrtf(wave_sum(ss) * (1.f / D) + EPS);
#pragma unroll
            for (int j = 0; j < 2; ++j) { const int c = 8 * lane + 512 * j; f32x4 o[2];
#pragma unroll
                for (int q = 0; q < 2; ++q) { const f32x4 gg = *(const f32x4*)(norm_mix_g + c + 4 * q), sc = *(const f32x4*)(mn + 1024 + c + 4 * q), sh = *(const f32x4*)(mn + c + 4 * q); o[q] = v[j][q] * rstd * gg * (sc + 1.f) + sh; }
                *(u32x4*)(H + (size_t)row * D + c) = pack8(o[0], o[1]); }
        }
    }
    PH_END;

    for (int layer = 0; layer < 4; ++layer) {
        const bool keep = layer < 3; const int li = layer >> 1; const int nrt = keep ? 68 : 64;
        layer_ = layer;
        if ((layer & 1) == 0) {
            if (EN(2) && PH_ON) { PH_LOCALS
                g8::GemmP g{H, D, WINA + (size_t)li * 1792 * 1024, 1024}; g8::StaticOrder S_; S_.init(68, 7, G, bx);
                EpiInA E{QA, KA, VA, Z, args.in[10] + li * 64, args.in[11] + li * 64, cosA, sinA};
                g8::gemm_phase(lds, g, S_, E);
            }
            PH_END;
            if (EN(3) && PH_ON) { PH_LOCALS
                const int nau = keep ? 544 : 512;
                if (!(PFLAG(1))) {
                    CvtBg bg; bg.init(args.in[28], args.in[30], WGU, WDN, (LAS float*)(lds + 57344 + wave * 8448), 0, layer == 0 ? 1 : 0, vcu, wave >= 4 ? wave - 4 : 0x40000000, 4);
                    for (int u = vcu; u < nau; u += G) wattn_unit(lds, u, QA, KA, VA, args.in[12] + li * 8, MIX, bg);
                    CVT_TAIL(bg);
                }
                if (!(PFLAG(2))) {
                    const float* dww = args.in[13] + (size_t)li * 31 * 512; const float* dwb = args.in[14] + li * 512; const float* lng = args.in[15] + li * 512; const float* lnb = args.in[16] + li * 512;
                    conv_strip<64>(lds, (vcu >> 6) * S, S, (vcu & 63) * 64, Z, dww, dwb, lng, lnb, MIX);
                    if (keep) conv_strip<4>(lds, NL + (vcu >> 6) * CL, CL, (vcu & 63) * 4, Z, dww, dwb, lng, lnb, MIX);
                }
            }
            PH_END;
            if (EN(4) && PH_ON) { PH_LOCALS
                g8::GemmP g{MIX, D, WOUTA + (size_t)li * 1024 * 1024, 1024}; g8::StaticOrder S_; S_.init(nrt, 4, G, bx);
                EpiResid E{X, layer == 0 ? x_in : X, layer == 0 ? ctx_in : X + (size_t)NL * D, ML + 2048, SSX};
                g8::gemm_phase(lds, g, S_, E);
            }
            PH_END;
        } else {
            if (EN(5) && PH_ON) { PH_LOCALS
                g8::GemmP g{H, D, WINC + (size_t)li * 1280 * 1024, 1024}; g8::StaticOrder S_; S_.init(68, 5, G, bx);
                EpiP E{P, SSP, KC, args.in[24] + li * 32, cosC, sinC};
                g8::gemm_phase(lds, g, S_, E);
            }
            PH_END;
            if (EN(7) && PH_ON) { PH_LOCALS
#ifndef MK_O3
#define MK_O3 3
#endif
                if ((MK_O3 & 1) && !(PFLAG(16))) { g8::GemmP g{P, PP, WQB + (size_t)li * 1536 * 768, 768}; g8::StaticOrder S_; S_.init(nrt, 6, G, bx); EpiBf16 E{QC, 1536, 1536}; g8::gemm_phase(lds, g, S_, E); }
                if ((MK_O3 & 2) && !(PFLAG(32))) { g8::GemmP g{P + 768, PP, WKVB + (size_t)li * 2048 * 256, 256}; g8::StaticOrder S_; S_.init(68, 8, G, bx); EpiKV E{KC, VC, SSP, args.in[23] + li * 64}; g8::gemm_phase(lds, g, S_, E); }
            }
            PH_END;
            if (EN(8) && PH_ON) { PH_LOCALS
                const int nau = keep ? 1088 : 1024;
                CvtBg bg; bg.init(args.in[28], args.in[30], WGU, WDN, (LAS float*)(lds + 57344 + wave * 8448), layer, (PFLAG(8)) ? 0 : ((layer == 1) ? 2 : 1), vcu, wave >= 4 ? wave - 4 : 0x40000000, 4);
                for (int u = vcu; u < nau; u += G) mla_unit(lds, u, QC, KC, VC, SSP, args.in[22] + li * 96, cosC, sinC, MIX, bg);
                CVT_TAIL(bg);
            }
            PH_END;
            if (EN(9) && PH_ON) { PH_LOCALS
                g8::GemmP g{MIX, D, WOUTC + (size_t)li * 1024 * 1024, 1024}; g8::StaticOrder S_; S_.init(nrt, 4, G, bx);
                EpiResid E{X, X, X + (size_t)NL * D, ML + 2048, SSX};
                g8::gemm_phase(lds, g, S_, E);
            }
            PH_END;
        }
        if (EN(10) && PH_ON) { PH_LOCALS
            LAS int* cntL = (LAS int*)(lds + LDS_TAB); LAS int* baseL = cntL + 32; LAS int* pend = (LAS int*)(lds + LDS_IDX + 10240);
            if (tid < 32) cntL[tid] = 0;
            router_load_table(lds, WR + (size_t)layer * 2 * 32 * 1024, tid);
            __syncthreads();
            int g = -1;
            if (wave < 4) g = bx * 4 + wave; else if (wave == 4 && keep && bx < 64) g = 1024 + bx;
            if (g >= 0) router_group(lds, g, wave, lane, X, SSX, norm_ffn_g + layer * D, ML + (size_t)(g < 1024 ? (g >> 8) : 4) * 6144, args.in[27] + layer * 32, F, GATE);
            __syncthreads();
            if (tid < 32) baseL[tid] = (PFLAG(4)) ? 0 : atomicAdd(CNT + (layer * 32 + tid) * 64, cntL[tid])    ;
            __syncthreads();
            if (tid < 320) { const int wv = tid >> 6; const bool has = (wv < 4) || (wv == 4 && keep && bx < 64);
                if (has) { const int pe = pend[tid], slot = pe & 0x1ffff, e = (pe >> 17) & 31, rl = pe >> 22; LIST[(size_t)e * T + baseL[e] + rl] = slot; } }
            __syncthreads();
        }
        PH_END;
        if (EN(11) && PH_ON) { PH_LOCALS
            moe_setup<8>(lds, CNT + layer * 32 * 64, LIST, layer, vcu, G);
            g8::GemmP g{F, D, WGU, 1024}; g8::MoeOrder<true> S_{(const LAS int*)(lds + LDS_TAB), (const LAS int*)(lds + LDS_IDX)};
            EpiGU E{ACT, args.in[29] + (size_t)layer * 32 * 2048};
            g8::gemm_phase(lds, g, S_, E);
        }
        PH_END;
        if (EN(12) && PH_ON) { PH_LOCALS
            moe_setup<4>(lds, CNT + layer * 32 * 64, LIST, layer, vcu, G);
            g8::GemmP g{ACT, 1024, WDN, 1024}; g8::MoeOrder<false> S_{(const LAS int*)(lds + LDS_TAB), (const LAS int*)(lds + LDS_IDX)};
            EpiDown E{YB, args.in[31] + (size_t)layer * 32 * 1024, GATE, (const LAS int*)(lds + LDS_IDX)};
            g8::gemm_phase(lds, g, S_, E);
        }
        PH_END;
        if (EN(13) && PH_ON) { PH_LOCALS
            const int nrows = keep ? T : NL;
            for (int row = gw; row < nrows; row += NGW)
                combine_row(row, lane, X, YB, ML, norm_mix_g + (layer + 1 < 4 ? layer + 1 : 0) * D, MOD + (size_t)(layer + 1 < 4 ? layer + 1 : 0) * 5 * 6144, layer < 3 ? H : nullptr, layer < 3 ? nullptr : args.out);
        }
        PH_END;
    }
#undef PH_ON
#undef PH_END
}
}

#ifndef MK_MULTI
#define MK_MULTI 0
#endif
#ifndef MK_DEBUG
#define MK_DEBUG 0
#endif
#if MK_DEBUG
namespace dbg {
__global__ void k_cmp_bf(const unsigned short* a, int lda, const float* b, int ldb, int rows, int cols, float s, float* acc, int cp) {
    float d2 = 0.f, r2 = 0.f;
    for (size_t i = (size_t)blockIdx.x * blockDim.x + threadIdx.x; i < (size_t)rows * cols; i += (size_t)gridDim.x * blockDim.x) {
        const size_t r = i / cols, c = i % cols; const float av = __uint_as_float(((unsigned)a[r * lda + c]) << 16), bv = s * b[r * ldb + c]; d2 += (av - bv) * (av - bv); r2 += bv * bv; }
    for (int o = 32; o >= 1; o >>= 1) { d2 += __shfl_xor(d2, o); r2 += __shfl_xor(r2, o); }
    if ((threadIdx.x & 63) == 0) { atomicAdd(acc + 2 * cp, d2); atomicAdd(acc + 2 * cp + 1, r2); }
}
__global__ void k_cmp_f(const float* a, const float* b, size_t n, float* acc, int cp) {
    float d2 = 0.f, r2 = 0.f;
    for (size_t i = (size_t)blockIdx.x * blockDim.x + threadIdx.x; i < n; i += (size_t)gridDim.x * blockDim.x) { const float av = a[i], bv = b[i]; d2 += (av - bv) * (av - bv); r2 += bv * bv; }
    for (int o = 32; o >= 1; o >>= 1) { d2 += __shfl_xor(d2, o); r2 += __shfl_xor(r2, o); }
    if ((threadIdx.x & 63) == 0) { atomicAdd(acc + 2 * cp, d2); atomicAdd(acc + 2 * cp + 1, r2); }
}
__global__ void k_report(const float* acc, int ncp, float thr, float* out) {
    if (blockIdx.x == 0 && threadIdx.x == 0) { int bad = -1; for (int i = 0; i < ncp; ++i) { const float d = acc[2 * i], r = acc[2 * i + 1]; if (!(d <= thr * r)) { bad = i; break; } }
        if (bad >= 0) out[0] += 100.f * (float)(bad + 1); }
}
}
#endif

extern "C" void kernel_launch(void* const* d_in, const int* in_sizes, int n_in, void* d_out, int out_size, void* d_ws, size_t ws_size, hipStream_t stream) {
    using namespace mk;
    static int grid = 0;
    if (grid == 0) {
        int dev = 0, cus = 0, per_cu = 0;
        if (hipGetDevice(&dev) != hipSuccess || hipDeviceGetAttribute(&cus, hipDeviceAttributeMultiprocessorCount, dev) != hipSuccess) { fprintf(stderr, "kernel_launch: device query failed\n"); grid = -1; return; }
        if (hipFuncSetAttribute((const void*)mega, hipFuncAttributeMaxDynamicSharedMemorySize, LDS_BYTES) != hipSuccess) { fprintf(stderr, "kernel_launch: hipFuncSetAttribute(%d B LDS) failed\n", LDS_BYTES); grid = -1; return; }
        if (hipOccupancyMaxActiveBlocksPerMultiprocessor(&per_cu, (const void*)mega, NTHR, LDS_BYTES) != hipSuccess || per_cu < 1) fprintf(stderr, "kernel_launch: occupancy query reports %d blocks per CU\n", per_cu);
        (void)hipGetLastError();
        grid = 256;
        if (cus < 256) { fprintf(stderr, "kernel_launch: %d CUs < 256: the persistent grid would not be resident; nothing launched\n", cus); grid = -1; return; }
        if (n_in != 32 || ws_size < WS_END) { fprintf(stderr, "kernel_launch: n_in %d ws %zu (need %zu)\n", n_in, ws_size, (size_t)WS_END); grid = -1; return; }
    }
    if (grid < 0) return;
    (void)hipMemsetAsync((char*)d_ws + WS_CTL, 0, CTL_BYTES, stream);
    Args a{};
    for (int i = 0; i < 32; ++i) a.in[i] = (const float*)d_in[i];
    a.out = (float*)d_out; a.ws = (unsigned char*)d_ws;
#if !MK_DEBUG
#if MK_MULTI
    for (int p = 0; p < N_PHASES; ++p) { a.lo = p; a.hi = p + 1; hipLaunchKernelGGL(mega, dim3(grid), dim3(NTHR), LDS_BYTES, stream, a); }
#else
    a.lo = 0; a.hi = N_PHASES; hipLaunchKernelGGL(mega, dim3(grid), dim3(NTHR), LDS_BYTES, stream, a);
#ifdef MK_PROBE_PH
    for (int r = 0; r < MK_PROBE_N; ++r) { a.lo = MK_PROBE_PH; a.hi = MK_PROBE_PH + 1; a.flags = MK_PROBE_FLAGS; hipLaunchKernelGGL(mega, dim3(grid), dim3(NTHR), LDS_BYTES, stream, a); }
#endif
#endif
    { const hipError_t le = hipPeekAtLastError(); if (le != hipSuccess) fprintf(stderr, "kernel_launch: launch failed: %s\n", hipGetErrorName(le)); }
#else
#endif
}
```

```cpp
#include <hip/hip_runtime.h>
#include <cstdio>
#include <cstdint>
#define MK_MULTI 0
#define MK_DEBUG 0
#define MK_DBG_THR 1e-3f
namespace mk {
#define LAS __attribute__((address_space(3)))
#define GAS __attribute__((address_space(1)))
typedef unsigned short bf16;
typedef short bf16x8 __attribute__((ext_vector_type(8)));
typedef short s16x4 __attribute__((ext_vector_type(4)));
typedef float f32x2 __attribute__((ext_vector_type(2)));
typedef float f32x4 __attribute__((ext_vector_type(4)));
typedef float f32x16 __attribute__((ext_vector_type(16)));
typedef unsigned u32x2 __attribute__((ext_vector_type(2)));
typedef unsigned u32x4 __attribute__((ext_vector_type(4)));

constexpr int D = 1024, NBATCH = 4, S = 4096, CL = 256, NL = NBATCH * S, NC = NBATCH * CL, T = NL + NC;
constexpr int NWAVES = 8, NTHR = 512;
constexpr float EPS = 1e-6f;
constexpr float LOG2E = 1.4426950408889634f;
constexpr float QSCALE_A = 0.125f * LOG2E;
constexpr float QSCALE_C = 0.10206207261596575f * LOG2E;

constexpr size_t al256(size_t x) { return (x + 255) & ~(size_t)255; }
constexpr size_t CTL_BYTES = 65536;
constexpr int CW_BAR = 1024, CW_CNT = 8192;
constexpr size_t WS_CTL = 0;
constexpr size_t WS_MOD = WS_CTL + CTL_BYTES;
constexpr size_t WS_COSA = WS_MOD + al256((size_t)4 * 5 * 6144 * 4);
constexpr size_t WS_SINA = WS_COSA + 4096 * 32 * 4;
constexpr size_t WS_COSC = WS_SINA + 4096 * 32 * 4;
constexpr size_t WS_SINC = WS_COSC + 4096 * 16 * 4;
constexpr size_t WS_WR = WS_SINC + 4096 * 16 * 4;
constexpr size_t WS_WINA = WS_WR + (size_t)4 * 2 * 32 * 1024 * 2;
constexpr size_t WS_WOUTA = WS_WINA + (size_t)2 * 1792 * 1024 * 2;
constexpr size_t WS_WINC = WS_WOUTA + (size_t)2 * 1024 * 1024 * 2;
constexpr size_t WS_WQB = WS_WINC + (size_t)2 * 1280 * 1024 * 2;
constexpr size_t WS_WKVB = WS_WQB + (size_t)2 * 1536 * 768 * 2;
constexpr size_t WS_WOUTC = WS_WKVB + (size_t)2 * 2048 * 256 * 2;
constexpr size_t WS_WGU = WS_WOUTC + (size_t)2 * 1024 * 1024 * 2;
constexpr size_t WS_WDN = WS_WGU + (size_t)128 * 2048 * 1024 * 2;
constexpr size_t WS_X = WS_WDN + (size_t)128 * 1024 * 1024 * 2;
constexpr size_t WS_H = WS_X + (size_t)T * D * 4;
constexpr size_t WS_QA = WS_H + (size_t)T * D * 2;
constexpr size_t WS_KA = WS_QA + (size_t)T * 512 * 2;
constexpr size_t WS_VA = WS_KA + (size_t)T * 128 * 2;
constexpr size_t WS_Z = WS_VA + (size_t)T * 128 * 2;
constexpr size_t WS_P = WS_Z + (size_t)T * 512 * 2;
constexpr int PP = 1056;
constexpr size_t WS_RS = WS_P + (size_t)T * PP * 2;
constexpr size_t WS_QC = WS_RS + (size_t)T * 2 * 4;
constexpr size_t WS_KC = WS_QC + (size_t)T * 1536 * 2;
constexpr size_t WS_VC = WS_KC + (size_t)T * 1536 * 2;
constexpr size_t WS_MIX = WS_VC + (size_t)T * 1024 * 2;
constexpr size_t WS_F = WS_MIX + (size_t)T * 1024 * 2;
constexpr size_t WS_GATE = WS_F + (size_t)T * 1024 * 2;
constexpr size_t WS_LIST = WS_GATE + (size_t)T * 4 * 4;
constexpr int ACT_ROWS = 304 * 256;
constexpr size_t WS_ACT = WS_LIST + (size_t)32 * T * 4;
constexpr size_t WS_YB = WS_ACT + (size_t)ACT_ROWS * 1024 * 2;
constexpr size_t WS_SSX = WS_YB + (size_t)T * 4 * 1024 * 2;
constexpr size_t WS_SSP = WS_SSX + (size_t)T * 16 * 4;
constexpr size_t WS_END = WS_SSP + (size_t)T * 16 * 4;

constexpr int STAGE_BYTES = 131072;
constexpr int LDS_IDX = 131072;
constexpr int MAXU = 12;
constexpr int LDS_TAB = LDS_IDX + MAXU * 1024;
constexpr int LDS_MISC = LDS_TAB + 1024;
constexpr int LDS_BYTES = LDS_MISC + 256;
constexpr int CV_HDR = 56320, CV_BUF = 57344;

__device__ __forceinline__ unsigned pk2(float lo, float hi) {
    typedef __bf16 bf2 __attribute__((ext_vector_type(2)));
    return __builtin_bit_cast(unsigned, __builtin_convertvector((f32x2){lo, hi}, bf2));
}
__device__ __forceinline__ float bflo(unsigned u) { return __uint_as_float(u << 16); }
__device__ __forceinline__ float bfhi(unsigned u) { return __uint_as_float(u & 0xffff0000u); }
__device__ __forceinline__ float bf1(bf16 u) { return __uint_as_float(((unsigned)u) << 16); }
__device__ __forceinline__ float fsigm(float v) { return __builtin_amdgcn_rcpf(1.f + __builtin_amdgcn_exp2f(-1.4426950408889634f * v)); }
__device__ __forceinline__ float fsilu(float v) { return v * fsigm(v); }
__device__ __forceinline__ int modrow(int row) { return row < NL ? (row >> 12) : 4; }
#define WS_DPP(v, ctrl) ((v) + __int_as_float(__builtin_amdgcn_update_dpp(0, __float_as_int(v), (ctrl), 0xF, 0xF, false)))
__device__ __forceinline__ float wave_sum(float v) {
    v = WS_DPP(v, 0xB1); v = WS_DPP(v, 0x4E); v = WS_DPP(v, 0x141); v = WS_DPP(v, 0x140);
    v += __shfl_xor(v, 16); v += __shfl_xor(v, 32);
    return v;
}
__device__ __forceinline__ int otid() { int t = threadIdx.x; asm volatile("" : "+v"(t)); return t; }
#define LDS_WAIT() asm volatile("s_waitcnt lgkmcnt(0)" ::: "memory")
#define VM_WAIT() asm volatile("s_waitcnt vmcnt(0)" ::: "memory")

#define XB_TMO      128
#define XB_XCNT(j)  (256  + 64 * (j))
#define XB_XSUB(j)  (1280 + 64 * (j))
#define XB_XGEN(j)  (2304 + 64 * (j))
#define XB_TOP      3328
#define XB_TOPGEN   3392
#define XCD_BAR_WORDS 3456
#define XB_SPIN_CAP (1u << 18)
__device__ __forceinline__ unsigned xb_ld(unsigned* p)              { return __hip_atomic_load(p, __ATOMIC_RELAXED, __HIP_MEMORY_SCOPE_AGENT); }
__device__ __forceinline__ unsigned xb_add(unsigned* p, unsigned v) { return __hip_atomic_fetch_add(p, v, __ATOMIC_RELAXED, __HIP_MEMORY_SCOPE_AGENT); }
__device__ __forceinline__ unsigned xb_xcc_id() { return (unsigned)__builtin_amdgcn_s_getreg((3 << 11) | 20) & 0xFu; }
#define XB_SPIN(cond, bar) do { unsigned _sp = 0; while (cond) { __builtin_amdgcn_s_sleep(1); \
    if ((++_sp & 255u) == 0u) { if (xb_ld(&(bar)[XB_TMO])) break; if (_sp > XB_SPIN_CAP) { atomicAdd(&(bar)[XB_TMO], 1u); break; } } } } while (0)
struct XcdBarrier { unsigned* bar; unsigned x; volatile LAS unsigned* st; };
__device__ __forceinline__ XcdBarrier xcd_barrier_post(unsigned* bar, volatile LAS unsigned* st) {
    XcdBarrier b; b.bar = bar; b.x = xb_xcc_id(); b.st = st;
    if (threadIdx.x == 0) (void)xb_add(&bar[XB_XCNT(b.x)], 1u);
    return b;
}
__device__ __forceinline__ void xcd_barrier_complete(unsigned* bar, unsigned x, unsigned& nloc, unsigned& nx) {
    const unsigned G = gridDim.x * gridDim.y * gridDim.z;
    unsigned sum, cnt, mine, sp = 0u;
    for (;;) {
        sum = 0u; cnt = 0u; mine = 0u;
#pragma unroll
        for (unsigned j = 0; j < 16; ++j) { const unsigned c = xb_ld(&bar[XB_XCNT(j)]); sum += c; cnt += (c > 0u) ? 1u : 0u; mine = (j == x) ? c : mine; }
        if (sum == G) break;
        __builtin_amdgcn_s_sleep(1);
        if ((++sp & 255u) == 0u) { if (xb_ld(&bar[XB_TMO])) break; if (sp > XB_SPIN_CAP) { atomicAdd(&bar[XB_TMO], 1u); break; } }
    }
    nloc = mine > 0u ? mine : 1u; nx = cnt > 0u ? cnt : 1u;
}
__device__ __forceinline__ void xcd_barrier(const XcdBarrier& b) {
    asm volatile("s_waitcnt vmcnt(0)" ::: "memory");
    __syncthreads();
    if (otid() == 0) {
        unsigned* bar = b.bar;
        __builtin_amdgcn_s_waitcnt(0);
        unsigned nloc = b.st[0], nx = b.st[1];
        if (nloc == 0u) { xcd_barrier_complete(bar, b.x, nloc, nx); b.st[0] = nloc; b.st[1] = nx; }
        const unsigned old = xb_add(&bar[XB_XSUB(b.x)], 1u);
        const unsigned gen = old / nloc;
        if (old + 1u == (gen + 1u) * nloc) {
            __builtin_amdgcn_fence(__ATOMIC_RELEASE, "agent");
            asm volatile("s_waitcnt vmcnt(0)" ::: "memory");
            const unsigned og = xb_add(&bar[XB_TOP], 1u);
            const unsigned tg = og / nx;
            if (og + 1u == (tg + 1u) * nx) xb_add(&bar[XB_TOPGEN], 1u);
            else XB_SPIN(xb_ld(&bar[XB_TOPGEN]) == tg, bar);
            __builtin_amdgcn_fence(__ATOMIC_ACQUIRE, "agent");
            xb_add(&bar[XB_XGEN(b.x)], 1u);
            asm volatile("s_waitcnt vmcnt(0)" ::: "memory");
        } else {
            XB_SPIN(xb_ld(&bar[XB_XGEN(b.x)]) == gen, bar);
            __builtin_amdgcn_fence(__ATOMIC_ACQUIRE, "agent");
            asm volatile("s_waitcnt vmcnt(0)" ::: "memory");
        }
    }
    __syncthreads();
}

namespace g8 {
constexpr int BM = 256, BK = 64, HALF = 128, HTB = HALF * BK * 2, NXCD = 8, WGM = 8;
__host__ __device__ __forceinline__ int lds_byte(int r, int c) { const int st = (r >> 4) * 2 + (c >> 5), rr = r & 15, cc = c & 31, ob = rr * 64 + cc * 2; return st * 1024 + (ob ^ (((ob >> 9) & 1) << 5)); }
__host__ __device__ __forceinline__ void stage_rc(int b, int& R, int& C) { const int st = b / 1024, sb = b % 1024, swz = sb ^ (((sb >> 9) & 1) << 5); R = (st >> 1) * 16 + swz / 64; C = (st & 1) * 32 + (swz % 64) / 2; }

struct Unit { int pm, pn, e, nt, gm, slot; };
struct GemmP { const bf16* A; int lda; const bf16* Bt; int K; };

struct StaticOrder {
    static constexpr bool GATHER = false;
    int nM, nN, nwg, G, c;
    __device__ void init(int nM_, int nN_, int G_, int c_) { nM = nM_; nN = nN_; nwg = nM * nN; G = G_; c = c_; }
    __device__ __forceinline__ bool next(int i, Unit& u) const {
        const long L = (long)i * G + c; if (L >= nwg) return false;
        int wgid = (int)L; { const int q = nwg / NXCD, r = nwg % NXCD, xcd = wgid % NXCD, off = wgid / NXCD; wgid = (xcd < r ? xcd * (q + 1) : r * (q + 1) + (xcd - r) * q) + off; }
        const int nig = WGM * nN, gid = wgid / nig, fm = gid * WGM, gsz = (nM - fm) < WGM ? (nM - fm) : WGM;
        u.pm = fm + ((wgid % nig) % gsz); u.pn = (wgid % nig) / gsz; u.e = 0; u.nt = u.pn; u.gm = u.pm; u.slot = 0; return true;
    }
    __device__ __forceinline__ int arow(const Unit& u, int r) const { return u.pm * BM + r; }
};
template <bool GATHER_> struct MoeOrder {
    static constexpr bool GATHER = GATHER_;
    const LAS int* tab; const LAS int* idx;
    __device__ __forceinline__ bool next(int i, Unit& u) const {
        if (i >= tab[127]) return false;
        u.gm = tab[128 + 4 * i]; u.pn = tab[129 + 4 * i]; u.e = tab[130 + 4 * i]; u.nt = tab[131 + 4 * i]; u.slot = i; u.pm = u.gm; return true;
    }
    __device__ __forceinline__ int arow(const Unit& u, int r) const {
        if (GATHER_) { const int s = idx[u.slot * 256 + r]; return s < 0 ? 0 : (s >> 2); }
        return u.gm * BM + r;
    }
};

template <class Epi, class Sched>
__device__ __forceinline__ void gemm_phase(LAS unsigned char* lds, const GemmP g, const Sched& S, const Epi& E) {
    const int tid = otid(), wid = __builtin_amdgcn_readfirstlane(tid >> 6), lane = tid & 63, wr = wid >> 2, wc = wid & 3, fr = lane & 15, fq = lane >> 4;
    const int K = g.K, nt = K / BK;
    int RR[2], CC[2]; unsigned voffB[2], voffA[2];
    const unsigned lda2 = (unsigned)g.lda * 2u;
#pragma unroll
    for (int i = 0; i < 2; ++i) { stage_rc(tid * 16 + i * 8192, RR[i], CC[i]); voffB[i] = (unsigned)(RR[i] * K + CC[i]) * 2u; voffA[i] = (unsigned)RR[i] * lda2 + (unsigned)CC[i] * 2u; }
    const size_t hstepA = (size_t)HALF * lda2, tstepA = 2 * hstepA;
    const size_t kstep = (size_t)(BK * 2);
    const size_t hstepB = (size_t)HALF * K * 2;
    const size_t tstepB = 2 * hstepB;
    const unsigned ldsw = (unsigned)wid * 1024u;
    const int aoff = lds_byte(wr * 64 + fr, fq * 8), boff = lds_byte(wc * 32 + fr, fq * 8);
#define G8_SA(b, h) (((b) * 2 + (h)) * HTB)
#define G8_SB(b, h) ((4 + (b) * 2 + (h)) * HTB)
#define G8_STAGE(bufoff, gbase, voff) do { _Pragma("unroll") for (int _i = 0; _i < 2; ++_i) \
        __builtin_amdgcn_global_load_lds((const unsigned*)((const char*)(gbase) + (voff)[_i]), (LAS unsigned*)(lds + (bufoff) + ldsw + _i * 8192), 16, 0, 0); } while (0)
#define G8_LDA(dst, b, h) do { _Pragma("unroll") for (int m = 0; m < 4; ++m) _Pragma("unroll") for (int k = 0; k < 2; ++k) dst[m][k] = *(const LAS bf16x8*)(lds + G8_SA(b, h) + aoff + m * 2048 + k * 1024); } while (0)
#define G8_LDB(dst, b, h) do { _Pragma("unroll") for (int n = 0; n < 2; ++n) _Pragma("unroll") for (int k = 0; k < 2; ++k) dst[n][k] = *(const LAS bf16x8*)(lds + G8_SB(b, h) + boff + n * 2048 + k * 1024); } while (0)
#define G8_MMA(ai, bj, At, Bt) do { __builtin_amdgcn_s_setprio(1); _Pragma("unroll") for (int m = 0; m < 4; ++m) _Pragma("unroll") for (int n = 0; n < 2; ++n) _Pragma("unroll") for (int k = 0; k < 2; ++k) \
        acc[ai][bj][m][n] = __builtin_amdgcn_mfma_f32_16x16x32_bf16(Bt[n][k], At[m][k], acc[ai][bj][m][n], 0, 0, 0); __builtin_amdgcn_s_setprio(0); } while (0)
#define G8_WAIT_V(n) asm volatile("s_waitcnt vmcnt(" #n ")" ::: "memory")
#define G8_WAIT_L(n) asm volatile("s_waitcnt lgkmcnt(" #n ")" ::: "memory")
#define G8_BAR __builtin_amdgcn_s_barrier()
#define G8_SCHED __builtin_amdgcn_sched_barrier(0)
#define G8_MKOFF(u, o) do { if constexpr (Sched::GATHER) { _Pragma("unroll") for (int _i = 0; _i < 2; ++_i) { int _R, _C; stage_rc(tid * 16 + _i * 8192, _R, _C); \
        _Pragma("unroll") for (int _h = 0; _h < 2; ++_h) o[_h][_i] = (unsigned)S.arow(u, _h * HALF + _R) * lda2 + (unsigned)_C * 2u; } } } while (0)
#define G8_STAGE_A(bufoff, kofs, h, usenext) do { if constexpr (Sched::GATHER) { unsigned _o[2]; _o[0] = (usenext) ? no[h][0] : co[h][0]; _o[1] = (usenext) ? no[h][1] : co[h][1]; G8_STAGE(bufoff, Ab + (kofs), _o); } \
        else { const char* _p = ((usenext) ? nAp : cAp) + (size_t)(h) * hstepA + (kofs); G8_STAGE(bufoff, _p, voffA); } } while (0)
    Unit cur, nxt; int ui = 0;
    if (!S.next(0, cur)) return;
    f32x4 acc[2][2][4][2];
#pragma unroll
    for (int a = 0; a < 2; ++a)
#pragma unroll
        for (int b = 0; b < 2; ++b)
#pragma unroll
            for (int m = 0; m < 4; ++m)
#pragma unroll
                for (int n = 0; n < 2; ++n) acc[a][b][m][n] = (f32x4){0.f, 0.f, 0.f, 0.f};
    bf16x8 At[4][2], B0[2][2], B1[2][2];
    unsigned co[2][2], no[2][2];
    G8_MKOFF(cur, co);
    if (Sched::GATHER) { G8_WAIT_L(0); }
    const char* Ab = (const char*)g.A;
    const char* cAp = Ab + (size_t)cur.pm * tstepA; const char* nAp = cAp;
    const char* cB = (const char*)g.Bt + (size_t)cur.pn * tstepB;
    G8_STAGE(G8_SB(0, 0), cB, voffB); G8_STAGE(G8_SB(0, 1), cB + hstepB, voffB); G8_STAGE_A(G8_SA(0, 0), 0, 0, false); G8_STAGE_A(G8_SA(0, 1), 0, 1, false);
    if (wr == 1) G8_BAR;
    G8_WAIT_V(2); G8_BAR;
    G8_STAGE(G8_SB(1, 0), cB + kstep, voffB); G8_STAGE_A(G8_SA(1, 0), kstep, 0, false); G8_STAGE(G8_SB(1, 1), cB + hstepB + kstep, voffB);
    G8_WAIT_V(6); G8_BAR;
    for (;;) {
        const bool has_next = S.next(ui + 1, nxt);
        if (has_next) { G8_MKOFF(nxt, no); if (Sched::GATHER) { G8_WAIT_L(0); } nAp = Ab + (size_t)nxt.pm * tstepA; }
        else {
            nAp = cAp;
            if constexpr (Sched::GATHER) {
#pragma unroll
                for (int h = 0; h < 2; ++h)
#pragma unroll
                    for (int i = 0; i < 2; ++i) no[h][i] = co[h][i];
            }
        }
        G8_SCHED;
        const char* nB = has_next ? (const char*)g.Bt + (size_t)nxt.pn * tstepB : cB;
#pragma unroll 1
        for (int t = 0; t < nt; t += 2) {
            const bool last = (t == nt - 2);
            const size_t k1 = (size_t)(t + 1) * kstep, k2 = last ? 0 : (size_t)(t + 2) * kstep, k3 = k2 + kstep;
            const char* b2 = last ? nB : cB + (size_t)(t + 2) * kstep; const char* b3 = b2 + kstep;
            G8_LDB(B0, 0, 0); G8_LDB(B1, 0, 1); G8_SCHED; G8_LDA(At, 0, 0); G8_STAGE_A(G8_SA(1, 1), k1, 1, false);
            G8_WAIT_V(8); G8_WAIT_L(0); G8_BAR; G8_MMA(0, 0, At, B0); G8_MMA(0, 1, At, B1); G8_BAR; G8_SCHED;
            G8_LDA(At, 0, 1); G8_STAGE(G8_SB(0, 0), b2, voffB); G8_STAGE(G8_SB(0, 1), b2 + hstepB, voffB); G8_STAGE_A(G8_SA(0, 0), k2, 0, last);
            G8_WAIT_V(8); G8_WAIT_L(0); G8_BAR; G8_MMA(1, 0, At, B0); G8_MMA(1, 1, At, B1); G8_BAR; G8_SCHED;
            G8_LDB(B0, 1, 0); G8_LDB(B1, 1, 1); G8_SCHED; G8_LDA(At, 1, 0); G8_STAGE_A(G8_SA(0, 1), k2, 1, last);
            G8_WAIT_V(8); G8_WAIT_L(0); G8_BAR; G8_MMA(0, 0, At, B0); G8_MMA(0, 1, At, B1); G8_BAR; G8_SCHED;
            G8_LDA(At, 1, 1); G8_STAGE(G8_SB(1, 0), b3, voffB); G8_STAGE(G8_SB(1, 1), b3 + hstepB, voffB); G8_STAGE_A(G8_SA(1, 0), k3, 0, last);
            G8_WAIT_V(8); G8_WAIT_L(0); G8_BAR; G8_MMA(1, 0, At, B0); G8_MMA(1, 1, At, B1); G8_BAR; G8_SCHED;
        }
        if (wr == 0) G8_BAR;
        E(acc, cur, wr, wc, fr, fq, lds);
        if (!has_next) break;
#pragma unroll
        for (int a = 0; a < 2; ++a)
#pragma unroll
            for (int b = 0; b < 2; ++b)
#pragma unroll
                for (int m = 0; m < 4; ++m)
#pragma unroll
                    for (int n = 0; n < 2; ++n) acc[a][b][m][n] = (f32x4){0.f, 0.f, 0.f, 0.f};
        cur = nxt; cB = nB; cAp = nAp; ++ui;
        if constexpr (Sched::GATHER) {
#pragma unroll
            for (int h = 0; h < 2; ++h)
#pragma unroll
                for (int i = 0; i < 2; ++i) co[h][i] = no[h][i];
        }
        if (wr == 1) G8_BAR;
    }
    G8_WAIT_V(0);
    G8_BAR;
#undef G8_SA
#undef G8_SB
#undef G8_STAGE
#undef G8_LDA
#undef G8_LDB
#undef G8_MMA
#undef G8_WAIT_V
#undef G8_WAIT_L
#undef G8_BAR
#undef G8_SCHED
#undef G8_MKOFF
#undef G8_STAGE_A
}
}

using g8::Unit;
typedef f32x4 Acc[2][2][4][2];
__device__ __forceinline__ u32x4 pack8(const f32x4 a, const f32x4 b) { u32x4 w; w.x = pk2(a[0], a[1]); w.y = pk2(a[2], a[3]); w.z = pk2(b[0], b[1]); w.w = pk2(b[2], b[3]); return w; }

struct EpiInA {
    bf16 *Qa, *Ka, *Va, *Z; const float *qg, *kg, *cosA, *sinA;
    __device__ __forceinline__ void operator()(const Acc& acc, const Unit& u, int wr, int wc, int fr, int fq, LAS unsigned char*) const {
        const int row0 = u.pm * 256 + wr * 64 + fr, pn = u.pn, a = fq >> 1, b = fq & 1;
        if (pn < 3) {
            const bool isv = (pn == 2 && wc >= 2), isq = pn < 2;
            const int dbase = 32 * a + 8 * b;
            if (isv) {
#pragma unroll
                for (int ai = 0; ai < 2; ++ai)
#pragma unroll
                    for (int m = 0; m < 4; ++m) { const int row = row0 + ai * 128 + m * 16; bf16* o = Va + (size_t)row * 128 + (wc - 2) * 64 + dbase;
#pragma unroll
                        for (int bj = 0; bj < 2; ++bj) *(u32x4*)(o + 16 * bj) = pack8(acc[ai][bj][m][0], acc[ai][bj][m][1]); }
                return;
            }
            const float* g = isq ? qg : kg;
            f32x4 gv[2][2];
#pragma unroll
            for (int bj = 0; bj < 2; ++bj)
#pragma unroll
                for (int n = 0; n < 2; ++n) gv[bj][n] = *(const f32x4*)(g + dbase + 16 * bj + 4 * n);
            const float sc = isq ? QSCALE_A : 1.f;
            bf16* obase = isq ? (Qa + (pn * 4 + wc) * 64 + dbase) : (Ka + wc * 64 + dbase);
            const int opitch = isq ? 512 : 128;
            f32x4 cc[2], sn[2], cn[2], snn[2];
            { const int t = row0 & 4095;
#pragma unroll
              for (int n = 0; n < 2; ++n) { cc[n] = *(const f32x4*)(cosA + t * 32 + 16 * a + 8 * b + 4 * n); sn[n] = *(const f32x4*)(sinA + t * 32 + 16 * a + 8 * b + 4 * n); } }
#pragma unroll
            for (int gidx = 0; gidx < 8; ++gidx) {
                    const int ai = gidx >> 2, m = gidx & 3;
                    const int row = row0 + ai * 128 + m * 16;
                    if (gidx < 7) { const int tn = (row0 + ((gidx + 1) >> 2) * 128 + ((gidx + 1) & 3) * 16) & 4095;
#pragma unroll
                        for (int n = 0; n < 2; ++n) { cn[n] = *(const f32x4*)(cosA + tn * 32 + 16 * a + 8 * b + 4 * n); snn[n] = *(const f32x4*)(sinA + tn * 32 + 16 * a + 8 * b + 4 * n); } }
                    float ss = 0.f;
#pragma unroll
                    for (int bj = 0; bj < 2; ++bj)
#pragma unroll
                        for (int n = 0; n < 2; ++n) { const f32x4 v = acc[ai][bj][m][n]; ss += (v[0] * v[0] + v[1] * v[1]) + (v[2] * v[2] + v[3] * v[3]); }
                    ss += __shfl_xor(ss, 16); ss += __shfl_xor(ss, 32);
                    const float rs = rsqrtf(ss * (1.f / 64.f) + EPS);
                    f32x4 y[2][2];
#pragma unroll
                    for (int bj = 0; bj < 2; ++bj)
#pragma unroll
                        for (int n = 0; n < 2; ++n) y[bj][n] = acc[ai][bj][m][n] * rs * gv[bj][n];
                    if (row < NL) {
#pragma unroll
                        for (int n = 0; n < 2; ++n) { const f32x4 y0 = y[0][n], y1 = y[1][n]; y[0][n] = y0 * cc[n] - y1 * sn[n]; y[1][n] = y1 * cc[n] + y0 * sn[n]; }
                    }
                    bf16* o = obase + (size_t)row * opitch;
#pragma unroll
                    for (int bj = 0; bj < 2; ++bj) *(u32x4*)(o + 16 * bj) = pack8(y[bj][0] * sc, y[bj][1] * sc);
                    asm volatile("" ::: "memory");
#pragma unroll
                    for (int n = 0; n < 2; ++n) { cc[n] = cn[n]; sn[n] = snn[n]; }
            }
        } else {
            const int j0 = 128 * (pn - 3) + 32 * wc + 8 * fq;
#pragma unroll
            for (int ai = 0; ai < 2; ++ai)
#pragma unroll
                for (int m = 0; m < 4; ++m) {
                    const int row = row0 + ai * 128 + m * 16; f32x4 z[2];
#pragma unroll
                    for (int n = 0; n < 2; ++n) { const f32x4 av = acc[ai][0][m][n], gt = acc[ai][1][m][n];
#pragma unroll
                        for (int r = 0; r < 4; ++r) z[n][r] = av[r] * fsigm(gt[r]); }
                    *(u32x4*)(Z + (size_t)row * 512 + j0) = pack8(z[0], z[1]);
                }
        }
    }
};
struct EpiResid {
    float* X; const float* Xlat; const float* Xctx; const float* gmod; float* SSX;
    __device__ __forceinline__ void operator()(const Acc& acc, const Unit& u, int wr, int wc, int fr, int fq, LAS unsigned char*) const {
        const int row0 = u.pm * 256 + wr * 64 + fr; const int mr = u.pm < 64 ? (u.pm >> 4) : 4;
        const float* gp = gmod + (size_t)mr * 6144; const float* src = u.pm < 64 ? Xlat : Xctx - (size_t)NL * D;
        float ssr[2][4];
#pragma unroll
        for (int ai = 0; ai < 2; ++ai)
#pragma unroll
            for (int m = 0; m < 4; ++m) ssr[ai][m] = 0.f;
#pragma unroll
        for (int bj = 0; bj < 2; ++bj) {
            const int c0 = 256 * u.pn + 128 * bj + 32 * wc + 4 * fq;
            const f32x4 g0 = *(const f32x4*)(gp + c0), g1 = *(const f32x4*)(gp + c0 + 16);
#pragma unroll
            for (int ai = 0; ai < 2; ++ai) {
                f32x4 xo[4][2];
#pragma unroll
                for (int m = 0; m < 4; ++m) { const float* xp = src + (size_t)(row0 + ai * 128 + m * 16) * D + c0; xo[m][0] = *(const f32x4*)xp; xo[m][1] = *(const f32x4*)(xp + 16); }
#pragma unroll
                for (int m = 0; m < 4; ++m) { float* op = X + (size_t)(row0 + ai * 128 + m * 16) * D + c0;
                    const f32x4 y0 = xo[m][0] + g0 * acc[ai][bj][m][0], y1 = xo[m][1] + g1 * acc[ai][bj][m][1];
                    *(f32x4*)op = y0; *(f32x4*)(op + 16) = y1;
                    ssr[ai][m] += (y0[0] * y0[0] + y0[1] * y0[1]) + (y0[2] * y0[2] + y0[3] * y0[3]) + (y1[0] * y1[0] + y1[1] * y1[1]) + (y1[2] * y1[2] + y1[3] * y1[3]); }
                asm volatile("" ::: "memory");
            }
        }
#pragma unroll
        for (int ai = 0; ai < 2; ++ai)
#pragma unroll
            for (int m = 0; m < 4; ++m) { float ss = ssr[ai][m]; ss += __shfl_xor(ss, 16); ss += __shfl_xor(ss, 32);
                if (fq == 0) SSX[(size_t)(row0 + ai * 128 + m * 16) * 16 + 4 * u.pn + wc] = ss; }
    }
};
struct EpiBf16 {
    bf16* O; int ldo, ncols;
    __device__ __forceinline__ void operator()(const Acc& acc, const Unit& u, int wr, int wc, int fr, int fq, LAS unsigned char*) const {
        const int row0 = u.pm * 256 + wr * 64 + fr;
#pragma unroll
        for (int bj = 0; bj < 2; ++bj) {
            const int c0 = 256 * u.pn + 128 * bj + 32 * wc + 8 * fq;
            if (c0 < ncols) {
#pragma unroll
                for (int ai = 0; ai < 2; ++ai)
#pragma unroll
                    for (int m = 0; m < 4; ++m) *(u32x4*)(O + (size_t)(row0 + ai * 128 + m * 16) * ldo + c0) = pack8(acc[ai][bj][m][0], acc[ai][bj][m][1]);
            }
        }
    }
};
struct EpiP {
    bf16* P; float* SSP; bf16* Kc; const float* krg; const float* cosC; const float* sinC;
    __device__ __forceinline__ void operator()(const Acc& acc, const Unit& u, int wr, int wc, int fr, int fq, LAS unsigned char*) const {
        const int row0 = u.pm * 256 + wr * 64 + fr;
        if (u.pn < 4) {
#pragma unroll
            for (int ai = 0; ai < 2; ++ai)
#pragma unroll
                for (int m = 0; m < 4; ++m) { const int row = row0 + ai * 128 + m * 16; float ss = 0.f;
#pragma unroll
                    for (int bj = 0; bj < 2; ++bj) { const f32x4 y0 = acc[ai][bj][m][0], y1 = acc[ai][bj][m][1];
                        *(u32x4*)(P + (size_t)row * PP + 256 * u.pn + 128 * bj + 32 * wc + 8 * fq) = pack8(y0, y1);
                        ss += (y0[0] * y0[0] + y0[1] * y0[1]) + (y0[2] * y0[2] + y0[3] * y0[3]) + (y1[0] * y1[0] + y1[1] * y1[1]) + (y1[2] * y1[2] + y1[3] * y1[3]); }
                    ss += __shfl_xor(ss, 16); ss += __shfl_xor(ss, 32);
                    if (fq == 0) SSP[(size_t)row * 16 + 4 * u.pn + wc] = ss; }
        } else if (wc == 0) {
            const f32x4 g0 = *(const f32x4*)(krg + 8 * fq), g1 = *(const f32x4*)(krg + 8 * fq + 4);
#pragma unroll
            for (int ai = 0; ai < 2; ++ai)
#pragma unroll
                for (int m = 0; m < 4; ++m) { const int row = row0 + ai * 128 + m * 16; const f32x4 v0 = acc[ai][0][m][0], v1 = acc[ai][0][m][1];
                    *(u32x4*)(P + (size_t)row * PP + 1024 + 8 * fq) = pack8(v0, v1);
                    float ss = (v0[0] * v0[0] + v0[1] * v0[1]) + (v0[2] * v0[2] + v0[3] * v0[3]) + (v1[0] * v1[0] + v1[1] * v1[1]) + (v1[2] * v1[2] + v1[3] * v1[3]);
                    ss += __shfl_xor(ss, 16); ss += __shfl_xor(ss, 32);
                    const float rk = rsqrtf(ss * (1.f / 32.f) + EPS);
                    f32x4 y0 = v0 * rk * g0, y1 = v1 * rk * g1;
                    const int t = row & 4095, ax = fq >> 1;
                    const f32x4 c0 = *(const f32x4*)(cosC + t * 16 + 8 * ax), c1 = *(const f32x4*)(cosC + t * 16 + 8 * ax + 4), s0 = *(const f32x4*)(sinC + t * 16 + 8 * ax), s1 = *(const f32x4*)(sinC + t * 16 + 8 * ax + 4);
                    f32x4 p0, p1;
#pragma unroll
                    for (int j = 0; j < 4; ++j) { p0[j] = __shfl_xor(y0[j], 16); p1[j] = __shfl_xor(y1[j], 16); }
                    if (row < NL) { if ((fq & 1) == 0) { y0 = y0 * c0 - p0 * s0; y1 = y1 * c1 - p1 * s1; } else { y0 = y0 * c0 + p0 * s0; y1 = y1 * c1 + p1 * s1; } }
                    const u32x4 wv = pack8(y0, y1);
#pragma unroll
                    for (int hd = 0; hd < 16; ++hd) *(u32x4*)(Kc + (size_t)row * 1536 + hd * 96 + 64 + 8 * fq) = wv;
                    asm volatile("" ::: "memory"); }
        }
    }
};
struct EpiKV {
    bf16 *Kc, *Vc; const float* SSP; const float* kg;
    __device__ __forceinline__ void operator()(const Acc& acc, const Unit& u, int wr, int wc, int fr, int fq, LAS unsigned char*) const {
        const int row0 = u.pm * 256 + wr * 64 + fr, head = 2 * u.pn + (wc >> 1), dbase = 8 * fq;
        const bool isk = (wc & 1) == 0;
        float rr[2][4];
#pragma unroll
        for (int ai = 0; ai < 2; ++ai)
#pragma unroll
            for (int m = 0; m < 4; ++m) { const f32x4 pq = *(const f32x4*)(SSP + (size_t)(row0 + ai * 128 + m * 16) * 16 + 12); rr[ai][m] = (pq[0] + pq[1]) + (pq[2] + pq[3]); }
        f32x4 gv[2][2];
#pragma unroll
        for (int bj = 0; bj < 2; ++bj)
#pragma unroll
            for (int n = 0; n < 2; ++n) gv[bj][n] = isk ? *(const f32x4*)(kg + dbase + 32 * bj + 4 * n) : (f32x4){1.f, 1.f, 1.f, 1.f};
#pragma unroll
        for (int ai = 0; ai < 2; ++ai)
#pragma unroll
            for (int m = 0; m < 4; ++m) {
                const int row = row0 + ai * 128 + m * 16; const float r = rsqrtf(rr[ai][m] * (1.f / 256.f) + EPS);
                float f = r;
                if (isk) {
                    float ss = 0.f;
#pragma unroll
                    for (int bj = 0; bj < 2; ++bj)
#pragma unroll
                        for (int n = 0; n < 2; ++n) { const f32x4 v = acc[ai][bj][m][n]; ss += (v[0] * v[0] + v[1] * v[1]) + (v[2] * v[2] + v[3] * v[3]); }
                    ss += __shfl_xor(ss, 16); ss += __shfl_xor(ss, 32);
                    f = r * rsqrtf(r * r * ss * (1.f / 64.f) + EPS);
                }
                bf16* o = isk ? (Kc + (size_t)row * 1536 + head * 96 + dbase) : (Vc + (size_t)row * 1024 + head * 64 + dbase);
#pragma unroll
                for (int bj = 0; bj < 2; ++bj) *(u32x4*)(o + 32 * bj) = pack8(acc[ai][bj][m][0] * f * gv[bj][0], acc[ai][bj][m][1] * f * gv[bj][1]);
            }
    }
};
struct EpiGU {
    bf16* ACT; const float* bgu;
    __device__ __forceinline__ void operator()(const Acc& acc, const Unit& u, int wr, int wc, int fr, int fq, LAS unsigned char*) const {
        const int row0 = u.gm * 256 + wr * 64 + fr, j0 = 128 * u.nt + 32 * wc + 8 * fq;
        const float* bp = bgu + (size_t)u.e * 2048;
        f32x4 bg[2], bu[2];
#pragma unroll
        for (int n = 0; n < 2; ++n) { bg[n] = *(const f32x4*)(bp + j0 + 4 * n); bu[n] = *(const f32x4*)(bp + 1024 + j0 + 4 * n); }
#pragma unroll
        for (int ai = 0; ai < 2; ++ai)
#pragma unroll
            for (int m = 0; m < 4; ++m) {
                f32x4 z[2];
#pragma unroll
                for (int n = 0; n < 2; ++n) { const f32x4 gt = acc[ai][0][m][n] + bg[n], up = acc[ai][1][m][n] + bu[n];
#pragma unroll
                    for (int r = 0; r < 4; ++r) { const float gg = fminf(gt[r], 7.f), uu = fminf(fmaxf(up[r], -7.f), 7.f); z[n][r] = (uu + 1.f) * (gg * fsigm(1.702f * gg)); } }
                *(u32x4*)(ACT + (size_t)(row0 + ai * 128 + m * 16) * 1024 + j0) = pack8(z[0], z[1]);
            }
    }
};
struct EpiDown {
    bf16* YB; const float* bdn; const float* gate; const LAS int* idx;
    __device__ __forceinline__ void operator()(const Acc& acc, const Unit& u, int wr, int wc, int fr, int fq, LAS unsigned char*) const {
        const int r0 = wr * 64 + fr; const float* bp = bdn + (size_t)u.e * 1024;
        f32x4 bv[2][2]; int c0[2];
#pragma unroll
        for (int bj = 0; bj < 2; ++bj) { c0[bj] = 256 * u.nt + 128 * bj + 32 * wc + 8 * fq; bv[bj][0] = *(const f32x4*)(bp + c0[bj]); bv[bj][1] = *(const f32x4*)(bp + c0[bj] + 4); }
#pragma unroll
        for (int ai = 0; ai < 2; ++ai)
#pragma unroll
            for (int m = 0; m < 4; ++m) {
                const int slot = idx[u.slot * 256 + r0 + ai * 128 + m * 16];
                if (slot >= 0) {
                    const float gw = gate[slot]; bf16* o = YB + (size_t)slot * 1024;
#pragma unroll
                    for (int bj = 0; bj < 2; ++bj) *(u32x4*)(o + c0[bj]) = pack8((acc[ai][bj][m][0] + bv[bj][0]) * gw, (acc[ai][bj][m][1] + bv[bj][1]) * gw);
                }
            }
    }
};

enum { LAY_STD = 0, LAY_HEAD = 1, LAY_INA = 2, LAY_GU = 3, LAY_F32 = 4, LAY_HEAD2 = 5 };
template <int LAY> __device__ __forceinline__ int colmap(int pn, int rho) {
    const int bj = rho >> 7, wc = (rho >> 5) & 3, n = (rho >> 4) & 1, fq = (rho >> 2) & 3, reg = rho & 3;
    const int std_c = 128 * bj + 32 * wc + 8 * fq + 4 * n + reg;
    const int head_c = 64 * wc + 32 * (fq >> 1) + 8 * (fq & 1) + 16 * bj + 4 * n + reg;
    if (LAY == LAY_STD) return 256 * pn + std_c;
    if (LAY == LAY_F32) return 256 * pn + rho;
    if (LAY == LAY_HEAD) return 256 * pn + head_c;
    if (LAY == LAY_HEAD2) return 256 * pn + 64 * wc + 32 * bj + 8 * fq + 4 * n + reg;
    if (LAY == LAY_INA) return pn < 3 ? 256 * pn + head_c : 768 + (bj ? 512 : 0) + 128 * (pn - 3) + 32 * wc + 8 * fq + 4 * n + reg;
    return (bj ? 1024 : 0) + 128 * pn + 32 * wc + 8 * fq + 4 * n + reg;
}
template <int LAY>
__device__ __forceinline__ void cvt_matrix(const float* src, size_t mat_stride, int ld, int nvalid, int K, int tiles_per_mat, int ntiles, bf16* dst, const float* kscale,
                                           LAS float* scr, int it_begin, int it_step, int lane, int it_end = 0x7fffffff) {
    const int kblocks = K / 64; int nitems = ntiles * 8 * kblocks; nitems = nitems < it_end ? nitems : it_end;
    const int gw = it_begin, NGW = it_step;
    const int i = lane & 31, kh = lane >> 5;
    float v[32], vn[32];
#define CVT_LOAD(it_, dstv) do { const int _kb = (it_) % kblocks, _tg = (it_) / kblocks, _grp = _tg & 7, _tile = _tg >> 3; \
        const int _mat = _tile / tiles_per_mat, _pn = _tile - _mat * tiles_per_mat; const int _c = colmap<LAY>(_pn, _grp * 32 + i); const bool _ok = _c < nvalid; \
        const float* _s = src + (size_t)_mat * mat_stride + (size_t)(_kb * 64 + kh) * ld + (_ok ? _c : 0); \
        _Pragma("unroll") for (int ii = 0; ii < 32; ++ii) dstv[ii] = _ok ? _s[(size_t)(2 * ii) * ld] : 0.f; } while (0)
    int it = gw;
    if (it < nitems) CVT_LOAD(it, v);
    for (; it < nitems; it += NGW) {
        const int itn = it + NGW;
        if (itn < nitems) CVT_LOAD(itn, vn);
        const int kb = it % kblocks, tg = it / kblocks, grp = tg & 7, tile = tg >> 3;
        if (kscale) {
#pragma unroll
            for (int ii = 0; ii < 32; ++ii) v[ii] *= kscale[kb * 64 + 2 * ii + kh];
        }
#pragma unroll
        for (int ii = 0; ii < 32; ++ii) scr[(2 * ii + kh) * 33 + i] = v[ii];
        LDS_WAIT(); asm volatile("" ::: "memory");
        const int c8 = lane & 7;
#pragma unroll
        for (int j = 0; j < 4; ++j) { const int n = (lane >> 3) + 8 * j; const LAS float* q = scr + (8 * c8) * 33 + n;
            u32x4 o; o.x = pk2(q[0 * 33], q[1 * 33]); o.y = pk2(q[2 * 33], q[3 * 33]); o.z = pk2(q[4 * 33], q[5 * 33]); o.w = pk2(q[6 * 33], q[7 * 33]);
            *(u32x4*)(dst + ((size_t)tile * 256 + grp * 32 + n) * K + kb * 64 + 8 * c8) = o; }
        LDS_WAIT(); asm volatile("" ::: "memory");
#pragma unroll
        for (int ii = 0; ii < 32; ++ii) v[ii] = vn[ii];
    }
#undef CVT_LOAD
}

struct CvtBg {
    const float* wgu; const float* wdn; bf16* dgu; bf16* ddn; int cl0, vcu, j, jend, step, tick;
    __device__ __forceinline__ void init(const float* wgu_, const float* wdn_, bf16* dgu_, bf16* ddn_, int cl0_, int nlay, int vcu_, int j0, int step_) {
        wgu = wgu_; wdn = wdn_; dgu = dgu_; ddn = ddn_; cl0 = cl0_; vcu = vcu_; j = j0; step = step_; jend = nlay * 192; tick = 0; }
    __device__ __forceinline__ void decode(int jj, bool& isgu, int& cl, int& it) const { cl = cl0 + jj / 192; const int r = jj % 192; isgu = r < 128; it = isgu ? vcu * 128 + r : vcu * 64 + (r - 128); }
    __device__ __forceinline__ int issue_dma(int lane, LAS unsigned char* buf) {
        const int jj = __builtin_amdgcn_readfirstlane(j);
        if (jj >= jend) return -1;
        bool isgu; int cl, it; decode(jj, isgu, cl, it);
        const int kb = it & 15, tg = it >> 4, grp = tg & 7, tile = tg >> 3;
        const int kr = lane >> 3, p = lane & 7;
        const float* s; unsigned ld;
        if (isgu) { const int mat = tile >> 3, pn = tile & 7; s = wgu + ((size_t)(cl * 32 + mat) * 1024 + kb * 64) * 2048 + colmap<LAY_GU>(pn, grp * 32); ld = 2048; }
        else { const int mat = tile >> 2, pn = tile & 3; s = wdn + ((size_t)(cl * 32 + mat) * 1024 + kb * 64) * 1024 + colmap<LAY_STD>(pn, grp * 32); ld = 1024; }
        const unsigned rowoff = (unsigned)kr * ld * 4u;
#pragma unroll
        for (int q = 0; q < 8; ++q) { const int cq = p ^ q; const unsigned coff = (unsigned)(8 * (cq & 3) + 4 * (cq >> 2)) * 4u;
            __builtin_amdgcn_global_load_lds((const unsigned*)((const char*)s + (size_t)(8 * q) * ld * 4 + rowoff + coff), (LAS unsigned*)(buf + q * 1024), 16, 0, 2); }
        j = jj + step; return jj;
    }
    __device__ __forceinline__ bf16* dstptr(int jj, int& kb) const { bool isgu; int cl, it; decode(jj, isgu, cl, it); kb = it & 15; const int tg = it >> 4, grp = tg & 7, tile = tg >> 3;
        return isgu ? dgu + ((size_t)(cl * 256 + tile) * 256 + grp * 32) * 1024 : ddn + ((size_t)(cl * 128 + tile) * 256 + grp * 32) * 1024; }
    __device__ __forceinline__ void out_chunk(const LAS unsigned char* buf, bf16* d, int kb, int n, int o) const {
        const LAS float* b = (const LAS float*)(buf + (8 * o) * 128 + (((n >> 2) ^ o) << 4)) + (n & 3);
        u32x4 w; w.x = pk2(b[0], b[32]); w.y = pk2(b[64], b[96]); w.z = pk2(b[128], b[160]); w.w = pk2(b[192], b[224]);
        *(u32x4*)(d + (size_t)n * 1024 + kb * 64 + 8 * o) = w; }
    __device__ __forceinline__ void process_slot(int tid, const LAS unsigned char* lds, int sl) const {
        const LAS int* hdr = (const LAS int*)(lds + CV_HDR);
#pragma unroll
        for (int hf = 0; hf < 2; ++hf) { const int id = tid + 512 * hf, c = id >> 8, jj = hdr[2 * c + sl];
            if (jj >= 0) { int kb; bf16* d = dstptr(jj, kb); out_chunk(lds + CV_BUF + (2 * c + sl) * 8192, d, kb, (id >> 3) & 31, id & 7); } }
    }
    __device__ __forceinline__ void tail_loop(int lane, LAS unsigned char* buf) {
        int a = issue_dma(lane, buf), sl = 0;
        while (a >= 0) {
            const int b = issue_dma(lane, buf + (sl ^ 1) * 8192);
            if (b >= 0) asm volatile("s_waitcnt vmcnt(8)" ::: "memory"); else asm volatile("s_waitcnt vmcnt(0)" ::: "memory");
            int kb; bf16* d = dstptr(a, kb);
#pragma unroll
            for (int x = 0; x < 4; ++x) { const int id = lane + 64 * x; out_chunk(buf + sl * 8192, d, kb, id >> 3, id & 7); }
            asm volatile("s_waitcnt lgkmcnt(0)" ::: "memory");
            a = b; sl ^= 1;
        }
    }
};
struct NoBg { __device__ __forceinline__ void issue(int) {} __device__ __forceinline__ void finish(int) {} };

__device__ __forceinline__ void normmod_store(const f32x4 (&v)[4], float rstd, const float* g, const float* mvec  , int sh_off, int sc_off, bf16* orow, int lane) {
#pragma unroll
    for (int j = 0; j < 4; ++j) { const int c = 4 * lane + 256 * j;
        const f32x4 gg = *(const f32x4*)(g + c), sc = *(const f32x4*)(mvec + sc_off + c), sh = *(const f32x4*)(mvec + sh_off + c);
        const f32x4 y = v[j] * rstd * gg * (sc + 1.f) + sh;
        u32x2 w; w.x = pk2(y[0], y[1]); w.y = pk2(y[2], y[3]); *(u32x2*)(orow + c) = w; }
}

template <int DQK> struct AT {
    static constexpr int CK = DQK / 8, KT = 64 * DQK * 2, VT = 64 * 128, STG = KT + VT, NKS = DQK / 16, NKI = CK / 4;
};
#define MFMA32(a, b, c) __builtin_amdgcn_mfma_f32_32x32x16_bf16((a), (b), (c), 0, 0, 0)
struct TileList { int nloc, row_loc0, kpos_loc0, row_ctx0, ntiles; };
template <int DQK, bool MASK, class Bg, int CAD>
__device__ __forceinline__ void attn_core(LAS unsigned char* lds, const bf16x8 (&qf)[DQK / 16], const TileList tl, const char* Kg, int kpitchB, const char* Vg, int vpitchB,
                                          int qpos, float& m, float& l, f32x16 (&O)[2], Bg& bg) {
    typedef AT<DQK> A;
    const int tid = otid(), lane = tid & 63, h = lane >> 5;
    const int wv = __builtin_amdgcn_readfirstlane(tid >> 6);
    const bool stager = wv < 4;
    unsigned koff[A::NKI], voff;
#pragma unroll
    for (int t = 0; t < A::NKI; ++t) { const int sl_ = 64 * t + lane; int rr, ch;
        if (DQK == 96) { rr = sl_ / 12; const int p = sl_ % 12, rot = (rr >> 2) & 3; ch = p - rot; ch = ch < 0 ? ch + 12 : ch; }
        else { rr = sl_ >> 3; ch = (sl_ & 7) ^ ((rr >> 1) & 7); }
        koff[t] = (unsigned)(rr * kpitchB + ch * 16); }
    voff = (unsigned)((lane >> 3) * vpitchB + (((lane & 7) ^ (4 * ((lane >> 4) & 1))) * 16));
    unsigned kf0, kf4 = 0, kf5 = 0;
    if (DQK == 96) { const int x = 16 * (h + ((lane >> 2) & 3)); kf0 = (unsigned)((lane & 31) * 192 + x); kf4 = kf0 + (x >= 64 ? 128 - 192 : 128); kf5 = kf0 + (x >= 32 ? 160 - 192 : 160); }
    else { const int sw = (lane >> 1) & 7; kf0 = (unsigned)((lane & 31) * 128 + 16 * (h ^ (sw & 1)) + 32 * (sw >> 1)); }
#define AT_KADDR(ks) (DQK == 96 ? ((ks) == 4 ? kf4 : (ks) == 5 ? kf5 : kf0 + 32u * (ks)) : (kf0 ^ (32u * (ks))))
    const unsigned vrow = (unsigned)((((lane & 15) >> 2) + 4 * h) * 128 + 32 * ((lane >> 4) & 1) + 8 * (lane & 3));
    const unsigned vfA = vrow + 64u * ((lane >> 3) & 1), vfB = vrow + 64u * (1 - ((lane >> 3) & 1));
    LAS int* cvh = (LAS int*)(lds + CV_HDR);
    const int cw = wv & 3;
#define AT_ROW0(i) ((i) < tl.nloc ? tl.row_loc0 + 64 * (i) : tl.row_ctx0 + 64 * ((i) - tl.nloc))
#define AT_DMA_K(i) do { const char* _kp = Kg + (size_t)(AT_ROW0(i) + 16 * wv) * kpitchB; LAS unsigned char* _b = lds + ((i) & 1) * A::KT + (A::NKI * wv) * 1024; \
        _Pragma("unroll") for (int t = 0; t < A::NKI; ++t) __builtin_amdgcn_global_load_lds((const unsigned*)(_kp + koff[t]), (LAS unsigned*)(_b + t * 1024), 16, 0, 0); } while (0)
#define AT_DMA_V(i) do { const char* _vp = Vg + (size_t)(AT_ROW0(i) + 16 * wv) * vpitchB; LAS unsigned char* _b = lds + 2 * A::KT + ((i) & 1) * A::VT + (2 * wv) * 1024; \
        _Pragma("unroll") for (int t = 0; t < 2; ++t) __builtin_amdgcn_global_load_lds((const unsigned*)(_vp + (size_t)(8 * t) * vpitchB + voff), (LAS unsigned*)(_b + t * 1024), 16, 0, 0); } while (0)
#define AT_BAR() do { asm volatile("s_waitcnt lgkmcnt(0)" ::: "memory"); __builtin_amdgcn_s_barrier(); asm volatile("" ::: "memory"); } while (0)
#define AT_SB() __builtin_amdgcn_sched_barrier(0)
#define AT_TR(dst, ad, off) asm volatile("ds_read_b64_tr_b16 %0, %1 offset:" #off : "=v"(dst) : "v"(ad))
#define AT_VWAIT() asm volatile("s_waitcnt lgkmcnt(0)" : "+v"(vlo[0][0]), "+v"(vlo[0][1]), "+v"(vlo[1][0]), "+v"(vlo[1][1]), "+v"(vhi[0][0]), "+v"(vhi[0][1]), "+v"(vhi[1][0]), "+v"(vhi[1][1]))
#define AT_QK(C0, C1, j) do { const LAS unsigned char* kt = lds + ((j) & 1) * A::KT; bf16x8 ka[A::NKS][2]; \
        _Pragma("unroll") for (int ks = 0; ks < A::NKS; ++ks) { ka[ks][0] = *(const LAS bf16x8*)(kt + AT_KADDR(ks)); ka[ks][1] = *(const LAS bf16x8*)(kt + AT_KADDR(ks) + 32 * DQK * 2); } \
        C0 = MFMA32(ka[0][0], qf[0], zero16); C1 = MFMA32(ka[0][1], qf[0], zero16); \
        _Pragma("unroll") for (int ks = 1; ks < A::NKS; ++ks) { C0 = MFMA32(ka[ks][0], qf[ks], C0); C1 = MFMA32(ka[ks][1], qf[ks], C1); } } while (0)
#define AT_FSM(P0, P1) do { float ps0 = 0.f, ps1 = 0.f, ps2 = 0.f, ps3 = 0.f; \
        _Pragma("unroll") for (int r = 0; r < 16; ++r) { P0[r] = __builtin_amdgcn_exp2f(P0[r]); P1[r] = __builtin_amdgcn_exp2f(P1[r]); } \
        _Pragma("unroll") for (int r = 0; r < 16; r += 2) { ps0 += P0[r]; ps1 += P0[r + 1]; ps2 += P1[r]; ps3 += P1[r + 1]; } \
        l += (ps0 + ps1) + (ps2 + ps3); \
        _Pragma("unroll") for (int sp = 0; sp < 2; ++sp) { u32x4 pw; \
            pw.x = pk2(P0[8 * sp + 0], P0[8 * sp + 1]); pw.y = pk2(P0[8 * sp + 2], P0[8 * sp + 3]); pw.z = pk2(P0[8 * sp + 4], P0[8 * sp + 5]); pw.w = pk2(P0[8 * sp + 6], P0[8 * sp + 7]); pp[0][sp] = __builtin_bit_cast(bf16x8, pw); \
            pw.x = pk2(P1[8 * sp + 0], P1[8 * sp + 1]); pw.y = pk2(P1[8 * sp + 2], P1[8 * sp + 3]); pw.z = pk2(P1[8 * sp + 4], P1[8 * sp + 5]); pw.w = pk2(P1[8 * sp + 6], P1[8 * sp + 7]); pp[1][sp] = __builtin_bit_cast(bf16x8, pw); } } while (0)
#define AT_RMAX(C0, C1, j) do { \
        if (MASK) { if ((j) < tl.nloc) { const int kb = tl.kpos_loc0 + 64 * (j) + 4 * h - qpos; \
            _Pragma("unroll") for (int r = 0; r < 16; ++r) { const int d0 = kb + (r & 3) + 8 * (r >> 2), d1 = d0 + 32; \
                if (d0 > 128 || d0 < -128) C0[r] = -1e30f; if (d1 > 128 || d1 < -128) C1[r] = -1e30f; } } } \
        tm = fmaxf(fmaxf(C0[0], C1[0]), fmaxf(C0[1], C1[1])); \
        _Pragma("unroll") for (int r = 2; r < 16; r += 2) tm = fmaxf(tm, fmaxf(fmaxf(C0[r], C1[r]), fmaxf(C0[r + 1], C1[r + 1]))); \
        { const auto sw_ = __builtin_amdgcn_permlane32_swap(__builtin_bit_cast(unsigned, tm), __builtin_bit_cast(unsigned, tm), false, false); \
          tm = fmaxf(__builtin_bit_cast(float, sw_[0]), __builtin_bit_cast(float, sw_[1])) - m; } } while (0)
#define AT_RESC(C0, C1) do { \
        if (__builtin_amdgcn_ballot_w64(tm > 8.f) != 0ull) { const float dlt = fmaxf(tm, 0.f), alpha = __builtin_amdgcn_exp2f(-dlt); m += dlt; l *= alpha; \
            _Pragma("unroll") for (int r = 0; r < 16; ++r) { O[0][r] *= alpha; O[1][r] *= alpha; } } \
        if (__builtin_amdgcn_ballot_w64(m != 0.f) != 0ull) { _Pragma("unroll") for (int r = 0; r < 16; ++r) { C0[r] -= m; C1[r] -= m; } } } while (0)
#define AT_PV(t, MID) do { const unsigned _vb = (unsigned)(size_t)lds + 2 * A::KT + ((t) & 1) * A::VT; const unsigned vta = _vb + vfA, vtb = _vb + vfB; s16x4 vlo[2][2], vhi[2][2]; \
        AT_TR(vlo[0][0], vta, 0); AT_TR(vhi[0][0], vta, 1024); AT_TR(vlo[0][1], vtb, 0); AT_TR(vhi[0][1], vtb, 1024); \
        AT_TR(vlo[1][0], vta, 2048); AT_TR(vhi[1][0], vta, 3072); AT_TR(vlo[1][1], vtb, 2048); AT_TR(vhi[1][1], vtb, 3072); \
        MID; \
        AT_VWAIT(); \
        _Pragma("unroll") for (int sp = 0; sp < 2; ++sp) _Pragma("unroll") for (int dvb = 0; dvb < 2; ++dvb) { \
            const bf16x8 va = __builtin_shufflevector(vlo[sp][dvb], vhi[sp][dvb], 0, 1, 2, 3, 4, 5, 6, 7); O[dvb] = MFMA32(va, pp[0][sp], O[dvb]); } \
        AT_TR(vlo[0][0], vta, 4096); AT_TR(vhi[0][0], vta, 5120); AT_TR(vlo[0][1], vtb, 4096); AT_TR(vhi[0][1], vtb, 5120); \
        AT_TR(vlo[1][0], vta, 6144); AT_TR(vhi[1][0], vta, 7168); AT_TR(vlo[1][1], vtb, 6144); AT_TR(vhi[1][1], vtb, 7168); \
        AT_VWAIT(); \
        _Pragma("unroll") for (int sp = 0; sp < 2; ++sp) _Pragma("unroll") for (int dvb = 0; dvb < 2; ++dvb) { \
            const bf16x8 va = __builtin_shufflevector(vlo[sp][dvb], vhi[sp][dvb], 0, 1, 2, 3, 4, 5, 6, 7); O[dvb] = MFMA32(va, pp[1][sp], O[dvb]); } } while (0)
#define AT_HEAD(j) do { if (stager) { if ((j) + 1 < n) AT_DMA_K((j) + 1); AT_DMA_V(j); } \
        issued = false; \
        if ((bg.tick & 1) == 0) { if (!stager) { const int sl_ = (bg.tick >> 1) & 1; const int jj = bg.issue_dma(lane, lds + CV_BUF + (2 * cw + sl_) * 8192); \
                if (lane == 0) cvh[2 * cw + sl_] = jj; issued = jj >= 0; } } \
        else bg.process_slot(tid, lds, ((bg.tick + 1) >> 1) & 1); } while (0)
#define AT_TAILSYNC() do { if (stager) asm volatile("s_waitcnt vmcnt(0)" ::: "memory"); \
        else if ((bg.tick & 1) == 0) { if (issued) asm volatile("s_waitcnt vmcnt(8)" ::: "memory"); else asm volatile("s_waitcnt vmcnt(0)" ::: "memory"); } \
        ++bg.tick; AT_BAR(); } while (0)
#define AT_STEP(C0, C1, P0, P1, j) do { AT_HEAD(j); AT_SB(); \
        AT_QK(C0, C1, j); AT_FSM(P0, P1); AT_SB(); \
        AT_PV((j) - 1, AT_RMAX(C0, C1, j)); AT_SB(); \
        AT_RESC(C0, C1); \
        AT_TAILSYNC(); } while (0)
    f32x16 zero16;
#pragma unroll
    for (int r = 0; r < 16; ++r) zero16[r] = 0.f;
    const int n = tl.ntiles;
    bool issued; float tm;
    bf16x8 pp[2][2];
    f32x16 A0, A1, B0, B1;
    if (stager) AT_DMA_K(0);
    asm volatile("s_waitcnt vmcnt(0)" ::: "memory");
    AT_BAR();
    AT_HEAD(0); AT_SB();
    AT_QK(A0, A1, 0); AT_RMAX(A0, A1, 0); AT_RESC(A0, A1);
    AT_TAILSYNC();
    int j = 1;
    for (; j + 1 < n; j += 2) { AT_STEP(B0, B1, A0, A1, j); AT_STEP(A0, A1, B0, B1, j + 1); }
    if (j < n) { AT_STEP(B0, B1, A0, A1, j); AT_FSM(B0, B1); } else { AT_FSM(A0, A1); }
    AT_SB();
    AT_PV(n - 1, (void)0);
#undef AT_ROW0
#undef AT_DMA_K
#undef AT_DMA_V
#undef AT_KADDR
#undef AT_BAR
#undef AT_SB
#undef AT_TR
#undef AT_VWAIT
#undef AT_QK
#undef AT_FSM
#undef AT_RMAX
#undef AT_RESC
#undef AT_PV
#undef AT_HEAD
#undef AT_TAILSYNC
#undef AT_STEP
}
__device__ __forceinline__ void attn_store(const f32x16 (&O)[2], float l, bf16* orow, int h) {
    const float lt = l + __shfl_xor(l, 32); const float inv = 1.f / lt;
#pragma unroll
    for (int dvb = 0; dvb < 2; ++dvb)
#pragma unroll
        for (int g4 = 0; g4 < 4; ++g4) { u32x2 w; w.x = pk2(O[dvb][4 * g4] * inv, O[dvb][4 * g4 + 1] * inv); w.y = pk2(O[dvb][4 * g4 + 2] * inv, O[dvb][4 * g4 + 3] * inv);
            *(u32x2*)(orow + 32 * dvb + 8 * g4 + 4 * h) = w; }
}

__device__ __forceinline__ void wattn_unit(LAS unsigned char* lds, int unit, const bf16* Qa, const bf16* Ka, const bf16* Va, const float* sink, bf16* MIX, CvtBg& bg) {
    const int tid = otid(), w = tid >> 6, lane = tid & 63, h = lane >> 5;
    int b, kvh, hp, tq, qpos; TileList tl;
    if (unit < 512) { b = unit >> 7; kvh = (unit >> 6) & 1; const int nb = (unit >> 1) & 31; hp = unit & 1;
        const int t0 = max(0, 128 * nb - 128), t1 = min(4096, 128 * nb + 256);
        tl.nloc = (t1 - t0) >> 6; tl.row_loc0 = b * S + t0; tl.kpos_loc0 = t0; tl.row_ctx0 = NL + b * CL; tl.ntiles = tl.nloc + 4;
        qpos = 128 * nb + (w & 3) * 32 + (lane & 31); tq = b * S + qpos;
    } else { const int u = unit - 512; b = u >> 3; kvh = (u >> 2) & 1; hp = (u >> 1) & 1; const int half = u & 1;
        tl.nloc = 0; tl.row_loc0 = 0; tl.kpos_loc0 = 0; tl.row_ctx0 = NL + b * CL; tl.ntiles = 4;
        qpos = 0; tq = NL + b * CL + half * 128 + (w & 3) * 32 + (lane & 31); }
    const int hq = kvh * 4 + hp * 2 + (w >> 2);
    bf16x8 qf[4];
#pragma unroll
    for (int ks = 0; ks < 4; ++ks) qf[ks] = *(const bf16x8*)(Qa + (size_t)tq * 512 + hq * 64 + 16 * ks + 8 * h);
    float m = 0.f, l = (h == 0) ? __expf(sink[hq]) : 0.f;
    f32x16 O[2];
#pragma unroll
    for (int r = 0; r < 16; ++r) { O[0][r] = 0.f; O[1][r] = 0.f; }
    attn_core<64, true, CvtBg, 2>(lds, qf, tl, (const char*)(Ka + kvh * 64), 256, (const char*)(Va + kvh * 64), 256, qpos, m, l, O, bg);
    attn_store(O, l, MIX + (size_t)tq * 1024 + hq * 64, h);
}
__device__ __forceinline__ void mla_unit(LAS unsigned char* lds, int unit, const bf16* Qc, const bf16* Kc, const bf16* Vc, const float* RS, const float* qg,
                                         const float* cosC, const float* sinC, bf16* MIX, CvtBg& bg) {
    const int tid = otid(), w = tid >> 6, lane = tid & 63, h = lane >> 5;
    int b, head, tq; TileList tl; bool lat;
    if (unit < 1024) { b = unit >> 8; head = (unit >> 4) & 15; const int qb = unit & 15; lat = true;
        tl.nloc = 64; tl.row_loc0 = b * S; tl.kpos_loc0 = 0; tl.row_ctx0 = NL + b * CL; tl.ntiles = 68; tq = b * S + qb * 256 + w * 32 + (lane & 31);
    } else { const int u = unit - 1024; b = u >> 4; head = u & 15; lat = false;
        tl.nloc = 0; tl.row_loc0 = 0; tl.kpos_loc0 = 0; tl.row_ctx0 = NL + b * CL; tl.ntiles = 4; tq = NL + b * CL + w * 32 + (lane & 31); }
    float v[6][8]; float ss = 0.f;
    const bf16* qp = Qc + (size_t)tq * 1536 + head * 96 + 8 * h;
#pragma unroll
    for (int ks = 0; ks < 6; ++ks) { const u32x4 raw = *(const u32x4*)(qp + 16 * ks);
        v[ks][0] = bflo(raw.x); v[ks][1] = bfhi(raw.x); v[ks][2] = bflo(raw.y); v[ks][3] = bfhi(raw.y); v[ks][4] = bflo(raw.z); v[ks][5] = bfhi(raw.z); v[ks][6] = bflo(raw.w); v[ks][7] = bfhi(raw.w);
#pragma unroll
        for (int j = 0; j < 8; ++j) ss += v[ks][j] * v[ks][j]; }
    ss += __shfl_xor(ss, 32);
    float r; { const f32x4 p0 = *(const f32x4*)(RS + (size_t)tq * 16), p1 = *(const f32x4*)(RS + (size_t)tq * 16 + 4), p2 = *(const f32x4*)(RS + (size_t)tq * 16 + 8);
      r = rsqrtf((((p0[0] + p0[1]) + (p0[2] + p0[3])) + ((p1[0] + p1[1]) + (p1[2] + p1[3])) + ((p2[0] + p2[1]) + (p2[2] + p2[3]))) * (1.f / 768.f) + EPS); }
    const float inv = r * rsqrtf(r * r * ss * (1.f / 96.f) + EPS);
#pragma unroll
    for (int ks = 0; ks < 6; ++ks) { const f32x4 g0 = *(const f32x4*)(qg + 16 * ks + 8 * h), g1 = *(const f32x4*)(qg + 16 * ks + 8 * h + 4);
#pragma unroll
        for (int j = 0; j < 4; ++j) { v[ks][j] *= inv * g0[j]; v[ks][4 + j] *= inv * g1[j]; } }
    {
        const int t = tq & 4095;
#pragma unroll
        for (int ax = 0; ax < 2; ++ax) {
            const f32x4 c0 = *(const f32x4*)(cosC + t * 16 + 8 * ax), c1 = *(const f32x4*)(cosC + t * 16 + 8 * ax + 4);
            const f32x4 s0 = *(const f32x4*)(sinC + t * 16 + 8 * ax), s1 = *(const f32x4*)(sinC + t * 16 + 8 * ax + 4);
#pragma unroll
            for (int j = 0; j < 8; ++j) { const float y = v[4 + ax][j], po = __shfl_xor(y, 32); const float c = j < 4 ? c0[j & 3] : c1[j & 3], s = j < 4 ? s0[j & 3] : s1[j & 3];
                const float yr = (h == 0) ? (y * c - po * s) : (y * c + po * s); v[4 + ax][j] = lat ? yr : y; }
        }
    }
    bf16x8 qf[6];
#pragma unroll
    for (int ks = 0; ks < 6; ++ks) { u32x4 pw; pw.x = pk2(v[ks][0] * QSCALE_C, v[ks][1] * QSCALE_C); pw.y = pk2(v[ks][2] * QSCALE_C, v[ks][3] * QSCALE_C);
        pw.z = pk2(v[ks][4] * QSCALE_C, v[ks][5] * QSCALE_C); pw.w = pk2(v[ks][6] * QSCALE_C, v[ks][7] * QSCALE_C); qf[ks] = __builtin_bit_cast(bf16x8, pw); }
    float m = 0.f, l = 0.f;
    f32x16 O[2];
#pragma unroll
    for (int rr = 0; rr < 16; ++rr) { O[0][rr] = 0.f; O[1][rr] = 0.f; }
    attn_core<96, false, CvtBg, 4>(lds, qf, tl, (const char*)(Kc + head * 96), 3072, (const char*)(Vc + head * 64), 2048, 0, m, l, O, bg);
    attn_store(O, l, MIX + (size_t)tq * 1024 + head * 64, h);
}

template <int NTOK>
__device__ __forceinline__ void conv_strip(LAS unsigned char* lds, int seq0, int len, int t0, const bf16* Z, const float* dw_w, const float* dw_b, const float* ln_g, const float* ln_b, bf16* MIX) {
    const int tid = otid(), w = tid >> 6, lane = tid & 63;
    constexpr int NROW = NTOK + 30, NCH = NROW * 64, NLD = (NCH + NTHR - 1) / NTHR, NSUB = (NTOK + 15) / 16;
    LAS bf16* zt = (LAS bf16*)lds; LAS float* ot = (LAS float*)(lds + 98304);
    u32x4 st[NLD];
#pragma unroll
    for (int i = 0; i < NLD; ++i) { const int q = tid + i * NTHR, r = q >> 6, cc = q & 63, tt = t0 - 15 + r; st[i] = (u32x4){0u, 0u, 0u, 0u};
        if (q < NCH && tt >= 0 && tt < len) st[i] = *(const u32x4*)(Z + (size_t)(seq0 + tt) * 512 + cc * 8); }
    float wt[31];
#pragma unroll
    for (int j = 0; j < 31; ++j) wt[j] = dw_w[j * 512 + tid];
    const float bias = dw_b[tid];
#pragma unroll
    for (int i = 0; i < NLD; ++i) { const int q = tid + i * NTHR; if (q < NCH) *(LAS u32x4*)(zt + (q >> 6) * 512 + (q & 63) * 8) = st[i]; }
    const f32x4 g0 = *(const f32x4*)(ln_g + 8 * lane), g1 = *(const f32x4*)(ln_g + 8 * lane + 4), b0 = *(const f32x4*)(ln_b + 8 * lane), b1 = *(const f32x4*)(ln_b + 8 * lane + 4);
    __syncthreads();
#pragma unroll 1
    for (int sb = 0; sb < NSUB; ++sb) {
        float acc[16];
#pragma unroll
        for (int t = 0; t < 16; ++t) acc[t] = bias;
        const LAS bf16* zp = zt + sb * 16 * 512 + tid;
        constexpr int NR = (NTOK >= 16 ? 16 : NTOK) + 30;
#pragma unroll
        for (int r = 0; r < NR; ++r) { const float zv = bf1(zp[r * 512]);
#pragma unroll
            for (int t = 0; t < 16; ++t) { const int j = r - t; if (j >= 0 && j < 31 && t < NTOK) acc[t] += zv * wt[j]; } }
#pragma unroll
        for (int t = 0; t < 16; ++t) ot[t * 512 + tid] = acc[t];
        __syncthreads();
#pragma unroll
        for (int q = 0; q < 2; ++q) { const int t = 2 * w + q, tok = sb * 16 + t;
            if (tok < NTOK) {
                const f32x4 x0 = *(const LAS f32x4*)(ot + t * 512 + 8 * lane), x1 = *(const LAS f32x4*)(ot + t * 512 + 8 * lane + 4);
                const float mu = wave_sum((x0[0] + x0[1]) + (x0[2] + x0[3]) + (x1[0] + x1[1]) + (x1[2] + x1[3])) * (1.f / 512.f);
                const f32x4 d0 = x0 - mu, d1 = x1 - mu;
                const float var = wave_sum((d0[0] * d0[0] + d0[1] * d0[1]) + (d0[2] * d0[2] + d0[3] * d0[3]) + (d1[0] * d1[0] + d1[1] * d1[1]) + (d1[2] * d1[2] + d1[3] * d1[3])) * (1.f / 512.f);
                const float rstd = rsqrtf(var + EPS);
                f32x4 y0 = d0 * rstd * g0 + b0, y1 = d1 * rstd * g1 + b1;
#pragma unroll
                for (int j = 0; j < 4; ++j) { y0[j] = fsilu(y0[j]); y1[j] = fsilu(y1[j]); }
                *(u32x4*)(MIX + (size_t)(seq0 + t0 + tok) * 1024 + 512 + 8 * lane) = pack8(y0, y1); } }
        __syncthreads();
    }
}

__device__ __forceinline__ void mla_stats_row(int row, int lane, const bf16* P, const float* krg, const float* cosC, const float* sinC, float* RS, bf16* Kc) {
    const bf16* p = P + (size_t)row * PP;
    const u32x4 a = *(const u32x4*)(p + 8 * lane);
    const u32x4 b = *(const u32x4*)(p + 8 * (lane + 64));
    u32x4 c = (u32x4){0u, 0u, 0u, 0u};
    if (lane < 4) c = *(const u32x4*)(p + 8 * (lane + 128));
    auto sq = [](u32x4 u) { float s = 0.f; s += bflo(u.x) * bflo(u.x) + bfhi(u.x) * bfhi(u.x); s += bflo(u.y) * bflo(u.y) + bfhi(u.y) * bfhi(u.y);
                            s += bflo(u.z) * bflo(u.z) + bfhi(u.z) * bfhi(u.z); s += bflo(u.w) * bflo(u.w) + bfhi(u.w) * bfhi(u.w); return s; };
    const float sa = sq(a), sb = sq(b), sc = sq(c);
    const float ssq = wave_sum(sa + (lane < 32 ? sb : 0.f)), skv = wave_sum(lane >= 32 ? sb : 0.f), skr = wave_sum(sc);
    if (lane == 0) { RS[(size_t)row * 2] = rsqrtf(ssq * (1.f / 768.f) + EPS); RS[(size_t)row * 2 + 1] = rsqrtf(skv * (1.f / 256.f) + EPS); }
    const float rk = rsqrtf(skr * (1.f / 32.f) + EPS);
    float y[8]; const int l4 = lane & 3;
    { const f32x4 g0 = *(const f32x4*)(krg + 8 * l4), g1 = *(const f32x4*)(krg + 8 * l4 + 4);
      y[0] = bflo(c.x) * rk * g0[0]; y[1] = bfhi(c.x) * rk * g0[1]; y[2] = bflo(c.y) * rk * g0[2]; y[3] = bfhi(c.y) * rk * g0[3];
      y[4] = bflo(c.z) * rk * g1[0]; y[5] = bfhi(c.z) * rk * g1[1]; y[6] = bflo(c.w) * rk * g1[2]; y[7] = bfhi(c.w) * rk * g1[3]; }
    const int t = row & 4095, ax = l4 >> 1, half = l4 & 1;
    const f32x4 c0 = *(const f32x4*)(cosC + t * 16 + 8 * ax), c1 = *(const f32x4*)(cosC + t * 16 + 8 * ax + 4), s0 = *(const f32x4*)(sinC + t * 16 + 8 * ax), s1 = *(const f32x4*)(sinC + t * 16 + 8 * ax + 4);
    float o[8];
#pragma unroll
    for (int j = 0; j < 8; ++j) { const float po = __shfl_xor(y[j], 1); const float cc = j < 4 ? c0[j & 3] : c1[j & 3], sn = j < 4 ? s0[j & 3] : s1[j & 3];
        const float yr = half == 0 ? (y[j] * cc - po * sn) : (y[j] * cc + po * sn); o[j] = row < NL ? yr : y[j]; }
    if (lane < 4) { u32x4 wv; wv.x = pk2(o[0], o[1]); wv.y = pk2(o[2], o[3]); wv.z = pk2(o[4], o[5]); wv.w = pk2(o[6], o[7]);
#pragma unroll
        for (int hd = 0; hd < 16; ++hd) *(u32x4*)(Kc + (size_t)row * 1536 + hd * 96 + 64 + 8 * lane) = wv; }
}

template <int NT>
__device__ __forceinline__ void moe_setup(LAS unsigned char* lds, const int* cntG, const int* list, int layer, int vcu, int G) {
    LAS int* tab = (LAS int*)(lds + LDS_TAB); LAS int* idx = (LAS int*)(lds + LDS_IDX);
    const int tid = otid(); constexpr int MG = 32 / NT;
    if (tid < 32) tab[tid] = cntG[tid * 64];
    __syncthreads();
    if (tid == 0) { int acc = 0; for (int e = 0; e < 32; ++e) { tab[32 + e] = acc; acc += (tab[e] + 255) >> 8; } tab[64] = acc;
        int n = 0;
        for (int i = 0; i < MAXU; ++i) { const int v = i * G + vcu, gm = (v >> 5) * MG + (v & 31) / NT, nt = v % NT; if (gm >= acc) break;
            int e = 0; while (e < 31 && tab[33 + e] <= gm) ++e;
            tab[128 + 4 * i] = gm; tab[129 + 4 * i] = (layer * 32 + e) * NT + nt; tab[130 + 4 * i] = e; tab[131 + 4 * i] = nt; n = i + 1; }
        tab[127] = n; }
    __syncthreads();
    const int n = tab[127];
    for (int q = tid; q < n * 256; q += NTHR) { const int i = q >> 8, r = q & 255, gm = tab[128 + 4 * i], e = tab[130 + 4 * i], rr = (gm - tab[32 + e]) * 256 + r;
        idx[q] = rr < tab[e] ? list[(size_t)e * T + rr] : -1; }
    __syncthreads();
}

__device__ __forceinline__ void combine_row(int row, int lane, float* X, const bf16* YB, const float* mcur  , const float* gnext, const float* mnext, bf16* H, float* out) {
    const int mr = modrow(row); const float* mv = mcur + (size_t)mr * 6144 + 5120;
    f32x4 v[2][2]; float ss = 0.f;
    u32x4 y[2][4];
#pragma unroll
    for (int j = 0; j < 2; ++j)
#pragma unroll
        for (int k = 0; k < 4; ++k) y[j][k] = *(const u32x4*)(YB + ((size_t)row * 4 + k) * 1024 + 8 * lane + 512 * j);
#pragma unroll
    for (int j = 0; j < 2; ++j) { const int c = 8 * lane + 512 * j; f32x4 a0 = (f32x4){0.f, 0.f, 0.f, 0.f}, a1 = a0;
#pragma unroll
        for (int k = 0; k < 4; ++k) { a0 += (f32x4){bflo(y[j][k].x), bfhi(y[j][k].x), bflo(y[j][k].y), bfhi(y[j][k].y)}; a1 += (f32x4){bflo(y[j][k].z), bfhi(y[j][k].z), bflo(y[j][k].w), bfhi(y[j][k].w)}; }
        float* xp = X + (size_t)row * D + c; const f32x4 g0 = *(const f32x4*)(mv + c), g1 = *(const f32x4*)(mv + c + 4);
        v[j][0] = *(const f32x4*)xp + g0 * a0; v[j][1] = *(const f32x4*)(xp + 4) + g1 * a1;
        float* op = out ? out + (size_t)row * D + c : xp;
        *(f32x4*)op = v[j][0]; *(f32x4*)(op + 4) = v[j][1];
#pragma unroll
        for (int q = 0; q < 2; ++q) ss += (v[j][q][0] * v[j][q][0] + v[j][q][1] * v[j][q][1]) + (v[j][q][2] * v[j][q][2] + v[j][q][3] * v[j][q][3]); }
    if (H) { const float rstd = rsqrtf(wave_sum(ss) * (1.f / D) + EPS); const float* mn = mnext + (size_t)mr * 6144;
#pragma unroll
        for (int j = 0; j < 2; ++j) { const int c = 8 * lane + 512 * j; f32x4 o[2];
#pragma unroll
            for (int q = 0; q < 2; ++q) { const f32x4 gg = *(const f32x4*)(gnext + c + 4 * q), sc = *(const f32x4*)(mn + 1024 + c + 4 * q), sh = *(const f32x4*)(mn + c + 4 * q); o[q] = v[j][q] * rstd * gg * (sc + 1.f) + sh; }
            *(u32x4*)(H + (size_t)row * D + c) = pack8(o[0], o[1]); } }
}

#define MFMA16(a, b, c) __builtin_amdgcn_mfma_f32_16x16x32_bf16((a), (b), (c), 0, 0, 0)
__device__ __forceinline__ void router_load_table(LAS unsigned char* lds, const bf16* Wr, int tid) {
    u32x4 v[16];
#pragma unroll
    for (int i = 0; i < 16; ++i) v[i] = *(const u32x4*)(Wr + (size_t)(tid + i * NTHR) * 8);
#pragma unroll
    for (int i = 0; i < 16; ++i) { const int q = tid + i * NTHR, row = q >> 7, c = q & 127; *(LAS u32x4*)(lds + row * 2048 + ((c ^ (row & 15)) << 4)) = v[i]; }
}
__device__ __forceinline__ void router_group(LAS unsigned char* lds, int g, int w, int lane, const float* X, const float* SSX, const float* gffn, const float* mvec, const float* rb,
                                             bf16* F, float* gate) {
    LAS float* lg = (LAS float*)(lds + LDS_IDX) + w * 512; LAS int* pend = (LAS int*)(lds + LDS_IDX + 10240) + w * 64; LAS int* cntL = (LAS int*)(lds + LDS_TAB);
    const int i = lane & 15, kq = lane >> 4, row = 16 * g + i;
    const float* xr = X + (size_t)row * D + 8 * kq;
    float ss; { const f32x4 pq = *(const f32x4*)(SSX + (size_t)row * 16 + 4 * kq); ss = (pq[0] + pq[1]) + (pq[2] + pq[3]); }
    ss += __shfl_xor(ss, 16); ss += __shfl_xor(ss, 32);
    const float rstd = rsqrtf(ss * (1.f / D) + EPS);
    f32x4 acc[2] = {(f32x4){0.f, 0.f, 0.f, 0.f}, (f32x4){0.f, 0.f, 0.f, 0.f}};
    const LAS unsigned char* tb = lds + i * 2048;
#pragma unroll 8
    for (int s = 0; s < 32; ++s) {
        const int k = 32 * s + 8 * kq;
        const f32x4 a = *(const f32x4*)(xr + 32 * s), b = *(const f32x4*)(xr + 32 * s + 4);
        const f32x4 g0 = *(const f32x4*)(gffn + k), g1 = *(const f32x4*)(gffn + k + 4), c0 = *(const f32x4*)(mvec + 4096 + k), c1 = *(const f32x4*)(mvec + 4096 + k + 4);
        const f32x4 h0 = *(const f32x4*)(mvec + 3072 + k), h1 = *(const f32x4*)(mvec + 3072 + k + 4);
        const f32x4 f0 = a * rstd * g0 * (c0 + 1.f) + h0, f1 = b * rstd * g1 * (c1 + 1.f) + h1;
        u32x4 hi; hi.x = pk2(f0[0], f0[1]); hi.y = pk2(f0[2], f0[3]); hi.z = pk2(f1[0], f1[1]); hi.w = pk2(f1[2], f1[3]);
        *(u32x4*)(F + (size_t)row * D + k) = hi;
        u32x4 lo; lo.x = pk2(f0[0] - bflo(hi.x), f0[1] - bfhi(hi.x)); lo.y = pk2(f0[2] - bflo(hi.y), f0[3] - bfhi(hi.y));
        lo.z = pk2(f1[0] - bflo(hi.z), f1[1] - bfhi(hi.z)); lo.w = pk2(f1[2] - bflo(hi.w), f1[3] - bfhi(hi.w));
        const bf16x8 ah = __builtin_bit_cast(bf16x8, hi), al = __builtin_bit_cast(bf16x8, lo);
        const int cs = ((4 * s + kq) ^ i) << 4;
#pragma unroll
        for (int et = 0; et < 2; ++et) { const bf16x8 bh = *(const LAS bf16x8*)(tb + et * 16 * 2048 + cs), bl = *(const LAS bf16x8*)(tb + (32 + et * 16) * 2048 + cs);
            acc[et] = MFMA16(ah, bh, acc[et]); acc[et] = MFMA16(al, bh, acc[et]); acc[et] = MFMA16(ah, bl, acc[et]); }
    }
#pragma unroll
    for (int et = 0; et < 2; ++et) { const float bias = rb[16 * et + i];
#pragma unroll
        for (int r = 0; r < 4; ++r) lg[(4 * kq + r) * 32 + 16 * et + i] = acc[et][r] + bias; }
    LDS_WAIT(); asm volatile("" ::: "memory");
    if (lane < 16) {
        const LAS float* my = lg + lane * 32; unsigned used = 0u; int bi[4]; float bv[4];
#pragma unroll
        for (int k = 0; k < 4; ++k) { float best = -3.0e38f; int be = 0;
#pragma unroll
            for (int e = 0; e < 32; ++e) { const float v = my[e]; const bool ok = !((used >> e) & 1u) && v > best; best = ok ? v : best; be = ok ? e : be; }
            used |= 1u << be; bi[k] = be; bv[k] = best; }
        float ex[4], sum = 0.f;
#pragma unroll
        for (int k = 0; k < 4; ++k) { ex[k] = __expf(bv[k] - bv[0]); sum += ex[k]; }
        const float inv = 1.f / sum; const int trow = 16 * g + lane;
#pragma unroll
        for (int k = 0; k < 4; ++k) { const int rl = __hip_atomic_fetch_add(cntL + bi[k], 1, __ATOMIC_RELAXED, __HIP_MEMORY_SCOPE_WORKGROUP);
            pend[lane * 4 + k] = (trow * 4 + k) | (bi[k] << 17) | (rl << 22); gate[trow * 4 + k] = ex[k] * inv; }
    }
}

struct Args { const float* in[32]; float* out; unsigned char* ws; int lo, hi, flags, pad; };
constexpr int N_PHASES = 2 + 2 * (7 + 8);

__global__ void __launch_bounds__(NTHR, 2) mega(Args args) {
    extern __shared__ __attribute__((aligned(16))) unsigned char lds_raw[];
    LAS unsigned char* lds = (LAS unsigned char*)lds_raw;
    const int tid = threadIdx.x, lane = tid & 63, wave = __builtin_amdgcn_readfirstlane(tid >> 6);
    constexpr int G = 256;
    const int bx = blockIdx.x & (G - 1), vcu = (bx % 8) * (G / 8) + bx / 8;
    const int gw = vcu * NWAVES + wave, NGW = G * NWAVES;
    unsigned* ctl = (unsigned*)(args.ws + WS_CTL);
#define PH_LOCALS \
    unsigned zsg_; asm volatile("s_mov_b32 %0, 0" : "=s"(zsg_)); unsigned char* ws = args.ws + zsg_;   const int tid = otid(), lane = tid & 63, wave = __builtin_amdgcn_readfirstlane(tid >> 6), gw = vcu * NWAVES + wave; (void)lane; (void)gw; \
    const float* x_in = args.in[0]; const float* c_in = args.in[1]; const float* ctx_in = args.in[2]; const float* cctx_in = args.in[3]; \
    const float* mod_w = args.in[4]; const float* mod_b = args.in[5]; const float* norm_mix_g = args.in[6]; const float* norm_ffn_g = args.in[7]; \
    float* MOD = (float*)(ws + WS_MOD); float* cosA = (float*)(ws + WS_COSA); float* sinA = (float*)(ws + WS_SINA); float* cosC = (float*)(ws + WS_COSC); float* sinC = (float*)(ws + WS_SINC); \
    bf16* WR = (bf16*)(ws + WS_WR); bf16* WINA = (bf16*)(ws + WS_WINA); bf16* WOUTA = (bf16*)(ws + WS_WOUTA); bf16* WINC = (bf16*)(ws + WS_WINC); bf16* WQB = (bf16*)(ws + WS_WQB); \
    bf16* WKVB = (bf16*)(ws + WS_WKVB); bf16* WOUTC = (bf16*)(ws + WS_WOUTC); bf16* WGU = (bf16*)(ws + WS_WGU); bf16* WDN = (bf16*)(ws + WS_WDN); \
    float* X = (float*)(ws + WS_X); bf16* H = (bf16*)(ws + WS_H); bf16* QA = (bf16*)(ws + WS_QA); bf16* KA = (bf16*)(ws + WS_KA); bf16* VA = (bf16*)(ws + WS_VA); bf16* Z = (bf16*)(ws + WS_Z); \
    bf16* P = (bf16*)(ws + WS_P); float* RS = (float*)(ws + WS_RS); bf16* QC = (bf16*)(ws + WS_QC); bf16* KC = (bf16*)(ws + WS_KC); bf16* VC = (bf16*)(ws + WS_VC); \
    bf16* MIX = (bf16*)(ws + WS_MIX); bf16* F = (bf16*)(ws + WS_F); float* GATE = (float*)(ws + WS_GATE); int* LIST = (int*)(ws + WS_LIST); bf16* ACT = (bf16*)(ws + WS_ACT); bf16* YB = (bf16*)(ws + WS_YB); \
    int* CNT = (int*)(ws + WS_CTL) + CW_CNT; float* SSX = (float*)(ws + WS_SSX); float* SSP = (float*)(ws + WS_SSP); (void)SSX; (void)SSP; const float* ML = MOD + (size_t)layer_ * 5 * 6144; \
    (void)x_in; (void)c_in; (void)ctx_in; (void)cctx_in; (void)mod_w; (void)mod_b; (void)norm_mix_g; (void)norm_ffn_g; (void)MOD; (void)cosA; (void)sinA; (void)cosC; (void)sinC; (void)WR; (void)WINA; (void)WOUTA; \
    (void)WINC; (void)WQB; (void)WKVB; (void)WOUTC; (void)WGU; (void)WDN; (void)X; (void)H; (void)QA; (void)KA; (void)VA; (void)Z; (void)P; (void)RS; (void)QC; (void)KC; (void)VC; (void)MIX; (void)F; (void)GATE; \
    (void)LIST; (void)ACT; (void)YB; (void)CNT; (void)ML;
    if (tid < 64) ((LAS unsigned*)(lds + LDS_MISC))[tid] = 0u;
    __syncthreads();
    const int lo = args.lo, hi = args.hi;
    XcdBarrier bar; bar.bar = ctl + CW_BAR; bar.x = 0; bar.st = nullptr;
    if (hi - lo > 1) bar = xcd_barrier_post(ctl + CW_BAR, (volatile LAS unsigned*)(lds + LDS_MISC));
    int ph = 0; int layer_ = 0;
#ifndef MK_EN
#define MK_EN 0xffffffffu
#endif
#ifdef MK_PROBE_PH
#define PFLAG(b) (args.flags & (b))
#else
#define PFLAG(b) 0
#endif
#define EN(k) (((MK_EN) >> (k)) & 1u)
#define PH_ON (ph >= lo && ph < hi)
#define CVT_HEAD do { if (tid < 8) ((LAS int*)(lds + CV_HDR))[tid] = -1; } while (0)
#define CVT_TAIL(bg) do { LAS int* _jn = (LAS int*)(lds + CV_HDR + 64); asm volatile("s_waitcnt vmcnt(0)" ::: "memory"); if (wave >= 4 && lane == 0) _jn[wave - 4] = bg.j; __syncthreads(); \
        bg.process_slot(tid, lds, 0); bg.process_slot(tid, lds, 1); \
        { const int _j = _jn[wave & 3]; bg.j = _j + (wave < 4 ? 0 : 4); bg.step = 8; } __syncthreads(); \
        bg.tail_loop(lane, lds + wave * 16384); __syncthreads(); } while (0)
#define PH_END do { const bool _b = (ph >= lo) && (ph + 1 < hi); ++ph; if (_b) xcd_barrier(bar); } while (0)

    if (EN(0) && PH_ON) { PH_LOCALS
        LAS float* st = (LAS float*)(lds + 73728);
        for (int q = tid; q < 5 * 1024; q += NTHR) { const float v = q < 4096 ? c_in[q] : cctx_in[q - 4096]; st[q] = fsilu(v); }
        __syncthreads();
        for (int u = vcu; u < 384; u += G) {
            const int l = u / 96, col = (u % 96) * 64 + lane;
            const float* wp = mod_w + ((size_t)l * D + 128 * wave) * 6144 + col; float a0 = 0.f, a1 = 0.f, a2 = 0.f, a3 = 0.f, a4 = 0.f;
#pragma unroll 1
            for (int k0 = 0; k0 < 128; k0 += 64) { float wv[64];
#pragma unroll
                for (int kk = 0; kk < 64; ++kk) wv[kk] = __builtin_nontemporal_load(wp + (size_t)(k0 + kk) * 6144);
#pragma unroll
                for (int kk = 0; kk < 64; ++kk) { const int k = 128 * wave + k0 + kk; a0 += st[k] * wv[kk]; a1 += st[1024 + k] * wv[kk]; a2 += st[2048 + k] * wv[kk]; a3 += st[3072 + k] * wv[kk]; a4 += st[4096 + k] * wv[kk]; } }
            LAS float* part = (LAS float*)(lds + 98304);
            part[(wave * 5 + 0) * 64 + lane] = a0; part[(wave * 5 + 1) * 64 + lane] = a1; part[(wave * 5 + 2) * 64 + lane] = a2; part[(wave * 5 + 3) * 64 + lane] = a3; part[(wave * 5 + 4) * 64 + lane] = a4;
            __syncthreads();
            if (wave < 5) { float s = mod_b[l * 6144 + col];
#pragma unroll
                for (int w8 = 0; w8 < 8; ++w8) s += part[(w8 * 5 + wave) * 64 + lane];
                MOD[((size_t)l * 5 + wave) * 6144 + col] = s; }
            __syncthreads();
        }
        for (int q = gw * 64 + lane; q < 4096 * 32; q += NGW * 64) {
            { const int t = q >> 5, j = q & 31, ax = j >> 4, i = j & 15; const float pos = (float)(ax == 0 ? (t >> 6) : (t & 63)); const float a = pos * powf(10000.f, -((float)i * 2.f) / 32.f); cosA[q] = cosf(a); sinA[q] = sinf(a); }
            if (q < 4096 * 16) { const int t = q >> 4, j = q & 15, ax = j >> 3, i = j & 7; const float pos = (float)(ax == 0 ? (t >> 6) : (t & 63)); const float a = pos * powf(10000.f, -((float)i * 2.f) / 16.f); cosC[q] = cosf(a); sinC[q] = sinf(a); }
        }
        { const float* rw = args.in[26];
          for (int q = gw * 64 + lane; q < 4 * 32 * 1024; q += NGW * 64) { const int l = q >> 15, e = (q >> 10) & 31, k = q & 1023; const float wv = rw[((size_t)l * 1024 + k) * 32 + e];
              const unsigned hb = pk2(wv, 0.f) & 0xffffu; const float hf = __uint_as_float(hb << 16); const unsigned lb = pk2(wv - hf, 0.f) & 0xffffu;
              WR[((size_t)(l * 2 + 0) * 32 + e) * 1024 + k] = (bf16)hb; WR[((size_t)(l * 2 + 1) * 32 + e) * 1024 + k] = (bf16)lb; } }
        LAS float* scr = (LAS float*)(lds + wave * 8448);
        cvt_matrix<LAY_INA>(args.in[8], (size_t)D * 1792, 1792, 1792, 1024, 7, 14, WINA, nullptr, scr, gw, NGW, lane);
        cvt_matrix<LAY_F32>(args.in[9], (size_t)D * 1024, 1024, 1024, 1024, 4, 8, WOUTA, nullptr, scr, gw, NGW, lane);
        cvt_matrix<LAY_STD>(args.in[17], (size_t)D * 1056, 1056, 1056, 1024, 5, 10, WINC, nullptr, scr, gw, NGW, lane);
        cvt_matrix<LAY_STD>(args.in[20], (size_t)768 * 1536, 1536, 1536, 768, 6, 6, WQB, args.in[18], scr, gw, NGW, lane);
        cvt_matrix<LAY_STD>(args.in[20] + (size_t)768 * 1536, 0, 1536, 1536, 768, 6, 6, WQB + (size_t)1536 * 768, args.in[18] + 768, scr, gw, NGW, lane);
        cvt_matrix<LAY_HEAD2>(args.in[21], (size_t)256 * 2048, 2048, 2048, 256, 8, 8, WKVB, args.in[19], scr, gw, NGW, lane);
        cvt_matrix<LAY_HEAD2>(args.in[21] + (size_t)256 * 2048, 0, 2048, 2048, 256, 8, 8, WKVB + (size_t)2048 * 256, args.in[19] + 256, scr, gw, NGW, lane);
        cvt_matrix<LAY_F32>(args.in[25], (size_t)D * 1024, 1024, 1024, 1024, 4, 8, WOUTC, nullptr, scr, gw, NGW, lane);
        __syncthreads();
    }
    PH_END;
    if (EN(1) && PH_ON) { PH_LOCALS
        for (int row = gw; row < T; row += NGW) {
            const float* xrow = row < NL ? x_in + (size_t)row * D : ctx_in + (size_t)(row - NL) * D; const float* mn = MOD + (size_t)modrow(row) * 6144;
            f32x4 v[2][2]; float ss = 0.f;
#pragma unroll
            for (int j = 0; j < 2; ++j)
#pragma unroll
                for (int q = 0; q < 2; ++q) { v[j][q] = *(const f32x4*)(xrow + 8 * lane + 512 * j + 4 * q); ss += (v[j][q][0] * v[j][q][0] + v[j][q][1] * v[j][q][1]) + (v[j][q][2] * v[j][q][2] + v[j][q][3] * v[j][q][3]); }
            const float rstd = rsqrtf(wave_sum(ss) * (1.f / D) + EPS);
#pragma unroll
            for (int j = 0; j < 2; ++j) { const int c = 8 * lane + 512 * j; f32x4 o[2];
#pragma unroll
                for (int q = 0; q < 2; ++q) { const f32x4 gg = *(const f32x4*)(norm_mix_g + c + 4 * q), sc = *(const f32x4*)(mn + 1024 + c + 4 * q), sh = *(const f32x4*)(mn + c + 4 * q); o[q] = v[j][q] * rstd * gg * (sc + 1.f) + sh; }
                *(u32x4*)(H + (size_t)row * D + c) = pack8(o[0], o[1]); }
        }
    }
    PH_END;

    for (int layer = 0; layer < 4; ++layer) {
        const bool keep = layer < 3; const int li = layer >> 1; const int nrt = keep ? 68 : 64;
        layer_ = layer;
        if ((layer & 1) == 0) {
            if (EN(2) && PH_ON) { PH_LOCALS
                g8::GemmP g{H, D, WINA + (size_t)li * 1792 * 1024, 1024}; g8::StaticOrder S_; S_.init(68, 7, G, bx);
                EpiInA E{QA, KA, VA, Z, args.in[10] + li * 64, args.in[11] + li * 64, cosA, sinA};
                g8::gemm_phase(lds, g, S_, E);
            }
            PH_END;
            if (EN(3) && PH_ON) { PH_LOCALS
                const int nau = keep ? 544 : 512;
                if (!(PFLAG(1))) {
                    CvtBg bg; bg.init(args.in[28], args.in[30], WGU, WDN, 0, layer == 0 ? 1 : 0, vcu, wave >= 4 ? wave - 4 : 0x40000000, 4); CVT_HEAD;
                    for (int u = vcu; u < nau; u += G) wattn_unit(lds, u, QA, KA, VA, args.in[12] + li * 8, MIX, bg);
                    CVT_TAIL(bg);
                }
                if (!(PFLAG(2))) {
                    const float* dww = args.in[13] + (size_t)li * 31 * 512; const float* dwb = args.in[14] + li * 512; const float* lng = args.in[15] + li * 512; const float* lnb = args.in[16] + li * 512;
                    conv_strip<64>(lds, (vcu >> 6) * S, S, (vcu & 63) * 64, Z, dww, dwb, lng, lnb, MIX);
                    if (keep) conv_strip<4>(lds, NL + (vcu >> 6) * CL, CL, (vcu & 63) * 4, Z, dww, dwb, lng, lnb, MIX);
                }
            }
            PH_END;
            if (EN(4) && PH_ON) { PH_LOCALS
                g8::GemmP g{MIX, D, WOUTA + (size_t)li * 1024 * 1024, 1024}; g8::StaticOrder S_; S_.init(nrt, 4, G, bx);
                EpiResid E{X, layer == 0 ? x_in : X, layer == 0 ? ctx_in : X + (size_t)NL * D, ML + 2048, SSX};
                g8::gemm_phase(lds, g, S_, E);
            }
            PH_END;
        } else {
            if (EN(5) && PH_ON) { PH_LOCALS
                g8::GemmP g{H, D, WINC + (size_t)li * 1280 * 1024, 1024}; g8::StaticOrder S_; S_.init(68, 5, G, bx);
                EpiP E{P, SSP, KC, args.in[24] + li * 32, cosC, sinC};
                g8::gemm_phase(lds, g, S_, E);
            }
            PH_END;
            if (EN(7) && PH_ON) { PH_LOCALS
#ifndef MK_O3
#define MK_O3 3
#endif
                if ((MK_O3 & 1) && !(PFLAG(16))) { g8::GemmP g{P, PP, WQB + (size_t)li * 1536 * 768, 768}; g8::StaticOrder S_; S_.init(nrt, 6, G, bx); EpiBf16 E{QC, 1536, 1536}; g8::gemm_phase(lds, g, S_, E); }
                if ((MK_O3 & 2) && !(PFLAG(32))) { g8::GemmP g{P + 768, PP, WKVB + (size_t)li * 2048 * 256, 256}; g8::StaticOrder S_; S_.init(68, 8, G, bx); EpiKV E{KC, VC, SSP, args.in[23] + li * 64}; g8::gemm_phase(lds, g, S_, E); }
            }
            PH_END;
            if (EN(8) && PH_ON) { PH_LOCALS
                const int nau = keep ? 1088 : 1024;
                CvtBg bg; bg.init(args.in[28], args.in[30], WGU, WDN, layer, (PFLAG(8)) ? 0 : ((layer == 1) ? 2 : 1), vcu, wave >= 4 ? wave - 4 : 0x40000000, 4); CVT_HEAD;
                for (int u = vcu; u < nau; u += G) mla_unit(lds, u, QC, KC, VC, SSP, args.in[22] + li * 96, cosC, sinC, MIX, bg);
                CVT_TAIL(bg);
            }
            PH_END;
            if (EN(9) && PH_ON) { PH_LOCALS
                g8::GemmP g{MIX, D, WOUTC + (size_t)li * 1024 * 1024, 1024}; g8::StaticOrder S_; S_.init(nrt, 4, G, bx);
                EpiResid E{X, X, X + (size_t)NL * D, ML + 2048, SSX};
                g8::gemm_phase(lds, g, S_, E);
            }
            PH_END;
        }
        if (EN(10) && PH_ON) { PH_LOCALS
            LAS int* cntL = (LAS int*)(lds + LDS_TAB); LAS int* baseL = cntL + 32; LAS int* pend = (LAS int*)(lds + LDS_IDX + 10240);
            if (tid < 32) cntL[tid] = 0;
            router_load_table(lds, WR + (size_t)layer * 2 * 32 * 1024, tid);
            __syncthreads();
            int g = -1;
            if (wave < 4) g = bx * 4 + wave; else if (wave == 4 && keep && bx < 64) g = 1024 + bx;
            if (g >= 0) router_group(lds, g, wave, lane, X, SSX, norm_ffn_g + layer * D, ML + (size_t)(g < 1024 ? (g >> 8) : 4) * 6144, args.in[27] + layer * 32, F, GATE);
            __syncthreads();
            if (tid < 32) baseL[tid] = (PFLAG(4)) ? 0 : atomicAdd(CNT + (layer * 32 + tid) * 64, cntL[tid])    ;
            __syncthreads();
            if (tid < 320) { const int wv = tid >> 6; const bool has = (wv < 4) || (wv == 4 && keep && bx < 64);
                if (has) { const int pe = pend[tid], slot = pe & 0x1ffff, e = (pe >> 17) & 31, rl = pe >> 22; LIST[(size_t)e * T + baseL[e] + rl] = slot; } }
            __syncthreads();
        }
        PH_END;
        if (EN(11) && PH_ON) { PH_LOCALS
            moe_setup<8>(lds, CNT + layer * 32 * 64, LIST, layer, vcu, G);
            g8::GemmP g{F, D, WGU, 1024}; g8::MoeOrder<true> S_{(const LAS int*)(lds + LDS_TAB), (const LAS int*)(lds + LDS_IDX)};
            EpiGU E{ACT, args.in[29] + (size_t)layer * 32 * 2048};
            g8::gemm_phase(lds, g, S_, E);
        }
        PH_END;
        if (EN(12) && PH_ON) { PH_LOCALS
            moe_setup<4>(lds, CNT + layer * 32 * 64, LIST, layer, vcu, G);
            g8::GemmP g{ACT, 1024, WDN, 1024}; g8::MoeOrder<false> S_{(const LAS int*)(lds + LDS_TAB), (const LAS int*)(lds + LDS_IDX)};
            EpiDown E{YB, args.in[31] + (size_t)layer * 32 * 1024, GATE, (const LAS int*)(lds + LDS_IDX)};
            g8::gemm_phase(lds, g, S_, E);
        }
        PH_END;
        if (EN(13) && PH_ON) { PH_LOCALS
            const int nrows = keep ? T : NL;
            for (int row = gw; row < nrows; row += NGW)
                combine_row(row, lane, X, YB, ML, norm_mix_g + (layer + 1 < 4 ? layer + 1 : 0) * D, MOD + (size_t)(layer + 1 < 4 ? layer + 1 : 0) * 5 * 6144, layer < 3 ? H : nullptr, layer < 3 ? nullptr : args.out);
        }
        PH_END;
    }
#undef PH_ON
#undef PH_END
}
}

#ifndef MK_MULTI
#define MK_MULTI 0
#endif
#ifndef MK_DEBUG
#define MK_DEBUG 0
#endif
#if MK_DEBUG
namespace dbg {
__global__ void k_cmp_bf(const unsigned short* a, int lda, const float* b, int ldb, int rows, int cols, float s, float* acc, int cp) {
    float d2 = 0.f, r2 = 0.f;
    for (size_t i = (size_t)blockIdx.x * blockDim.x + threadIdx.x; i < (size_t)rows * cols; i += (size_t)gridDim.x * blockDim.x) {
        const size_t r = i / cols, c = i % cols; const float av = __uint_as_float(((unsigned)a[r * lda + c]) << 16), bv = s * b[r * ldb + c]; d2 += (av - bv) * (av - bv); r2 += bv * bv; }
    for (int o = 32; o >= 1; o >>= 1) { d2 += __shfl_xor(d2, o); r2 += __shfl_xor(r2, o); }
    if ((threadIdx.x & 63) == 0) { atomicAdd(acc + 2 * cp, d2); atomicAdd(acc + 2 * cp + 1, r2); }
}
__global__ void k_cmp_f(const float* a, const float* b, size_t n, float* acc, int cp) {
    float d2 = 0.f, r2 = 0.f;
    for (size_t i = (size_t)blockIdx.x * blockDim.x + threadIdx.x; i < n; i += (size_t)gridDim.x * blockDim.x) { const float av = a[i], bv = b[i]; d2 += (av - bv) * (av - bv); r2 += bv * bv; }
    for (int o = 32; o >= 1; o >>= 1) { d2 += __shfl_xor(d2, o); r2 += __shfl_xor(r2, o); }
    if ((threadIdx.x & 63) == 0) { atomicAdd(acc + 2 * cp, d2); atomicAdd(acc + 2 * cp + 1, r2); }
}
__global__ void k_report(const float* acc, int ncp, float thr, float* out) {
    if (blockIdx.x == 0 && threadIdx.x == 0) { int bad = -1; for (int i = 0; i < ncp; ++i) { const float d = acc[2 * i], r = acc[2 * i + 1]; if (!(d <= thr * r)) { bad = i; break; } }
        if (bad >= 0) out[0] += 100.f * (float)(bad + 1); }
}
}
#endif

extern "C" void kernel_launch(void* const* d_in, const int* in_sizes, int n_in, void* d_out, int out_size, void* d_ws, size_t ws_size, hipStream_t stream) {
    using namespace mk;
    static int grid = 0;
    if (grid == 0) {
        int dev = 0, cus = 0, per_cu = 0;
        if (hipGetDevice(&dev) != hipSuccess || hipDeviceGetAttribute(&cus, hipDeviceAttributeMultiprocessorCount, dev) != hipSuccess) { fprintf(stderr, "kernel_launch: device query failed\n"); grid = -1; return; }
        if (hipFuncSetAttribute((const void*)mega, hipFuncAttributeMaxDynamicSharedMemorySize, LDS_BYTES) != hipSuccess) { fprintf(stderr, "kernel_launch: hipFuncSetAttribute(%d B LDS) failed\n", LDS_BYTES); grid = -1; return; }
        if (hipOccupancyMaxActiveBlocksPerMultiprocessor(&per_cu, (const void*)mega, NTHR, LDS_BYTES) != hipSuccess || per_cu < 1) fprintf(stderr, "kernel_launch: occupancy query reports %d blocks per CU\n", per_cu);
        (void)hipGetLastError();
        grid = 256;
        if (cus < 256) { fprintf(stderr, "kernel_launch: %d CUs < 256: the persistent grid would not be resident; nothing launched\n", cus); grid = -1; return; }
        if (n_in != 32 || ws_size < WS_END) { fprintf(stderr, "kernel_launch: n_in %d ws %zu (need %zu)\n", n_in, ws_size, (size_t)WS_END); grid = -1; return; }
    }
    if (grid < 0) return;
    (void)hipMemsetAsync((char*)d_ws + WS_CTL, 0, CTL_BYTES, stream);
    Args a{};
    for (int i = 0; i < 32; ++i) a.in[i] = (const float*)d_in[i];
    a.out = (float*)d_out; a.ws = (unsigned char*)d_ws;
#if !MK_DEBUG
#if MK_MULTI
    for (int p = 0; p < N_PHASES; ++p) { a.lo = p; a.hi = p + 1; hipLaunchKernelGGL(mega, dim3(grid), dim3(NTHR), LDS_BYTES, stream, a); }
#else
    a.lo = 0; a.hi = N_PHASES; hipLaunchKernelGGL(mega, dim3(grid), dim3(NTHR), LDS_BYTES, stream, a);
#ifdef MK_PROBE_PH
    for (int r = 0; r < MK_PROBE_N; ++r) { a.lo = MK_PROBE_PH; a.hi = MK_PROBE_PH + 1; a.flags = MK_PROBE_FLAGS; hipLaunchKernelGGL(mega, dim3(grid), dim3(NTHR), LDS_BYTES, stream, a); }
#endif
#endif
    { const hipError_t le = hipPeekAtLastError(); if (le != hipSuccess) fprintf(stderr, "kernel_launch: launch failed: %s\n", hipGetErrorName(le)); }
#else
#endif
}
```

```cpp
#include <hip/hip_runtime.h>
#include <cstdio>
#include <cstdint>
#define MK_MULTI 0
#define MK_DEBUG 0
#define MK_DBG_THR 1e-3f
namespace mk {
#define LAS __attribute__((address_space(3)))
#define GAS __attribute__((address_space(1)))
typedef unsigned short bf16;
typedef short bf16x8 __attribute__((ext_vector_type(8)));
typedef short s16x4 __attribute__((ext_vector_type(4)));
typedef float f32x2 __attribute__((ext_vector_type(2)));
typedef float f32x4 __attribute__((ext_vector_type(4)));
typedef float f32x16 __attribute__((ext_vector_type(16)));
typedef unsigned u32x2 __attribute__((ext_vector_type(2)));
typedef unsigned u32x4 __attribute__((ext_vector_type(4)));

constexpr int D = 1024, NBATCH = 4, S = 4096, CL = 256, NL = NBATCH * S, NC = NBATCH * CL, T = NL + NC;
constexpr int NWAVES = 8, NTHR = 512;
constexpr float EPS = 1e-6f;
constexpr float LOG2E = 1.4426950408889634f;
constexpr float QSCALE_A = 0.125f * LOG2E;
constexpr float QSCALE_C = 0.10206207261596575f * LOG2E;

constexpr size_t al256(size_t x) { return (x + 255) & ~(size_t)255; }
constexpr size_t CTL_BYTES = 65536;
constexpr int CW_BAR = 1024, CW_CNT = 8192;
constexpr size_t WS_CTL = 0;
constexpr size_t WS_MOD = WS_CTL + CTL_BYTES;
constexpr size_t WS_COSA = WS_MOD + al256((size_t)4 * 5 * 6144 * 4);
constexpr size_t WS_SINA = WS_COSA + 4096 * 32 * 4;
constexpr size_t WS_COSC = WS_SINA + 4096 * 32 * 4;
constexpr size_t WS_SINC = WS_COSC + 4096 * 16 * 4;
constexpr size_t WS_WR = WS_SINC + 4096 * 16 * 4;
constexpr size_t WS_WINA = WS_WR + (size_t)4 * 2 * 32 * 1024 * 2;
constexpr size_t WS_WOUTA = WS_WINA + (size_t)2 * 1792 * 1024 * 2;
constexpr size_t WS_WINC = WS_WOUTA + (size_t)2 * 1024 * 1024 * 2;
constexpr size_t WS_WQB = WS_WINC + (size_t)2 * 1280 * 1024 * 2;
constexpr size_t WS_WKVB = WS_WQB + (size_t)2 * 1536 * 768 * 2;
constexpr size_t WS_WOUTC = WS_WKVB + (size_t)2 * 2048 * 256 * 2;
constexpr size_t WS_WGU = WS_WOUTC + (size_t)2 * 1024 * 1024 * 2;
constexpr size_t WS_WDN = WS_WGU + (size_t)128 * 2048 * 1024 * 2;
constexpr size_t WS_X = WS_WDN + (size_t)128 * 1024 * 1024 * 2;
constexpr size_t WS_H = WS_X + (size_t)T * D * 4;
constexpr size_t WS_QA = WS_H + (size_t)T * D * 2;
constexpr size_t WS_KA = WS_QA + (size_t)T * 512 * 2;
constexpr size_t WS_VA = WS_KA + (size_t)T * 128 * 2;
constexpr size_t WS_Z = WS_VA + (size_t)T * 128 * 2;
constexpr size_t WS_P = WS_Z + (size_t)T * 512 * 2;
constexpr int PP = 1056;
constexpr size_t WS_RS = WS_P + (size_t)T * PP * 2;
constexpr size_t WS_QC = WS_RS + (size_t)T * 2 * 4;
constexpr size_t WS_KC = WS_QC + (size_t)T * 1536 * 2;
constexpr size_t WS_VC = WS_KC + (size_t)T * 1536 * 2;
constexpr size_t WS_MIX = WS_VC + (size_t)T * 1024 * 2;
constexpr size_t WS_F = WS_MIX + (size_t)T * 1024 * 2;
constexpr size_t WS_GATE = WS_F + (size_t)T * 1024 * 2;
constexpr size_t WS_LIST = WS_GATE + (size_t)T * 4 * 4;
constexpr int ACT_ROWS = 304 * 256;
constexpr size_t WS_ACT = WS_LIST + (size_t)32 * T * 4;
constexpr size_t WS_YB = WS_ACT + (size_t)ACT_ROWS * 1024 * 2;
constexpr size_t WS_SSX = WS_YB + (size_t)T * 4 * 1024 * 2;
constexpr size_t WS_SSP = WS_SSX + (size_t)T * 16 * 4;
constexpr size_t WS_END = WS_SSP + (size_t)T * 16 * 4;

constexpr int STAGE_BYTES = 131072;
constexpr int LDS_IDX = 131072;
constexpr int MAXU = 12;
constexpr int LDS_TAB = LDS_IDX + MAXU * 1024;
constexpr int LDS_MISC = LDS_TAB + 1024;
constexpr int LDS_BYTES = LDS_MISC + 256;
constexpr int CV_HDR = 56320, CV_BUF = 57344;

__device__ __forceinline__ unsigned pk2(float lo, float hi) {
    typedef __bf16 bf2 __attribute__((ext_vector_type(2)));
    return __builtin_bit_cast(unsigned, __builtin_convertvector((f32x2){lo, hi}, bf2));
}
__device__ __forceinline__ float bflo(unsigned u) { return __uint_as_float(u << 16); }
__device__ __forceinline__ float bfhi(unsigned u) { return __uint_as_float(u & 0xffff0000u); }
__device__ __forceinline__ float bf1(bf16 u) { return __uint_as_float(((unsigned)u) << 16); }
__device__ __forceinline__ float fsigm(float v) { return __builtin_amdgcn_rcpf(1.f + __builtin_amdgcn_exp2f(-1.4426950408889634f * v)); }
__device__ __forceinline__ float fsilu(float v) { return v * fsigm(v); }
__device__ __forceinline__ int modrow(int row) { return row < NL ? (row >> 12) : 4; }
#define WS_DPP(v, ctrl) ((v) + __int_as_float(__builtin_amdgcn_update_dpp(0, __float_as_int(v), (ctrl), 0xF, 0xF, false)))
__device__ __forceinline__ float wave_sum(float v) {
    v = WS_DPP(v, 0xB1); v = WS_DPP(v, 0x4E); v = WS_DPP(v, 0x141); v = WS_DPP(v, 0x140);
    v += __shfl_xor(v, 16); v += __shfl_xor(v, 32);
    return v;
}
__device__ __forceinline__ int otid() { int t = threadIdx.x; asm volatile("" : "+v"(t)); return t; }
#define LDS_WAIT() asm volatile("s_waitcnt lgkmcnt(0)" ::: "memory")
#define VM_WAIT() asm volatile("s_waitcnt vmcnt(0)" ::: "memory")

#define XB_TMO      128
#define XB_XCNT(j)  (256  + 64 * (j))
#define XB_XSUB(j)  (1280 + 64 * (j))
#define XB_XGEN(j)  (2304 + 64 * (j))
#define XB_TOP      3328
#define XB_TOPGEN   3392
#define XCD_BAR_WORDS 3456
#define XB_SPIN_CAP (1u << 18)
__device__ __forceinline__ unsigned xb_ld(unsigned* p)              { return __hip_atomic_load(p, __ATOMIC_RELAXED, __HIP_MEMORY_SCOPE_AGENT); }
__device__ __forceinline__ unsigned xb_add(unsigned* p, unsigned v) { return __hip_atomic_fetch_add(p, v, __ATOMIC_RELAXED, __HIP_MEMORY_SCOPE_AGENT); }
__device__ __forceinline__ unsigned xb_xcc_id() { return (unsigned)__builtin_amdgcn_s_getreg((3 << 11) | 20) & 0xFu; }
#define XB_SPIN(cond, bar) do { unsigned _sp = 0; while (cond) { __builtin_amdgcn_s_sleep(1); \
    if ((++_sp & 255u) == 0u) { if (xb_ld(&(bar)[XB_TMO])) break; if (_sp > XB_SPIN_CAP) { atomicAdd(&(bar)[XB_TMO], 1u); break; } } } } while (0)
struct XcdBarrier { unsigned* bar; unsigned x; volatile LAS unsigned* st; };
__device__ __forceinline__ XcdBarrier xcd_barrier_post(unsigned* bar, volatile LAS unsigned* st) {
    XcdBarrier b; b.bar = bar; b.x = xb_xcc_id(); b.st = st;
    if (threadIdx.x == 0) (void)xb_add(&bar[XB_XCNT(b.x)], 1u);
    return b;
}
__device__ __forceinline__ void xcd_barrier_complete(unsigned* bar, unsigned x, unsigned& nloc, unsigned& nx) {
    const unsigned G = gridDim.x * gridDim.y * gridDim.z;
    unsigned sum, cnt, mine, sp = 0u;
    for (;;) {
        sum = 0u; cnt = 0u; mine = 0u;
#pragma unroll
        for (unsigned j = 0; j < 16; ++j) { const unsigned c = xb_ld(&bar[XB_XCNT(j)]); sum += c; cnt += (c > 0u) ? 1u : 0u; mine = (j == x) ? c : mine; }
        if (sum == G) break;
        __builtin_amdgcn_s_sleep(1);
        if ((++sp & 255u) == 0u) { if (xb_ld(&bar[XB_TMO])) break; if (sp > XB_SPIN_CAP) { atomicAdd(&bar[XB_TMO], 1u); break; } }
    }
    nloc = mine > 0u ? mine : 1u; nx = cnt > 0u ? cnt : 1u;
}
__device__ __forceinline__ void xcd_barrier(const XcdBarrier& b) {
    asm volatile("s_waitcnt vmcnt(0)" ::: "memory");
    __syncthreads();
    if (otid() == 0) {
        unsigned* bar = b.bar;
        __builtin_amdgcn_s_waitcnt(0);
        unsigned nloc = b.st[0], nx = b.st[1];
        if (nloc == 0u) { xcd_barrier_complete(bar, b.x, nloc, nx); b.st[0] = nloc; b.st[1] = nx; }
        const unsigned old = xb_add(&bar[XB_XSUB(b.x)], 1u);
        const unsigned gen = old / nloc;
        if (old + 1u == (gen + 1u) * nloc) {
            __builtin_amdgcn_fence(__ATOMIC_RELEASE, "agent");
            asm volatile("s_waitcnt vmcnt(0)" ::: "memory");
            const unsigned og = xb_add(&bar[XB_TOP], 1u);
            const unsigned tg = og / nx;
            if (og + 1u == (tg + 1u) * nx) xb_add(&bar[XB_TOPGEN], 1u);
            else XB_SPIN(xb_ld(&bar[XB_TOPGEN]) == tg, bar);
            __builtin_amdgcn_fence(__ATOMIC_ACQUIRE, "agent");
            xb_add(&bar[XB_XGEN(b.x)], 1u);
            asm volatile("s_waitcnt vmcnt(0)" ::: "memory");
        } else {
            XB_SPIN(xb_ld(&bar[XB_XGEN(b.x)]) == gen, bar);
            __builtin_amdgcn_fence(__ATOMIC_ACQUIRE, "agent");
            asm volatile("s_waitcnt vmcnt(0)" ::: "memory");
        }
    }
    __syncthreads();
}

namespace g8 {
constexpr int BM = 256, BK = 64, HALF = 128, HTB = HALF * BK * 2, NXCD = 8, WGM = 8;
__host__ __device__ __forceinline__ int lds_byte(int r, int c) { const int st = (r >> 4) * 2 + (c >> 5), rr = r & 15, cc = c & 31, ob = rr * 64 + cc * 2; return st * 1024 + (ob ^ (((ob >> 9) & 1) << 5)); }
__host__ __device__ __forceinline__ void stage_rc(int b, int& R, int& C) { const int st = b / 1024, sb = b % 1024, swz = sb ^ (((sb >> 9) & 1) << 5); R = (st >> 1) * 16 + swz / 64; C = (st & 1) * 32 + (swz % 64) / 2; }

struct Unit { int pm, pn, e, nt, gm, slot; };
struct GemmP { const bf16* A; int lda; const bf16* Bt; int K; };

struct StaticOrder {
    static constexpr bool GATHER = false;
    int nM, nN, nwg, G, c;
    __device__ void init(int nM_, int nN_, int G_, int c_) { nM = nM_; nN = nN_; nwg = nM * nN; G = G_; c = c_; }
    __device__ __forceinline__ bool next(int i, Unit& u) const {
        const long L = (long)i * G + c; if (L >= nwg) return false;
        int wgid = (int)L; { const int q = nwg / NXCD, r = nwg % NXCD, xcd = wgid % NXCD, off = wgid / NXCD; wgid = (xcd < r ? xcd * (q + 1) : r * (q + 1) + (xcd - r) * q) + off; }
        const int nig = WGM * nN, gid = wgid / nig, fm = gid * WGM, gsz = (nM - fm) < WGM ? (nM - fm) : WGM;
        u.pm = fm + ((wgid % nig) % gsz); u.pn = (wgid % nig) / gsz; u.e = 0; u.nt = u.pn; u.gm = u.pm; u.slot = 0; return true;
    }
    __device__ __forceinline__ int arow(const Unit& u, int r) const { return u.pm * BM + r; }
};
template <bool GATHER_> struct MoeOrder {
    static constexpr bool GATHER = GATHER_;
    const LAS int* tab; const LAS int* idx;
    __device__ __forceinline__ bool next(int i, Unit& u) const {
        if (i >= tab[127]) return false;
        u.gm = tab[128 + 4 * i]; u.pn = tab[129 + 4 * i]; u.e = tab[130 + 4 * i]; u.nt = tab[131 + 4 * i]; u.slot = i; u.pm = u.gm; return true;
    }
    __device__ __forceinline__ int arow(const Unit& u, int r) const {
        if (GATHER_) { const int s = idx[u.slot * 256 + r]; return s < 0 ? 0 : (s >> 2); }
        return u.gm * BM + r;
    }
};

template <class Epi, class Sched>
__device__ __forceinline__ void gemm_phase(LAS unsigned char* lds, const GemmP g, const Sched& S, const Epi& E) {
    const int tid = otid(), wid = __builtin_amdgcn_readfirstlane(tid >> 6), lane = tid & 63, wr = wid >> 2, wc = wid & 3, fr = lane & 15, fq = lane >> 4;
    const int K = g.K, nt = K / BK;
    int RR[2], CC[2]; unsigned voffB[2], voffA[2];
    const unsigned lda2 = (unsigned)g.lda * 2u;
#pragma unroll
    for (int i = 0; i < 2; ++i) { stage_rc(tid * 16 + i * 8192, RR[i], CC[i]); voffB[i] = (unsigned)(RR[i] * K + CC[i]) * 2u; voffA[i] = (unsigned)RR[i] * lda2 + (unsigned)CC[i] * 2u; }
    const size_t hstepA = (size_t)HALF * lda2, tstepA = 2 * hstepA;
    const size_t kstep = (size_t)(BK * 2);
    const size_t hstepB = (size_t)HALF * K * 2;
    const size_t tstepB = 2 * hstepB;
    const unsigned ldsw = (unsigned)wid * 1024u;
    const int aoff = lds_byte(wr * 64 + fr, fq * 8), boff = lds_byte(wc * 32 + fr, fq * 8);
#define G8_SA(b, h) (((b) * 2 + (h)) * HTB)
#define G8_SB(b, h) ((4 + (b) * 2 + (h)) * HTB)
#define G8_STAGE(bufoff, gbase, voff) do { _Pragma("unroll") for (int _i = 0; _i < 2; ++_i) \
        __builtin_amdgcn_global_load_lds((const unsigned*)((const char*)(gbase) + (voff)[_i]), (LAS unsigned*)(lds + (bufoff) + ldsw + _i * 8192), 16, 0, 0); } while (0)
#define G8_LDA(dst, b, h) do { _Pragma("unroll") for (int m = 0; m < 4; ++m) _Pragma("unroll") for (int k = 0; k < 2; ++k) dst[m][k] = *(const LAS bf16x8*)(lds + G8_SA(b, h) + aoff + m * 2048 + k * 1024); } while (0)
#define G8_LDB(dst, b, h) do { _Pragma("unroll") for (int n = 0; n < 2; ++n) _Pragma("unroll") for (int k = 0; k < 2; ++k) dst[n][k] = *(const LAS bf16x8*)(lds + G8_SB(b, h) + boff + n * 2048 + k * 1024); } while (0)
#define G8_MMA(ai, bj, At, Bt) do { __builtin_amdgcn_s_setprio(1); _Pragma("unroll") for (int m = 0; m < 4; ++m) _Pragma("unroll") for (int n = 0; n < 2; ++n) _Pragma("unroll") for (int k = 0; k < 2; ++k) \
        acc[ai][bj][m][n] = __builtin_amdgcn_mfma_f32_16x16x32_bf16(Bt[n][k], At[m][k], acc[ai][bj][m][n], 0, 0, 0); __builtin_amdgcn_s_setprio(0); } while (0)
#define G8_WAIT_V(n) asm volatile("s_waitcnt vmcnt(" #n ")" ::: "memory")
#define G8_WAIT_L(n) asm volatile("s_waitcnt lgkmcnt(" #n ")" ::: "memory")
#define G8_BAR __builtin_amdgcn_s_barrier()
#define G8_SCHED __builtin_amdgcn_sched_barrier(0)
#define G8_MKOFF(u, o) do { if constexpr (Sched::GATHER) { _Pragma("unroll") for (int _i = 0; _i < 2; ++_i) { int _R, _C; stage_rc(tid * 16 + _i * 8192, _R, _C); \
        _Pragma("unroll") for (int _h = 0; _h < 2; ++_h) o[_h][_i] = (unsigned)S.arow(u, _h * HALF + _R) * lda2 + (unsigned)_C * 2u; } } } while (0)
#define G8_STAGE_A(bufoff, kofs, h, usenext) do { if constexpr (Sched::GATHER) { unsigned _o[2]; _o[0] = (usenext) ? no[h][0] : co[h][0]; _o[1] = (usenext) ? no[h][1] : co[h][1]; G8_STAGE(bufoff, Ab + (kofs), _o); } \
        else { const char* _p = ((usenext) ? nAp : cAp) + (size_t)(h) * hstepA + (kofs); G8_STAGE(bufoff, _p, voffA); } } while (0)
    Unit cur, nxt; int ui = 0;
    if (!S.next(0, cur)) return;
    f32x4 acc[2][2][4][2];
#pragma unroll
    for (int a = 0; a < 2; ++a)
#pragma unroll
        for (int b = 0; b < 2; ++b)
#pragma unroll
            for (int m = 0; m < 4; ++m)
#pragma unroll
                for (int n = 0; n < 2; ++n) acc[a][b][m][n] = (f32x4){0.f, 0.f, 0.f, 0.f};
    bf16x8 At[4][2], B0[2][2], B1[2][2];
    unsigned co[2][2], no[2][2];
    G8_MKOFF(cur, co);
    if (Sched::GATHER) { G8_WAIT_L(0); }
    const char* Ab = (const char*)g.A;
    const char* cAp = Ab + (size_t)cur.pm * tstepA; const char* nAp = cAp;
    const char* cB = (const char*)g.Bt + (size_t)cur.pn * tstepB;
    G8_STAGE(G8_SB(0, 0), cB, voffB); G8_STAGE(G8_SB(0, 1), cB + hstepB, voffB); G8_STAGE_A(G8_SA(0, 0), 0, 0, false); G8_STAGE_A(G8_SA(0, 1), 0, 1, false);
    if (wr == 1) G8_BAR;
    G8_WAIT_V(2); G8_BAR;
    G8_STAGE(G8_SB(1, 0), cB + kstep, voffB); G8_STAGE_A(G8_SA(1, 0), kstep, 0, false); G8_STAGE(G8_SB(1, 1), cB + hstepB + kstep, voffB);
    G8_WAIT_V(6); G8_BAR;
    for (;;) {
        const bool has_next = S.next(ui + 1, nxt);
        if (has_next) { G8_MKOFF(nxt, no); if (Sched::GATHER) { G8_WAIT_L(0); } nAp = Ab + (size_t)nxt.pm * tstepA; }
        else {
            nAp = cAp;
            if constexpr (Sched::GATHER) {
#pragma unroll
                for (int h = 0; h < 2; ++h)
#pragma unroll
                    for (int i = 0; i < 2; ++i) no[h][i] = co[h][i];
            }
        }
        G8_SCHED;
        const char* nB = has_next ? (const char*)g.Bt + (size_t)nxt.pn * tstepB : cB;
#pragma unroll 1
        for (int t = 0; t < nt; t += 2) {
            const bool last = (t == nt - 2);
            const size_t k1 = (size_t)(t + 1) * kstep, k2 = last ? 0 : (size_t)(t + 2) * kstep, k3 = k2 + kstep;
            const char* b2 = last ? nB : cB + (size_t)(t + 2) * kstep; const char* b3 = b2 + kstep;
            G8_LDB(B0, 0, 0); G8_LDB(B1, 0, 1); G8_SCHED; G8_LDA(At, 0, 0); G8_STAGE_A(G8_SA(1, 1), k1, 1, false);
            G8_WAIT_V(8); G8_WAIT_L(0); G8_BAR; G8_MMA(0, 0, At, B0); G8_MMA(0, 1, At, B1); G8_BAR; G8_SCHED;
            G8_LDA(At, 0, 1); G8_STAGE(G8_SB(0, 0), b2, voffB); G8_STAGE(G8_SB(0, 1), b2 + hstepB, voffB); G8_STAGE_A(G8_SA(0, 0), k2, 0, last);
            G8_WAIT_V(8); G8_WAIT_L(0); G8_BAR; G8_MMA(1, 0, At, B0); G8_MMA(1, 1, At, B1); G8_BAR; G8_SCHED;
            G8_LDB(B0, 1, 0); G8_LDB(B1, 1, 1); G8_SCHED; G8_LDA(At, 1, 0); G8_STAGE_A(G8_SA(0, 1), k2, 1, last);
            G8_WAIT_V(8); G8_WAIT_L(0); G8_BAR; G8_MMA(0, 0, At, B0); G8_MMA(0, 1, At, B1); G8_BAR; G8_SCHED;
            G8_LDA(At, 1, 1); G8_STAGE(G8_SB(1, 0), b3, voffB); G8_STAGE(G8_SB(1, 1), b3 + hstepB, voffB); G8_STAGE_A(G8_SA(1, 0), k3, 0, last);
            G8_WAIT_V(8); G8_WAIT_L(0); G8_BAR; G8_MMA(1, 0, At, B0); G8_MMA(1, 1, At, B1); G8_BAR; G8_SCHED;
        }
        if (wr == 0) G8_BAR;
        E(acc, cur, wr, wc, fr, fq, lds);
        if (!has_next) break;
#pragma unroll
        for (int a = 0; a < 2; ++a)
#pragma unroll
            for (int b = 0; b < 2; ++b)
#pragma unroll
                for (int m = 0; m < 4; ++m)
#pragma unroll
                    for (int n = 0; n < 2; ++n) acc[a][b][m][n] = (f32x4){0.f, 0.f, 0.f, 0.f};
        cur = nxt; cB = nB; cAp = nAp; ++ui;
        if constexpr (Sched::GATHER) {
#pragma unroll
            for (int h = 0; h < 2; ++h)
#pragma unroll
                for (int i = 0; i < 2; ++i) co[h][i] = no[h][i];
        }
        if (wr == 1) G8_BAR;
    }
    G8_WAIT_V(0);
    G8_BAR;
#undef G8_SA
#undef G8_SB
#undef G8_STAGE
#undef G8_LDA
#undef G8_LDB
#undef G8_MMA
#undef G8_WAIT_V
#undef G8_WAIT_L
#undef G8_BAR
#undef G8_SCHED
#undef G8_MKOFF
#undef G8_STAGE_A
}
}

using g8::Unit;
typedef f32x4 Acc[2][2][4][2];
__device__ __forceinline__ u32x4 pack8(const f32x4 a, const f32x4 b) { u32x4 w; w.x = pk2(a[0], a[1]); w.y = pk2(a[2], a[3]); w.z = pk2(b[0], b[1]); w.w = pk2(b[2], b[3]); return w; }

struct EpiInA {
    bf16 *Qa, *Ka, *Va, *Z; const float *qg, *kg, *cosA, *sinA;
    __device__ __forceinline__ void operator()(const Acc& acc, const Unit& u, int wr, int wc, int fr, int fq, LAS unsigned char*) const {
        const int row0 = u.pm * 256 + wr * 64 + fr, pn = u.pn, a = fq >> 1, b = fq & 1;
        if (pn < 3) {
            const bool isv = (pn == 2 && wc >= 2), isq = pn < 2;
            const int dbase = 32 * a + 8 * b;
            if (isv) {
#pragma unroll
                for (int ai = 0; ai < 2; ++ai)
#pragma unroll
                    for (int m = 0; m < 4; ++m) { const int row = row0 + ai * 128 + m * 16; bf16* o = Va + (size_t)row * 128 + (wc - 2) * 64 + dbase;
#pragma unroll
                        for (int bj = 0; bj < 2; ++bj) *(u32x4*)(o + 16 * bj) = pack8(acc[ai][bj][m][0], acc[ai][bj][m][1]); }
                return;
            }
            const float* g = isq ? qg : kg;
            f32x4 gv[2][2];
#pragma unroll
            for (int bj = 0; bj < 2; ++bj)
#pragma unroll
                for (int n = 0; n < 2; ++n) gv[bj][n] = *(const f32x4*)(g + dbase + 16 * bj + 4 * n);
            const float sc = isq ? QSCALE_A : 1.f;
            bf16* obase = isq ? (Qa + (pn * 4 + wc) * 64 + dbase) : (Ka + wc * 64 + dbase);
            const int opitch = isq ? 512 : 128;
            f32x4 cc[2], sn[2], cn[2], snn[2];
            { const int t = row0 & 4095;
#pragma unroll
              for (int n = 0; n < 2; ++n) { cc[n] = *(const f32x4*)(cosA + t * 32 + 16 * a + 8 * b + 4 * n); sn[n] = *(const f32x4*)(sinA + t * 32 + 16 * a + 8 * b + 4 * n); } }
#pragma unroll
            for (int gidx = 0; gidx < 8; ++gidx) {
                    const int ai = gidx >> 2, m = gidx & 3;
                    const int row = row0 + ai * 128 + m * 16;
                    if (gidx < 7) { const int tn = (row0 + ((gidx + 1) >> 2) * 128 + ((gidx + 1) & 3) * 16) & 4095;
#pragma unroll
                        for (int n = 0; n < 2; ++n) { cn[n] = *(const f32x4*)(cosA + tn * 32 + 16 * a + 8 * b + 4 * n); snn[n] = *(const f32x4*)(sinA + tn * 32 + 16 * a + 8 * b + 4 * n); } }
                    float ss = 0.f;
#pragma unroll
                    for (int bj = 0; bj < 2; ++bj)
#pragma unroll
                        for (int n = 0; n < 2; ++n) { const f32x4 v = acc[ai][bj][m][n]; ss += (v[0] * v[0] + v[1] * v[1]) + (v[2] * v[2] + v[3] * v[3]); }
                    ss += __shfl_xor(ss, 16); ss += __shfl_xor(ss, 32);
                    const float rs = rsqrtf(ss * (1.f / 64.f) + EPS);
                    f32x4 y[2][2];
#pragma unroll
                    for (int bj = 0; bj < 2; ++bj)
#pragma unroll
                        for (int n = 0; n < 2; ++n) y[bj][n] = acc[ai][bj][m][n] * rs * gv[bj][n];
                    if (row < NL) {
#pragma unroll
                        for (int n = 0; n < 2; ++n) { const f32x4 y0 = y[0][n], y1 = y[1][n]; y[0][n] = y0 * cc[n] - y1 * sn[n]; y[1][n] = y1 * cc[n] + y0 * sn[n]; }
                    }
                    bf16* o = obase + (size_t)row * opitch;
#pragma unroll
                    for (int bj = 0; bj < 2; ++bj) *(u32x4*)(o + 16 * bj) = pack8(y[bj][0] * sc, y[bj][1] * sc);
                    asm volatile("" ::: "memory");
#pragma unroll
                    for (int n = 0; n < 2; ++n) { cc[n] = cn[n]; sn[n] = snn[n]; }
            }
        } else {
            const int j0 = 128 * (pn - 3) + 32 * wc + 8 * fq;
#pragma unroll
            for (int ai = 0; ai < 2; ++ai)
#pragma unroll
                for (int m = 0; m < 4; ++m) {
                    const int row = row0 + ai * 128 + m * 16; f32x4 z[2];
#pragma unroll
                    for (int n = 0; n < 2; ++n) { const f32x4 av = acc[ai][0][m][n], gt = acc[ai][1][m][n];
#pragma unroll
                        for (int r = 0; r < 4; ++r) z[n][r] = av[r] * fsigm(gt[r]); }
                    *(u32x4*)(Z + (size_t)row * 512 + j0) = pack8(z[0], z[1]);
                }
        }
    }
};
struct EpiResid {
    float* X; const float* Xlat; const float* Xctx; const float* gmod; float* SSX;
    __device__ __forceinline__ void operator()(const Acc& acc, const Unit& u, int wr, int wc, int fr, int fq, LAS unsigned char*) const {
        const int row0 = u.pm * 256 + wr * 64 + fr; const int mr = u.pm < 64 ? (u.pm >> 4) : 4;
        const float* gp = gmod + (size_t)mr * 6144; const float* src = u.pm < 64 ? Xlat : Xctx - (size_t)NL * D;
        float ssr[2][4];
#pragma unroll
        for (int ai = 0; ai < 2; ++ai)
#pragma unroll
            for (int m = 0; m < 4; ++m) ssr[ai][m] = 0.f;
#pragma unroll
        for (int bj = 0; bj < 2; ++bj) {
            const int c0 = 256 * u.pn + 128 * bj + 32 * wc + 4 * fq;
            const f32x4 g0 = *(const f32x4*)(gp + c0), g1 = *(const f32x4*)(gp + c0 + 16);
#pragma unroll
            for (int ai = 0; ai < 2; ++ai) {
                f32x4 xo[4][2];
#pragma unroll
                for (int m = 0; m < 4; ++m) { const float* xp = src + (size_t)(row0 + ai * 128 + m * 16) * D + c0; xo[m][0] = *(const f32x4*)xp; xo[m][1] = *(const f32x4*)(xp + 16); }
#pragma unroll
                for (int m = 0; m < 4; ++m) { float* op = X + (size_t)(row0 + ai * 128 + m * 16) * D + c0;
                    const f32x4 y0 = xo[m][0] + g0 * acc[ai][bj][m][0], y1 = xo[m][1] + g1 * acc[ai][bj][m][1];
                    *(f32x4*)op = y0; *(f32x4*)(op + 16) = y1;
                    ssr[ai][m] += (y0[0] * y0[0] + y0[1] * y0[1]) + (y0[2] * y0[2] + y0[3] * y0[3]) + (y1[0] * y1[0] + y1[1] * y1[1]) + (y1[2] * y1[2] + y1[3] * y1[3]); }
                asm volatile("" ::: "memory");
            }
        }
#pragma unroll
        for (int ai = 0; ai < 2; ++ai)
#pragma unroll
            for (int m = 0; m < 4; ++m) { float ss = ssr[ai][m]; ss += __shfl_xor(ss, 16); ss += __shfl_xor(ss, 32);
                if (fq == 0) SSX[(size_t)(row0 + ai * 128 + m * 16) * 16 + 4 * u.pn + wc] = ss; }
    }
};
struct EpiBf16 {
    bf16* O; int ldo, ncols;
    __device__ __forceinline__ void operator()(const Acc& acc, const Unit& u, int wr, int wc, int fr, int fq, LAS unsigned char*) const {
        const int row0 = u.pm * 256 + wr * 64 + fr;
#pragma unroll
        for (int bj = 0; bj < 2; ++bj) {
            const int c0 = 256 * u.pn + 128 * bj + 32 * wc + 8 * fq;
            if (c0 < ncols) {
#pragma unroll
                for (int ai = 0; ai < 2; ++ai)
#pragma unroll
                    for (int m = 0; m < 4; ++m) *(u32x4*)(O + (size_t)(row0 + ai * 128 + m * 16) * ldo + c0) = pack8(acc[ai][bj][m][0], acc[ai][bj][m][1]);
            }
        }
    }
};
struct EpiP {
    bf16* P; float* SSP; bf16* Kc; const float* krg; const float* cosC; const float* sinC;
    __device__ __forceinline__ void operator()(const Acc& acc, const Unit& u, int wr, int wc, int fr, int fq, LAS unsigned char*) const {
        const int row0 = u.pm * 256 + wr * 64 + fr;
        if (u.pn < 4) {
#pragma unroll
            for (int ai = 0; ai < 2; ++ai)
#pragma unroll
                for (int m = 0; m < 4; ++m) { const int row = row0 + ai * 128 + m * 16; float ss = 0.f;
#pragma unroll
                    for (int bj = 0; bj < 2; ++bj) { const f32x4 y0 = acc[ai][bj][m][0], y1 = acc[ai][bj][m][1];
                        *(u32x4*)(P + (size_t)row * PP + 256 * u.pn + 128 * bj + 32 * wc + 8 * fq) = pack8(y0, y1);
                        ss += (y0[0] * y0[0] + y0[1] * y0[1]) + (y0[2] * y0[2] + y0[3] * y0[3]) + (y1[0] * y1[0] + y1[1] * y1[1]) + (y1[2] * y1[2] + y1[3] * y1[3]); }
                    ss += __shfl_xor(ss, 16); ss += __shfl_xor(ss, 32);
                    if (fq == 0) SSP[(size_t)row * 16 + 4 * u.pn + wc] = ss; }
        } else if (wc == 0) {
            const f32x4 g0 = *(const f32x4*)(krg + 8 * fq), g1 = *(const f32x4*)(krg + 8 * fq + 4);
#pragma unroll
            for (int ai = 0; ai < 2; ++ai)
#pragma unroll
                for (int m = 0; m < 4; ++m) { const int row = row0 + ai * 128 + m * 16; const f32x4 v0 = acc[ai][0][m][0], v1 = acc[ai][0][m][1];
                    *(u32x4*)(P + (size_t)row * PP + 1024 + 8 * fq) = pack8(v0, v1);
                    float ss = (v0[0] * v0[0] + v0[1] * v0[1]) + (v0[2] * v0[2] + v0[3] * v0[3]) + (v1[0] * v1[0] + v1[1] * v1[1]) + (v1[2] * v1[2] + v1[3] * v1[3]);
                    ss += __shfl_xor(ss, 16); ss += __shfl_xor(ss, 32);
                    const float rk = rsqrtf(ss * (1.f / 32.f) + EPS);
                    f32x4 y0 = v0 * rk * g0, y1 = v1 * rk * g1;
                    const int t = row & 4095, ax = fq >> 1;
                    const f32x4 c0 = *(const f32x4*)(cosC + t * 16 + 8 * ax), c1 = *(const f32x4*)(cosC + t * 16 + 8 * ax + 4), s0 = *(const f32x4*)(sinC + t * 16 + 8 * ax), s1 = *(const f32x4*)(sinC + t * 16 + 8 * ax + 4);
                    f32x4 p0, p1;
#pragma unroll
                    for (int j = 0; j < 4; ++j) { p0[j] = __shfl_xor(y0[j], 16); p1[j] = __shfl_xor(y1[j], 16); }
                    if (row < NL) { if ((fq & 1) == 0) { y0 = y0 * c0 - p0 * s0; y1 = y1 * c1 - p1 * s1; } else { y0 = y0 * c0 + p0 * s0; y1 = y1 * c1 + p1 * s1; } }
                    const u32x4 wv = pack8(y0, y1);
#pragma unroll
                    for (int hd = 0; hd < 16; ++hd) *(u32x4*)(Kc + (size_t)row * 1536 + hd * 96 + 64 + 8 * fq) = wv;
                    asm volatile("" ::: "memory"); }
        }
    }
};
struct EpiKV {
    bf16 *Kc, *Vc; const float* SSP; const float* kg;
    __device__ __forceinline__ void operator()(const Acc& acc, const Unit& u, int wr, int wc, int fr, int fq, LAS unsigned char*) const {
        const int row0 = u.pm * 256 + wr * 64 + fr, head = 2 * u.pn + (wc >> 1), dbase = 8 * fq;
        const bool isk = (wc & 1) == 0;
        float rr[2][4];
#pragma unroll
        for (int ai = 0; ai < 2; ++ai)
#pragma unroll
            for (int m = 0; m < 4; ++m) { const f32x4 pq = *(const f32x4*)(SSP + (size_t)(row0 + ai * 128 + m * 16) * 16 + 12); rr[ai][m] = (pq[0] + pq[1]) + (pq[2] + pq[3]); }
        f32x4 gv[2][2];
#pragma unroll
        for (int bj = 0; bj < 2; ++bj)
#pragma unroll
            for (int n = 0; n < 2; ++n) gv[bj][n] = isk ? *(const f32x4*)(kg + dbase + 32 * bj + 4 * n) : (f32x4){1.f, 1.f, 1.f, 1.f};
#pragma unroll
        for (int ai = 0; ai < 2; ++ai)
#pragma unroll
            for (int m = 0; m < 4; ++m) {
                const int row = row0 + ai * 128 + m * 16; const float r = rsqrtf(rr[ai][m] * (1.f / 256.f) + EPS);
                float f = r;
                if (isk) {
                    float ss = 0.f;
#pragma unroll
                    for (int bj = 0; bj < 2; ++bj)
#pragma unroll
                        for (int n = 0; n < 2; ++n) { const f32x4 v = acc[ai][bj][m][n]; ss += (v[0] * v[0] + v[1] * v[1]) + (v[2] * v[2] + v[3] * v[3]); }
                    ss += __shfl_xor(ss, 16); ss += __shfl_xor(ss, 32);
                    f = r * rsqrtf(r * r * ss * (1.f / 64.f) + EPS);
                }
                bf16* o = isk ? (Kc + (size_t)row * 1536 + head * 96 + dbase) : (Vc + (size_t)row * 1024 + head * 64 + dbase);
#pragma unroll
                for (int bj = 0; bj < 2; ++bj) *(u32x4*)(o + 32 * bj) = pack8(acc[ai][bj][m][0] * f * gv[bj][0], acc[ai][bj][m][1] * f * gv[bj][1]);
            }
    }
};
struct EpiGU {
    bf16* ACT; const float* bgu;
    __device__ __forceinline__ void operator()(const Acc& acc, const Unit& u, int wr, int wc, int fr, int fq, LAS unsigned char*) const {
        const int row0 = u.gm * 256 + wr * 64 + fr, j0 = 128 * u.nt + 32 * wc + 8 * fq;
        const float* bp = bgu + (size_t)u.e * 2048;
        f32x4 bg[2], bu[2];
#pragma unroll
        for (int n = 0; n < 2; ++n) { bg[n] = *(const f32x4*)(bp + j0 + 4 * n); bu[n] = *(const f32x4*)(bp + 1024 + j0 + 4 * n); }
#pragma unroll
        for (int ai = 0; ai < 2; ++ai)
#pragma unroll
            for (int m = 0; m < 4; ++m) {
                f32x4 z[2];
#pragma unroll
                for (int n = 0; n < 2; ++n) { const f32x4 gt = acc[ai][0][m][n] + bg[n], up = acc[ai][1][m][n] + bu[n];
#pragma unroll
                    for (int r = 0; r < 4; ++r) { const float gg = fminf(gt[r], 7.f), uu = fminf(fmaxf(up[r], -7.f), 7.f); z[n][r] = (uu + 1.f) * (gg * fsigm(1.702f * gg)); } }
                *(u32x4*)(ACT + (size_t)(row0 + ai * 128 + m * 16) * 1024 + j0) = pack8(z[0], z[1]);
            }
    }
};
struct EpiDown {
    bf16* YB; const float* bdn; const float* gate; const LAS int* idx;
    __device__ __forceinline__ void operator()(const Acc& acc, const Unit& u, int wr, int wc, int fr, int fq, LAS unsigned char*) const {
        const int r0 = wr * 64 + fr; const float* bp = bdn + (size_t)u.e * 1024;
        f32x4 bv[2][2]; int c0[2];
#pragma unroll
        for (int bj = 0; bj < 2; ++bj) { c0[bj] = 256 * u.nt + 128 * bj + 32 * wc + 8 * fq; bv[bj][0] = *(const f32x4*)(bp + c0[bj]); bv[bj][1] = *(const f32x4*)(bp + c0[bj] + 4); }
#pragma unroll
        for (int ai = 0; ai < 2; ++ai)
#pragma unroll
            for (int m = 0; m < 4; ++m) {
                const int slot = idx[u.slot * 256 + r0 + ai * 128 + m * 16];
                if (slot >= 0) {
                    const float gw = gate[slot]; bf16* o = YB + (size_t)slot * 1024;
#pragma unroll
                    for (int bj = 0; bj < 2; ++bj) *(u32x4*)(o + c0[bj]) = pack8((acc[ai][bj][m][0] + bv[bj][0]) * gw, (acc[ai][bj][m][1] + bv[bj][1]) * gw);
                }
            }
    }
};

enum { LAY_STD = 0, LAY_HEAD = 1, LAY_INA = 2, LAY_GU = 3, LAY_F32 = 4, LAY_HEAD2 = 5 };
template <int LAY> __device__ __forceinline__ int colmap(int pn, int rho) {
    const int bj = rho >> 7, wc = (rho >> 5) & 3, n = (rho >> 4) & 1, fq = (rho >> 2) & 3, reg = rho & 3;
    const int std_c = 128 * bj + 32 * wc + 8 * fq + 4 * n + reg;
    const int head_c = 64 * wc + 32 * (fq >> 1) + 8 * (fq & 1) + 16 * bj + 4 * n + reg;
    if (LAY == LAY_STD) return 256 * pn + std_c;
    if (LAY == LAY_F32) return 256 * pn + rho;
    if (LAY == LAY_HEAD) return 256 * pn + head_c;
    if (LAY == LAY_HEAD2) return 256 * pn + 64 * wc + 32 * bj + 8 * fq + 4 * n + reg;
    if (LAY == LAY_INA) return pn < 3 ? 256 * pn + head_c : 768 + (bj ? 512 : 0) + 128 * (pn - 3) + 32 * wc + 8 * fq + 4 * n + reg;
    return (bj ? 1024 : 0) + 128 * pn + 32 * wc + 8 * fq + 4 * n + reg;
}
template <int LAY>
__device__ __forceinline__ void cvt_matrix(const float* src, size_t mat_stride, int ld, int nvalid, int K, int tiles_per_mat, int ntiles, bf16* dst, const float* kscale,
                                           LAS float* scr, int it_begin, int it_step, int lane, int it_end = 0x7fffffff) {
    const int kblocks = K / 64; int nitems = ntiles * 8 * kblocks; nitems = nitems < it_end ? nitems : it_end;
    const int gw = it_begin, NGW = it_step;
    const int i = lane & 31, kh = lane >> 5;
    float v[32], vn[32];
#define CVT_LOAD(it_, dstv) do { const int _kb = (it_) % kblocks, _tg = (it_) / kblocks, _grp = _tg & 7, _tile = _tg >> 3; \
        const int _mat = _tile / tiles_per_mat, _pn = _tile - _mat * tiles_per_mat; const int _c = colmap<LAY>(_pn, _grp * 32 + i); const bool _ok = _c < nvalid; \
        const float* _s = src + (size_t)_mat * mat_stride + (size_t)(_kb * 64 + kh) * ld + (_ok ? _c : 0); \
        _Pragma("unroll") for (int ii = 0; ii < 32; ++ii) dstv[ii] = _ok ? _s[(size_t)(2 * ii) * ld] : 0.f; } while (0)
    int it = gw;
    if (it < nitems) CVT_LOAD(it, v);
    for (; it < nitems; it += NGW) {
        const int itn = it + NGW;
        if (itn < nitems) CVT_LOAD(itn, vn);
        const int kb = it % kblocks, tg = it / kblocks, grp = tg & 7, tile = tg >> 3;
        if (kscale) {
#pragma unroll
            for (int ii = 0; ii < 32; ++ii) v[ii] *= kscale[kb * 64 + 2 * ii + kh];
        }
#pragma unroll
        for (int ii = 0; ii < 32; ++ii) scr[(2 * ii + kh) * 33 + i] = v[ii];
        LDS_WAIT(); asm volatile("" ::: "memory");
        const int c8 = lane & 7;
#pragma unroll
        for (int j = 0; j < 4; ++j) { const int n = (lane >> 3) + 8 * j; const LAS float* q = scr + (8 * c8) * 33 + n;
            u32x4 o; o.x = pk2(q[0 * 33], q[1 * 33]); o.y = pk2(q[2 * 33], q[3 * 33]); o.z = pk2(q[4 * 33], q[5 * 33]); o.w = pk2(q[6 * 33], q[7 * 33]);
            *(u32x4*)(dst + ((size_t)tile * 256 + grp * 32 + n) * K + kb * 64 + 8 * c8) = o; }
        LDS_WAIT(); asm volatile("" ::: "memory");
#pragma unroll
        for (int ii = 0; ii < 32; ++ii) v[ii] = vn[ii];
    }
#undef CVT_LOAD
}

struct CvtBg {
    const float* wgu; const float* wdn; bf16* dgu; bf16* ddn; int cl0, vcu, j, jend, step, tick;
    __device__ __forceinline__ void init(const float* wgu_, const float* wdn_, bf16* dgu_, bf16* ddn_, int cl0_, int nlay, int vcu_, int j0, int step_) {
        wgu = wgu_; wdn = wdn_; dgu = dgu_; ddn = ddn_; cl0 = cl0_; vcu = vcu_; j = j0; step = step_; jend = nlay * 192; tick = 0; }
    __device__ __forceinline__ void decode(int jj, bool& isgu, int& cl, int& it) const { cl = cl0 + jj / 192; const int r = jj % 192; isgu = r < 128; it = isgu ? vcu * 128 + r : vcu * 64 + (r - 128); }
    __device__ __forceinline__ int issue_dma(int lane, LAS unsigned char* buf) {
        const int jj = __builtin_amdgcn_readfirstlane(j);
        if (jj >= jend) return -1;
        bool isgu; int cl, it; decode(jj, isgu, cl, it);
        const int kb = it & 15, tg = it >> 4, grp = tg & 7, tile = tg >> 3;
        const int kr = lane >> 3, p = lane & 7;
        const float* s; unsigned ld;
        if (isgu) { const int mat = tile >> 3, pn = tile & 7; s = wgu + ((size_t)(cl * 32 + mat) * 1024 + kb * 64) * 2048 + colmap<LAY_GU>(pn, grp * 32); ld = 2048; }
        else { const int mat = tile >> 2, pn = tile & 3; s = wdn + ((size_t)(cl * 32 + mat) * 1024 + kb * 64) * 1024 + colmap<LAY_STD>(pn, grp * 32); ld = 1024; }
        const unsigned rowoff = (unsigned)kr * ld * 4u;
#pragma unroll
        for (int q = 0; q < 8; ++q) { const int cq = p ^ q; const unsigned coff = (unsigned)(8 * (cq & 3) + 4 * (cq >> 2)) * 4u;
            __builtin_amdgcn_global_load_lds((const unsigned*)((const char*)s + (size_t)(8 * q) * ld * 4 + rowoff + coff), (LAS unsigned*)(buf + q * 1024), 16, 0, 2); }
        j = jj + step; return jj;
    }
    __device__ __forceinline__ bf16* dstptr(int jj, int& kb) const { bool isgu; int cl, it; decode(jj, isgu, cl, it); kb = it & 15; const int tg = it >> 4, grp = tg & 7, tile = tg >> 3;
        return isgu ? dgu + ((size_t)(cl * 256 + tile) * 256 + grp * 32) * 1024 : ddn + ((size_t)(cl * 128 + tile) * 256 + grp * 32) * 1024; }
    __device__ __forceinline__ void out_chunk(const LAS unsigned char* buf, bf16* d, int kb, int n, int o) const {
        const LAS float* b = (const LAS float*)(buf + (8 * o) * 128 + (((n >> 2) ^ o) << 4)) + (n & 3);
        u32x4 w; w.x = pk2(b[0], b[32]); w.y = pk2(b[64], b[96]); w.z = pk2(b[128], b[160]); w.w = pk2(b[192], b[224]);
        *(u32x4*)(d + (size_t)n * 1024 + kb * 64 + 8 * o) = w; }
    __device__ __forceinline__ void process_slot(int tid, const LAS unsigned char* lds, int sl) const {
        const LAS int* hdr = (const LAS int*)(lds + CV_HDR);
#pragma unroll
        for (int hf = 0; hf < 2; ++hf) { const int id = tid + 512 * hf, c = id >> 8, jj = hdr[2 * c + sl];
            if (jj >= 0) { int kb; bf16* d = dstptr(jj, kb); out_chunk(lds + CV_BUF + (2 * c + sl) * 8192, d, kb, (id >> 3) & 31, id & 7); } }
    }
    __device__ __forceinline__ void tail_loop(int lane, LAS unsigned char* buf) {
        int a = issue_dma(lane, buf), sl = 0;
        while (a >= 0) {
            const int b = issue_dma(lane, buf + (sl ^ 1) * 8192);
            if (b >= 0) asm volatile("s_waitcnt vmcnt(8)" ::: "memory"); else asm volatile("s_waitcnt vmcnt(0)" ::: "memory");
            int kb; bf16* d = dstptr(a, kb);
#pragma unroll
            for (int x = 0; x < 4; ++x) { const int id = lane + 64 * x; out_chunk(buf + sl * 8192, d, kb, id >> 3, id & 7); }
            asm volatile("s_waitcnt lgkmcnt(0)" ::: "memory");
            a = b; sl ^= 1;
        }
    }
};
struct NoBg { __device__ __forceinline__ void issue(int) {} __device__ __forceinline__ void finish(int) {} };

__device__ __forceinline__ void normmod_store(const f32x4 (&v)[4], float rstd, const float* g, const float* mvec  , int sh_off, int sc_off, bf16* orow, int lane) {
#pragma unroll
    for (int j = 0; j < 4; ++j) { const int c = 4 * lane + 256 * j;
        const f32x4 gg = *(const f32x4*)(g + c), sc = *(const f32x4*)(mvec + sc_off + c), sh = *(const f32x4*)(mvec + sh_off + c);
        const f32x4 y = v[j] * rstd * gg * (sc + 1.f) + sh;
        u32x2 w; w.x = pk2(y[0], y[1]); w.y = pk2(y[2], y[3]); *(u32x2*)(orow + c) = w; }
}

template <int DQK> struct AT {
    static constexpr int CK = DQK / 8, KT = 64 * DQK * 2, VT = 64 * 128, STG = KT + VT, NKS = DQK / 16, NKI = CK / 4;
};
#define MFMA32(a, b, c) __builtin_amdgcn_mfma_f32_32x32x16_bf16((a), (b), (c), 0, 0, 0)
struct TileList { int nloc, row_loc0, kpos_loc0, row_ctx0, ntiles; };
__device__ __forceinline__ float at_max3(float a, float b, float c) { float r; asm("v_max3_f32 %0, %1, %2, %3" : "=v"(r) : "v"(a), "v"(b), "v"(c)); return r; }
template <int DQK, bool MASK, class Bg, int CAD, int XP = 0>
__device__ __forceinline__ void attn_core(LAS unsigned char* lds, const bf16x8 (&qf)[DQK / 16], const TileList tl, const char* Kg, int kpitchB, const char* Vg, int vpitchB,
                                          int qpos, float& m, float& l, f32x16 (&O)[2], Bg& bg) {
    typedef AT<DQK> A;
    const int tid = otid(), lane = tid & 63, h = lane >> 5;
    const int wv = __builtin_amdgcn_readfirstlane(tid >> 6);
    const bool stager = wv < 4;
    unsigned koff[A::NKI], voff;
#pragma unroll
    for (int t = 0; t < A::NKI; ++t) { const int sl_ = 64 * t + lane; int rr, ch;
        if (DQK == 96) { rr = sl_ / 12; const int p = sl_ % 12, rot = (rr >> 2) & 3; ch = p - rot; ch = ch < 0 ? ch + 12 : ch; }
        else { rr = sl_ >> 3; ch = (sl_ & 7) ^ ((rr >> 1) & 7); }
        koff[t] = (unsigned)(rr * kpitchB + ch * 16); }
    voff = (unsigned)((lane >> 3) * vpitchB + (((lane & 7) ^ (4 * ((lane >> 4) & 1))) * 16));
    unsigned kf0, kf4 = 0, kf5 = 0;
    if (DQK == 96) { const int x = 16 * (h + ((lane >> 2) & 3)); kf0 = (unsigned)((lane & 31) * 192 + x); kf4 = kf0 + (x >= 64 ? 128 - 192 : 128); kf5 = kf0 + (x >= 32 ? 160 - 192 : 160); }
    else { const int sw = (lane >> 1) & 7; kf0 = (unsigned)((lane & 31) * 128 + 16 * (h ^ (sw & 1)) + 32 * (sw >> 1)); }
#define AT_KADDR(ks) (DQK == 96 ? ((ks) == 4 ? kf4 : (ks) == 5 ? kf5 : kf0 + 32u * (ks)) : (kf0 ^ (32u * (ks))))
    const unsigned vrow = (unsigned)((((lane & 15) >> 2) + 4 * h) * 128 + 32 * ((lane >> 4) & 1) + 8 * (lane & 3));
    const unsigned vfA = vrow + 64u * ((lane >> 3) & 1), vfB = vrow + 64u * (1 - ((lane >> 3) & 1));
    LAS int* cvh = (LAS int*)(lds + CV_HDR);
    const int cw = wv & 3;
#define AT_ROW0(i) ((i) < tl.nloc ? tl.row_loc0 + 64 * (i) : tl.row_ctx0 + 64 * ((i) - tl.nloc))
#define AT_DMA_K(i) do { const char* _kp = Kg + (size_t)(AT_ROW0(i) + 16 * wv) * kpitchB; LAS unsigned char* _b = lds + ((i) & 1) * A::KT + (A::NKI * wv) * 1024; \
        _Pragma("unroll") for (int t = 0; t < A::NKI; ++t) __builtin_amdgcn_global_load_lds((const unsigned*)(_kp + koff[t]), (LAS unsigned*)(_b + t * 1024), 16, 0, 0); } while (0)
#define AT_DMA_V(i) do { const char* _vp = Vg + (size_t)(AT_ROW0(i) + 16 * wv) * vpitchB; LAS unsigned char* _b = lds + 2 * A::KT + ((i) & 1) * A::VT + (2 * wv) * 1024; \
        _Pragma("unroll") for (int t = 0; t < 2; ++t) __builtin_amdgcn_global_load_lds((const unsigned*)(_vp + (size_t)(8 * t) * vpitchB + voff), (LAS unsigned*)(_b + t * 1024), 16, 0, 0); } while (0)
#define AT_BAR() do { asm volatile("s_waitcnt lgkmcnt(0)" ::: "memory"); if (!(XP & 1)) __builtin_amdgcn_s_barrier(); asm volatile("" ::: "memory"); } while (0)
#define AT_SB() __builtin_amdgcn_sched_barrier(0)
#define AT_TR(dst, ad, off) asm volatile("ds_read_b64_tr_b16 %0, %1 offset:" #off : "=v"(dst) : "v"(ad))
#define AT_VWAIT() asm volatile("s_waitcnt lgkmcnt(0)" : "+v"(vlo[0][0]), "+v"(vlo[0][1]), "+v"(vlo[1][0]), "+v"(vlo[1][1]), "+v"(vhi[0][0]), "+v"(vhi[0][1]), "+v"(vhi[1][0]), "+v"(vhi[1][1]))
#define AT_QK(C0, C1, j) do { if (XP & 16) { C0 = zero16; C1 = zero16; C0[0] = (float)(j); break; } const LAS unsigned char* kt = lds + ((j) & 1) * A::KT; bf16x8 ka[A::NKS][2]; \
        _Pragma("unroll") for (int ks = 0; ks < A::NKS; ++ks) { ka[ks][0] = *(const LAS bf16x8*)(kt + AT_KADDR(ks)); ka[ks][1] = *(const LAS bf16x8*)(kt + AT_KADDR(ks) + 32 * DQK * 2); } \
        C0 = MFMA32(ka[0][0], qf[0], zero16); C1 = MFMA32(ka[0][1], qf[0], zero16); \
        _Pragma("unroll") for (int ks = 1; ks < A::NKS; ++ks) { C0 = MFMA32(ka[ks][0], qf[ks], C0); C1 = MFMA32(ka[ks][1], qf[ks], C1); } } while (0)
#define AT_FSM(P0, P1) do { \
        if (!(XP & 4)) { _Pragma("unroll") for (int r = 0; r < 16; ++r) { P0[r] = __builtin_amdgcn_exp2f(P0[r]); P1[r] = __builtin_amdgcn_exp2f(P1[r]); } } \
        _Pragma("unroll") for (int sp = 0; sp < 2; ++sp) { u32x4 pw; \
            pw.x = pk2(P0[8 * sp + 0], P0[8 * sp + 1]); pw.y = pk2(P0[8 * sp + 2], P0[8 * sp + 3]); pw.z = pk2(P0[8 * sp + 4], P0[8 * sp + 5]); pw.w = pk2(P0[8 * sp + 6], P0[8 * sp + 7]); pp[0][sp] = __builtin_bit_cast(bf16x8, pw); \
            pw.x = pk2(P1[8 * sp + 0], P1[8 * sp + 1]); pw.y = pk2(P1[8 * sp + 2], P1[8 * sp + 3]); pw.z = pk2(P1[8 * sp + 4], P1[8 * sp + 5]); pw.w = pk2(P1[8 * sp + 6], P1[8 * sp + 7]); pp[1][sp] = __builtin_bit_cast(bf16x8, pw); } } while (0)
#define AT_RMAX(C0, C1, j) do { if (XP & 32) { tm = C0[0] - m; break; } \
        if (MASK) { if ((j) < tl.nloc) { const int kb = tl.kpos_loc0 + 64 * (j) + 4 * h - qpos; \
            _Pragma("unroll") for (int r = 0; r < 16; ++r) { const int d0 = kb + (r & 3) + 8 * (r >> 2), d1 = d0 + 32; \
                if (d0 > 128 || d0 < -128) C0[r] = -1e30f; if (d1 > 128 || d1 < -128) C1[r] = -1e30f; } } } \
        tm = at_max3(C0[0], C0[1], C1[0]); tm = at_max3(tm, C1[1], C0[2]); \
        _Pragma("unroll") for (int r = 2; r < 16; r += 2) { if (r > 2) tm = at_max3(tm, C0[r - 1], C0[r]); tm = at_max3(tm, C1[r], C1[r + 1]); } \
        tm = fmaxf(tm, C0[15]); \
        { const auto sw_ = __builtin_amdgcn_permlane32_swap(__builtin_bit_cast(unsigned, tm), __builtin_bit_cast(unsigned, tm), false, false); \
          tm = fmaxf(__builtin_bit_cast(float, sw_[0]), __builtin_bit_cast(float, sw_[1])) - m; } } while (0)
#define AT_RESC(C0, C1) do { \
        if (__builtin_amdgcn_ballot_w64(tm > 8.f) != 0ull) { const float dlt = fmaxf(tm, 0.f), alpha = __builtin_amdgcn_exp2f(-dlt); m += dlt; l *= alpha; \
            _Pragma("unroll") for (int r = 0; r < 16; ++r) { O[0][r] *= alpha; O[1][r] *= alpha; Lacc[r] *= alpha; } } \
        if (__builtin_amdgcn_ballot_w64(m != 0.f) != 0ull) { _Pragma("unroll") for (int r = 0; r < 16; ++r) { C0[r] -= m; C1[r] -= m; } } } while (0)
#define AT_PV(t, MID) do { if (XP & 8) { MID; break; } const unsigned _vb = (unsigned)(size_t)lds + 2 * A::KT + ((t) & 1) * A::VT; const unsigned vta = _vb + vfA, vtb = _vb + vfB; s16x4 vlo[2][2], vhi[2][2]; \
        AT_TR(vlo[0][0], vta, 0); AT_TR(vhi[0][0], vta, 1024); AT_TR(vlo[0][1], vtb, 0); AT_TR(vhi[0][1], vtb, 1024); \
        AT_TR(vlo[1][0], vta, 2048); AT_TR(vhi[1][0], vta, 3072); AT_TR(vlo[1][1], vtb, 2048); AT_TR(vhi[1][1], vtb, 3072); \
        MID; \
        Lacc = MFMA32(ones8, pp[0][0], Lacc); Lacc = MFMA32(ones8, pp[0][1], Lacc); Lacc = MFMA32(ones8, pp[1][0], Lacc); Lacc = MFMA32(ones8, pp[1][1], Lacc); \
        asm volatile("" : "+v"(tm), "+v"(Lacc));              \
        AT_VWAIT(); \
        _Pragma("unroll") for (int sp = 0; sp < 2; ++sp) _Pragma("unroll") for (int dvb = 0; dvb < 2; ++dvb) { \
            const bf16x8 va = __builtin_shufflevector(vlo[sp][dvb], vhi[sp][dvb], 0, 1, 2, 3, 4, 5, 6, 7); O[dvb] = MFMA32(va, pp[0][sp], O[dvb]); } \
        AT_TR(vlo[0][0], vta, 4096); AT_TR(vhi[0][0], vta, 5120); AT_TR(vlo[0][1], vtb, 4096); AT_TR(vhi[0][1], vtb, 5120); \
        AT_TR(vlo[1][0], vta, 6144); AT_TR(vhi[1][0], vta, 7168); AT_TR(vlo[1][1], vtb, 6144); AT_TR(vhi[1][1], vtb, 7168); \
        AT_VWAIT(); \
        _Pragma("unroll") for (int sp = 0; sp < 2; ++sp) _Pragma("unroll") for (int dvb = 0; dvb < 2; ++dvb) { \
            const bf16x8 va = __builtin_shufflevector(vlo[sp][dvb], vhi[sp][dvb], 0, 1, 2, 3, 4, 5, 6, 7); O[dvb] = MFMA32(va, pp[1][sp], O[dvb]); } } while (0)
#define AT_HEAD(j) do { if (stager && !(XP & 2)) { if ((j) + 1 < n) AT_DMA_K((j) + 1); AT_DMA_V(j); } \
        issued = false; \
        if ((bg.tick & 1) == 0) { if (!stager) { const int sl_ = (bg.tick >> 1) & 1; const int jj = bg.issue_dma(lane, lds + CV_BUF + (2 * cw + sl_) * 8192); \
                if (lane == 0) cvh[2 * cw + sl_] = jj; issued = jj >= 0; } } \
        else bg.process_slot(tid, lds, ((bg.tick + 1) >> 1) & 1); } while (0)
#define AT_TAILSYNC() do { if (stager) asm volatile("s_waitcnt vmcnt(0)" ::: "memory"); \
        else if ((bg.tick & 1) == 0) { if (issued) asm volatile("s_waitcnt vmcnt(8)" ::: "memory"); else asm volatile("s_waitcnt vmcnt(0)" ::: "memory"); } \
        ++bg.tick; AT_BAR(); } while (0)
#define AT_QKF(C0, C1, P0, P1, j) do { const LAS unsigned char* kt = lds + ((j) & 1) * A::KT; bf16x8 ka[A::NKS][2]; \
        _Pragma("unroll") for (int ks = 0; ks < A::NKS; ++ks) { ka[ks][0] = *(const LAS bf16x8*)(kt + AT_KADDR(ks)); ka[ks][1] = *(const LAS bf16x8*)(kt + AT_KADDR(ks) + 32 * DQK * 2); } \
        _Pragma("unroll") for (int r = 0; r < 16; ++r) P0[r] = __builtin_amdgcn_exp2f(P0[r]); \
        asm volatile("" : "+v"(ka[0][0]), "+v"(ka[0][1]), "+v"(P0)); \
        C0 = MFMA32(ka[0][0], qf[0], zero16); C1 = MFMA32(ka[0][1], qf[0], zero16); \
        _Pragma("unroll") for (int ks = 1; ks < A::NKS; ++ks) { C0 = MFMA32(ka[ks][0], qf[ks], C0); C1 = MFMA32(ka[ks][1], qf[ks], C1); } \
        _Pragma("unroll") for (int r = 0; r < 16; ++r) P1[r] = __builtin_amdgcn_exp2f(P1[r]); \
        _Pragma("unroll") for (int sp = 0; sp < 2; ++sp) { u32x4 pw; \
            pw.x = pk2(P0[8 * sp + 0], P0[8 * sp + 1]); pw.y = pk2(P0[8 * sp + 2], P0[8 * sp + 3]); pw.z = pk2(P0[8 * sp + 4], P0[8 * sp + 5]); pw.w = pk2(P0[8 * sp + 6], P0[8 * sp + 7]); pp[0][sp] = __builtin_bit_cast(bf16x8, pw); \
            pw.x = pk2(P1[8 * sp + 0], P1[8 * sp + 1]); pw.y = pk2(P1[8 * sp + 2], P1[8 * sp + 3]); pw.z = pk2(P1[8 * sp + 4], P1[8 * sp + 5]); pw.w = pk2(P1[8 * sp + 6], P1[8 * sp + 7]); pp[1][sp] = __builtin_bit_cast(bf16x8, pw); } } while (0)
#define AT_STEP(C0, C1, P0, P1, j) do { AT_HEAD(j); AT_SB(); \
        if (!(XP & 64)) { AT_QK(C0, C1, j); AT_FSM(P0, P1); } else AT_QKF(C0, C1, P0, P1, j); AT_SB(); \
        AT_PV((j) - 1, AT_RMAX(C0, C1, j)); AT_SB(); \
        AT_RESC(C0, C1); \
        AT_TAILSYNC(); } while (0)
    f32x16 zero16;
#pragma unroll
    for (int r = 0; r < 16; ++r) zero16[r] = 0.f;
    const int n = tl.ntiles;
    bool issued; float tm;
    bf16x8 pp[2][2];
    f32x16 A0, A1, B0, B1, Lacc = zero16;
    const bf16x8 ones8 = (bf16x8){0x3F80, 0x3F80, 0x3F80, 0x3F80, 0x3F80, 0x3F80, 0x3F80, 0x3F80};
    if (stager) AT_DMA_K(0);
    asm volatile("s_waitcnt vmcnt(0)" ::: "memory");
    AT_BAR();
    AT_HEAD(0); AT_SB();
    AT_QK(A0, A1, 0); AT_RMAX(A0, A1, 0); AT_RESC(A0, A1);
    AT_TAILSYNC();
    int j = 1;
    for (; j + 1 < n; j += 2) { AT_STEP(B0, B1, A0, A1, j); AT_STEP(A0, A1, B0, B1, j + 1); }
    if (j < n) { AT_STEP(B0, B1, A0, A1, j); AT_FSM(B0, B1); } else { AT_FSM(A0, A1); }
    AT_SB();
    AT_PV(n - 1, (void)0);
    l += 0.5f * Lacc[0];
#undef AT_ROW0
#undef AT_DMA_K
#undef AT_DMA_V
#undef AT_KADDR
#undef AT_BAR
#undef AT_SB
#undef AT_TR
#undef AT_VWAIT
#undef AT_QK
#undef AT_QKF
#undef AT_FSM
#undef AT_RMAX
#undef AT_RESC
#undef AT_PV
#undef AT_HEAD
#undef AT_TAILSYNC
#undef AT_STEP
}
__device__ __forceinline__ void attn_store(const f32x16 (&O)[2], float l, bf16* orow, int h) {
    const float lt = l + __shfl_xor(l, 32); const float inv = 1.f / lt;
#pragma unroll
    for (int dvb = 0; dvb < 2; ++dvb)
#pragma unroll
        for (int g4 = 0; g4 < 4; ++g4) { u32x2 w; w.x = pk2(O[dvb][4 * g4] * inv, O[dvb][4 * g4 + 1] * inv); w.y = pk2(O[dvb][4 * g4 + 2] * inv, O[dvb][4 * g4 + 3] * inv);
            *(u32x2*)(orow + 32 * dvb + 8 * g4 + 4 * h) = w; }
}

__device__ __forceinline__ void wattn_unit(LAS unsigned char* lds, int unit, const bf16* Qa, const bf16* Ka, const bf16* Va, const float* sink, bf16* MIX, CvtBg& bg) {
    const int tid = otid(), w = tid >> 6, lane = tid & 63, h = lane >> 5;
    int b, kvh, hp, tq, qpos; TileList tl;
    if (unit < 512) { b = unit >> 7; kvh = (unit >> 6) & 1; const int nb = (unit >> 1) & 31; hp = unit & 1;
        const int t0 = max(0, 128 * nb - 128), t1 = min(4096, 128 * nb + 256);
        tl.nloc = (t1 - t0) >> 6; tl.row_loc0 = b * S + t0; tl.kpos_loc0 = t0; tl.row_ctx0 = NL + b * CL; tl.ntiles = tl.nloc + 4;
        qpos = 128 * nb + (w & 3) * 32 + (lane & 31); tq = b * S + qpos;
    } else { const int u = unit - 512; b = u >> 3; kvh = (u >> 2) & 1; hp = (u >> 1) & 1; const int half = u & 1;
        tl.nloc = 0; tl.row_loc0 = 0; tl.kpos_loc0 = 0; tl.row_ctx0 = NL + b * CL; tl.ntiles = 4;
        qpos = 0; tq = NL + b * CL + half * 128 + (w & 3) * 32 + (lane & 31); }
    const int hq = kvh * 4 + hp * 2 + (w >> 2);
    bf16x8 qf[4];
#pragma unroll
    for (int ks = 0; ks < 4; ++ks) qf[ks] = *(const bf16x8*)(Qa + (size_t)tq * 512 + hq * 64 + 16 * ks + 8 * h);
    float m = 0.f, l = (h == 0) ? __expf(sink[hq]) : 0.f;
    f32x16 O[2];
#pragma unroll
    for (int r = 0; r < 16; ++r) { O[0][r] = 0.f; O[1][r] = 0.f; }
    attn_core<64, true, CvtBg, 2>(lds, qf, tl, (const char*)(Ka + kvh * 64), 256, (const char*)(Va + kvh * 64), 256, qpos, m, l, O, bg);
    attn_store(O, l, MIX + (size_t)tq * 1024 + hq * 64, h);
}
template <int XP = 0>
__device__ __forceinline__ void mla_unit(LAS unsigned char* lds, int unit, const bf16* Qc, const bf16* Kc, const bf16* Vc, const float* RS, const float* qg,
                                         const float* cosC, const float* sinC, bf16* MIX, CvtBg& bg) {
    const int tid = otid(), w = tid >> 6, lane = tid & 63, h = lane >> 5;
    int b, head, tq; TileList tl; bool lat;
    if (unit < 1024) { b = unit >> 8; head = (unit >> 4) & 15; const int qb = unit & 15; lat = true;
        tl.nloc = 64; tl.row_loc0 = b * S; tl.kpos_loc0 = 0; tl.row_ctx0 = NL + b * CL; tl.ntiles = 68; tq = b * S + qb * 256 + w * 32 + (lane & 31);
    } else { const int u = unit - 1024; b = u >> 4; head = u & 15; lat = false;
        tl.nloc = 0; tl.row_loc0 = 0; tl.kpos_loc0 = 0; tl.row_ctx0 = NL + b * CL; tl.ntiles = 4; tq = NL + b * CL + w * 32 + (lane & 31); }
    float v[6][8]; float ss = 0.f;
    const bf16* qp = Qc + (size_t)tq * 1536 + head * 96 + 8 * h;
#pragma unroll
    for (int ks = 0; ks < 6; ++ks) { const u32x4 raw = *(const u32x4*)(qp + 16 * ks);
        v[ks][0] = bflo(raw.x); v[ks][1] = bfhi(raw.x); v[ks][2] = bflo(raw.y); v[ks][3] = bfhi(raw.y); v[ks][4] = bflo(raw.z); v[ks][5] = bfhi(raw.z); v[ks][6] = bflo(raw.w); v[ks][7] = bfhi(raw.w);
#pragma unroll
        for (int j = 0; j < 8; ++j) ss += v[ks][j] * v[ks][j]; }
    ss += __shfl_xor(ss, 32);
    float r; { const f32x4 p0 = *(const f32x4*)(RS + (size_t)tq * 16), p1 = *(const f32x4*)(RS + (size_t)tq * 16 + 4), p2 = *(const f32x4*)(RS + (size_t)tq * 16 + 8);
      r = rsqrtf((((p0[0] + p0[1]) + (p0[2] + p0[3])) + ((p1[0] + p1[1]) + (p1[2] + p1[3])) + ((p2[0] + p2[1]) + (p2[2] + p2[3]))) * (1.f / 768.f) + EPS); }
    const float inv = r * rsqrtf(r * r * ss * (1.f / 96.f) + EPS);
#pragma unroll
    for (int ks = 0; ks < 6; ++ks) { const f32x4 g0 = *(const f32x4*)(qg + 16 * ks + 8 * h), g1 = *(const f32x4*)(qg + 16 * ks + 8 * h + 4);
#pragma unroll
        for (int j = 0; j < 4; ++j) { v[ks][j] *= inv * g0[j]; v[ks][4 + j] *= inv * g1[j]; } }
    {
        const int t = tq & 4095;
#pragma unroll
        for (int ax = 0; ax < 2; ++ax) {
            const f32x4 c0 = *(const f32x4*)(cosC + t * 16 + 8 * ax), c1 = *(const f32x4*)(cosC + t * 16 + 8 * ax + 4);
            const f32x4 s0 = *(const f32x4*)(sinC + t * 16 + 8 * ax), s1 = *(const f32x4*)(sinC + t * 16 + 8 * ax + 4);
#pragma unroll
            for (int j = 0; j < 8; ++j) { const float y = v[4 + ax][j], po = __shfl_xor(y, 32); const float c = j < 4 ? c0[j & 3] : c1[j & 3], s = j < 4 ? s0[j & 3] : s1[j & 3];
                const float yr = (h == 0) ? (y * c - po * s) : (y * c + po * s); v[4 + ax][j] = lat ? yr : y; }
        }
    }
    bf16x8 qf[6];
#pragma unroll
    for (int ks = 0; ks < 6; ++ks) { u32x4 pw; pw.x = pk2(v[ks][0] * QSCALE_C, v[ks][1] * QSCALE_C); pw.y = pk2(v[ks][2] * QSCALE_C, v[ks][3] * QSCALE_C);
        pw.z = pk2(v[ks][4] * QSCALE_C, v[ks][5] * QSCALE_C); pw.w = pk2(v[ks][6] * QSCALE_C, v[ks][7] * QSCALE_C); qf[ks] = __builtin_bit_cast(bf16x8, pw); }
    float m = 0.f, l = 0.f;
    f32x16 O[2];
#pragma unroll
    for (int rr = 0; rr < 16; ++rr) { O[0][rr] = 0.f; O[1][rr] = 0.f; }
    attn_core<96, false, CvtBg, 4, XP>(lds, qf, tl, (const char*)(Kc + head * 96), 3072, (const char*)(Vc + head * 64), 2048, 0, m, l, O, bg);
    attn_store(O, l, MIX + (size_t)tq * 1024 + head * 64, h);
}

template <int NTOK>
__device__ __forceinline__ void conv_strip(LAS unsigned char* lds, int seq0, int len, int t0, const bf16* Z, const float* dw_w, const float* dw_b, const float* ln_g, const float* ln_b, bf16* MIX) {
    const int tid = otid(), w = tid >> 6, lane = tid & 63;
    constexpr int NROW = NTOK + 30, NCH = NROW * 64, NLD = (NCH + NTHR - 1) / NTHR, NSUB = (NTOK + 15) / 16;
    LAS bf16* zt = (LAS bf16*)lds; LAS float* ot = (LAS float*)(lds + 98304);
    u32x4 st[NLD];
#pragma unroll
    for (int i = 0; i < NLD; ++i) { const int q = tid + i * NTHR, r = q >> 6, cc = q & 63, tt = t0 - 15 + r; st[i] = (u32x4){0u, 0u, 0u, 0u};
        if (q < NCH && tt >= 0 && tt < len) st[i] = *(const u32x4*)(Z + (size_t)(seq0 + tt) * 512 + cc * 8); }
    float wt[31];
#pragma unroll
    for (int j = 0; j < 31; ++j) wt[j] = dw_w[j * 512 + tid];
    const float bias = dw_b[tid];
#pragma unroll
    for (int i = 0; i < NLD; ++i) { const int q = tid + i * NTHR; if (q < NCH) *(LAS u32x4*)(zt + (q >> 6) * 512 + (q & 63) * 8) = st[i]; }
    const f32x4 g0 = *(const f32x4*)(ln_g + 8 * lane), g1 = *(const f32x4*)(ln_g + 8 * lane + 4), b0 = *(const f32x4*)(ln_b + 8 * lane), b1 = *(const f32x4*)(ln_b + 8 * lane + 4);
    __syncthreads();
#pragma unroll 1
    for (int sb = 0; sb < NSUB; ++sb) {
        float acc[16];
#pragma unroll
        for (int t = 0; t < 16; ++t) acc[t] = bias;
        const LAS bf16* zp = zt + sb * 16 * 512 + tid;
        constexpr int NR = (NTOK >= 16 ? 16 : NTOK) + 30;
#pragma unroll
        for (int r = 0; r < NR; ++r) { const float zv = bf1(zp[r * 512]);
#pragma unroll
            for (int t = 0; t < 16; ++t) { const int j = r - t; if (j >= 0 && j < 31 && t < NTOK) acc[t] += zv * wt[j]; } }
#pragma unroll
        for (int t = 0; t < 16; ++t) ot[t * 512 + tid] = acc[t];
        __syncthreads();
#pragma unroll
        for (int q = 0; q < 2; ++q) { const int t = 2 * w + q, tok = sb * 16 + t;
            if (tok < NTOK) {
                const f32x4 x0 = *(const LAS f32x4*)(ot + t * 512 + 8 * lane), x1 = *(const LAS f32x4*)(ot + t * 512 + 8 * lane + 4);
                const float mu = wave_sum((x0[0] + x0[1]) + (x0[2] + x0[3]) + (x1[0] + x1[1]) + (x1[2] + x1[3])) * (1.f / 512.f);
                const f32x4 d0 = x0 - mu, d1 = x1 - mu;
                const float var = wave_sum((d0[0] * d0[0] + d0[1] * d0[1]) + (d0[2] * d0[2] + d0[3] * d0[3]) + (d1[0] * d1[0] + d1[1] * d1[1]) + (d1[2] * d1[2] + d1[3] * d1[3])) * (1.f / 512.f);
                const float rstd = rsqrtf(var + EPS);
                f32x4 y0 = d0 * rstd * g0 + b0, y1 = d1 * rstd * g1 + b1;
#pragma unroll
                for (int j = 0; j < 4; ++j) { y0[j] = fsilu(y0[j]); y1[j] = fsilu(y1[j]); }
                *(u32x4*)(MIX + (size_t)(seq0 + t0 + tok) * 1024 + 512 + 8 * lane) = pack8(y0, y1); } }
        __syncthreads();
    }
}

__device__ __forceinline__ void mla_stats_row(int row, int lane, const bf16* P, const float* krg, const float* cosC, const float* sinC, float* RS, bf16* Kc) {
    const bf16* p = P + (size_t)row * PP;
    const u32x4 a = *(const u32x4*)(p + 8 * lane);
    const u32x4 b = *(const u32x4*)(p + 8 * (lane + 64));
    u32x4 c = (u32x4){0u, 0u, 0u, 0u};
    if (lane < 4) c = *(const u32x4*)(p + 8 * (lane + 128));
    auto sq = [](u32x4 u) { float s = 0.f; s += bflo(u.x) * bflo(u.x) + bfhi(u.x) * bfhi(u.x); s += bflo(u.y) * bflo(u.y) + bfhi(u.y) * bfhi(u.y);
                            s += bflo(u.z) * bflo(u.z) + bfhi(u.z) * bfhi(u.z); s += bflo(u.w) * bflo(u.w) + bfhi(u.w) * bfhi(u.w); return s; };
    const float sa = sq(a), sb = sq(b), sc = sq(c);
    const float ssq = wave_sum(sa + (lane < 32 ? sb : 0.f)), skv = wave_sum(lane >= 32 ? sb : 0.f), skr = wave_sum(sc);
    if (lane == 0) { RS[(size_t)row * 2] = rsqrtf(ssq * (1.f / 768.f) + EPS); RS[(size_t)row * 2 + 1] = rsqrtf(skv * (1.f / 256.f) + EPS); }
    const float rk = rsqrtf(skr * (1.f / 32.f) + EPS);
    float y[8]; const int l4 = lane & 3;
    { const f32x4 g0 = *(const f32x4*)(krg + 8 * l4), g1 = *(const f32x4*)(krg + 8 * l4 + 4);
      y[0] = bflo(c.x) * rk * g0[0]; y[1] = bfhi(c.x) * rk * g0[1]; y[2] = bflo(c.y) * rk * g0[2]; y[3] = bfhi(c.y) * rk * g0[3];
      y[4] = bflo(c.z) * rk * g1[0]; y[5] = bfhi(c.z) * rk * g1[1]; y[6] = bflo(c.w) * rk * g1[2]; y[7] = bfhi(c.w) * rk * g1[3]; }
    const int t = row & 4095, ax = l4 >> 1, half = l4 & 1;
    const f32x4 c0 = *(const f32x4*)(cosC + t * 16 + 8 * ax), c1 = *(const f32x4*)(cosC + t * 16 + 8 * ax + 4), s0 = *(const f32x4*)(sinC + t * 16 + 8 * ax), s1 = *(const f32x4*)(sinC + t * 16 + 8 * ax + 4);
    float o[8];
#pragma unroll
    for (int j = 0; j < 8; ++j) { const float po = __shfl_xor(y[j], 1); const float cc = j < 4 ? c0[j & 3] : c1[j & 3], sn = j < 4 ? s0[j & 3] : s1[j & 3];
        const float yr = half == 0 ? (y[j] * cc - po * sn) : (y[j] * cc + po * sn); o[j] = row < NL ? yr : y[j]; }
    if (lane < 4) { u32x4 wv; wv.x = pk2(o[0], o[1]); wv.y = pk2(o[2], o[3]); wv.z = pk2(o[4], o[5]); wv.w = pk2(o[6], o[7]);
#pragma unroll
        for (int hd = 0; hd < 16; ++hd) *(u32x4*)(Kc + (size_t)row * 1536 + hd * 96 + 64 + 8 * lane) = wv; }
}

template <int NT>
__device__ __forceinline__ void moe_setup(LAS unsigned char* lds, const int* cntG, const int* list, int layer, int vcu, int G) {
    LAS int* tab = (LAS int*)(lds + LDS_TAB); LAS int* idx = (LAS int*)(lds + LDS_IDX);
    const int tid = otid(); constexpr int MG = 32 / NT;
    if (tid < 32) tab[tid] = cntG[tid * 64];
    __syncthreads();
    if (tid == 0) { int acc = 0; for (int e = 0; e < 32; ++e) { tab[32 + e] = acc; acc += (tab[e] + 255) >> 8; } tab[64] = acc;
        int n = 0;
        for (int i = 0; i < MAXU; ++i) { const int v = i * G + vcu, gm = (v >> 5) * MG + (v & 31) / NT, nt = v % NT; if (gm >= acc) break;
            int e = 0; while (e < 31 && tab[33 + e] <= gm) ++e;
            tab[128 + 4 * i] = gm; tab[129 + 4 * i] = (layer * 32 + e) * NT + nt; tab[130 + 4 * i] = e; tab[131 + 4 * i] = nt; n = i + 1; }
        tab[127] = n; }
    __syncthreads();
    const int n = tab[127];
    for (int q = tid; q < n * 256; q += NTHR) { const int i = q >> 8, r = q & 255, gm = tab[128 + 4 * i], e = tab[130 + 4 * i], rr = (gm - tab[32 + e]) * 256 + r;
        idx[q] = rr < tab[e] ? list[(size_t)e * T + rr] : -1; }
    __syncthreads();
}

__device__ __forceinline__ void ctx_minigemm(LAS unsigned char* lds, const bf16* MIX, const bf16* W  , float* X, const float* srcctx  ,
                                             const float* gmod  , float* SSX, int bx) {
    const int tid = otid(), lane = tid & 63, w = __builtin_amdgcn_readfirstlane(tid >> 6), fr = lane & 15, fq = lane >> 4;
    const int tr = bx >> 4, tc = bx & 15;
    const bf16* ap = MIX + (size_t)(NL + 64 * tr + fr) * 1024 + 128 * w + 8 * fq;
    const bf16* bp = W + (size_t)(64 * tc + fr) * 1024 + 128 * w + 8 * fq;
    bf16x8 a[4][4], b[4][4];
#pragma unroll
    for (int t = 0; t < 4; ++t)
#pragma unroll
        for (int ks = 0; ks < 4; ++ks) { a[t][ks] = *(const bf16x8*)(ap + (size_t)(16 * t) * 1024 + 32 * ks); b[t][ks] = *(const bf16x8*)(bp + (size_t)(16 * t) * 1024 + 32 * ks); }
    f32x4 acc[4][4];
#pragma unroll
    for (int mt = 0; mt < 4; ++mt)
#pragma unroll
        for (int nt = 0; nt < 4; ++nt) { acc[mt][nt] = (f32x4){0.f, 0.f, 0.f, 0.f};
#pragma unroll
            for (int ks = 0; ks < 4; ++ks) acc[mt][nt] = __builtin_amdgcn_mfma_f32_16x16x32_bf16(b[nt][ks], a[mt][ks], acc[mt][nt], 0, 0, 0); }
    LAS f32x4* part = (LAS f32x4*)lds;
#pragma unroll
    for (int mt = 0; mt < 4; ++mt)
#pragma unroll
        for (int nt = 0; nt < 4; ++nt) part[(w * 16 + mt * 4 + nt) * 64 + lane] = acc[mt][nt];
    __syncthreads();
    LAS float* ssq = (LAS float*)(lds + LDS_IDX);
    const float* gp = gmod + (size_t)4 * 6144;
#pragma unroll
    for (int hf = 0; hf < 2; ++hf) { const int o = tid + 512 * hf, tile = o >> 6, ol = o & 63, mt = tile >> 2, nt = tile & 3, r = 16 * mt + (ol & 15), c = 64 * tc + 16 * nt + 4 * (ol >> 4);
        f32x4 s = part[o];
#pragma unroll
        for (int ww = 1; ww < 8; ++ww) s += part[ww * 1024 + o];
        const size_t gi = (size_t)(64 * tr + r) * D + c;
        const f32x4 y = *(const f32x4*)(srcctx + gi) + *(const f32x4*)(gp + c) * s;
        *(f32x4*)(X + (size_t)NL * D + gi) = y;
        ssq[r * 16 + nt * 4 + (ol >> 4)] = (y[0] * y[0] + y[1] * y[1]) + (y[2] * y[2] + y[3] * y[3]); }
    __syncthreads();
    if (tid < 64) { float ss = 0.f;
#pragma unroll
        for (int q = 0; q < 16; ++q) ss += ssq[tid * 16 + q];
        SSX[(size_t)(NL + 64 * tr + tid) * 16 + tc] = ss; }
    __syncthreads();
}

__device__ __forceinline__ void combine_row(int row, int lane, float* X, const bf16* YB, const float* mcur  , const float* gnext, const float* mnext, bf16* H, float* out) {
    const int mr = modrow(row); const float* mv = mcur + (size_t)mr * 6144 + 5120;
    f32x4 v[2][2]; float ss = 0.f;
    u32x4 y[2][4];
#pragma unroll
    for (int j = 0; j < 2; ++j)
#pragma unroll
        for (int k = 0; k < 4; ++k) y[j][k] = *(const u32x4*)(YB + ((size_t)row * 4 + k) * 1024 + 8 * lane + 512 * j);
#pragma unroll
    for (int j = 0; j < 2; ++j) { const int c = 8 * lane + 512 * j; f32x4 a0 = (f32x4){0.f, 0.f, 0.f, 0.f}, a1 = a0;
#pragma unroll
        for (int k = 0; k < 4; ++k) { a0 += (f32x4){bflo(y[j][k].x), bfhi(y[j][k].x), bflo(y[j][k].y), bfhi(y[j][k].y)}; a1 += (f32x4){bflo(y[j][k].z), bfhi(y[j][k].z), bflo(y[j][k].w), bfhi(y[j][k].w)}; }
        float* xp = X + (size_t)row * D + c; const f32x4 g0 = *(const f32x4*)(mv + c), g1 = *(const f32x4*)(mv + c + 4);
        v[j][0] = *(const f32x4*)xp + g0 * a0; v[j][1] = *(const f32x4*)(xp + 4) + g1 * a1;
        float* op = out ? out + (size_t)row * D + c : xp;
        *(f32x4*)op = v[j][0]; *(f32x4*)(op + 4) = v[j][1];
#pragma unroll
        for (int q = 0; q < 2; ++q) ss += (v[j][q][0] * v[j][q][0] + v[j][q][1] * v[j][q][1]) + (v[j][q][2] * v[j][q][2] + v[j][q][3] * v[j][q][3]); }
    if (H) { const float rstd = rsqrtf(wave_sum(ss) * (1.f / D) + EPS); const float* mn = mnext + (size_t)mr * 6144;
#pragma unroll
        for (int j = 0; j < 2; ++j) { const int c = 8 * lane + 512 * j; f32x4 o[2];
#pragma unroll
            for (int q = 0; q < 2; ++q) { const f32x4 gg = *(const f32x4*)(gnext + c + 4 * q), sc = *(const f32x4*)(mn + 1024 + c + 4 * q), sh = *(const f32x4*)(mn + c + 4 * q); o[q] = v[j][q] * rstd * gg * (sc + 1.f) + sh; }
            *(u32x4*)(H + (size_t)row * D + c) = pack8(o[0], o[1]); } }
}

#define MFMA16(a, b, c) __builtin_amdgcn_mfma_f32_16x16x32_bf16((a), (b), (c), 0, 0, 0)
__device__ __forceinline__ void router_load_table(LAS unsigned char* lds, const bf16* Wr, int tid) {
    u32x4 v[16];
#pragma unroll
    for (int i = 0; i < 16; ++i) v[i] = *(const u32x4*)(Wr + (size_t)(tid + i * NTHR) * 8);
#pragma unroll
    for (int i = 0; i < 16; ++i) { const int q = tid + i * NTHR, row = q >> 7, c = q & 127; *(LAS u32x4*)(lds + row * 2048 + ((c ^ (row & 15)) << 4)) = v[i]; }
}
__device__ __forceinline__ void router_group(LAS unsigned char* lds, int g, int w, int lane, const float* X, const float* SSX, const float* gffn, const float* mvec, const float* rb,
                                             bf16* F, float* gate) {
    LAS float* lg = (LAS float*)(lds + LDS_IDX) + w * 512; LAS int* pend = (LAS int*)(lds + LDS_IDX + 10240) + w * 64; LAS int* cntL = (LAS int*)(lds + LDS_TAB);
    const int i = lane & 15, kq = lane >> 4, row = 16 * g + i;
    const float* xr = X + (size_t)row * D + 8 * kq;
    float ss; { const f32x4 pq = *(const f32x4*)(SSX + (size_t)row * 16 + 4 * kq); ss = (pq[0] + pq[1]) + (pq[2] + pq[3]); }
    ss += __shfl_xor(ss, 16); ss += __shfl_xor(ss, 32);
    const float rstd = rsqrtf(ss * (1.f / D) + EPS);
    f32x4 acc[2] = {(f32x4){0.f, 0.f, 0.f, 0.f}, (f32x4){0.f, 0.f, 0.f, 0.f}};
    const LAS unsigned char* tb = lds + i * 2048;
#pragma unroll 8
    for (int s = 0; s < 32; ++s) {
        const int k = 32 * s + 8 * kq;
        const f32x4 a = *(const f32x4*)(xr + 32 * s), b = *(const f32x4*)(xr + 32 * s + 4);
        const f32x4 g0 = *(const f32x4*)(gffn + k), g1 = *(const f32x4*)(gffn + k + 4), c0 = *(const f32x4*)(mvec + 4096 + k), c1 = *(const f32x4*)(mvec + 4096 + k + 4);
        const f32x4 h0 = *(const f32x4*)(mvec + 3072 + k), h1 = *(const f32x4*)(mvec + 3072 + k + 4);
        const f32x4 f0 = a * rstd * g0 * (c0 + 1.f) + h0, f1 = b * rstd * g1 * (c1 + 1.f) + h1;
        u32x4 hi; hi.x = pk2(f0[0], f0[1]); hi.y = pk2(f0[2], f0[3]); hi.z = pk2(f1[0], f1[1]); hi.w = pk2(f1[2], f1[3]);
        *(u32x4*)(F + (size_t)row * D + k) = hi;
        u32x4 lo; lo.x = pk2(f0[0] - bflo(hi.x), f0[1] - bfhi(hi.x)); lo.y = pk2(f0[2] - bflo(hi.y), f0[3] - bfhi(hi.y));
        lo.z = pk2(f1[0] - bflo(hi.z), f1[1] - bfhi(hi.z)); lo.w = pk2(f1[2] - bflo(hi.w), f1[3] - bfhi(hi.w));
        const bf16x8 ah = __builtin_bit_cast(bf16x8, hi), al = __builtin_bit_cast(bf16x8, lo);
        const int cs = ((4 * s + kq) ^ i) << 4;
#pragma unroll
        for (int et = 0; et < 2; ++et) { const bf16x8 bh = *(const LAS bf16x8*)(tb + et * 16 * 2048 + cs), bl = *(const LAS bf16x8*)(tb + (32 + et * 16) * 2048 + cs);
            acc[et] = MFMA16(ah, bh, acc[et]); acc[et] = MFMA16(al, bh, acc[et]); acc[et] = MFMA16(ah, bl, acc[et]); }
    }
#pragma unroll
    for (int et = 0; et < 2; ++et) { const float bias = rb[16 * et + i];
#pragma unroll
        for (int r = 0; r < 4; ++r) lg[(4 * kq + r) * 32 + 16 * et + i] = acc[et][r] + bias; }
    LDS_WAIT(); asm volatile("" ::: "memory");
    if (lane < 16) {
        const LAS float* my = lg + lane * 32; unsigned used = 0u; int bi[4]; float bv[4];
#pragma unroll
        for (int k = 0; k < 4; ++k) { float best = -3.0e38f; int be = 0;
#pragma unroll
            for (int e = 0; e < 32; ++e) { const float v = my[e]; const bool ok = !((used >> e) & 1u) && v > best; best = ok ? v : best; be = ok ? e : be; }
            used |= 1u << be; bi[k] = be; bv[k] = best; }
        float ex[4], sum = 0.f;
#pragma unroll
        for (int k = 0; k < 4; ++k) { ex[k] = __expf(bv[k] - bv[0]); sum += ex[k]; }
        const float inv = 1.f / sum; const int trow = 16 * g + lane;
#pragma unroll
        for (int k = 0; k < 4; ++k) { const int rl = __hip_atomic_fetch_add(cntL + bi[k], 1, __ATOMIC_RELAXED, __HIP_MEMORY_SCOPE_WORKGROUP);
            pend[lane * 4 + k] = (trow * 4 + k) | (bi[k] << 17) | (rl << 22); gate[trow * 4 + k] = ex[k] * inv; }
    }
}

struct Args { const float* in[32]; float* out; unsigned char* ws; int lo, hi, flags, pad; };
constexpr int N_PHASES = 2 + 2 * (7 + 8);

__global__ void __launch_bounds__(NTHR, 2) mega(Args args) {
    extern __shared__ __attribute__((aligned(16))) unsigned char lds_raw[];
    LAS unsigned char* lds = (LAS unsigned char*)lds_raw;
    const int tid = threadIdx.x, lane = tid & 63, wave = __builtin_amdgcn_readfirstlane(tid >> 6);
    constexpr int G = 256;
    const int bx = blockIdx.x & (G - 1), vcu = (bx % 8) * (G / 8) + bx / 8;
    const int gw = vcu * NWAVES + wave, NGW = G * NWAVES;
    unsigned* ctl = (unsigned*)(args.ws + WS_CTL);
#define PH_LOCALS \
    unsigned zsg_; asm volatile("s_mov_b32 %0, 0" : "=s"(zsg_)); unsigned char* ws = args.ws + zsg_;   const int tid = otid(), lane = tid & 63, wave = __builtin_amdgcn_readfirstlane(tid >> 6), gw = vcu * NWAVES + wave; (void)lane; (void)gw; \
    const float* x_in = args.in[0]; const float* c_in = args.in[1]; const float* ctx_in = args.in[2]; const float* cctx_in = args.in[3]; \
    const float* mod_w = args.in[4]; const float* mod_b = args.in[5]; const float* norm_mix_g = args.in[6]; const float* norm_ffn_g = args.in[7]; \
    float* MOD = (float*)(ws + WS_MOD); float* cosA = (float*)(ws + WS_COSA); float* sinA = (float*)(ws + WS_SINA); float* cosC = (float*)(ws + WS_COSC); float* sinC = (float*)(ws + WS_SINC); \
    bf16* WR = (bf16*)(ws + WS_WR); bf16* WINA = (bf16*)(ws + WS_WINA); bf16* WOUTA = (bf16*)(ws + WS_WOUTA); bf16* WINC = (bf16*)(ws + WS_WINC); bf16* WQB = (bf16*)(ws + WS_WQB); \
    bf16* WKVB = (bf16*)(ws + WS_WKVB); bf16* WOUTC = (bf16*)(ws + WS_WOUTC); bf16* WGU = (bf16*)(ws + WS_WGU); bf16* WDN = (bf16*)(ws + WS_WDN); \
    float* X = (float*)(ws + WS_X); bf16* H = (bf16*)(ws + WS_H); bf16* QA = (bf16*)(ws + WS_QA); bf16* KA = (bf16*)(ws + WS_KA); bf16* VA = (bf16*)(ws + WS_VA); bf16* Z = (bf16*)(ws + WS_Z); \
    bf16* P = (bf16*)(ws + WS_P); float* RS = (float*)(ws + WS_RS); bf16* QC = (bf16*)(ws + WS_QC); bf16* KC = (bf16*)(ws + WS_KC); bf16* VC = (bf16*)(ws + WS_VC); \
    bf16* MIX = (bf16*)(ws + WS_MIX); bf16* F = (bf16*)(ws + WS_F); float* GATE = (float*)(ws + WS_GATE); int* LIST = (int*)(ws + WS_LIST); bf16* ACT = (bf16*)(ws + WS_ACT); bf16* YB = (bf16*)(ws + WS_YB); \
    int* CNT = (int*)(ws + WS_CTL) + CW_CNT; float* SSX = (float*)(ws + WS_SSX); float* SSP = (float*)(ws + WS_SSP); (void)SSX; (void)SSP; const float* ML = MOD + (size_t)layer_ * 5 * 6144; \
    (void)x_in; (void)c_in; (void)ctx_in; (void)cctx_in; (void)mod_w; (void)mod_b; (void)norm_mix_g; (void)norm_ffn_g; (void)MOD; (void)cosA; (void)sinA; (void)cosC; (void)sinC; (void)WR; (void)WINA; (void)WOUTA; \
    (void)WINC; (void)WQB; (void)WKVB; (void)WOUTC; (void)WGU; (void)WDN; (void)X; (void)H; (void)QA; (void)KA; (void)VA; (void)Z; (void)P; (void)RS; (void)QC; (void)KC; (void)VC; (void)MIX; (void)F; (void)GATE; \
    (void)LIST; (void)ACT; (void)YB; (void)CNT; (void)ML;
    if (tid < 64) ((LAS unsigned*)(lds + LDS_MISC))[tid] = 0u;
    __syncthreads();
    const int lo = args.lo, hi = args.hi;
    XcdBarrier bar; bar.bar = ctl + CW_BAR; bar.x = 0; bar.st = nullptr;
    if (hi - lo > 1) bar = xcd_barrier_post(ctl + CW_BAR, (volatile LAS unsigned*)(lds + LDS_MISC));
    int ph = 0; int layer_ = 0;
#ifndef MK_EN
#define MK_EN 0xffffffffu
#endif
#ifdef MK_PROBE_PH
#define PFLAG(b) (args.flags & (b))
#else
#define PFLAG(b) 0
#endif
#define EN(k) (((MK_EN) >> (k)) & 1u)
#define PH_ON (ph >= lo && ph < hi)
#define CVT_HEAD do { if (tid < 8) ((LAS int*)(lds + CV_HDR))[tid] = -1; } while (0)
#define CVT_TAIL(bg) do { LAS int* _jn = (LAS int*)(lds + CV_HDR + 64); asm volatile("s_waitcnt vmcnt(0)" ::: "memory"); if (wave >= 4 && lane == 0) _jn[wave - 4] = bg.j; __syncthreads(); \
        bg.process_slot(tid, lds, 0); bg.process_slot(tid, lds, 1); \
        { const int _j = _jn[wave & 3]; bg.j = _j + (wave < 4 ? 0 : 4); bg.step = 8; } __syncthreads(); \
        bg.tail_loop(lane, lds + wave * 16384); __syncthreads(); } while (0)
#define PH_END do { const bool _b = (ph >= lo) && (ph + 1 < hi); ++ph; if (_b) xcd_barrier(bar); } while (0)

    if (EN(0) && PH_ON) { PH_LOCALS
        LAS float* st = (LAS float*)(lds + 73728);
        for (int q = tid; q < 5 * 1024; q += NTHR) { const float v = q < 4096 ? c_in[q] : cctx_in[q - 4096]; st[q] = fsilu(v); }
        __syncthreads();
        for (int u = vcu; u < 384; u += G) {
            const int l = u / 96, col = (u % 96) * 64 + lane;
            const float* wp = mod_w + ((size_t)l * D + 128 * wave) * 6144 + col; float a0 = 0.f, a1 = 0.f, a2 = 0.f, a3 = 0.f, a4 = 0.f;
#pragma unroll 1
            for (int k0 = 0; k0 < 128; k0 += 64) { float wv[64];
#pragma unroll
                for (int kk = 0; kk < 64; ++kk) wv[kk] = __builtin_nontemporal_load(wp + (size_t)(k0 + kk) * 6144);
#pragma unroll
                for (int kk = 0; kk < 64; ++kk) { const int k = 128 * wave + k0 + kk; a0 += st[k] * wv[kk]; a1 += st[1024 + k] * wv[kk]; a2 += st[2048 + k] * wv[kk]; a3 += st[3072 + k] * wv[kk]; a4 += st[4096 + k] * wv[kk]; } }
            LAS float* part = (LAS float*)(lds + 98304);
            part[(wave * 5 + 0) * 64 + lane] = a0; part[(wave * 5 + 1) * 64 + lane] = a1; part[(wave * 5 + 2) * 64 + lane] = a2; part[(wave * 5 + 3) * 64 + lane] = a3; part[(wave * 5 + 4) * 64 + lane] = a4;
            __syncthreads();
            if (wave < 5) { float s = mod_b[l * 6144 + col];
#pragma unroll
                for (int w8 = 0; w8 < 8; ++w8) s += part[(w8 * 5 + wave) * 64 + lane];
                MOD[((size_t)l * 5 + wave) * 6144 + col] = s; }
            __syncthreads();
        }
        for (int q = gw * 64 + lane; q < 4096 * 32; q += NGW * 64) {
            { const int t = q >> 5, j = q & 31, ax = j >> 4, i = j & 15; const float pos = (float)(ax == 0 ? (t >> 6) : (t & 63)); const float a = pos * powf(10000.f, -((float)i * 2.f) / 32.f); cosA[q] = cosf(a); sinA[q] = sinf(a); }
            if (q < 4096 * 16) { const int t = q >> 4, j = q & 15, ax = j >> 3, i = j & 7; const float pos = (float)(ax == 0 ? (t >> 6) : (t & 63)); const float a = pos * powf(10000.f, -((float)i * 2.f) / 16.f); cosC[q] = cosf(a); sinC[q] = sinf(a); }
        }
        { const float* rw = args.in[26];
          for (int q = gw * 64 + lane; q < 4 * 32 * 1024; q += NGW * 64) { const int l = q >> 15, e = (q >> 10) & 31, k = q & 1023; const float wv = rw[((size_t)l * 1024 + k) * 32 + e];
              const unsigned hb = pk2(wv, 0.f) & 0xffffu; const float hf = __uint_as_float(hb << 16); const unsigned lb = pk2(wv - hf, 0.f) & 0xffffu;
              WR[((size_t)(l * 2 + 0) * 32 + e) * 1024 + k] = (bf16)hb; WR[((size_t)(l * 2 + 1) * 32 + e) * 1024 + k] = (bf16)lb; } }
        LAS float* scr = (LAS float*)(lds + wave * 8448);
        cvt_matrix<LAY_INA>(args.in[8], (size_t)D * 1792, 1792, 1792, 1024, 7, 14, WINA, nullptr, scr, gw, NGW, lane);
        cvt_matrix<LAY_F32>(args.in[9], (size_t)D * 1024, 1024, 1024, 1024, 4, 8, WOUTA, nullptr, scr, gw, NGW, lane);
        cvt_matrix<LAY_STD>(args.in[17], (size_t)D * 1056, 1056, 1056, 1024, 5, 10, WINC, nullptr, scr, gw, NGW, lane);
        cvt_matrix<LAY_STD>(args.in[20], (size_t)768 * 1536, 1536, 1536, 768, 6, 6, WQB, args.in[18], scr, gw, NGW, lane);
        cvt_matrix<LAY_STD>(args.in[20] + (size_t)768 * 1536, 0, 1536, 1536, 768, 6, 6, WQB + (size_t)1536 * 768, args.in[18] + 768, scr, gw, NGW, lane);
        cvt_matrix<LAY_HEAD2>(args.in[21], (size_t)256 * 2048, 2048, 2048, 256, 8, 8, WKVB, args.in[19], scr, gw, NGW, lane);
        cvt_matrix<LAY_HEAD2>(args.in[21] + (size_t)256 * 2048, 0, 2048, 2048, 256, 8, 8, WKVB + (size_t)2048 * 256, args.in[19] + 256, scr, gw, NGW, lane);
        cvt_matrix<LAY_F32>(args.in[25], (size_t)D * 1024, 1024, 1024, 1024, 4, 8, WOUTC, nullptr, scr, gw, NGW, lane);
        __syncthreads();
    }
    PH_END;
    if (EN(1) && PH_ON) { PH_LOCALS
        for (int row = gw; row < T; row += NGW) {
            const float* xrow = row < NL ? x_in + (size_t)row * D : ctx_in + (size_t)(row - NL) * D; const float* mn = MOD + (size_t)modrow(row) * 6144;
            f32x4 v[2][2]; float ss = 0.f;
#pragma unroll
            for (int j = 0; j < 2; ++j)
#pragma unroll
                for (int q = 0; q < 2; ++q) { v[j][q] = *(const f32x4*)(xrow + 8 * lane + 512 * j + 4 * q); ss += (v[j][q][0] * v[j][q][0] + v[j][q][1] * v[j][q][1]) + (v[j][q][2] * v[j][q][2] + v[j][q][3] * v[j][q][3]); }
            const float rstd = rsqrtf(wave_sum(ss) * (1.f / D) + EPS);
#pragma unroll
            for (int j = 0; j < 2; ++j) { const int c = 8 * lane + 512 * j; f32x4 o[2];
#pragma unroll
                for (int q = 0; q < 2; ++q) { const f32x4 gg = *(const f32x4*)(norm_mix_g + c + 4 * q), sc = *(const f32x4*)(mn + 1024 + c + 4 * q), sh = *(const f32x4*)(mn + c + 4 * q); o[q] = v[j][q] * rstd * gg * (sc + 1.f) + sh; }
                *(u32x4*)(H + (size_t)row * D + c) = pack8(o[0], o[1]); }
        }
    }
    PH_END;

    for (int layer = 0; layer < 4; ++layer) {
        const bool keep = layer < 3; const int li = layer >> 1; const int nrt = keep ? 68 : 64;
        layer_ = layer;
        if ((layer & 1) == 0) {
            if (EN(2) && PH_ON) { PH_LOCALS
                g8::GemmP g{H, D, WINA + (size_t)li * 1792 * 1024, 1024}; g8::StaticOrder S_; S_.init(68, 7, G, bx);
                EpiInA E{QA, KA, VA, Z, args.in[10] + li * 64, args.in[11] + li * 64, cosA, sinA};
                g8::gemm_phase(lds, g, S_, E);
            }
            PH_END;
            if (EN(3) && PH_ON) { PH_LOCALS
                const int nau = keep ? 544 : 512;
                if (!(PFLAG(1))) {
                    CvtBg bg; bg.init(args.in[28], args.in[30], WGU, WDN, 0, layer == 0 ? 1 : 0, vcu, wave >= 4 ? wave - 4 : 0x40000000, 4); CVT_HEAD;
                    for (int u = vcu; u < nau; u += G) wattn_unit(lds, u, QA, KA, VA, args.in[12] + li * 8, MIX, bg);
                    CVT_TAIL(bg);
                }
                if (!(PFLAG(2))) {
                    const float* dww = args.in[13] + (size_t)li * 31 * 512; const float* dwb = args.in[14] + li * 512; const float* lng = args.in[15] + li * 512; const float* lnb = args.in[16] + li * 512;
                    conv_strip<64>(lds, (vcu >> 6) * S, S, (vcu & 63) * 64, Z, dww, dwb, lng, lnb, MIX);
                    if (keep) conv_strip<4>(lds, NL + (vcu >> 6) * CL, CL, (vcu & 63) * 4, Z, dww, dwb, lng, lnb, MIX);
                }
            }
            PH_END;
            if (EN(4) && PH_ON) { PH_LOCALS
                g8::GemmP g{MIX, D, WOUTA + (size_t)li * 1024 * 1024, 1024}; g8::StaticOrder S_; S_.init(64, 4, G, bx);
                EpiResid E{X, layer == 0 ? x_in : X, layer == 0 ? ctx_in : X + (size_t)NL * D, ML + 2048, SSX};
                g8::gemm_phase(lds, g, S_, E);
                if (keep) ctx_minigemm(lds, MIX, WOUTA + (size_t)li * 1024 * 1024, X, layer == 0 ? ctx_in : X + (size_t)NL * D, ML + 2048, SSX, bx);
            }
            PH_END;
        } else {
            if (EN(5) && PH_ON) { PH_LOCALS
                g8::GemmP g{H, D, WINC + (size_t)li * 1280 * 1024, 1024}; g8::StaticOrder S_; S_.init(68, 5, G, bx);
                EpiP E{P, SSP, KC, args.in[24] + li * 32, cosC, sinC};
                g8::gemm_phase(lds, g, S_, E);
            }
            PH_END;
            if (EN(7) && PH_ON) { PH_LOCALS
#ifndef MK_O3
#define MK_O3 3
#endif
                if ((MK_O3 & 1) && !(PFLAG(16))) { g8::GemmP g{P, PP, WQB + (size_t)li * 1536 * 768, 768}; g8::StaticOrder S_; S_.init(nrt, 6, G, bx); EpiBf16 E{QC, 1536, 1536}; g8::gemm_phase(lds, g, S_, E); }
                if ((MK_O3 & 2) && !(PFLAG(32))) { g8::GemmP g{P + 768, PP, WKVB + (size_t)li * 2048 * 256, 256}; g8::StaticOrder S_; S_.init(68, 8, G, (bx + 104) & 255);         EpiKV E{KC, VC, SSP, args.in[23] + li * 64}; g8::gemm_phase(lds, g, S_, E); }
            }
            PH_END;
            if (EN(8) && PH_ON) { PH_LOCALS
                const int nau = keep ? 1088 : 1024;
                CvtBg bg; bg.init(args.in[28], args.in[30], WGU, WDN, layer, (PFLAG(8)) ? 0 : ((layer == 1) ? 2 : 1), vcu, wave >= 4 ? wave - 4 : 0x40000000, 4); CVT_HEAD;
#if defined(MK_XP) && MK_XP != 0
                if (PFLAG(64)) { for (int u = vcu; u < nau; u += G) mla_unit<MK_XP>(lds, u, QC, KC, VC, SSP, args.in[22] + li * 96, cosC, sinC, MIX, bg); } else
#endif
                for (int u = vcu; u < nau; u += G) mla_unit(lds, u, QC, KC, VC, SSP, args.in[22] + li * 96, cosC, sinC, MIX, bg);
                CVT_TAIL(bg);
            }
            PH_END;
            if (EN(9) && PH_ON) { PH_LOCALS
                g8::GemmP g{MIX, D, WOUTC + (size_t)li * 1024 * 1024, 1024}; g8::StaticOrder S_; S_.init(64, 4, G, bx);
                EpiResid E{X, X, X + (size_t)NL * D, ML + 2048, SSX};
                g8::gemm_phase(lds, g, S_, E);
                if (keep) ctx_minigemm(lds, MIX, WOUTC + (size_t)li * 1024 * 1024, X, X + (size_t)NL * D, ML + 2048, SSX, bx);
            }
            PH_END;
        }
        if (EN(10) && PH_ON) { PH_LOCALS
            LAS int* cntL = (LAS int*)(lds + LDS_TAB); LAS int* baseL = cntL + 32; LAS int* pend = (LAS int*)(lds + LDS_IDX + 10240);
            if (tid < 32) cntL[tid] = 0;
            router_load_table(lds, WR + (size_t)layer * 2 * 32 * 1024, tid);
            __syncthreads();
            int g = -1;
            if (wave < 4) g = bx * 4 + wave; else if (wave == 4 && keep && bx < 64) g = 1024 + bx;
            if (g >= 0) router_group(lds, g, wave, lane, X, SSX, norm_ffn_g + layer * D, ML + (size_t)(g < 1024 ? (g >> 8) : 4) * 6144, args.in[27] + layer * 32, F, GATE);
            __syncthreads();
            if (tid < 32) baseL[tid] = (PFLAG(4)) ? 0 : atomicAdd(CNT + (layer * 32 + tid) * 64, cntL[tid])    ;
            __syncthreads();
            if (tid < 320) { const int wv = tid >> 6; const bool has = (wv < 4) || (wv == 4 && keep && bx < 64);
                if (has) { const int pe = pend[tid], slot = pe & 0x1ffff, e = (pe >> 17) & 31, rl = pe >> 22; LIST[(size_t)e * T + baseL[e] + rl] = slot; } }
            __syncthreads();
        }
        PH_END;
        if (EN(11) && PH_ON) { PH_LOCALS
            moe_setup<8>(lds, CNT + layer * 32 * 64, LIST, layer, vcu, G);
            g8::GemmP g{F, D, WGU, 1024}; g8::MoeOrder<true> S_{(const LAS int*)(lds + LDS_TAB), (const LAS int*)(lds + LDS_IDX)};
            EpiGU E{ACT, args.in[29] + (size_t)layer * 32 * 2048};
            g8::gemm_phase(lds, g, S_, E);
        }
        PH_END;
        if (EN(12) && PH_ON) { PH_LOCALS
            moe_setup<4>(lds, CNT + layer * 32 * 64, LIST, layer, vcu, G);
            g8::GemmP g{ACT, 1024, WDN, 1024}; g8::MoeOrder<false> S_{(const LAS int*)(lds + LDS_TAB), (const LAS int*)(lds + LDS_IDX)};
            EpiDown E{YB, args.in[31] + (size_t)layer * 32 * 1024, GATE, (const LAS int*)(lds + LDS_IDX)};
            g8::gemm_phase(lds, g, S_, E);
        }
        PH_END;
        if (EN(13) && PH_ON) { PH_LOCALS
            const int nrows = keep ? T : NL;
            for (int row = gw; row < nrows; row += NGW)
                combine_row(row, lane, X, YB, ML, norm_mix_g + (layer + 1 < 4 ? layer + 1 : 0) * D, MOD + (size_t)(layer + 1 < 4 ? layer + 1 : 0) * 5 * 6144, layer < 3 ? H : nullptr, layer < 3 ? nullptr : args.out);
        }
        PH_END;
    }
#undef PH_ON
#undef PH_END
}
}

#ifndef MK_MULTI
#define MK_MULTI 0
#endif
#ifndef MK_DEBUG
#define MK_DEBUG 0
#endif
#if MK_DEBUG
namespace dbg {
__global__ void k_cmp_bf(const unsigned short* a, int lda, const float* b, int ldb, int rows, int cols, float s, float* acc, int cp) {
    float d2 = 0.f, r2 = 0.f;
    for (size_t i = (size_t)blockIdx.x * blockDim.x + threadIdx.x; i < (size_t)rows * cols; i += (size_t)gridDim.x * blockDim.x) {
        const size_t r = i / cols, c = i % cols; const float av = __uint_as_float(((unsigned)a[r * lda + c]) << 16), bv = s * b[r * ldb + c]; d2 += (av - bv) * (av - bv); r2 += bv * bv; }
    for (int o = 32; o >= 1; o >>= 1) { d2 += __shfl_xor(d2, o); r2 += __shfl_xor(r2, o); }
    if ((threadIdx.x & 63) == 0) { atomicAdd(acc + 2 * cp, d2); atomicAdd(acc + 2 * cp + 1, r2); }
}
__global__ void k_cmp_f(const float* a, const float* b, size_t n, float* acc, int cp) {
    float d2 = 0.f, r2 = 0.f;
    for (size_t i = (size_t)blockIdx.x * blockDim.x + threadIdx.x; i < n; i += (size_t)gridDim.x * blockDim.x) { const float av = a[i], bv = b[i]; d2 += (av - bv) * (av - bv); r2 += bv * bv; }
    for (int o = 32; o >= 1; o >>= 1) { d2 += __shfl_xor(d2, o); r2 += __shfl_xor(r2, o); }
    if ((threadIdx.x & 63) == 0) { atomicAdd(acc + 2 * cp, d2); atomicAdd(acc + 2 * cp + 1, r2); }
}
__global__ void k_report(const float* acc, int ncp, float thr, float* out) {
    if (blockIdx.x == 0 && threadIdx.x == 0) { int bad = -1; for (int i = 0; i < ncp; ++i) { const float d = acc[2 * i], r = acc[2 * i + 1]; if (!(d <= thr * r)) { bad = i; break; } }
        if (bad >= 0) out[0] += 100.f * (float)(bad + 1); }
}
}
#endif

extern "C" void kernel_launch(void* const* d_in, const int* in_sizes, int n_in, void* d_out, int out_size, void* d_ws, size_t ws_size, hipStream_t stream) {
    using namespace mk;
    static int grid = 0;
    if (grid == 0) {
        int dev = 0, cus = 0, per_cu = 0;
        if (hipGetDevice(&dev) != hipSuccess || hipDeviceGetAttribute(&cus, hipDeviceAttributeMultiprocessorCount, dev) != hipSuccess) { fprintf(stderr, "kernel_launch: device query failed\n"); grid = -1; return; }
        if (hipFuncSetAttribute((const void*)mega, hipFuncAttributeMaxDynamicSharedMemorySize, LDS_BYTES) != hipSuccess) { fprintf(stderr, "kernel_launch: hipFuncSetAttribute(%d B LDS) failed\n", LDS_BYTES); grid = -1; return; }
        if (hipOccupancyMaxActiveBlocksPerMultiprocessor(&per_cu, (const void*)mega, NTHR, LDS_BYTES) != hipSuccess || per_cu < 1) fprintf(stderr, "kernel_launch: occupancy query reports %d blocks per CU\n", per_cu);
        (void)hipGetLastError();
        grid = 256;
        if (cus < 256) { fprintf(stderr, "kernel_launch: %d CUs < 256: the persistent grid would not be resident; nothing launched\n", cus); grid = -1; return; }
        if (n_in != 32 || ws_size < WS_END) { fprintf(stderr, "kernel_launch: n_in %d ws %zu (need %zu)\n", n_in, ws_size, (size_t)WS_END); grid = -1; return; }
    }
    if (grid < 0) return;
    (void)hipMemsetAsync((char*)d_ws + WS_CTL, 0, CTL_BYTES, stream);
    Args a{};
    for (int i = 0; i < 32; ++i) a.in[i] = (const float*)d_in[i];
    a.out = (float*)d_out; a.ws = (unsigned char*)d_ws;
#if !MK_DEBUG
#if MK_MULTI
    for (int p = 0; p < N_PHASES; ++p) { a.lo = p; a.hi = p + 1; hipLaunchKernelGGL(mega, dim3(grid), dim3(NTHR), LDS_BYTES, stream, a); }
#else
    a.lo = 0; a.hi = N_PHASES; hipLaunchKernelGGL(mega, dim3(grid), dim3(NTHR), LDS_BYTES, stream, a);
#ifdef MK_PROBE_PH
    for (int r = 0; r < MK_PROBE_N; ++r) { a.lo = MK_PROBE_PH; a.hi = MK_PROBE_PH + 1; a.flags = MK_PROBE_FLAGS; hipLaunchKernelGGL(mega, dim3(grid), dim3(NTHR), LDS_BYTES, stream, a); }
#endif
#endif
    { const hipError_t le = hipPeekAtLastError(); if (le != hipSuccess) fprintf(stderr, "kernel_launch: launch failed: %s\n", hipGetErrorName(le)); }
#else
#endif
}
```

```cpp
#include <hip/hip_runtime.h>
#include <cstdio>
#include <cstdint>
#define MK_MULTI 0
#define MK_DEBUG 0
#define MK_DBG_THR 1e-3f
namespace mk {
#define LAS __attribute__((address_space(3)))
#define GAS __attribute__((address_space(1)))
typedef unsigned short bf16;
typedef short bf16x8 __attribute__((ext_vector_type(8)));
typedef short s16x4 __attribute__((ext_vector_type(4)));
typedef float f32x2 __attribute__((ext_vector_type(2)));
typedef float f32x4 __attribute__((ext_vector_type(4)));
typedef float f32x16 __attribute__((ext_vector_type(16)));
typedef unsigned u32x2 __attribute__((ext_vector_type(2)));
typedef unsigned u32x4 __attribute__((ext_vector_type(4)));

constexpr int D = 1024, NBATCH = 4, S = 4096, CL = 256, NL = NBATCH * S, NC = NBATCH * CL, T = NL + NC;
constexpr int NWAVES = 8, NTHR = 512;
constexpr float EPS = 1e-6f;
constexpr float LOG2E = 1.4426950408889634f;
constexpr float QSCALE_A = 0.125f * LOG2E;
constexpr float QSCALE_C = 0.10206207261596575f * LOG2E;

constexpr size_t al256(size_t x) { return (x + 255) & ~(size_t)255; }
constexpr size_t CTL_BYTES = 65536;
constexpr int CW_BAR = 1024, CW_CNT = 8192;
constexpr size_t WS_CTL = 0;
constexpr size_t WS_MOD = WS_CTL + CTL_BYTES;
constexpr size_t WS_COSA = WS_MOD + al256((size_t)4 * 5 * 6144 * 4);
constexpr size_t WS_SINA = WS_COSA + 4096 * 32 * 4;
constexpr size_t WS_COSC = WS_SINA + 4096 * 32 * 4;
constexpr size_t WS_SINC = WS_COSC + 4096 * 16 * 4;
constexpr size_t WS_WR = WS_SINC + 4096 * 16 * 4;
constexpr size_t WS_WINA = WS_WR + (size_t)4 * 2 * 32 * 1024 * 2;
constexpr size_t WS_WOUTA = WS_WINA + (size_t)2 * 1792 * 1024 * 2;
constexpr size_t WS_WINC = WS_WOUTA + (size_t)2 * 1024 * 1024 * 2;
constexpr size_t WS_WQB = WS_WINC + (size_t)2 * 1280 * 1024 * 2;
constexpr size_t WS_WKVB = WS_WQB + (size_t)2 * 1536 * 768 * 2;
constexpr size_t WS_WOUTC = WS_WKVB + (size_t)2 * 2048 * 256 * 2;
constexpr size_t WS_WGU = WS_WOUTC + (size_t)2 * 1024 * 1024 * 2;
constexpr size_t WS_WDN = WS_WGU + (size_t)128 * 2048 * 1024 * 2;
constexpr size_t WS_X = WS_WDN + (size_t)128 * 1024 * 1024 * 2;
constexpr size_t WS_H = WS_X + (size_t)T * D * 4;
constexpr size_t WS_QA = WS_H + (size_t)T * D * 2;
constexpr size_t WS_KA = WS_QA + (size_t)T * 512 * 2;
constexpr size_t WS_VA = WS_KA + (size_t)T * 128 * 2;
constexpr size_t WS_Z = WS_VA + (size_t)T * 128 * 2;
constexpr size_t WS_P = WS_Z + (size_t)T * 512 * 2;
constexpr int PP = 1056;
constexpr size_t WS_RS = WS_P + (size_t)T * PP * 2;
constexpr size_t WS_QC = WS_RS + (size_t)T * 2 * 4;
constexpr size_t WS_KC = WS_QC + (size_t)T * 1536 * 2;
constexpr size_t WS_VC = WS_KC + (size_t)T * 1536 * 2;
constexpr size_t WS_MIX = WS_VC + (size_t)T * 1024 * 2;
constexpr size_t WS_F = WS_MIX + (size_t)T * 1024 * 2;
constexpr size_t WS_GATE = WS_F + (size_t)T * 1024 * 2;
constexpr size_t WS_LIST = WS_GATE + (size_t)T * 4 * 4;
constexpr int ACT_ROWS = 304 * 256;
constexpr size_t WS_ACT = WS_LIST + (size_t)32 * T * 4;
constexpr size_t WS_YB = WS_ACT + (size_t)ACT_ROWS * 1024 * 2;
constexpr size_t WS_SSX = WS_YB + (size_t)T * 4 * 1024 * 2;
constexpr size_t WS_SSP = WS_SSX + (size_t)T * 16 * 4;
constexpr size_t WS_END = WS_SSP + (size_t)T * 16 * 4;

constexpr int STAGE_BYTES = 131072;
constexpr int LDS_IDX = 131072;
constexpr int MAXU = 12;
constexpr int LDS_TAB = LDS_IDX + MAXU * 1024;
constexpr int LDS_MISC = LDS_TAB + 1024;
constexpr int LDS_BYTES = LDS_MISC + 256;
constexpr int CV_HDR = 56320, CV_BUF = 57344;

__device__ __forceinline__ unsigned pk2(float lo, float hi) {
    typedef __bf16 bf2 __attribute__((ext_vector_type(2)));
    return __builtin_bit_cast(unsigned, __builtin_convertvector((f32x2){lo, hi}, bf2));
}
__device__ __forceinline__ float bflo(unsigned u) { return __uint_as_float(u << 16); }
__device__ __forceinline__ float bfhi(unsigned u) { return __uint_as_float(u & 0xffff0000u); }
__device__ __forceinline__ float bf1(bf16 u) { return __uint_as_float(((unsigned)u) << 16); }
__device__ __forceinline__ float fsigm(float v) { return __builtin_amdgcn_rcpf(1.f + __builtin_amdgcn_exp2f(-1.4426950408889634f * v)); }
__device__ __forceinline__ float fsilu(float v) { return v * fsigm(v); }
__device__ __forceinline__ int modrow(int row) { return row < NL ? (row >> 12) : 4; }
#define WS_DPP(v, ctrl) ((v) + __int_as_float(__builtin_amdgcn_update_dpp(0, __float_as_int(v), (ctrl), 0xF, 0xF, false)))
__device__ __forceinline__ float wave_sum(float v) {
    v = WS_DPP(v, 0xB1); v = WS_DPP(v, 0x4E); v = WS_DPP(v, 0x141); v = WS_DPP(v, 0x140);
    v += __shfl_xor(v, 16); v += __shfl_xor(v, 32);
    return v;
}
__device__ __forceinline__ int otid() { int t = threadIdx.x; asm volatile("" : "+v"(t)); return t; }
#define LDS_WAIT() asm volatile("s_waitcnt lgkmcnt(0)" ::: "memory")
#define VM_WAIT() asm volatile("s_waitcnt vmcnt(0)" ::: "memory")

#define XB_TMO      128
#define XB_XCNT(j)  (256  + 64 * (j))
#define XB_XSUB(j)  (1280 + 64 * (j))
#define XB_XGEN(j)  (2304 + 64 * (j))
#define XB_TOP      3328
#define XB_TOPGEN   3392
#define XCD_BAR_WORDS 3456
#define XB_SPIN_CAP (1u << 18)
__device__ __forceinline__ unsigned xb_ld(unsigned* p)              { return __hip_atomic_load(p, __ATOMIC_RELAXED, __HIP_MEMORY_SCOPE_AGENT); }
__device__ __forceinline__ unsigned xb_add(unsigned* p, unsigned v) { return __hip_atomic_fetch_add(p, v, __ATOMIC_RELAXED, __HIP_MEMORY_SCOPE_AGENT); }
__device__ __forceinline__ unsigned xb_xcc_id() { return (unsigned)__builtin_amdgcn_s_getreg((3 << 11) | 20) & 0xFu; }
#define XB_SPIN(cond, bar) do { unsigned _sp = 0; while (cond) { __builtin_amdgcn_s_sleep(1); \
    if ((++_sp & 255u) == 0u) { if (xb_ld(&(bar)[XB_TMO])) break; if (_sp > XB_SPIN_CAP) { atomicAdd(&(bar)[XB_TMO], 1u); break; } } } } while (0)
struct XcdBarrier { unsigned* bar; unsigned x; volatile LAS unsigned* st; };
__device__ __forceinline__ XcdBarrier xcd_barrier_post(unsigned* bar, volatile LAS unsigned* st) {
    XcdBarrier b; b.bar = bar; b.x = xb_xcc_id(); b.st = st;
    if (threadIdx.x == 0) (void)xb_add(&bar[XB_XCNT(b.x)], 1u);
    return b;
}
__device__ __forceinline__ void xcd_barrier_complete(unsigned* bar, unsigned x, unsigned& nloc, unsigned& nx) {
    const unsigned G = gridDim.x * gridDim.y * gridDim.z;
    unsigned sum, cnt, mine, sp = 0u;
    for (;;) {
        sum = 0u; cnt = 0u; mine = 0u;
#pragma unroll
        for (unsigned j = 0; j < 16; ++j) { const unsigned c = xb_ld(&bar[XB_XCNT(j)]); sum += c; cnt += (c > 0u) ? 1u : 0u; mine = (j == x) ? c : mine; }
        if (sum == G) break;
        __builtin_amdgcn_s_sleep(1);
        if ((++sp & 255u) == 0u) { if (xb_ld(&bar[XB_TMO])) break; if (sp > XB_SPIN_CAP) { atomicAdd(&bar[XB_TMO], 1u); break; } }
    }
    nloc = mine > 0u ? mine : 1u; nx = cnt > 0u ? cnt : 1u;
}
__device__ __forceinline__ void xcd_barrier(const XcdBarrier& b) {
    asm volatile("s_waitcnt vmcnt(0)" ::: "memory");
    __syncthreads();
    if (otid() == 0) {
        unsigned* bar = b.bar;
        __builtin_amdgcn_s_waitcnt(0);
        unsigned nloc = b.st[0], nx = b.st[1];
        if (nloc == 0u) { xcd_barrier_complete(bar, b.x, nloc, nx); b.st[0] = nloc; b.st[1] = nx; }
        const unsigned old = xb_add(&bar[XB_XSUB(b.x)], 1u);
        const unsigned gen = old / nloc;
        if (old + 1u == (gen + 1u) * nloc) {
            __builtin_amdgcn_fence(__ATOMIC_RELEASE, "agent");
            asm volatile("s_waitcnt vmcnt(0)" ::: "memory");
            const unsigned og = xb_add(&bar[XB_TOP], 1u);
            const unsigned tg = og / nx;
            if (og + 1u == (tg + 1u) * nx) xb_add(&bar[XB_TOPGEN], 1u);
            else XB_SPIN(xb_ld(&bar[XB_TOPGEN]) == tg, bar);
            __builtin_amdgcn_fence(__ATOMIC_ACQUIRE, "agent");
            xb_add(&bar[XB_XGEN(b.x)], 1u);
            asm volatile("s_waitcnt vmcnt(0)" ::: "memory");
        } else {
            XB_SPIN(xb_ld(&bar[XB_XGEN(b.x)]) == gen, bar);
            __builtin_amdgcn_fence(__ATOMIC_ACQUIRE, "agent");
            asm volatile("s_waitcnt vmcnt(0)" ::: "memory");
        }
    }
    __syncthreads();
}

namespace g8 {
constexpr int BM = 256, BK = 64, HALF = 128, HTB = HALF * BK * 2, NXCD = 8, WGM = 8;
__host__ __device__ __forceinline__ int lds_byte(int r, int c) { const int st = (r >> 4) * 2 + (c >> 5), rr = r & 15, cc = c & 31, ob = rr * 64 + cc * 2; return st * 1024 + (ob ^ (((ob >> 9) & 1) << 5)); }
__host__ __device__ __forceinline__ void stage_rc(int b, int& R, int& C) { const int st = b / 1024, sb = b % 1024, swz = sb ^ (((sb >> 9) & 1) << 5); R = (st >> 1) * 16 + swz / 64; C = (st & 1) * 32 + (swz % 64) / 2; }

struct Unit { int pm, pn, e, nt, gm, slot; };
struct GemmP { const bf16* A; int lda; const bf16* Bt; int K; };

struct StaticOrder {
    static constexpr bool GATHER = false;
    int nM, nN, nwg, G, c;
    __device__ void init(int nM_, int nN_, int G_, int c_) { nM = nM_; nN = nN_; nwg = nM * nN; G = G_; c = c_; }
    __device__ __forceinline__ bool next(int i, Unit& u) const {
        const long L = (long)i * G + c; if (L >= nwg) return false;
        int wgid = (int)L; { const int q = nwg / NXCD, r = nwg % NXCD, xcd = wgid % NXCD, off = wgid / NXCD; wgid = (xcd < r ? xcd * (q + 1) : r * (q + 1) + (xcd - r) * q) + off; }
        const int nig = WGM * nN, gid = wgid / nig, fm = gid * WGM, gsz = (nM - fm) < WGM ? (nM - fm) : WGM;
        u.pm = fm + ((wgid % nig) % gsz); u.pn = (wgid % nig) / gsz; u.e = 0; u.nt = u.pn; u.gm = u.pm; u.slot = 0; return true;
    }
    __device__ __forceinline__ int arow(const Unit& u, int r) const { return u.pm * BM + r; }
};
template <bool GATHER_> struct MoeOrder {
    static constexpr bool GATHER = GATHER_;
    const LAS int* tab; const LAS int* idx;
    __device__ __forceinline__ bool next(int i, Unit& u) const {
        if (i >= tab[127]) return false;
        u.gm = tab[128 + 4 * i]; u.pn = tab[129 + 4 * i]; u.e = tab[130 + 4 * i]; u.nt = tab[131 + 4 * i]; u.slot = i; u.pm = u.gm; return true;
    }
    __device__ __forceinline__ int arow(const Unit& u, int r) const {
        if (GATHER_) { const int s = idx[u.slot * 256 + r]; return s < 0 ? 0 : (s >> 2); }
        return u.gm * BM + r;
    }
};

template <class Epi, class Sched>
__device__ __forceinline__ void gemm_phase(LAS unsigned char* lds, const GemmP g, const Sched& S, const Epi& E) {
    const int tid = otid(), wid = __builtin_amdgcn_readfirstlane(tid >> 6), lane = tid & 63, wr = wid >> 2, wc = wid & 3, fr = lane & 15, fq = lane >> 4;
    const int K = g.K, nt = K / BK;
    int RR[2], CC[2]; unsigned voffB[2], voffA[2];
    const unsigned lda2 = (unsigned)g.lda * 2u;
#pragma unroll
    for (int i = 0; i < 2; ++i) { stage_rc(tid * 16 + i * 8192, RR[i], CC[i]); voffB[i] = (unsigned)(RR[i] * K + CC[i]) * 2u; voffA[i] = (unsigned)RR[i] * lda2 + (unsigned)CC[i] * 2u; }
    const size_t hstepA = (size_t)HALF * lda2, tstepA = 2 * hstepA;
    const size_t kstep = (size_t)(BK * 2);
    const size_t hstepB = (size_t)HALF * K * 2;
    const size_t tstepB = 2 * hstepB;
    const unsigned ldsw = (unsigned)wid * 1024u;
    const int aoff = lds_byte(wr * 64 + fr, fq * 8), boff = lds_byte(wc * 32 + fr, fq * 8);
#define G8_SA(b, h) (((b) * 2 + (h)) * HTB)
#define G8_SB(b, h) ((4 + (b) * 2 + (h)) * HTB)
#define G8_STAGE(bufoff, gbase, voff) do { _Pragma("unroll") for (int _i = 0; _i < 2; ++_i) \
        __builtin_amdgcn_global_load_lds((const unsigned*)((const char*)(gbase) + (voff)[_i]), (LAS unsigned*)(lds + (bufoff) + ldsw + _i * 8192), 16, 0, 0); } while (0)
#define G8_LDA(dst, b, h) do { _Pragma("unroll") for (int m = 0; m < 4; ++m) _Pragma("unroll") for (int k = 0; k < 2; ++k) dst[m][k] = *(const LAS bf16x8*)(lds + G8_SA(b, h) + aoff + m * 2048 + k * 1024); } while (0)
#define G8_LDB(dst, b, h) do { _Pragma("unroll") for (int n = 0; n < 2; ++n) _Pragma("unroll") for (int k = 0; k < 2; ++k) dst[n][k] = *(const LAS bf16x8*)(lds + G8_SB(b, h) + boff + n * 2048 + k * 1024); } while (0)
#define G8_MMA(ai, bj, At, Bt) do { __builtin_amdgcn_s_setprio(1); _Pragma("unroll") for (int m = 0; m < 4; ++m) _Pragma("unroll") for (int n = 0; n < 2; ++n) _Pragma("unroll") for (int k = 0; k < 2; ++k) \
        acc[ai][bj][m][n] = __builtin_amdgcn_mfma_f32_16x16x32_bf16(Bt[n][k], At[m][k], acc[ai][bj][m][n], 0, 0, 0); __builtin_amdgcn_s_setprio(0); } while (0)
#define G8_WAIT_V(n) asm volatile("s_waitcnt vmcnt(" #n ")" ::: "memory")
#define G8_WAIT_L(n) asm volatile("s_waitcnt lgkmcnt(" #n ")" ::: "memory")
#define G8_BAR __builtin_amdgcn_s_barrier()
#define G8_SCHED __builtin_amdgcn_sched_barrier(0)
#define G8_MKOFF(u, o) do { if constexpr (Sched::GATHER) { _Pragma("unroll") for (int _i = 0; _i < 2; ++_i) { int _R, _C; stage_rc(tid * 16 + _i * 8192, _R, _C); \
        _Pragma("unroll") for (int _h = 0; _h < 2; ++_h) o[_h][_i] = (unsigned)S.arow(u, _h * HALF + _R) * lda2 + (unsigned)_C * 2u; } } } while (0)
#define G8_STAGE_A(bufoff, kofs, h, usenext) do { if constexpr (Sched::GATHER) { unsigned _o[2]; _o[0] = (usenext) ? no[h][0] : co[h][0]; _o[1] = (usenext) ? no[h][1] : co[h][1]; G8_STAGE(bufoff, Ab + (kofs), _o); } \
        else { const char* _p = ((usenext) ? nAp : cAp) + (size_t)(h) * hstepA + (kofs); G8_STAGE(bufoff, _p, voffA); } } while (0)
    Unit cur, nxt; int ui = 0;
    if (!S.next(0, cur)) return;
    f32x4 acc[2][2][4][2];
#pragma unroll
    for (int a = 0; a < 2; ++a)
#pragma unroll
        for (int b = 0; b < 2; ++b)
#pragma unroll
            for (int m = 0; m < 4; ++m)
#pragma unroll
                for (int n = 0; n < 2; ++n) acc[a][b][m][n] = (f32x4){0.f, 0.f, 0.f, 0.f};
    bf16x8 At[4][2], B0[2][2], B1[2][2];
    unsigned co[2][2], no[2][2];
    G8_MKOFF(cur, co);
    if (Sched::GATHER) { G8_WAIT_L(0); }
    const char* Ab = (const char*)g.A;
    const char* cAp = Ab + (size_t)cur.pm * tstepA; const char* nAp = cAp;
    const char* cB = (const char*)g.Bt + (size_t)cur.pn * tstepB;
    G8_STAGE(G8_SB(0, 0), cB, voffB); G8_STAGE(G8_SB(0, 1), cB + hstepB, voffB); G8_STAGE_A(G8_SA(0, 0), 0, 0, false); G8_STAGE_A(G8_SA(0, 1), 0, 1, false);
    if (wr == 1) G8_BAR;
    G8_WAIT_V(2); G8_BAR;
    G8_STAGE(G8_SB(1, 0), cB + kstep, voffB); G8_STAGE_A(G8_SA(1, 0), kstep, 0, false); G8_STAGE(G8_SB(1, 1), cB + hstepB + kstep, voffB);
    G8_WAIT_V(6); G8_BAR;
    for (;;) {
        const bool has_next = S.next(ui + 1, nxt);
        if (has_next) { G8_MKOFF(nxt, no); if (Sched::GATHER) { G8_WAIT_L(0); } nAp = Ab + (size_t)nxt.pm * tstepA; }
        else {
            nAp = cAp;
            if constexpr (Sched::GATHER) {
#pragma unroll
                for (int h = 0; h < 2; ++h)
#pragma unroll
                    for (int i = 0; i < 2; ++i) no[h][i] = co[h][i];
            }
        }
        G8_SCHED;
        const char* nB = has_next ? (const char*)g.Bt + (size_t)nxt.pn * tstepB : cB;
#pragma unroll 1
        for (int t = 0; t < nt; t += 2) {
            const bool last = (t == nt - 2);
            const size_t k1 = (size_t)(t + 1) * kstep, k2 = last ? 0 : (size_t)(t + 2) * kstep, k3 = k2 + kstep;
            const char* b2 = last ? nB : cB + (size_t)(t + 2) * kstep; const char* b3 = b2 + kstep;
            G8_LDB(B0, 0, 0); G8_LDB(B1, 0, 1); G8_SCHED; G8_LDA(At, 0, 0); G8_STAGE_A(G8_SA(1, 1), k1, 1, false);
            G8_WAIT_V(8); G8_WAIT_L(0); G8_BAR; G8_MMA(0, 0, At, B0); G8_MMA(0, 1, At, B1); G8_BAR; G8_SCHED;
            G8_LDA(At, 0, 1); G8_STAGE(G8_SB(0, 0), b2, voffB); G8_STAGE(G8_SB(0, 1), b2 + hstepB, voffB); G8_STAGE_A(G8_SA(0, 0), k2, 0, last);
            G8_WAIT_V(8); G8_WAIT_L(0); G8_BAR; G8_MMA(1, 0, At, B0); G8_MMA(1, 1, At, B1); G8_BAR; G8_SCHED;
            G8_LDB(B0, 1, 0); G8_LDB(B1, 1, 1); G8_SCHED; G8_LDA(At, 1, 0); G8_STAGE_A(G8_SA(0, 1), k2, 1, last);
            G8_WAIT_V(8); G8_WAIT_L(0); G8_BAR; G8_MMA(0, 0, At, B0); G8_MMA(0, 1, At, B1); G8_BAR; G8_SCHED;
            G8_LDA(At, 1, 1); G8_STAGE(G8_SB(1, 0), b3, voffB); G8_STAGE(G8_SB(1, 1), b3 + hstepB, voffB); G8_STAGE_A(G8_SA(1, 0), k3, 0, last);
            G8_WAIT_V(8); G8_WAIT_L(0); G8_BAR; G8_MMA(1, 0, At, B0); G8_MMA(1, 1, At, B1); G8_BAR; G8_SCHED;
        }
        if (wr == 0) G8_BAR;
        E(acc, cur, wr, wc, fr, fq, lds);
        if (!has_next) break;
#pragma unroll
        for (int a = 0; a < 2; ++a)
#pragma unroll
            for (int b = 0; b < 2; ++b)
#pragma unroll
                for (int m = 0; m < 4; ++m)
#pragma unroll
                    for (int n = 0; n < 2; ++n) acc[a][b][m][n] = (f32x4){0.f, 0.f, 0.f, 0.f};
        cur = nxt; cB = nB; cAp = nAp; ++ui;
        if constexpr (Sched::GATHER) {
#pragma unroll
            for (int h = 0; h < 2; ++h)
#pragma unroll
                for (int i = 0; i < 2; ++i) co[h][i] = no[h][i];
        }
        if (wr == 1) G8_BAR;
    }
    G8_WAIT_V(0);
    G8_BAR;
#undef G8_SA
#undef G8_SB
#undef G8_STAGE
#undef G8_LDA
#undef G8_LDB
#undef G8_MMA
#undef G8_WAIT_V
#undef G8_WAIT_L
#undef G8_BAR
#undef G8_SCHED
#undef G8_MKOFF
#undef G8_STAGE_A
}
}

using g8::Unit;
typedef f32x4 Acc[2][2][4][2];
__device__ __forceinline__ u32x4 pack8(const f32x4 a, const f32x4 b) { u32x4 w; w.x = pk2(a[0], a[1]); w.y = pk2(a[2], a[3]); w.z = pk2(b[0], b[1]); w.w = pk2(b[2], b[3]); return w; }

struct EpiInA {
    bf16 *Qa, *Ka, *Va, *Z; const float *qg, *kg, *cosA, *sinA;
    __device__ __forceinline__ void operator()(const Acc& acc, const Unit& u, int wr, int wc, int fr, int fq, LAS unsigned char*) const {
        const int row0 = u.pm * 256 + wr * 64 + fr, pn = u.pn, a = fq >> 1, b = fq & 1;
        if (pn < 3) {
            const bool isv = (pn == 2 && wc >= 2), isq = pn < 2;
            const int dbase = 32 * a + 8 * b;
            if (isv) {
#pragma unroll
                for (int ai = 0; ai < 2; ++ai)
#pragma unroll
                    for (int m = 0; m < 4; ++m) { const int row = row0 + ai * 128 + m * 16; bf16* o = Va + (size_t)row * 128 + (wc - 2) * 64 + dbase;
#pragma unroll
                        for (int bj = 0; bj < 2; ++bj) *(u32x4*)(o + 16 * bj) = pack8(acc[ai][bj][m][0], acc[ai][bj][m][1]); }
                return;
            }
            const float* g = isq ? qg : kg;
            f32x4 gv[2][2];
#pragma unroll
            for (int bj = 0; bj < 2; ++bj)
#pragma unroll
                for (int n = 0; n < 2; ++n) gv[bj][n] = *(const f32x4*)(g + dbase + 16 * bj + 4 * n);
            const float sc = isq ? QSCALE_A : 1.f;
            bf16* obase = isq ? (Qa + (pn * 4 + wc) * 64 + dbase) : (Ka + wc * 64 + dbase);
            const int opitch = isq ? 512 : 128;
            f32x4 cc[2], sn[2], cn[2], snn[2];
            { const int t = row0 & 4095;
#pragma unroll
              for (int n = 0; n < 2; ++n) { cc[n] = *(const f32x4*)(cosA + t * 32 + 16 * a + 8 * b + 4 * n); sn[n] = *(const f32x4*)(sinA + t * 32 + 16 * a + 8 * b + 4 * n); } }
#pragma unroll
            for (int gidx = 0; gidx < 8; ++gidx) {
                    const int ai = gidx >> 2, m = gidx & 3;
                    const int row = row0 + ai * 128 + m * 16;
                    if (gidx < 7) { const int tn = (row0 + ((gidx + 1) >> 2) * 128 + ((gidx + 1) & 3) * 16) & 4095;
#pragma unroll
                        for (int n = 0; n < 2; ++n) { cn[n] = *(const f32x4*)(cosA + tn * 32 + 16 * a + 8 * b + 4 * n); snn[n] = *(const f32x4*)(sinA + tn * 32 + 16 * a + 8 * b + 4 * n); } }
                    float ss = 0.f;
#pragma unroll
                    for (int bj = 0; bj < 2; ++bj)
#pragma unroll
                        for (int n = 0; n < 2; ++n) { const f32x4 v = acc[ai][bj][m][n]; ss += (v[0] * v[0] + v[1] * v[1]) + (v[2] * v[2] + v[3] * v[3]); }
                    ss += __shfl_xor(ss, 16); ss += __shfl_xor(ss, 32);
                    const float rs = rsqrtf(ss * (1.f / 64.f) + EPS);
                    f32x4 y[2][2];
#pragma unroll
                    for (int bj = 0; bj < 2; ++bj)
#pragma unroll
                        for (int n = 0; n < 2; ++n) y[bj][n] = acc[ai][bj][m][n] * rs * gv[bj][n];
                    if (row < NL) {
#pragma unroll
                        for (int n = 0; n < 2; ++n) { const f32x4 y0 = y[0][n], y1 = y[1][n]; y[0][n] = y0 * cc[n] - y1 * sn[n]; y[1][n] = y1 * cc[n] + y0 * sn[n]; }
                    }
                    bf16* o = obase + (size_t)row * opitch;
#pragma unroll
                    for (int bj = 0; bj < 2; ++bj) *(u32x4*)(o + 16 * bj) = pack8(y[bj][0] * sc, y[bj][1] * sc);
                    asm volatile("" ::: "memory");
#pragma unroll
                    for (int n = 0; n < 2; ++n) { cc[n] = cn[n]; sn[n] = snn[n]; }
            }
        } else {
            const int j0 = 128 * (pn - 3) + 32 * wc + 8 * fq;
#pragma unroll
            for (int ai = 0; ai < 2; ++ai)
#pragma unroll
                for (int m = 0; m < 4; ++m) {
                    const int row = row0 + ai * 128 + m * 16; f32x4 z[2];
#pragma unroll
                    for (int n = 0; n < 2; ++n) { const f32x4 av = acc[ai][0][m][n], gt = acc[ai][1][m][n];
#pragma unroll
                        for (int r = 0; r < 4; ++r) z[n][r] = av[r] * fsigm(gt[r]); }
                    *(u32x4*)(Z + (size_t)row * 512 + j0) = pack8(z[0], z[1]);
                }
        }
    }
};
struct EpiResid {
    float* X; const float* Xlat; const float* Xctx; const float* gmod; float* SSX;
    __device__ __forceinline__ void operator()(const Acc& acc, const Unit& u, int wr, int wc, int fr, int fq, LAS unsigned char*) const {
        const int row0 = u.pm * 256 + wr * 64 + fr; const int mr = u.pm < 64 ? (u.pm >> 4) : 4;
        const float* gp = gmod + (size_t)mr * 6144; const float* src = u.pm < 64 ? Xlat : Xctx - (size_t)NL * D;
        float ssr[2][4];
#pragma unroll
        for (int ai = 0; ai < 2; ++ai)
#pragma unroll
            for (int m = 0; m < 4; ++m) ssr[ai][m] = 0.f;
#pragma unroll
        for (int bj = 0; bj < 2; ++bj) {
            const int c0 = 256 * u.pn + 128 * bj + 32 * wc + 4 * fq;
            const f32x4 g0 = *(const f32x4*)(gp + c0), g1 = *(const f32x4*)(gp + c0 + 16);
#pragma unroll
            for (int ai = 0; ai < 2; ++ai) {
                f32x4 xo[4][2];
#pragma unroll
                for (int m = 0; m < 4; ++m) { const float* xp = src + (size_t)(row0 + ai * 128 + m * 16) * D + c0; xo[m][0] = *(const f32x4*)xp; xo[m][1] = *(const f32x4*)(xp + 16); }
#pragma unroll
                for (int m = 0; m < 4; ++m) { float* op = X + (size_t)(row0 + ai * 128 + m * 16) * D + c0;
                    const f32x4 y0 = xo[m][0] + g0 * acc[ai][bj][m][0], y1 = xo[m][1] + g1 * acc[ai][bj][m][1];
                    *(f32x4*)op = y0; *(f32x4*)(op + 16) = y1;
                    ssr[ai][m] += (y0[0] * y0[0] + y0[1] * y0[1]) + (y0[2] * y0[2] + y0[3] * y0[3]) + (y1[0] * y1[0] + y1[1] * y1[1]) + (y1[2] * y1[2] + y1[3] * y1[3]); }
                asm volatile("" ::: "memory");
            }
        }
#pragma unroll
        for (int ai = 0; ai < 2; ++ai)
#pragma unroll
            for (int m = 0; m < 4; ++m) { float ss = ssr[ai][m]; ss += __shfl_xor(ss, 16); ss += __shfl_xor(ss, 32);
                if (fq == 0) SSX[(size_t)(row0 + ai * 128 + m * 16) * 16 + 4 * u.pn + wc] = ss; }
    }
};
struct EpiBf16 {
    bf16* O; int ldo, ncols;
    __device__ __forceinline__ void operator()(const Acc& acc, const Unit& u, int wr, int wc, int fr, int fq, LAS unsigned char*) const {
        const int row0 = u.pm * 256 + wr * 64 + fr;
#pragma unroll
        for (int bj = 0; bj < 2; ++bj) {
            const int c0 = 256 * u.pn + 128 * bj + 32 * wc + 8 * fq;
            if (c0 < ncols) {
#pragma unroll
                for (int ai = 0; ai < 2; ++ai)
#pragma unroll
                    for (int m = 0; m < 4; ++m) *(u32x4*)(O + (size_t)(row0 + ai * 128 + m * 16) * ldo + c0) = pack8(acc[ai][bj][m][0], acc[ai][bj][m][1]);
            }
        }
    }
};
struct EpiP {
    bf16* P; float* SSP; bf16* Kc; const float* krg; const float* cosC; const float* sinC;
    __device__ __forceinline__ void operator()(const Acc& acc, const Unit& u, int wr, int wc, int fr, int fq, LAS unsigned char*) const {
        const int row0 = u.pm * 256 + wr * 64 + fr;
        if (u.pn < 4) {
#pragma unroll
            for (int ai = 0; ai < 2; ++ai)
#pragma unroll
                for (int m = 0; m < 4; ++m) { const int row = row0 + ai * 128 + m * 16; float ss = 0.f;
#pragma unroll
                    for (int bj = 0; bj < 2; ++bj) { const f32x4 y0 = acc[ai][bj][m][0], y1 = acc[ai][bj][m][1];
                        *(u32x4*)(P + (size_t)row * PP + 256 * u.pn + 128 * bj + 32 * wc + 8 * fq) = pack8(y0, y1);
                        ss += (y0[0] * y0[0] + y0[1] * y0[1]) + (y0[2] * y0[2] + y0[3] * y0[3]) + (y1[0] * y1[0] + y1[1] * y1[1]) + (y1[2] * y1[2] + y1[3] * y1[3]); }
                    ss += __shfl_xor(ss, 16); ss += __shfl_xor(ss, 32);
                    if (fq == 0) SSP[(size_t)row * 16 + 4 * u.pn + wc] = ss; }
        } else if (wc == 0) {
            const f32x4 g0 = *(const f32x4*)(krg + 8 * fq), g1 = *(const f32x4*)(krg + 8 * fq + 4);
#pragma unroll
            for (int ai = 0; ai < 2; ++ai)
#pragma unroll
                for (int m = 0; m < 4; ++m) { const int row = row0 + ai * 128 + m * 16; const f32x4 v0 = acc[ai][0][m][0], v1 = acc[ai][0][m][1];
                    *(u32x4*)(P + (size_t)row * PP + 1024 + 8 * fq) = pack8(v0, v1);
                    float ss = (v0[0] * v0[0] + v0[1] * v0[1]) + (v0[2] * v0[2] + v0[3] * v0[3]) + (v1[0] * v1[0] + v1[1] * v1[1]) + (v1[2] * v1[2] + v1[3] * v1[3]);
                    ss += __shfl_xor(ss, 16); ss += __shfl_xor(ss, 32);
                    const float rk = rsqrtf(ss * (1.f / 32.f) + EPS);
                    f32x4 y0 = v0 * rk * g0, y1 = v1 * rk * g1;
                    const int t = row & 4095, ax = fq >> 1;
                    const f32x4 c0 = *(const f32x4*)(cosC + t * 16 + 8 * ax), c1 = *(const f32x4*)(cosC + t * 16 + 8 * ax + 4), s0 = *(const f32x4*)(sinC + t * 16 + 8 * ax), s1 = *(const f32x4*)(sinC + t * 16 + 8 * ax + 4);
                    f32x4 p0, p1;
#pragma unroll
                    for (int j = 0; j < 4; ++j) { p0[j] = __shfl_xor(y0[j], 16); p1[j] = __shfl_xor(y1[j], 16); }
                    if (row < NL) { if ((fq & 1) == 0) { y0 = y0 * c0 - p0 * s0; y1 = y1 * c1 - p1 * s1; } else { y0 = y0 * c0 + p0 * s0; y1 = y1 * c1 + p1 * s1; } }
                    const u32x4 wv = pack8(y0, y1);
#pragma unroll
                    for (int hd = 0; hd < 16; ++hd) *(u32x4*)(Kc + (size_t)row * 1536 + hd * 96 + 64 + 8 * fq) = wv;
                    asm volatile("" ::: "memory"); }
        }
    }
};
struct EpiKV {
    bf16 *Kc, *Vc; const float* SSP; const float* kg;
    __device__ __forceinline__ void operator()(const Acc& acc, const Unit& u, int wr, int wc, int fr, int fq, LAS unsigned char*) const {
        const int row0 = u.pm * 256 + wr * 64 + fr, head = 2 * u.pn + (wc >> 1), dbase = 8 * fq;
        const bool isk = (wc & 1) == 0;
        float rr[2][4];
#pragma unroll
        for (int ai = 0; ai < 2; ++ai)
#pragma unroll
            for (int m = 0; m < 4; ++m) { const f32x4 pq = *(const f32x4*)(SSP + (size_t)(row0 + ai * 128 + m * 16) * 16 + 12); rr[ai][m] = (pq[0] + pq[1]) + (pq[2] + pq[3]); }
        f32x4 gv[2][2];
#pragma unroll
        for (int bj = 0; bj < 2; ++bj)
#pragma unroll
            for (int n = 0; n < 2; ++n) gv[bj][n] = isk ? *(const f32x4*)(kg + dbase + 32 * bj + 4 * n) : (f32x4){1.f, 1.f, 1.f, 1.f};
#pragma unroll
        for (int ai = 0; ai < 2; ++ai)
#pragma unroll
            for (int m = 0; m < 4; ++m) {
                const int row = row0 + ai * 128 + m * 16; const float r = rsqrtf(rr[ai][m] * (1.f / 256.f) + EPS);
                float f = r;
                if (isk) {
                    float ss = 0.f;
#pragma unroll
                    for (int bj = 0; bj < 2; ++bj)
#pragma unroll
                        for (int n = 0; n < 2; ++n) { const f32x4 v = acc[ai][bj][m][n]; ss += (v[0] * v[0] + v[1] * v[1]) + (v[2] * v[2] + v[3] * v[3]); }
                    ss += __shfl_xor(ss, 16); ss += __shfl_xor(ss, 32);
                    f = r * rsqrtf(r * r * ss * (1.f / 64.f) + EPS);
                }
                bf16* o = isk ? (Kc + (size_t)row * 1536 + head * 96 + dbase) : (Vc + (size_t)row * 1024 + head * 64 + dbase);
#pragma unroll
                for (int bj = 0; bj < 2; ++bj) *(u32x4*)(o + 32 * bj) = pack8(acc[ai][bj][m][0] * f * gv[bj][0], acc[ai][bj][m][1] * f * gv[bj][1]);
            }
    }
};
struct EpiGU {
    bf16* ACT; const float* bgu;
    __device__ __forceinline__ void operator()(const Acc& acc, const Unit& u, int wr, int wc, int fr, int fq, LAS unsigned char*) const {
        const int row0 = u.gm * 256 + wr * 64 + fr, j0 = 128 * u.nt + 32 * wc + 8 * fq;
        const float* bp = bgu + (size_t)u.e * 2048;
        f32x4 bg[2], bu[2];
#pragma unroll
        for (int n = 0; n < 2; ++n) { bg[n] = *(const f32x4*)(bp + j0 + 4 * n); bu[n] = *(const f32x4*)(bp + 1024 + j0 + 4 * n); }
#pragma unroll
        for (int ai = 0; ai < 2; ++ai)
#pragma unroll
            for (int m = 0; m < 4; ++m) {
                f32x4 z[2];
#pragma unroll
                for (int n = 0; n < 2; ++n) { const f32x4 gt = acc[ai][0][m][n] + bg[n], up = acc[ai][1][m][n] + bu[n];
#pragma unroll
                    for (int r = 0; r < 4; ++r) { const float gg = fminf(gt[r], 7.f), uu = fminf(fmaxf(up[r], -7.f), 7.f); z[n][r] = (uu + 1.f) * (gg * fsigm(1.702f * gg)); } }
                *(u32x4*)(ACT + (size_t)(row0 + ai * 128 + m * 16) * 1024 + j0) = pack8(z[0], z[1]);
            }
    }
};
struct EpiDown {
    bf16* YB; const float* bdn; const float* gate; const LAS int* idx;
    __device__ __forceinline__ void operator()(const Acc& acc, const Unit& u, int wr, int wc, int fr, int fq, LAS unsigned char*) const {
        const int r0 = wr * 64 + fr; const float* bp = bdn + (size_t)u.e * 1024;
        f32x4 bv[2][2]; int c0[2];
#pragma unroll
        for (int bj = 0; bj < 2; ++bj) { c0[bj] = 256 * u.nt + 128 * bj + 32 * wc + 8 * fq; bv[bj][0] = *(const f32x4*)(bp + c0[bj]); bv[bj][1] = *(const f32x4*)(bp + c0[bj] + 4); }
#pragma unroll
        for (int ai = 0; ai < 2; ++ai)
#pragma unroll
            for (int m = 0; m < 4; ++m) {
                const int slot = idx[u.slot * 256 + r0 + ai * 128 + m * 16];
                if (slot >= 0) {
                    const float gw = gate[slot]; bf16* o = YB + (size_t)slot * 1024;
#pragma unroll
                    for (int bj = 0; bj < 2; ++bj) *(u32x4*)(o + c0[bj]) = pack8((acc[ai][bj][m][0] + bv[bj][0]) * gw, (acc[ai][bj][m][1] + bv[bj][1]) * gw);
                }
            }
    }
};

enum { LAY_STD = 0, LAY_HEAD = 1, LAY_INA = 2, LAY_GU = 3, LAY_F32 = 4, LAY_HEAD2 = 5 };
template <int LAY> __device__ __forceinline__ int colmap(int pn, int rho) {
    const int bj = rho >> 7, wc = (rho >> 5) & 3, n = (rho >> 4) & 1, fq = (rho >> 2) & 3, reg = rho & 3;
    const int std_c = 128 * bj + 32 * wc + 8 * fq + 4 * n + reg;
    const int head_c = 64 * wc + 32 * (fq >> 1) + 8 * (fq & 1) + 16 * bj + 4 * n + reg;
    if (LAY == LAY_STD) return 256 * pn + std_c;
    if (LAY == LAY_F32) return 256 * pn + rho;
    if (LAY == LAY_HEAD) return 256 * pn + head_c;
    if (LAY == LAY_HEAD2) return 256 * pn + 64 * wc + 32 * bj + 8 * fq + 4 * n + reg;
    if (LAY == LAY_INA) return pn < 3 ? 256 * pn + head_c : 768 + (bj ? 512 : 0) + 128 * (pn - 3) + 32 * wc + 8 * fq + 4 * n + reg;
    return (bj ? 1024 : 0) + 128 * pn + 32 * wc + 8 * fq + 4 * n + reg;
}
template <int LAY>
__device__ __forceinline__ void cvt_matrix(const float* src, size_t mat_stride, int ld, int nvalid, int K, int tiles_per_mat, int ntiles, bf16* dst, const float* kscale,
                                           LAS float* scr, int it_begin, int it_step, int lane, int it_end = 0x7fffffff) {
    const int kblocks = K / 64; int nitems = ntiles * 8 * kblocks; nitems = nitems < it_end ? nitems : it_end;
    const int gw = it_begin, NGW = it_step;
    const int i = lane & 31, kh = lane >> 5;
    float v[32], vn[32];
#define CVT_LOAD(it_, dstv) do { const int _kb = (it_) % kblocks, _tg = (it_) / kblocks, _grp = _tg & 7, _tile = _tg >> 3; \
        const int _mat = _tile / tiles_per_mat, _pn = _tile - _mat * tiles_per_mat; const int _c = colmap<LAY>(_pn, _grp * 32 + i); const bool _ok = _c < nvalid; \
        const float* _s = src + (size_t)_mat * mat_stride + (size_t)(_kb * 64 + kh) * ld + (_ok ? _c : 0); \
        _Pragma("unroll") for (int ii = 0; ii < 32; ++ii) dstv[ii] = _ok ? _s[(size_t)(2 * ii) * ld] : 0.f; } while (0)
    int it = gw;
    if (it < nitems) CVT_LOAD(it, v);
    for (; it < nitems; it += NGW) {
        const int itn = it + NGW;
        if (itn < nitems) CVT_LOAD(itn, vn);
        const int kb = it % kblocks, tg = it / kblocks, grp = tg & 7, tile = tg >> 3;
        if (kscale) {
#pragma unroll
            for (int ii = 0; ii < 32; ++ii) v[ii] *= kscale[kb * 64 + 2 * ii + kh];
        }
#pragma unroll
        for (int ii = 0; ii < 32; ++ii) scr[(2 * ii + kh) * 33 + i] = v[ii];
        LDS_WAIT(); asm volatile("" ::: "memory");
        const int c8 = lane & 7;
#pragma unroll
        for (int j = 0; j < 4; ++j) { const int n = (lane >> 3) + 8 * j; const LAS float* q = scr + (8 * c8) * 33 + n;
            u32x4 o; o.x = pk2(q[0 * 33], q[1 * 33]); o.y = pk2(q[2 * 33], q[3 * 33]); o.z = pk2(q[4 * 33], q[5 * 33]); o.w = pk2(q[6 * 33], q[7 * 33]);
            *(u32x4*)(dst + ((size_t)tile * 256 + grp * 32 + n) * K + kb * 64 + 8 * c8) = o; }
        LDS_WAIT(); asm volatile("" ::: "memory");
#pragma unroll
        for (int ii = 0; ii < 32; ++ii) v[ii] = vn[ii];
    }
#undef CVT_LOAD
}

struct CvtBg {
    const float* wgu; const float* wdn; bf16* dgu; bf16* ddn; int cl0, vcu, j, jend, step, tick;
    __device__ __forceinline__ void init(const float* wgu_, const float* wdn_, bf16* dgu_, bf16* ddn_, int cl0_, int nlay, int vcu_, int j0, int step_) {
        wgu = wgu_; wdn = wdn_; dgu = dgu_; ddn = ddn_; cl0 = cl0_; vcu = vcu_; j = j0; step = step_; jend = nlay * 192; tick = 0; }
    __device__ __forceinline__ void decode(int jj, bool& isgu, int& cl, int& it) const { cl = cl0 + jj / 192; const int r = jj % 192; isgu = r < 128; it = isgu ? vcu * 128 + r : vcu * 64 + (r - 128); }
    __device__ __forceinline__ int issue_dma(int lane, LAS unsigned char* buf) {
        const int jj = __builtin_amdgcn_readfirstlane(j);
        if (jj >= jend) return -1;
        bool isgu; int cl, it; decode(jj, isgu, cl, it);
        const int kb = it & 15, tg = it >> 4, grp = tg & 7, tile = tg >> 3;
        const int kr = lane >> 3, p = lane & 7;
        const float* s; unsigned ld;
        if (isgu) { const int mat = tile >> 3, pn = tile & 7; s = wgu + ((size_t)(cl * 32 + mat) * 1024 + kb * 64) * 2048 + colmap<LAY_GU>(pn, grp * 32); ld = 2048; }
        else { const int mat = tile >> 2, pn = tile & 3; s = wdn + ((size_t)(cl * 32 + mat) * 1024 + kb * 64) * 1024 + colmap<LAY_STD>(pn, grp * 32); ld = 1024; }
        const unsigned rowoff = (unsigned)kr * ld * 4u;
#pragma unroll
        for (int q = 0; q < 8; ++q) { const int cq = p ^ q; const unsigned coff = (unsigned)(8 * (cq & 3) + 4 * (cq >> 2)) * 4u;
            __builtin_amdgcn_global_load_lds((const unsigned*)((const char*)s + (size_t)(8 * q) * ld * 4 + rowoff + coff), (LAS unsigned*)(buf + q * 1024), 16, 0, 2); }
        j = jj + step; return jj;
    }
    __device__ __forceinline__ bf16* dstptr(int jj, int& kb) const { bool isgu; int cl, it; decode(jj, isgu, cl, it); kb = it & 15; const int tg = it >> 4, grp = tg & 7, tile = tg >> 3;
        return isgu ? dgu + ((size_t)(cl * 256 + tile) * 256 + grp * 32) * 1024 : ddn + ((size_t)(cl * 128 + tile) * 256 + grp * 32) * 1024; }
    __device__ __forceinline__ void out_chunk(const LAS unsigned char* buf, bf16* d, int kb, int n, int o) const {
        const LAS float* b = (const LAS float*)(buf + (8 * o) * 128 + (((n >> 2) ^ o) << 4)) + (n & 3);
        u32x4 w; w.x = pk2(b[0], b[32]); w.y = pk2(b[64], b[96]); w.z = pk2(b[128], b[160]); w.w = pk2(b[192], b[224]);
        *(u32x4*)(d + (size_t)n * 1024 + kb * 64 + 8 * o) = w; }
    __device__ __forceinline__ void process_slot(int tid, const LAS unsigned char* lds, int sl) const {
        const LAS int* hdr = (const LAS int*)(lds + CV_HDR);
#pragma unroll
        for (int hf = 0; hf < 2; ++hf) { const int id = tid + 512 * hf, c = id >> 8, jj = hdr[2 * c + sl];
            if (jj >= 0) { int kb; bf16* d = dstptr(jj, kb); out_chunk(lds + CV_BUF + (2 * c + sl) * 8192, d, kb, (id >> 3) & 31, id & 7); } }
    }
    __device__ __forceinline__ void tail_loop(int lane, LAS unsigned char* buf) {
        int a = issue_dma(lane, buf), sl = 0;
        while (a >= 0) {
            const int b = issue_dma(lane, buf + (sl ^ 1) * 8192);
            if (b >= 0) asm volatile("s_waitcnt vmcnt(8)" ::: "memory"); else asm volatile("s_waitcnt vmcnt(0)" ::: "memory");
            int kb; bf16* d = dstptr(a, kb);
#pragma unroll
            for (int x = 0; x < 4; ++x) { const int id = lane + 64 * x; out_chunk(buf + sl * 8192, d, kb, id >> 3, id & 7); }
            asm volatile("s_waitcnt lgkmcnt(0)" ::: "memory");
            a = b; sl ^= 1;
        }
    }
};
struct NoBg { __device__ __forceinline__ void issue(int) {} __device__ __forceinline__ void finish(int) {} };

__device__ __forceinline__ void normmod_store(const f32x4 (&v)[4], float rstd, const float* g, const float* mvec  , int sh_off, int sc_off, bf16* orow, int lane) {
#pragma unroll
    for (int j = 0; j < 4; ++j) { const int c = 4 * lane + 256 * j;
        const f32x4 gg = *(const f32x4*)(g + c), sc = *(const f32x4*)(mvec + sc_off + c), sh = *(const f32x4*)(mvec + sh_off + c);
        const f32x4 y = v[j] * rstd * gg * (sc + 1.f) + sh;
        u32x2 w; w.x = pk2(y[0], y[1]); w.y = pk2(y[2], y[3]); *(u32x2*)(orow + c) = w; }
}

template <int DQK> struct AT {
    static constexpr int CK = DQK / 8, KT = 64 * DQK * 2, VT = 64 * 128, STG = KT + VT, NKS = DQK / 16, NKI = CK / 4;
};
#define MFMA32(a, b, c) __builtin_amdgcn_mfma_f32_32x32x16_bf16((a), (b), (c), 0, 0, 0)
struct TileList { int nloc, row_loc0, kpos_loc0, row_ctx0, ntiles; };
__device__ __forceinline__ float at_max3(float a, float b, float c) { float r; asm("v_max3_f32 %0, %1, %2, %3" : "=v"(r) : "v"(a), "v"(b), "v"(c)); return r; }
template <int DQK, bool MASK, class Bg, int CAD, int XP = 0>
__device__ __forceinline__ void attn_core(LAS unsigned char* lds, const bf16x8 (&qf)[DQK / 16], const TileList tl, const char* Kg, int kpitchB, const char* Vg, int vpitchB,
                                          int qpos, float& m, float& l, f32x16 (&O)[2], Bg& bg) {
    typedef AT<DQK> A;
    const int tid = otid(), lane = tid & 63, h = lane >> 5;
    const int wv = __builtin_amdgcn_readfirstlane(tid >> 6);
    const bool stager = wv < 4;
    unsigned koff[A::NKI], voff;
#pragma unroll
    for (int t = 0; t < A::NKI; ++t) { const int sl_ = 64 * t + lane; int rr, ch;
        if (DQK == 96) { rr = sl_ / 12; const int p = sl_ % 12, rot = (rr >> 2) & 3; ch = p - rot; ch = ch < 0 ? ch + 12 : ch; }
        else { rr = sl_ >> 3; ch = (sl_ & 7) ^ ((rr >> 1) & 7); }
        koff[t] = (unsigned)(rr * kpitchB + ch * 16); }
    voff = (unsigned)((lane >> 3) * vpitchB + (((lane & 7) ^ (4 * ((lane >> 4) & 1))) * 16));
    unsigned kf0, kf4 = 0, kf5 = 0;
    if (DQK == 96) { const int x = 16 * (h + ((lane >> 2) & 3)); kf0 = (unsigned)((lane & 31) * 192 + x); kf4 = kf0 + (x >= 64 ? 128 - 192 : 128); kf5 = kf0 + (x >= 32 ? 160 - 192 : 160); }
    else { const int sw = (lane >> 1) & 7; kf0 = (unsigned)((lane & 31) * 128 + 16 * (h ^ (sw & 1)) + 32 * (sw >> 1)); }
#define AT_KADDR(ks) (DQK == 96 ? ((ks) == 4 ? kf4 : (ks) == 5 ? kf5 : kf0 + 32u * (ks)) : (kf0 ^ (32u * (ks))))
    const unsigned vrow = (unsigned)((((lane & 15) >> 2) + 4 * h) * 128 + 32 * ((lane >> 4) & 1) + 8 * (lane & 3));
    const unsigned vfA = vrow + 64u * ((lane >> 3) & 1), vfB = vrow + 64u * (1 - ((lane >> 3) & 1));
    LAS int* cvh = (LAS int*)(lds + CV_HDR);
    const int cw = wv & 3;
#define AT_ROW0(i) ((i) < tl.nloc ? tl.row_loc0 + 64 * (i) : tl.row_ctx0 + 64 * ((i) - tl.nloc))
#define AT_DMA_K(i) do { const char* _kp = Kg + (size_t)(AT_ROW0(i) + 16 * wv) * kpitchB; LAS unsigned char* _b = lds + ((i) & 1) * A::KT + (A::NKI * wv) * 1024; \
        _Pragma("unroll") for (int t = 0; t < A::NKI; ++t) __builtin_amdgcn_global_load_lds((const unsigned*)(_kp + koff[t]), (LAS unsigned*)(_b + t * 1024), 16, 0, 0); } while (0)
#define AT_DMA_V(i) do { const char* _vp = Vg + (size_t)(AT_ROW0(i) + 16 * wv) * vpitchB; LAS unsigned char* _b = lds + 2 * A::KT + ((i) & 1) * A::VT + (2 * wv) * 1024; \
        _Pragma("unroll") for (int t = 0; t < 2; ++t) __builtin_amdgcn_global_load_lds((const unsigned*)(_vp + (size_t)(8 * t) * vpitchB + voff), (LAS unsigned*)(_b + t * 1024), 16, 0, 0); } while (0)
#define AT_BAR() do { asm volatile("s_waitcnt lgkmcnt(0)" ::: "memory"); if (!(XP & 1)) __builtin_amdgcn_s_barrier(); asm volatile("" ::: "memory"); } while (0)
#define AT_SB() __builtin_amdgcn_sched_barrier(0)
#define AT_TR(dst, ad, off) asm volatile("ds_read_b64_tr_b16 %0, %1 offset:" #off : "=v"(dst) : "v"(ad))
#define AT_VWAIT() asm volatile("s_waitcnt lgkmcnt(0)" : "+v"(vlo[0][0]), "+v"(vlo[0][1]), "+v"(vlo[1][0]), "+v"(vlo[1][1]), "+v"(vhi[0][0]), "+v"(vhi[0][1]), "+v"(vhi[1][0]), "+v"(vhi[1][1]))
#define AT_QK(C0, C1, j) do { if (XP & 16) { C0 = zero16; C1 = zero16; C0[0] = (float)(j); break; } const LAS unsigned char* kt = lds + ((j) & 1) * A::KT; bf16x8 ka[A::NKS][2]; \
        _Pragma("unroll") for (int ks = 0; ks < A::NKS; ++ks) { ka[ks][0] = *(const LAS bf16x8*)(kt + AT_KADDR(ks)); ka[ks][1] = *(const LAS bf16x8*)(kt + AT_KADDR(ks) + 32 * DQK * 2); } \
        C0 = MFMA32(ka[0][0], qf[0], zero16); C1 = MFMA32(ka[0][1], qf[0], zero16); \
        _Pragma("unroll") for (int ks = 1; ks < A::NKS; ++ks) { C0 = MFMA32(ka[ks][0], qf[ks], C0); C1 = MFMA32(ka[ks][1], qf[ks], C1); } } while (0)
#define AT_FSM(P0, P1) do { \
        if (!(XP & 4)) { _Pragma("unroll") for (int r = 0; r < 16; ++r) { P0[r] = __builtin_amdgcn_exp2f(P0[r]); P1[r] = __builtin_amdgcn_exp2f(P1[r]); } } \
        _Pragma("unroll") for (int sp = 0; sp < 2; ++sp) { u32x4 pw; \
            pw.x = pk2(P0[8 * sp + 0], P0[8 * sp + 1]); pw.y = pk2(P0[8 * sp + 2], P0[8 * sp + 3]); pw.z = pk2(P0[8 * sp + 4], P0[8 * sp + 5]); pw.w = pk2(P0[8 * sp + 6], P0[8 * sp + 7]); pp[0][sp] = __builtin_bit_cast(bf16x8, pw); \
            pw.x = pk2(P1[8 * sp + 0], P1[8 * sp + 1]); pw.y = pk2(P1[8 * sp + 2], P1[8 * sp + 3]); pw.z = pk2(P1[8 * sp + 4], P1[8 * sp + 5]); pw.w = pk2(P1[8 * sp + 6], P1[8 * sp + 7]); pp[1][sp] = __builtin_bit_cast(bf16x8, pw); } } while (0)
#define AT_RMAX(C0, C1, j) do { if (XP & 32) { tm = C0[0] - m; break; } \
        if (MASK) { const int k0_ = tl.kpos_loc0 + 64 * (j); if ((j) < tl.nloc && (k0_ + 63 - qw > 128 || qw + 31 - k0_ > 128)) { const int kb = k0_ + 4 * h - qpos;     \
            _Pragma("unroll") for (int r = 0; r < 16; ++r) { const int d0 = kb + (r & 3) + 8 * (r >> 2), d1 = d0 + 32; \
                if (d0 > 128 || d0 < -128) C0[r] = -1e30f; if (d1 > 128 || d1 < -128) C1[r] = -1e30f; } } } \
        tm = at_max3(C0[0], C0[1], C1[0]); tm = at_max3(tm, C1[1], C0[2]); \
        _Pragma("unroll") for (int r = 2; r < 16; r += 2) { if (r > 2) tm = at_max3(tm, C0[r - 1], C0[r]); tm = at_max3(tm, C1[r], C1[r + 1]); } \
        tm = fmaxf(tm, C0[15]); \
        { const auto sw_ = __builtin_amdgcn_permlane32_swap(__builtin_bit_cast(unsigned, tm), __builtin_bit_cast(unsigned, tm), false, false); \
          tm = fmaxf(__builtin_bit_cast(float, sw_[0]), __builtin_bit_cast(float, sw_[1])) - m; } } while (0)
#define AT_RESC(C0, C1) do { \
        if (__builtin_amdgcn_ballot_w64(tm > 8.f) != 0ull) { const float dlt = fmaxf(tm, 0.f), alpha = __builtin_amdgcn_exp2f(-dlt); m += dlt; l *= alpha; \
            _Pragma("unroll") for (int r = 0; r < 16; ++r) { O[0][r] *= alpha; O[1][r] *= alpha; Lacc[r] *= alpha; } } \
        if (__builtin_amdgcn_ballot_w64(m != 0.f) != 0ull) { _Pragma("unroll") for (int r = 0; r < 16; ++r) { C0[r] -= m; C1[r] -= m; } } } while (0)
#define AT_PV(t, MID) do { if (XP & 8) { MID; break; } const unsigned _vb = (unsigned)(size_t)lds + 2 * A::KT + ((t) & 1) * A::VT; const unsigned vta = _vb + vfA, vtb = _vb + vfB; s16x4 vlo[2][2], vhi[2][2]; \
        AT_TR(vlo[0][0], vta, 0); AT_TR(vhi[0][0], vta, 1024); AT_TR(vlo[0][1], vtb, 0); AT_TR(vhi[0][1], vtb, 1024); \
        AT_TR(vlo[1][0], vta, 2048); AT_TR(vhi[1][0], vta, 3072); AT_TR(vlo[1][1], vtb, 2048); AT_TR(vhi[1][1], vtb, 3072); \
        MID; \
        Lacc = MFMA32(ones8, pp[0][0], Lacc); Lacc = MFMA32(ones8, pp[0][1], Lacc); Lacc = MFMA32(ones8, pp[1][0], Lacc); Lacc = MFMA32(ones8, pp[1][1], Lacc); \
        asm volatile("" : "+v"(tm), "+v"(Lacc));              \
        AT_VWAIT(); \
        _Pragma("unroll") for (int sp = 0; sp < 2; ++sp) _Pragma("unroll") for (int dvb = 0; dvb < 2; ++dvb) { \
            const bf16x8 va = __builtin_shufflevector(vlo[sp][dvb], vhi[sp][dvb], 0, 1, 2, 3, 4, 5, 6, 7); O[dvb] = MFMA32(va, pp[0][sp], O[dvb]); } \
        AT_TR(vlo[0][0], vta, 4096); AT_TR(vhi[0][0], vta, 5120); AT_TR(vlo[0][1], vtb, 4096); AT_TR(vhi[0][1], vtb, 5120); \
        AT_TR(vlo[1][0], vta, 6144); AT_TR(vhi[1][0], vta, 7168); AT_TR(vlo[1][1], vtb, 6144); AT_TR(vhi[1][1], vtb, 7168); \
        AT_VWAIT(); \
        _Pragma("unroll") for (int sp = 0; sp < 2; ++sp) _Pragma("unroll") for (int dvb = 0; dvb < 2; ++dvb) { \
            const bf16x8 va = __builtin_shufflevector(vlo[sp][dvb], vhi[sp][dvb], 0, 1, 2, 3, 4, 5, 6, 7); O[dvb] = MFMA32(va, pp[1][sp], O[dvb]); } } while (0)
#define AT_HEAD(j) do { if (stager && !(XP & 2)) { if ((j) + 1 < n) AT_DMA_K((j) + 1); AT_DMA_V(j); } \
        issued = false; \
        if ((bg.tick & 1) == 0) { if (!stager) { const int sl_ = (bg.tick >> 1) & 1; const int jj = bg.issue_dma(lane, lds + CV_BUF + (2 * cw + sl_) * 8192); \
                if (lane == 0) cvh[2 * cw + sl_] = jj; issued = jj >= 0; } } \
        else bg.process_slot(tid, lds, ((bg.tick + 1) >> 1) & 1); } while (0)
#define AT_TAILSYNC() do { if (stager) asm volatile("s_waitcnt vmcnt(0)" ::: "memory"); \
        else if ((bg.tick & 1) == 0) { if (issued) asm volatile("s_waitcnt vmcnt(8)" ::: "memory"); else asm volatile("s_waitcnt vmcnt(0)" ::: "memory"); } \
        ++bg.tick; AT_BAR(); } while (0)
#define AT_QKF(C0, C1, P0, P1, j) do { const LAS unsigned char* kt = lds + ((j) & 1) * A::KT; bf16x8 ka[A::NKS][2]; \
        _Pragma("unroll") for (int ks = 0; ks < A::NKS; ++ks) { ka[ks][0] = *(const LAS bf16x8*)(kt + AT_KADDR(ks)); ka[ks][1] = *(const LAS bf16x8*)(kt + AT_KADDR(ks) + 32 * DQK * 2); } \
        _Pragma("unroll") for (int r = 0; r < 16; ++r) P0[r] = __builtin_amdgcn_exp2f(P0[r]); \
        asm volatile("" : "+v"(ka[0][0]), "+v"(ka[0][1]), "+v"(P0)); \
        C0 = MFMA32(ka[0][0], qf[0], zero16); C1 = MFMA32(ka[0][1], qf[0], zero16); \
        _Pragma("unroll") for (int ks = 1; ks < A::NKS; ++ks) { C0 = MFMA32(ka[ks][0], qf[ks], C0); C1 = MFMA32(ka[ks][1], qf[ks], C1); } \
        _Pragma("unroll") for (int r = 0; r < 16; ++r) P1[r] = __builtin_amdgcn_exp2f(P1[r]); \
        _Pragma("unroll") for (int sp = 0; sp < 2; ++sp) { u32x4 pw; \
            pw.x = pk2(P0[8 * sp + 0], P0[8 * sp + 1]); pw.y = pk2(P0[8 * sp + 2], P0[8 * sp + 3]); pw.z = pk2(P0[8 * sp + 4], P0[8 * sp + 5]); pw.w = pk2(P0[8 * sp + 6], P0[8 * sp + 7]); pp[0][sp] = __builtin_bit_cast(bf16x8, pw); \
            pw.x = pk2(P1[8 * sp + 0], P1[8 * sp + 1]); pw.y = pk2(P1[8 * sp + 2], P1[8 * sp + 3]); pw.z = pk2(P1[8 * sp + 4], P1[8 * sp + 5]); pw.w = pk2(P1[8 * sp + 6], P1[8 * sp + 7]); pp[1][sp] = __builtin_bit_cast(bf16x8, pw); } } while (0)
#define AT_STEP(C0, C1, P0, P1, j) do { AT_HEAD(j); AT_SB(); \
        if (!(XP & 64)) { AT_QK(C0, C1, j); AT_FSM(P0, P1); } else AT_QKF(C0, C1, P0, P1, j); \
        if (MASK) asm volatile("" : "+v"(pp[0][0]), "+v"(pp[0][1]), "+v"(pp[1][0]), "+v"(pp[1][1]));     \
        AT_SB(); \
        AT_PV((j) - 1, AT_RMAX(C0, C1, j)); AT_SB(); \
        AT_RESC(C0, C1); \
        AT_TAILSYNC(); } while (0)
    f32x16 zero16;
#pragma unroll
    for (int r = 0; r < 16; ++r) zero16[r] = 0.f;
    const int n = tl.ntiles;
    const int qw = __builtin_amdgcn_readfirstlane(qpos);
    bool issued; float tm;
    bf16x8 pp[2][2];
    f32x16 A0, A1, B0, B1, Lacc = zero16;
    const bf16x8 ones8 = (bf16x8){0x3F80, 0x3F80, 0x3F80, 0x3F80, 0x3F80, 0x3F80, 0x3F80, 0x3F80};
    if (stager) AT_DMA_K(0);
    asm volatile("s_waitcnt vmcnt(0)" ::: "memory");
    AT_BAR();
    AT_HEAD(0); AT_SB();
    AT_QK(A0, A1, 0); AT_RMAX(A0, A1, 0); AT_RESC(A0, A1);
    AT_TAILSYNC();
    int j = 1;
    for (; j + 1 < n; j += 2) { AT_STEP(B0, B1, A0, A1, j); AT_STEP(A0, A1, B0, B1, j + 1); }
    if (j < n) { AT_STEP(B0, B1, A0, A1, j); AT_FSM(B0, B1); } else { AT_FSM(A0, A1); }
    AT_SB();
    AT_PV(n - 1, (void)0);
    l += 0.5f * Lacc[0];
#undef AT_ROW0
#undef AT_DMA_K
#undef AT_DMA_V
#undef AT_KADDR
#undef AT_BAR
#undef AT_SB
#undef AT_TR
#undef AT_VWAIT
#undef AT_QK
#undef AT_QKF
#undef AT_FSM
#undef AT_RMAX
#undef AT_RESC
#undef AT_PV
#undef AT_HEAD
#undef AT_TAILSYNC
#undef AT_STEP
}
__device__ __forceinline__ void attn_store(const f32x16 (&O)[2], float l, bf16* orow, int h) {
    const float lt = l + __shfl_xor(l, 32); const float inv = 1.f / lt;
#pragma unroll
    for (int dvb = 0; dvb < 2; ++dvb)
#pragma unroll
        for (int g4 = 0; g4 < 4; ++g4) { u32x2 w; w.x = pk2(O[dvb][4 * g4] * inv, O[dvb][4 * g4 + 1] * inv); w.y = pk2(O[dvb][4 * g4 + 2] * inv, O[dvb][4 * g4 + 3] * inv);
            *(u32x2*)(orow + 32 * dvb + 8 * g4 + 4 * h) = w; }
}

__device__ __forceinline__ void wattn_unit(LAS unsigned char* lds, int unit, const bf16* Qa, const bf16* Ka, const bf16* Va, const float* sink, bf16* MIX, CvtBg& bg) {
    const int tid = otid(), w = tid >> 6, lane = tid & 63, h = lane >> 5;
    int b, kvh, hp, tq, qpos; TileList tl;
    if (unit < 512) { b = unit >> 7; kvh = (unit >> 6) & 1; const int nb = (unit >> 1) & 31; hp = unit & 1;
        const int t0 = max(0, 128 * nb - 128), t1 = min(4096, 128 * nb + 256);
        tl.nloc = (t1 - t0) >> 6; tl.row_loc0 = b * S + t0; tl.kpos_loc0 = t0; tl.row_ctx0 = NL + b * CL; tl.ntiles = tl.nloc + 4;
        qpos = 128 * nb + (w & 3) * 32 + (lane & 31); tq = b * S + qpos;
    } else { const int u = unit - 512; b = u >> 3; kvh = (u >> 2) & 1; hp = (u >> 1) & 1; const int half = u & 1;
        tl.nloc = 0; tl.row_loc0 = 0; tl.kpos_loc0 = 0; tl.row_ctx0 = NL + b * CL; tl.ntiles = 4;
        qpos = 0; tq = NL + b * CL + half * 128 + (w & 3) * 32 + (lane & 31); }
    const int hq = kvh * 4 + hp * 2 + (w >> 2);
    bf16x8 qf[4];
#pragma unroll
    for (int ks = 0; ks < 4; ++ks) qf[ks] = *(const bf16x8*)(Qa + (size_t)tq * 512 + hq * 64 + 16 * ks + 8 * h);
    float m = 0.f, l = (h == 0) ? __expf(sink[hq]) : 0.f;
    f32x16 O[2];
#pragma unroll
    for (int r = 0; r < 16; ++r) { O[0][r] = 0.f; O[1][r] = 0.f; }
    attn_core<64, true, CvtBg, 2>(lds, qf, tl, (const char*)(Ka + kvh * 64), 256, (const char*)(Va + kvh * 64), 256, qpos, m, l, O, bg);
    attn_store(O, l, MIX + (size_t)tq * 1024 + hq * 64, h);
}
template <int XP = 0>
__device__ __forceinline__ void mla_unit(LAS unsigned char* lds, int unit, const bf16* Qc, const bf16* Kc, const bf16* Vc, const float* RS, const float* qg,
                                         const float* cosC, const float* sinC, bf16* MIX, CvtBg& bg) {
    const int tid = otid(), w = tid >> 6, lane = tid & 63, h = lane >> 5;
    int b, head, tq; TileList tl; bool lat;
    if (unit < 1024) { b = unit >> 8; head = (unit >> 4) & 15; const int qb = unit & 15; lat = true;
        tl.nloc = 64; tl.row_loc0 = b * S; tl.kpos_loc0 = 0; tl.row_ctx0 = NL + b * CL; tl.ntiles = 68; tq = b * S + qb * 256 + w * 32 + (lane & 31);
    } else { const int u = unit - 1024; b = u >> 4; head = u & 15; lat = false;
        tl.nloc = 0; tl.row_loc0 = 0; tl.kpos_loc0 = 0; tl.row_ctx0 = NL + b * CL; tl.ntiles = 4; tq = NL + b * CL + w * 32 + (lane & 31); }
    float v[6][8]; float ss = 0.f;
    const bf16* qp = Qc + (size_t)tq * 1536 + head * 96 + 8 * h;
#pragma unroll
    for (int ks = 0; ks < 6; ++ks) { const u32x4 raw = *(const u32x4*)(qp + 16 * ks);
        v[ks][0] = bflo(raw.x); v[ks][1] = bfhi(raw.x); v[ks][2] = bflo(raw.y); v[ks][3] = bfhi(raw.y); v[ks][4] = bflo(raw.z); v[ks][5] = bfhi(raw.z); v[ks][6] = bflo(raw.w); v[ks][7] = bfhi(raw.w);
#pragma unroll
        for (int j = 0; j < 8; ++j) ss += v[ks][j] * v[ks][j]; }
    ss += __shfl_xor(ss, 32);
    float r; { const f32x4 p0 = *(const f32x4*)(RS + (size_t)tq * 16), p1 = *(const f32x4*)(RS + (size_t)tq * 16 + 4), p2 = *(const f32x4*)(RS + (size_t)tq * 16 + 8);
      r = rsqrtf((((p0[0] + p0[1]) + (p0[2] + p0[3])) + ((p1[0] + p1[1]) + (p1[2] + p1[3])) + ((p2[0] + p2[1]) + (p2[2] + p2[3]))) * (1.f / 768.f) + EPS); }
    const float inv = r * rsqrtf(r * r * ss * (1.f / 96.f) + EPS);
#pragma unroll
    for (int ks = 0; ks < 6; ++ks) { const f32x4 g0 = *(const f32x4*)(qg + 16 * ks + 8 * h), g1 = *(const f32x4*)(qg + 16 * ks + 8 * h + 4);
#pragma unroll
        for (int j = 0; j < 4; ++j) { v[ks][j] *= inv * g0[j]; v[ks][4 + j] *= inv * g1[j]; } }
    {
        const int t = tq & 4095;
#pragma unroll
        for (int ax = 0; ax < 2; ++ax) {
            const f32x4 c0 = *(const f32x4*)(cosC + t * 16 + 8 * ax), c1 = *(const f32x4*)(cosC + t * 16 + 8 * ax + 4);
            const f32x4 s0 = *(const f32x4*)(sinC + t * 16 + 8 * ax), s1 = *(const f32x4*)(sinC + t * 16 + 8 * ax + 4);
#pragma unroll
            for (int j = 0; j < 8; ++j) { const float y = v[4 + ax][j], po = __shfl_xor(y, 32); const float c = j < 4 ? c0[j & 3] : c1[j & 3], s = j < 4 ? s0[j & 3] : s1[j & 3];
                const float yr = (h == 0) ? (y * c - po * s) : (y * c + po * s); v[4 + ax][j] = lat ? yr : y; }
        }
    }
    bf16x8 qf[6];
#pragma unroll
    for (int ks = 0; ks < 6; ++ks) { u32x4 pw; pw.x = pk2(v[ks][0] * QSCALE_C, v[ks][1] * QSCALE_C); pw.y = pk2(v[ks][2] * QSCALE_C, v[ks][3] * QSCALE_C);
        pw.z = pk2(v[ks][4] * QSCALE_C, v[ks][5] * QSCALE_C); pw.w = pk2(v[ks][6] * QSCALE_C, v[ks][7] * QSCALE_C); qf[ks] = __builtin_bit_cast(bf16x8, pw); }
    float m = 0.f, l = 0.f;
    f32x16 O[2];
#pragma unroll
    for (int rr = 0; rr < 16; ++rr) { O[0][rr] = 0.f; O[1][rr] = 0.f; }
    attn_core<96, false, CvtBg, 4, XP>(lds, qf, tl, (const char*)(Kc + head * 96), 3072, (const char*)(Vc + head * 64), 2048, 0, m, l, O, bg);
    attn_store(O, l, MIX + (size_t)tq * 1024 + head * 64, h);
}

template <int NTOK>
__device__ __forceinline__ void conv_strip(LAS unsigned char* lds, int seq0, int len, int t0, const bf16* Z, const float* dw_w, const float* dw_b, const float* ln_g, const float* ln_b, bf16* MIX) {
    const int tid = otid(), w = tid >> 6, lane = tid & 63;
    constexpr int NROW = NTOK + 30, NCH = NROW * 64, NLD = (NCH + NTHR - 1) / NTHR, NSUB = (NTOK + 15) / 16;
    LAS bf16* zt = (LAS bf16*)lds; LAS float* ot = (LAS float*)(lds + 98304);
    u32x4 st[NLD];
#pragma unroll
    for (int i = 0; i < NLD; ++i) { const int q = tid + i * NTHR, r = q >> 6, cc = q & 63, tt = t0 - 15 + r; st[i] = (u32x4){0u, 0u, 0u, 0u};
        if (q < NCH && tt >= 0 && tt < len) st[i] = *(const u32x4*)(Z + (size_t)(seq0 + tt) * 512 + cc * 8); }
    float wt[31];
#pragma unroll
    for (int j = 0; j < 31; ++j) wt[j] = dw_w[j * 512 + tid];
    const float bias = dw_b[tid];
#pragma unroll
    for (int i = 0; i < NLD; ++i) { const int q = tid + i * NTHR; if (q < NCH) *(LAS u32x4*)(zt + (q >> 6) * 512 + (q & 63) * 8) = st[i]; }
    const f32x4 g0 = *(const f32x4*)(ln_g + 8 * lane), g1 = *(const f32x4*)(ln_g + 8 * lane + 4), b0 = *(const f32x4*)(ln_b + 8 * lane), b1 = *(const f32x4*)(ln_b + 8 * lane + 4);
    __syncthreads();
#pragma unroll 1
    for (int sb = 0; sb < NSUB; ++sb) {
        float acc[16];
#pragma unroll
        for (int t = 0; t < 16; ++t) acc[t] = bias;
        const LAS bf16* zp = zt + sb * 16 * 512 + tid;
        constexpr int NR = (NTOK >= 16 ? 16 : NTOK) + 30;
#pragma unroll
        for (int r = 0; r < NR; ++r) { const float zv = bf1(zp[r * 512]);
#pragma unroll
            for (int t = 0; t < 16; ++t) { const int j = r - t; if (j >= 0 && j < 31 && t < NTOK) acc[t] += zv * wt[j]; } }
#pragma unroll
        for (int t = 0; t < 16; ++t) ot[t * 512 + tid] = acc[t];
        __syncthreads();
#pragma unroll
        for (int q = 0; q < 2; ++q) { const int t = 2 * w + q, tok = sb * 16 + t;
            if (tok < NTOK) {
                const f32x4 x0 = *(const LAS f32x4*)(ot + t * 512 + 8 * lane), x1 = *(const LAS f32x4*)(ot + t * 512 + 8 * lane + 4);
                const float mu = wave_sum((x0[0] + x0[1]) + (x0[2] + x0[3]) + (x1[0] + x1[1]) + (x1[2] + x1[3])) * (1.f / 512.f);
                const f32x4 d0 = x0 - mu, d1 = x1 - mu;
                const float var = wave_sum((d0[0] * d0[0] + d0[1] * d0[1]) + (d0[2] * d0[2] + d0[3] * d0[3]) + (d1[0] * d1[0] + d1[1] * d1[1]) + (d1[2] * d1[2] + d1[3] * d1[3])) * (1.f / 512.f);
                const float rstd = rsqrtf(var + EPS);
                f32x4 y0 = d0 * rstd * g0 + b0, y1 = d1 * rstd * g1 + b1;
#pragma unroll
                for (int j = 0; j < 4; ++j) { y0[j] = fsilu(y0[j]); y1[j] = fsilu(y1[j]); }
                *(u32x4*)(MIX + (size_t)(seq0 + t0 + tok) * 1024 + 512 + 8 * lane) = pack8(y0, y1); } }
        __syncthreads();
    }
}

__device__ __forceinline__ void mla_stats_row(int row, int lane, const bf16* P, const float* krg, const float* cosC, const float* sinC, float* RS, bf16* Kc) {
    const bf16* p = P + (size_t)row * PP;
    const u32x4 a = *(const u32x4*)(p + 8 * lane);
    const u32x4 b = *(const u32x4*)(p + 8 * (lane + 64));
    u32x4 c = (u32x4){0u, 0u, 0u, 0u};
    if (lane < 4) c = *(const u32x4*)(p + 8 * (lane + 128));
    auto sq = [](u32x4 u) { float s = 0.f; s += bflo(u.x) * bflo(u.x) + bfhi(u.x) * bfhi(u.x); s += bflo(u.y) * bflo(u.y) + bfhi(u.y) * bfhi(u.y);
                            s += bflo(u.z) * bflo(u.z) + bfhi(u.z) * bfhi(u.z); s += bflo(u.w) * bflo(u.w) + bfhi(u.w) * bfhi(u.w); return s; };
    const float sa = sq(a), sb = sq(b), sc = sq(c);
    const float ssq = wave_sum(sa + (lane < 32 ? sb : 0.f)), skv = wave_sum(lane >= 32 ? sb : 0.f), skr = wave_sum(sc);
    if (lane == 0) { RS[(size_t)row * 2] = rsqrtf(ssq * (1.f / 768.f) + EPS); RS[(size_t)row * 2 + 1] = rsqrtf(skv * (1.f / 256.f) + EPS); }
    const float rk = rsqrtf(skr * (1.f / 32.f) + EPS);
    float y[8]; const int l4 = lane & 3;
    { const f32x4 g0 = *(const f32x4*)(krg + 8 * l4), g1 = *(const f32x4*)(krg + 8 * l4 + 4);
      y[0] = bflo(c.x) * rk * g0[0]; y[1] = bfhi(c.x) * rk * g0[1]; y[2] = bflo(c.y) * rk * g0[2]; y[3] = bfhi(c.y) * rk * g0[3];
      y[4] = bflo(c.z) * rk * g1[0]; y[5] = bfhi(c.z) * rk * g1[1]; y[6] = bflo(c.w) * rk * g1[2]; y[7] = bfhi(c.w) * rk * g1[3]; }
    const int t = row & 4095, ax = l4 >> 1, half = l4 & 1;
    const f32x4 c0 = *(const f32x4*)(cosC + t * 16 + 8 * ax), c1 = *(const f32x4*)(cosC + t * 16 + 8 * ax + 4), s0 = *(const f32x4*)(sinC + t * 16 + 8 * ax), s1 = *(const f32x4*)(sinC + t * 16 + 8 * ax + 4);
    float o[8];
#pragma unroll
    for (int j = 0; j < 8; ++j) { const float po = __shfl_xor(y[j], 1); const float cc = j < 4 ? c0[j & 3] : c1[j & 3], sn = j < 4 ? s0[j & 3] : s1[j & 3];
        const float yr = half == 0 ? (y[j] * cc - po * sn) : (y[j] * cc + po * sn); o[j] = row < NL ? yr : y[j]; }
    if (lane < 4) { u32x4 wv; wv.x = pk2(o[0], o[1]); wv.y = pk2(o[2], o[3]); wv.z = pk2(o[4], o[5]); wv.w = pk2(o[6], o[7]);
#pragma unroll
        for (int hd = 0; hd < 16; ++hd) *(u32x4*)(Kc + (size_t)row * 1536 + hd * 96 + 64 + 8 * lane) = wv; }
}

template <int NT>
__device__ __forceinline__ void moe_setup(LAS unsigned char* lds, const int* cntG, const int* list, int layer, int vcu, int G) {
    LAS int* tab = (LAS int*)(lds + LDS_TAB); LAS int* idx = (LAS int*)(lds + LDS_IDX);
    const int tid = otid(); constexpr int MG = 32 / NT;
    if (tid < 32) tab[tid] = cntG[tid * 64];
    __syncthreads();
    if (tid == 0) { int acc = 0; for (int e = 0; e < 32; ++e) { tab[32 + e] = acc; acc += (tab[e] + 255) >> 8; } tab[64] = acc;
        int n = 0;
        for (int i = 0; i < MAXU; ++i) { const int v = i * G + vcu, gm = (v >> 5) * MG + (v & 31) / NT, nt = v % NT; if (gm >= acc) break;
            int e = 0; while (e < 31 && tab[33 + e] <= gm) ++e;
            tab[128 + 4 * i] = gm; tab[129 + 4 * i] = (layer * 32 + e) * NT + nt; tab[130 + 4 * i] = e; tab[131 + 4 * i] = nt; n = i + 1; }
        tab[127] = n; }
    __syncthreads();
    const int n = tab[127];
    for (int q = tid; q < n * 256; q += NTHR) { const int i = q >> 8, r = q & 255, gm = tab[128 + 4 * i], e = tab[130 + 4 * i], rr = (gm - tab[32 + e]) * 256 + r;
        idx[q] = rr < tab[e] ? list[(size_t)e * T + rr] : -1; }
    __syncthreads();
}

__device__ __forceinline__ void ctx_minigemm(LAS unsigned char* lds, const bf16* MIX, const bf16* W  , float* X, const float* srcctx  ,
                                             const float* gmod  , float* SSX, int bx) {
    const int tid = otid(), lane = tid & 63, w = __builtin_amdgcn_readfirstlane(tid >> 6), fr = lane & 15, fq = lane >> 4;
    const int tr = bx >> 4, tc = bx & 15;
    const bf16* ap = MIX + (size_t)(NL + 64 * tr + fr) * 1024 + 128 * w + 8 * fq;
    const bf16* bp = W + (size_t)(64 * tc + fr) * 1024 + 128 * w + 8 * fq;
    bf16x8 a[4][4], b[4][4];
#pragma unroll
    for (int t = 0; t < 4; ++t)
#pragma unroll
        for (int ks = 0; ks < 4; ++ks) { a[t][ks] = *(const bf16x8*)(ap + (size_t)(16 * t) * 1024 + 32 * ks); b[t][ks] = *(const bf16x8*)(bp + (size_t)(16 * t) * 1024 + 32 * ks); }
    f32x4 acc[4][4];
#pragma unroll
    for (int mt = 0; mt < 4; ++mt)
#pragma unroll
        for (int nt = 0; nt < 4; ++nt) { acc[mt][nt] = (f32x4){0.f, 0.f, 0.f, 0.f};
#pragma unroll
            for (int ks = 0; ks < 4; ++ks) acc[mt][nt] = __builtin_amdgcn_mfma_f32_16x16x32_bf16(b[nt][ks], a[mt][ks], acc[mt][nt], 0, 0, 0); }
    LAS f32x4* part = (LAS f32x4*)lds;
#pragma unroll
    for (int mt = 0; mt < 4; ++mt)
#pragma unroll
        for (int nt = 0; nt < 4; ++nt) part[(w * 16 + mt * 4 + nt) * 64 + lane] = acc[mt][nt];
    __syncthreads();
    LAS float* ssq = (LAS float*)(lds + LDS_IDX);
    const float* gp = gmod + (size_t)4 * 6144;
#pragma unroll
    for (int hf = 0; hf < 2; ++hf) { const int o = tid + 512 * hf, tile = o >> 6, ol = o & 63, mt = tile >> 2, nt = tile & 3, r = 16 * mt + (ol & 15), c = 64 * tc + 16 * nt + 4 * (ol >> 4);
        f32x4 s = part[o];
#pragma unroll
        for (int ww = 1; ww < 8; ++ww) s += part[ww * 1024 + o];
        const size_t gi = (size_t)(64 * tr + r) * D + c;
        const f32x4 y = *(const f32x4*)(srcctx + gi) + *(const f32x4*)(gp + c) * s;
        *(f32x4*)(X + (size_t)NL * D + gi) = y;
        ssq[r * 16 + nt * 4 + (ol >> 4)] = (y[0] * y[0] + y[1] * y[1]) + (y[2] * y[2] + y[3] * y[3]); }
    __syncthreads();
    if (tid < 64) { float ss = 0.f;
#pragma unroll
        for (int q = 0; q < 16; ++q) ss += ssq[tid * 16 + q];
        SSX[(size_t)(NL + 64 * tr + tid) * 16 + tc] = ss; }
    __syncthreads();
}

__device__ __forceinline__ void combine_row(int row, int lane, float* X, const bf16* YB, const float* mcur  , const float* gnext, const float* mnext, bf16* H, float* out) {
    const int mr = modrow(row); const float* mv = mcur + (size_t)mr * 6144 + 5120;
    f32x4 v[2][2]; float ss = 0.f;
    u32x4 y[2][4];
#pragma unroll
    for (int j = 0; j < 2; ++j)
#pragma unroll
        for (int k = 0; k < 4; ++k) y[j][k] = *(const u32x4*)(YB + ((size_t)row * 4 + k) * 1024 + 8 * lane + 512 * j);
#pragma unroll
    for (int j = 0; j < 2; ++j) { const int c = 8 * lane + 512 * j; f32x4 a0 = (f32x4){0.f, 0.f, 0.f, 0.f}, a1 = a0;
#pragma unroll
        for (int k = 0; k < 4; ++k) { a0 += (f32x4){bflo(y[j][k].x), bfhi(y[j][k].x), bflo(y[j][k].y), bfhi(y[j][k].y)}; a1 += (f32x4){bflo(y[j][k].z), bfhi(y[j][k].z), bflo(y[j][k].w), bfhi(y[j][k].w)}; }
        float* xp = X + (size_t)row * D + c; const f32x4 g0 = *(const f32x4*)(mv + c), g1 = *(const f32x4*)(mv + c + 4);
        v[j][0] = *(const f32x4*)xp + g0 * a0; v[j][1] = *(const f32x4*)(xp + 4) + g1 * a1;
        float* op = out ? out + (size_t)row * D + c : xp;
        *(f32x4*)op = v[j][0]; *(f32x4*)(op + 4) = v[j][1];
#pragma unroll
        for (int q = 0; q < 2; ++q) ss += (v[j][q][0] * v[j][q][0] + v[j][q][1] * v[j][q][1]) + (v[j][q][2] * v[j][q][2] + v[j][q][3] * v[j][q][3]); }
    if (H) { const float rstd = rsqrtf(wave_sum(ss) * (1.f / D) + EPS); const float* mn = mnext + (size_t)mr * 6144;
#pragma unroll
        for (int j = 0; j < 2; ++j) { const int c = 8 * lane + 512 * j; f32x4 o[2];
#pragma unroll
            for (int q = 0; q < 2; ++q) { const f32x4 gg = *(const f32x4*)(gnext + c + 4 * q), sc = *(const f32x4*)(mn + 1024 + c + 4 * q), sh = *(const f32x4*)(mn + c + 4 * q); o[q] = v[j][q] * rstd * gg * (sc + 1.f) + sh; }
            *(u32x4*)(H + (size_t)row * D + c) = pack8(o[0], o[1]); } }
}

#define MFMA16(a, b, c) __builtin_amdgcn_mfma_f32_16x16x32_bf16((a), (b), (c), 0, 0, 0)
__device__ __forceinline__ void router_load_table(LAS unsigned char* lds, const bf16* Wr, int tid) {
    u32x4 v[16];
#pragma unroll
    for (int i = 0; i < 16; ++i) v[i] = *(const u32x4*)(Wr + (size_t)(tid + i * NTHR) * 8);
#pragma unroll
    for (int i = 0; i < 16; ++i) { const int q = tid + i * NTHR, row = q >> 7, c = q & 127; *(LAS u32x4*)(lds + row * 2048 + ((c ^ (row & 15)) << 4)) = v[i]; }
}
__device__ __forceinline__ void router_group(LAS unsigned char* lds, int g, int w, int lane, const float* X, const float* SSX, const float* gffn, const float* mvec, const float* rb,
                                             bf16* F, float* gate) {
    LAS float* lg = (LAS float*)(lds + LDS_IDX) + w * 512; LAS int* pend = (LAS int*)(lds + LDS_IDX + 10240) + w * 64; LAS int* cntL = (LAS int*)(lds + LDS_TAB);
    const int i = lane & 15, kq = lane >> 4, row = 16 * g + i;
    const float* xr = X + (size_t)row * D + 8 * kq;
    float ss; { const f32x4 pq = *(const f32x4*)(SSX + (size_t)row * 16 + 4 * kq); ss = (pq[0] + pq[1]) + (pq[2] + pq[3]); }
    ss += __shfl_xor(ss, 16); ss += __shfl_xor(ss, 32);
    const float rstd = rsqrtf(ss * (1.f / D) + EPS);
    f32x4 acc[2] = {(f32x4){0.f, 0.f, 0.f, 0.f}, (f32x4){0.f, 0.f, 0.f, 0.f}};
    const LAS unsigned char* tb = lds + i * 2048;
#pragma unroll 8
    for (int s = 0; s < 32; ++s) {
        const int k = 32 * s + 8 * kq;
        const f32x4 a = *(const f32x4*)(xr + 32 * s), b = *(const f32x4*)(xr + 32 * s + 4);
        const f32x4 g0 = *(const f32x4*)(gffn + k), g1 = *(const f32x4*)(gffn + k + 4), c0 = *(const f32x4*)(mvec + 4096 + k), c1 = *(const f32x4*)(mvec + 4096 + k + 4);
        const f32x4 h0 = *(const f32x4*)(mvec + 3072 + k), h1 = *(const f32x4*)(mvec + 3072 + k + 4);
        const f32x4 f0 = a * rstd * g0 * (c0 + 1.f) + h0, f1 = b * rstd * g1 * (c1 + 1.f) + h1;
        u32x4 hi; hi.x = pk2(f0[0], f0[1]); hi.y = pk2(f0[2], f0[3]); hi.z = pk2(f1[0], f1[1]); hi.w = pk2(f1[2], f1[3]);
        *(u32x4*)(F + (size_t)row * D + k) = hi;
        u32x4 lo; lo.x = pk2(f0[0] - bflo(hi.x), f0[1] - bfhi(hi.x)); lo.y = pk2(f0[2] - bflo(hi.y), f0[3] - bfhi(hi.y));
        lo.z = pk2(f1[0] - bflo(hi.z), f1[1] - bfhi(hi.z)); lo.w = pk2(f1[2] - bflo(hi.w), f1[3] - bfhi(hi.w));
        const bf16x8 ah = __builtin_bit_cast(bf16x8, hi), al = __builtin_bit_cast(bf16x8, lo);
        const int cs = ((4 * s + kq) ^ i) << 4;
#pragma unroll
        for (int et = 0; et < 2; ++et) { const bf16x8 bh = *(const LAS bf16x8*)(tb + et * 16 * 2048 + cs), bl = *(const LAS bf16x8*)(tb + (32 + et * 16) * 2048 + cs);
            acc[et] = MFMA16(ah, bh, acc[et]); acc[et] = MFMA16(al, bh, acc[et]); acc[et] = MFMA16(ah, bl, acc[et]); }
    }
#pragma unroll
    for (int et = 0; et < 2; ++et) { const float bias = rb[16 * et + i];
#pragma unroll
        for (int r = 0; r < 4; ++r) lg[(4 * kq + r) * 32 + 16 * et + i] = acc[et][r] + bias; }
    LDS_WAIT(); asm volatile("" ::: "memory");
    if (lane < 16) {
        const LAS float* my = lg + lane * 32; unsigned used = 0u; int bi[4]; float bv[4];
#pragma unroll
        for (int k = 0; k < 4; ++k) { float best = -3.0e38f; int be = 0;
#pragma unroll
            for (int e = 0; e < 32; ++e) { const float v = my[e]; const bool ok = !((used >> e) & 1u) && v > best; best = ok ? v : best; be = ok ? e : be; }
            used |= 1u << be; bi[k] = be; bv[k] = best; }
        float ex[4], sum = 0.f;
#pragma unroll
        for (int k = 0; k < 4; ++k) { ex[k] = __expf(bv[k] - bv[0]); sum += ex[k]; }
        const float inv = 1.f / sum; const int trow = 16 * g + lane;
#pragma unroll
        for (int k = 0; k < 4; ++k) { const int rl = __hip_atomic_fetch_add(cntL + bi[k], 1, __ATOMIC_RELAXED, __HIP_MEMORY_SCOPE_WORKGROUP);
            pend[lane * 4 + k] = (trow * 4 + k) | (bi[k] << 17) | (rl << 22); gate[trow * 4 + k] = ex[k] * inv; }
    }
}

struct Args { const float* in[32]; float* out; unsigned char* ws; int lo, hi, flags, pad; };
constexpr int N_PHASES = 2 + 2 * (7 + 8);

__global__ void __launch_bounds__(NTHR, 2) mega(Args args) {
    extern __shared__ __attribute__((aligned(16))) unsigned char lds_raw[];
    LAS unsigned char* lds = (LAS unsigned char*)lds_raw;
    const int tid = threadIdx.x, lane = tid & 63, wave = __builtin_amdgcn_readfirstlane(tid >> 6);
    constexpr int G = 256;
    const int bx = blockIdx.x & (G - 1), vcu = (bx % 8) * (G / 8) + bx / 8;
    const int gw = vcu * NWAVES + wave, NGW = G * NWAVES;
    unsigned* ctl = (unsigned*)(args.ws + WS_CTL);
#define PH_LOCALS \
    unsigned zsg_; asm volatile("s_mov_b32 %0, 0" : "=s"(zsg_)); unsigned char* ws = args.ws + zsg_;   const int tid = otid(), lane = tid & 63, wave = __builtin_amdgcn_readfirstlane(tid >> 6), gw = vcu * NWAVES + wave; (void)lane; (void)gw; \
    const float* x_in = args.in[0]; const float* c_in = args.in[1]; const float* ctx_in = args.in[2]; const float* cctx_in = args.in[3]; \
    const float* mod_w = args.in[4]; const float* mod_b = args.in[5]; const float* norm_mix_g = args.in[6]; const float* norm_ffn_g = args.in[7]; \
    float* MOD = (float*)(ws + WS_MOD); float* cosA = (float*)(ws + WS_COSA); float* sinA = (float*)(ws + WS_SINA); float* cosC = (float*)(ws + WS_COSC); float* sinC = (float*)(ws + WS_SINC); \
    bf16* WR = (bf16*)(ws + WS_WR); bf16* WINA = (bf16*)(ws + WS_WINA); bf16* WOUTA = (bf16*)(ws + WS_WOUTA); bf16* WINC = (bf16*)(ws + WS_WINC); bf16* WQB = (bf16*)(ws + WS_WQB); \
    bf16* WKVB = (bf16*)(ws + WS_WKVB); bf16* WOUTC = (bf16*)(ws + WS_WOUTC); bf16* WGU = (bf16*)(ws + WS_WGU); bf16* WDN = (bf16*)(ws + WS_WDN); \
    float* X = (float*)(ws + WS_X); bf16* H = (bf16*)(ws + WS_H); bf16* QA = (bf16*)(ws + WS_QA); bf16* KA = (bf16*)(ws + WS_KA); bf16* VA = (bf16*)(ws + WS_VA); bf16* Z = (bf16*)(ws + WS_Z); \
    bf16* P = (bf16*)(ws + WS_P); float* RS = (float*)(ws + WS_RS); bf16* QC = (bf16*)(ws + WS_QC); bf16* KC = (bf16*)(ws + WS_KC); bf16* VC = (bf16*)(ws + WS_VC); \
    bf16* MIX = (bf16*)(ws + WS_MIX); bf16* F = (bf16*)(ws + WS_F); float* GATE = (float*)(ws + WS_GATE); int* LIST = (int*)(ws + WS_LIST); bf16* ACT = (bf16*)(ws + WS_ACT); bf16* YB = (bf16*)(ws + WS_YB); \
    int* CNT = (int*)(ws + WS_CTL) + CW_CNT; float* SSX = (float*)(ws + WS_SSX); float* SSP = (float*)(ws + WS_SSP); (void)SSX; (void)SSP; const float* ML = MOD + (size_t)layer_ * 5 * 6144; \
    (void)x_in; (void)c_in; (void)ctx_in; (void)cctx_in; (void)mod_w; (void)mod_b; (void)norm_mix_g; (void)norm_ffn_g; (void)MOD; (void)cosA; (void)sinA; (void)cosC; (void)sinC; (void)WR; (void)WINA; (void)WOUTA; \
    (void)WINC; (void)WQB; (void)WKVB; (void)WOUTC; (void)WGU; (void)WDN; (void)X; (void)H; (void)QA; (void)KA; (void)VA; (void)Z; (void)P; (void)RS; (void)QC; (void)KC; (void)VC; (void)MIX; (void)F; (void)GATE; \
    (void)LIST; (void)ACT; (void)YB; (void)CNT; (void)ML;
    if (tid < 64) ((LAS unsigned*)(lds + LDS_MISC))[tid] = 0u;
    __syncthreads();
    const int lo = args.lo, hi = args.hi;
    XcdBarrier bar; bar.bar = ctl + CW_BAR; bar.x = 0; bar.st = nullptr;
    if (hi - lo > 1) bar = xcd_barrier_post(ctl + CW_BAR, (volatile LAS unsigned*)(lds + LDS_MISC));
    int ph = 0; int layer_ = 0;
#ifndef MK_EN
#define MK_EN 0xffffffffu
#endif
#ifdef MK_PROBE_PH
#define PFLAG(b) (args.flags & (b))
#else
#define PFLAG(b) 0
#endif
#define EN(k) (((MK_EN) >> (k)) & 1u)
#define PH_ON (ph >= lo && ph < hi)
#define CVT_HEAD do { if (tid < 8) ((LAS int*)(lds + CV_HDR))[tid] = -1; } while (0)
#define CVT_TAIL(bg) do { LAS int* _jn = (LAS int*)(lds + CV_HDR + 64); asm volatile("s_waitcnt vmcnt(0)" ::: "memory"); if (wave >= 4 && lane == 0) _jn[wave - 4] = bg.j; __syncthreads(); \
        bg.process_slot(tid, lds, 0); bg.process_slot(tid, lds, 1); \
        { const int _j = _jn[wave & 3]; bg.j = _j + (wave < 4 ? 0 : 4); bg.step = 8; } __syncthreads(); \
        bg.tail_loop(lane, lds + wave * 16384); __syncthreads(); } while (0)
#define PH_END do { const bool _b = (ph >= lo) && (ph + 1 < hi); ++ph; if (_b) xcd_barrier(bar); } while (0)

    if (EN(0) && PH_ON) { PH_LOCALS
        LAS float* st = (LAS float*)(lds + 73728);
        for (int q = tid; q < 5 * 1024; q += NTHR) { const float v = q < 4096 ? c_in[q] : cctx_in[q - 4096]; st[q] = fsilu(v); }
        __syncthreads();
        for (int u = vcu; u < 384; u += G) {
            const int l = u / 96, col = (u % 96) * 64 + lane;
            const float* wp = mod_w + ((size_t)l * D + 128 * wave) * 6144 + col; float a0 = 0.f, a1 = 0.f, a2 = 0.f, a3 = 0.f, a4 = 0.f;
#pragma unroll 1
            for (int k0 = 0; k0 < 128; k0 += 64) { float wv[64];
#pragma unroll
                for (int kk = 0; kk < 64; ++kk) wv[kk] = __builtin_nontemporal_load(wp + (size_t)(k0 + kk) * 6144);
#pragma unroll
                for (int kk = 0; kk < 64; ++kk) { const int k = 128 * wave + k0 + kk; a0 += st[k] * wv[kk]; a1 += st[1024 + k] * wv[kk]; a2 += st[2048 + k] * wv[kk]; a3 += st[3072 + k] * wv[kk]; a4 += st[4096 + k] * wv[kk]; } }
            LAS float* part = (LAS float*)(lds + 98304);
            part[(wave * 5 + 0) * 64 + lane] = a0; part[(wave * 5 + 1) * 64 + lane] = a1; part[(wave * 5 + 2) * 64 + lane] = a2; part[(wave * 5 + 3) * 64 + lane] = a3; part[(wave * 5 + 4) * 64 + lane] = a4;
            __syncthreads();
            if (wave < 5) { float s = mod_b[l * 6144 + col];
#pragma unroll
                for (int w8 = 0; w8 < 8; ++w8) s += part[(w8 * 5 + wave) * 64 + lane];
                MOD[((size_t)l * 5 + wave) * 6144 + col] = s; }
            __syncthreads();
        }
        for (int q = gw * 64 + lane; q < 4096 * 32; q += NGW * 64) {
            { const int t = q >> 5, j = q & 31, ax = j >> 4, i = j & 15; const float pos = (float)(ax == 0 ? (t >> 6) : (t & 63)); const float a = pos * powf(10000.f, -((float)i * 2.f) / 32.f); cosA[q] = cosf(a); sinA[q] = sinf(a); }
            if (q < 4096 * 16) { const int t = q >> 4, j = q & 15, ax = j >> 3, i = j & 7; const float pos = (float)(ax == 0 ? (t >> 6) : (t & 63)); const float a = pos * powf(10000.f, -((float)i * 2.f) / 16.f); cosC[q] = cosf(a); sinC[q] = sinf(a); }
        }
        { const float* rw = args.in[26];
          for (int q = gw * 64 + lane; q < 4 * 32 * 1024; q += NGW * 64) { const int l = q >> 15, e = (q >> 10) & 31, k = q & 1023; const float wv = rw[((size_t)l * 1024 + k) * 32 + e];
              const unsigned hb = pk2(wv, 0.f) & 0xffffu; const float hf = __uint_as_float(hb << 16); const unsigned lb = pk2(wv - hf, 0.f) & 0xffffu;
              WR[((size_t)(l * 2 + 0) * 32 + e) * 1024 + k] = (bf16)hb; WR[((size_t)(l * 2 + 1) * 32 + e) * 1024 + k] = (bf16)lb; } }
        LAS float* scr = (LAS float*)(lds + wave * 8448);
        cvt_matrix<LAY_INA>(args.in[8], (size_t)D * 1792, 1792, 1792, 1024, 7, 14, WINA, nullptr, scr, gw, NGW, lane);
        cvt_matrix<LAY_F32>(args.in[9], (size_t)D * 1024, 1024, 1024, 1024, 4, 8, WOUTA, nullptr, scr, gw, NGW, lane);
        cvt_matrix<LAY_STD>(args.in[17], (size_t)D * 1056, 1056, 1056, 1024, 5, 10, WINC, nullptr, scr, gw, NGW, lane);
        cvt_matrix<LAY_STD>(args.in[20], (size_t)768 * 1536, 1536, 1536, 768, 6, 6, WQB, args.in[18], scr, gw, NGW, lane);
        cvt_matrix<LAY_STD>(args.in[20] + (size_t)768 * 1536, 0, 1536, 1536, 768, 6, 6, WQB + (size_t)1536 * 768, args.in[18] + 768, scr, gw, NGW, lane);
        cvt_matrix<LAY_HEAD2>(args.in[21], (size_t)256 * 2048, 2048, 2048, 256, 8, 8, WKVB, args.in[19], scr, gw, NGW, lane);
        cvt_matrix<LAY_HEAD2>(args.in[21] + (size_t)256 * 2048, 0, 2048, 2048, 256, 8, 8, WKVB + (size_t)2048 * 256, args.in[19] + 256, scr, gw, NGW, lane);
        cvt_matrix<LAY_F32>(args.in[25], (size_t)D * 1024, 1024, 1024, 1024, 4, 8, WOUTC, nullptr, scr, gw, NGW, lane);
        __syncthreads();
    }
    PH_END;
    if (EN(1) && PH_ON) { PH_LOCALS
        for (int row = gw; row < T; row += NGW) {
            const float* xrow = row < NL ? x_in + (size_t)row * D : ctx_in + (size_t)(row - NL) * D; const float* mn = MOD + (size_t)modrow(row) * 6144;
            f32x4 v[2][2]; float ss = 0.f;
#pragma unroll
            for (int j = 0; j < 2; ++j)
#pragma unroll
                for (int q = 0; q < 2; ++q) { v[j][q] = *(const f32x4*)(xrow + 8 * lane + 512 * j + 4 * q); ss += (v[j][q][0] * v[j][q][0] + v[j][q][1] * v[j][q][1]) + (v[j][q][2] * v[j][q][2] + v[j][q][3] * v[j][q][3]); }
            const float rstd = rsqrtf(wave_sum(ss) * (1.f / D) + EPS);
#pragma unroll
            for (int j = 0; j < 2; ++j) { const int c = 8 * lane + 512 * j; f32x4 o[2];
#pragma unroll
                for (int q = 0; q < 2; ++q) { const f32x4 gg = *(const f32x4*)(norm_mix_g + c + 4 * q), sc = *(const f32x4*)(mn + 1024 + c + 4 * q), sh = *(const f32x4*)(mn + c + 4 * q); o[q] = v[j][q] * rstd * gg * (sc + 1.f) + sh; }
                *(u32x4*)(H + (size_t)row * D + c) = pack8(o[0], o[1]); }
        }
    }
    PH_END;

    for (int layer = 0; layer < 4; ++layer) {
        const bool keep = layer < 3; const int li = layer >> 1; const int nrt = keep ? 68 : 64;
        layer_ = layer;
        if ((layer & 1) == 0) {
            if (EN(2) && PH_ON) { PH_LOCALS
                g8::GemmP g{H, D, WINA + (size_t)li * 1792 * 1024, 1024}; g8::StaticOrder S_; S_.init(68, 7, G, bx);
                EpiInA E{QA, KA, VA, Z, args.in[10] + li * 64, args.in[11] + li * 64, cosA, sinA};
                g8::gemm_phase(lds, g, S_, E);
            }
            PH_END;
            if (EN(3) && PH_ON) { PH_LOCALS
                const int nau = keep ? 544 : 512;
                if (!(PFLAG(1))) {
                    CvtBg bg; bg.init(args.in[28], args.in[30], WGU, WDN, 0, layer == 0 ? 1 : 0, vcu, wave >= 4 ? wave - 4 : 0x40000000, 4); CVT_HEAD;
                    for (int u = vcu; u < nau; u += G) wattn_unit(lds, u, QA, KA, VA, args.in[12] + li * 8, MIX, bg);
                    CVT_TAIL(bg);
                }
                if (!(PFLAG(2))) {
                    const float* dww = args.in[13] + (size_t)li * 31 * 512; const float* dwb = args.in[14] + li * 512; const float* lng = args.in[15] + li * 512; const float* lnb = args.in[16] + li * 512;
                    conv_strip<64>(lds, (vcu >> 6) * S, S, (vcu & 63) * 64, Z, dww, dwb, lng, lnb, MIX);
                    if (keep) conv_strip<4>(lds, NL + (vcu >> 6) * CL, CL, (vcu & 63) * 4, Z, dww, dwb, lng, lnb, MIX);
                }
            }
            PH_END;
            if (EN(4) && PH_ON) { PH_LOCALS
                g8::GemmP g{MIX, D, WOUTA + (size_t)li * 1024 * 1024, 1024}; g8::StaticOrder S_; S_.init(64, 4, G, bx);
                EpiResid E{X, layer == 0 ? x_in : X, layer == 0 ? ctx_in : X + (size_t)NL * D, ML + 2048, SSX};
                g8::gemm_phase(lds, g, S_, E);
                if (keep) ctx_minigemm(lds, MIX, WOUTA + (size_t)li * 1024 * 1024, X, layer == 0 ? ctx_in : X + (size_t)NL * D, ML + 2048, SSX, bx);
            }
            PH_END;
        } else {
            if (EN(5) && PH_ON) { PH_LOCALS
                g8::GemmP g{H, D, WINC + (size_t)li * 1280 * 1024, 1024}; g8::StaticOrder S_; S_.init(68, 5, G, bx);
                EpiP E{P, SSP, KC, args.in[24] + li * 32, cosC, sinC};
                g8::gemm_phase(lds, g, S_, E);
            }
            PH_END;
            if (EN(7) && PH_ON) { PH_LOCALS
#ifndef MK_O3
#define MK_O3 3
#endif
                if ((MK_O3 & 1) && !(PFLAG(16))) { g8::GemmP g{P, PP, WQB + (size_t)li * 1536 * 768, 768}; g8::StaticOrder S_; S_.init(nrt, 6, G, bx); EpiBf16 E{QC, 1536, 1536}; g8::gemm_phase(lds, g, S_, E); }
                if ((MK_O3 & 2) && !(PFLAG(32))) { g8::GemmP g{P + 768, PP, WKVB + (size_t)li * 2048 * 256, 256}; g8::StaticOrder S_; S_.init(68, 8, G, (bx + 104) & 255);         EpiKV E{KC, VC, SSP, args.in[23] + li * 64}; g8::gemm_phase(lds, g, S_, E); }
            }
            PH_END;
            if (EN(8) && PH_ON) { PH_LOCALS
                const int nau = keep ? 1088 : 1024;
                CvtBg bg; bg.init(args.in[28], args.in[30], WGU, WDN, layer, (PFLAG(8)) ? 0 : ((layer == 1) ? 2 : 1), vcu, wave >= 4 ? wave - 4 : 0x40000000, 4); CVT_HEAD;
#if defined(MK_XP) && MK_XP != 0
                if (PFLAG(64)) { for (int u = vcu; u < nau; u += G) mla_unit<MK_XP>(lds, u, QC, KC, VC, SSP, args.in[22] + li * 96, cosC, sinC, MIX, bg); } else
#endif
                for (int u = vcu; u < nau; u += G) mla_unit(lds, u, QC, KC, VC, SSP, args.in[22] + li * 96, cosC, sinC, MIX, bg);
                CVT_TAIL(bg);
            }
            PH_END;
            if (EN(9) && PH_ON) { PH_LOCALS
                g8::GemmP g{MIX, D, WOUTC + (size_t)li * 1024 * 1024, 1024}; g8::StaticOrder S_; S_.init(64, 4, G, bx);
                EpiResid E{X, X, X + (size_t)NL * D, ML + 2048, SSX};
                g8::gemm_phase(lds, g, S_, E);
                if (keep) ctx_minigemm(lds, MIX, WOUTC + (size_t)li * 1024 * 1024, X, X + (size_t)NL * D, ML + 2048, SSX, bx);
            }
            PH_END;
        }
        if (EN(10) && PH_ON) { PH_LOCALS
            LAS int* cntL = (LAS int*)(lds + LDS_TAB); LAS int* baseL = cntL + 32; LAS int* pend = (LAS int*)(lds + LDS_IDX + 10240);
            if (tid < 32) cntL[tid] = 0;
            router_load_table(lds, WR + (size_t)layer * 2 * 32 * 1024, tid);
            __syncthreads();
            int g = -1;
            if (wave < 4) g = bx * 4 + wave; else if (wave == 4 && keep && bx < 64) g = 1024 + bx;
            if (g >= 0) router_group(lds, g, wave, lane, X, SSX, norm_ffn_g + layer * D, ML + (size_t)(g < 1024 ? (g >> 8) : 4) * 6144, args.in[27] + layer * 32, F, GATE);
            __syncthreads();
            if (tid < 32) baseL[tid] = (PFLAG(4)) ? 0 : atomicAdd(CNT + (layer * 32 + tid) * 64, cntL[tid])    ;
            __syncthreads();
            if (tid < 320) { const int wv = tid >> 6; const bool has = (wv < 4) || (wv == 4 && keep && bx < 64);
                if (has) { const int pe = pend[tid], slot = pe & 0x1ffff, e = (pe >> 17) & 31, rl = pe >> 22; LIST[(size_t)e * T + baseL[e] + rl] = slot; } }
            __syncthreads();
        }
        PH_END;
        if (EN(11) && PH_ON) { PH_LOCALS
            moe_setup<8>(lds, CNT + layer * 32 * 64, LIST, layer, vcu, G);
            g8::GemmP g{F, D, WGU, 1024}; g8::MoeOrder<true> S_{(const LAS int*)(lds + LDS_TAB), (const LAS int*)(lds + LDS_IDX)};
            EpiGU E{ACT, args.in[29] + (size_t)layer * 32 * 2048};
            g8::gemm_phase(lds, g, S_, E);
        }
        PH_END;
        if (EN(12) && PH_ON) { PH_LOCALS
            moe_setup<4>(lds, CNT + layer * 32 * 64, LIST, layer, vcu, G);
            g8::GemmP g{ACT, 1024, WDN, 1024}; g8::MoeOrder<false> S_{(const LAS int*)(lds + LDS_TAB), (const LAS int*)(lds + LDS_IDX)};
            EpiDown E{YB, args.in[31] + (size_t)layer * 32 * 1024, GATE, (const LAS int*)(lds + LDS_IDX)};
            g8::gemm_phase(lds, g, S_, E);
        }
        PH_END;
        if (EN(13) && PH_ON) { PH_LOCALS
            const int nrows = keep ? T : NL;
            for (int row = gw; row < nrows; row += NGW)
                combine_row(row, lane, X, YB, ML, norm_mix_g + (layer + 1 < 4 ? layer + 1 : 0) * D, MOD + (size_t)(layer + 1 < 4 ? layer + 1 : 0) * 5 * 6144, layer < 3 ? H : nullptr, layer < 3 ? nullptr : args.out);
        }
        PH_END;
    }
#undef PH_ON
#undef PH_END
}
}

#ifndef MK_MULTI
#define MK_MULTI 0
#endif
#ifndef MK_DEBUG
#define MK_DEBUG 0
#endif
#if MK_DEBUG
namespace dbg {
__global__ void k_cmp_bf(const unsigned short* a, int lda, const float* b, int ldb, int rows, int cols, float s, float* acc, int cp) {
    float d2 = 0.f, r2 = 0.f;
    for (size_t i = (size_t)blockIdx.x * blockDim.x + threadIdx.x; i < (size_t)rows * cols; i += (size_t)gridDim.x * blockDim.x) {
        const size_t r = i / cols, c = i % cols; const float av = __uint_as_float(((unsigned)a[r * lda + c]) << 16), bv = s * b[r * ldb + c]; d2 += (av - bv) * (av - bv); r2 += bv * bv; }
    for (int o = 32; o >= 1; o >>= 1) { d2 += __shfl_xor(d2, o); r2 += __shfl_xor(r2, o); }
    if ((threadIdx.x & 63) == 0) { atomicAdd(acc + 2 * cp, d2); atomicAdd(acc + 2 * cp + 1, r2); }
}
__global__ void k_cmp_f(const float* a, const float* b, size_t n, float* acc, int cp) {
    float d2 = 0.f, r2 = 0.f;
    for (size_t i = (size_t)blockIdx.x * blockDim.x + threadIdx.x; i < n; i += (size_t)gridDim.x * blockDim.x) { const float av = a[i], bv = b[i]; d2 += (av - bv) * (av - bv); r2 += bv * bv; }
    for (int o = 32; o >= 1; o >>= 1) { d2 += __shfl_xor(d2, o); r2 += __shfl_xor(r2, o); }
    if ((threadIdx.x & 63) == 0) { atomicAdd(acc + 2 * cp, d2); atomicAdd(acc + 2 * cp + 1, r2); }
}
__global__ void k_report(const float* acc, int ncp, float thr, float* out) {
    if (blockIdx.x == 0 && threadIdx.x == 0) { int bad = -1; for (int i = 0; i < ncp; ++i) { const float d = acc[2 * i], r = acc[2 * i + 1]; if (!(d <= thr * r)) { bad = i; break; } }
        if (bad >= 0) out[0] += 100.f * (float)(bad + 1); }
}
}
#endif

extern "C" void kernel_launch(void* const* d_in, const int* in_sizes, int n_in, void* d_out, int out_size, void* d_ws, size_t ws_size, hipStream_t stream) {
    using namespace mk;
    static int grid = 0;
    if (grid == 0) {
        int dev = 0, cus = 0, per_cu = 0;
        if (hipGetDevice(&dev) != hipSuccess || hipDeviceGetAttribute(&cus, hipDeviceAttributeMultiprocessorCount, dev) != hipSuccess) { fprintf(stderr, "kernel_launch: device query failed\n"); grid = -1; return; }
        if (hipFuncSetAttribute((const void*)mega, hipFuncAttributeMaxDynamicSharedMemorySize, LDS_BYTES) != hipSuccess) { fprintf(stderr, "kernel_launch: hipFuncSetAttribute(%d B LDS) failed\n", LDS_BYTES); grid = -1; return; }
        if (hipOccupancyMaxActiveBlocksPerMultiprocessor(&per_cu, (const void*)mega, NTHR, LDS_BYTES) != hipSuccess || per_cu < 1) fprintf(stderr, "kernel_launch: occupancy query reports %d blocks per CU\n", per_cu);
        (void)hipGetLastError();
        grid = 256;
        if (cus < 256) { fprintf(stderr, "kernel_launch: %d CUs < 256: the persistent grid would not be resident; nothing launched\n", cus); grid = -1; return; }
        if (n_in != 32 || ws_size < WS_END) { fprintf(stderr, "kernel_launch: n_in %d ws %zu (need %zu)\n", n_in, ws_size, (size_t)WS_END); grid = -1; return; }
    }
    if (grid < 0) return;
    (void)hipMemsetAsync((char*)d_ws + WS_CTL, 0, CTL_BYTES, stream);
    Args a{};
    for (int i = 0; i < 32; ++i) a.in[i] = (const float*)d_in[i];
    a.out = (float*)d_out; a.ws = (unsigned char*)d_ws;
#if !MK_DEBUG
#if MK_MULTI
    for (int p = 0; p < N_PHASES; ++p) { a.lo = p; a.hi = p + 1; hipLaunchKernelGGL(mega, dim3(grid), dim3(NTHR), LDS_BYTES, stream, a); }
#else
    a.lo = 0; a.hi = N_PHASES; hipLaunchKernelGGL(mega, dim3(grid), dim3(NTHR), LDS_BYTES, stream, a);
#ifdef MK_PROBE_PH
    for (int r = 0; r < MK_PROBE_N; ++r) { a.lo = MK_PROBE_PH; a.hi = MK_PROBE_PH + 1; a.flags = MK_PROBE_FLAGS; hipLaunchKernelGGL(mega, dim3(grid), dim3(NTHR), LDS_BYTES, stream, a); }
#endif
#endif
    { const hipError_t le = hipPeekAtLastError(); if (le != hipSuccess) fprintf(stderr, "kernel_launch: launch failed: %s\n", hipGetErrorName(le)); }
#else
#endif
}
```

```cpp
#include <hip/hip_runtime.h>
#include <cstdio>
#include <cstdint>
#define MK_MULTI 0
#define MK_DEBUG 0
#define MK_DBG_THR 1e-3f
namespace mk {
#define LAS __attribute__((address_space(3)))
#define GAS __attribute__((address_space(1)))
typedef unsigned short bf16;
typedef short bf16x8 __attribute__((ext_vector_type(8)));
typedef short s16x4 __attribute__((ext_vector_type(4)));
typedef float f32x2 __attribute__((ext_vector_type(2)));
typedef int i32x4 __attribute__((ext_vector_type(4)));
typedef float f32x4 __attribute__((ext_vector_type(4)));
typedef float f32x16 __attribute__((ext_vector_type(16)));
typedef unsigned u32x2 __attribute__((ext_vector_type(2)));
typedef unsigned u32x4 __attribute__((ext_vector_type(4)));

constexpr int D = 1024, NBATCH = 4, S = 4096, CL = 256, NL = NBATCH * S, NC = NBATCH * CL, T = NL + NC;
constexpr int NWAVES = 8, NTHR = 512;
constexpr float EPS = 1e-6f;
constexpr float LOG2E = 1.4426950408889634f;
constexpr float QSCALE_A = 0.125f * LOG2E;
constexpr float QSCALE_C = 0.10206207261596575f * LOG2E;

constexpr size_t al256(size_t x) { return (x + 255) & ~(size_t)255; }
constexpr size_t CTL_BYTES = 65536;
constexpr int CW_BAR = 1024, CW_CNT = 8192;
constexpr size_t WS_CTL = 0;
constexpr size_t WS_MOD = WS_CTL + CTL_BYTES;
constexpr size_t WS_COSA = WS_MOD + al256((size_t)4 * 5 * 6144 * 4);
constexpr size_t WS_SINA = WS_COSA + 4096 * 32 * 4;
constexpr size_t WS_COSC = WS_SINA + 4096 * 32 * 4;
constexpr size_t WS_SINC = WS_COSC + 4096 * 16 * 4;
constexpr size_t WS_WR = WS_SINC + 4096 * 16 * 4;
constexpr size_t WS_WINA = WS_WR + (size_t)4 * 2 * 32 * 1024 * 2;
constexpr size_t WS_WOUTA = WS_WINA + (size_t)2 * 1792 * 1024 * 2;
constexpr size_t WS_WINC = WS_WOUTA + (size_t)2 * 1024 * 1024 * 2;
constexpr size_t WS_WQB = WS_WINC + (size_t)2 * 1280 * 1024 * 2;
constexpr size_t WS_WKVB = WS_WQB + (size_t)2 * 1536 * 768 * 2;
constexpr size_t WS_WOUTC = WS_WKVB + (size_t)2 * 2048 * 256 * 2;
constexpr size_t WS_WGU = WS_WOUTC + (size_t)2 * 1024 * 1024 * 2;
constexpr size_t WS_WDN = WS_WGU + (size_t)128 * 2048 * 1024 * 2;
constexpr size_t WS_X = WS_WDN + (size_t)128 * 1024 * 1024 * 2;
constexpr size_t WS_H = WS_X + (size_t)T * D * 4;
constexpr size_t WS_QA = WS_H + (size_t)T * D * 2;
constexpr size_t WS_KA = WS_QA + (size_t)T * 512 * 2;
constexpr size_t WS_VA = WS_KA + (size_t)T * 128 * 2;
constexpr size_t WS_Z = WS_VA + (size_t)T * 128 * 2;
constexpr size_t WS_P = WS_Z + (size_t)T * 512 * 2;
constexpr int PP = 1056;
constexpr size_t WS_RS = WS_P + (size_t)T * PP * 2;
constexpr size_t WS_QC = WS_RS + (size_t)T * 2 * 4;
constexpr size_t WS_KC = WS_QC + (size_t)T * 1536 * 2;
constexpr size_t WS_VC = WS_KC + (size_t)T * 1536 * 2;
constexpr size_t WS_MIX = WS_VC + (size_t)T * 1024 * 2;
constexpr size_t WS_F = WS_MIX + (size_t)T * 1024 * 2;
constexpr size_t WS_GATE = WS_F + (size_t)T * 1024 * 2;
constexpr size_t WS_LIST = WS_GATE + (size_t)T * 4 * 4;
constexpr int ACT_ROWS = 304 * 256;
constexpr size_t WS_ACT = WS_LIST + (size_t)32 * T * 4;
constexpr size_t WS_YB = WS_ACT + (size_t)ACT_ROWS * 1024 * 2;
constexpr size_t WS_SSX = WS_YB + (size_t)T * 4 * 1024 * 2;
constexpr size_t WS_SSP = WS_SSX + (size_t)T * 16 * 4;
constexpr size_t WS_END = WS_SSP + (size_t)T * 16 * 4;

constexpr int STAGE_BYTES = 131072;
constexpr int LDS_IDX = 131072;
constexpr int MAXU = 12;
constexpr int LDS_TAB = LDS_IDX + MAXU * 1024;
constexpr int LDS_MISC = LDS_TAB + 1024;
constexpr int LDS_BYTES = LDS_MISC + 256;
constexpr int CV_HDR = 56320, CV_BUF = 57344;

__device__ __forceinline__ unsigned pk2(float lo, float hi) {
    typedef __bf16 bf2 __attribute__((ext_vector_type(2)));
    return __builtin_bit_cast(unsigned, __builtin_convertvector((f32x2){lo, hi}, bf2));
}
__device__ __forceinline__ float bflo(unsigned u) { return __uint_as_float(u << 16); }
__device__ __forceinline__ float bfhi(unsigned u) { return __uint_as_float(u & 0xffff0000u); }
__device__ __forceinline__ float bf1(bf16 u) { return __uint_as_float(((unsigned)u) << 16); }
__device__ __forceinline__ float fsigm(float v) { return __builtin_amdgcn_rcpf(1.f + __builtin_amdgcn_exp2f(-1.4426950408889634f * v)); }
__device__ __forceinline__ float fsilu(float v) { return v * fsigm(v); }
__device__ __forceinline__ int modrow(int row) { return row < NL ? (row >> 12) : 4; }
#define WS_DPP(v, ctrl) ((v) + __int_as_float(__builtin_amdgcn_update_dpp(0, __float_as_int(v), (ctrl), 0xF, 0xF, false)))
__device__ __forceinline__ float wave_sum(float v) {
    v = WS_DPP(v, 0xB1); v = WS_DPP(v, 0x4E); v = WS_DPP(v, 0x141); v = WS_DPP(v, 0x140);
    v += __shfl_xor(v, 16); v += __shfl_xor(v, 32);
    return v;
}
__device__ __forceinline__ int otid() { int t = threadIdx.x; asm volatile("" : "+v"(t)); return t; }
#define LDS_WAIT() asm volatile("s_waitcnt lgkmcnt(0)" ::: "memory")
#define VM_WAIT() asm volatile("s_waitcnt vmcnt(0)" ::: "memory")

#define XB_TMO      128
#define XB_XCNT(j)  (256  + 64 * (j))
#define XB_XSUB(j)  (1280 + 64 * (j))
#define XB_XGEN(j)  (2304 + 64 * (j))
#define XB_TOP      3328
#define XB_TOPGEN   3392
#define XCD_BAR_WORDS 3456
#define XB_SPIN_CAP (1u << 18)
__device__ __forceinline__ unsigned xb_ld(unsigned* p)              { return __hip_atomic_load(p, __ATOMIC_RELAXED, __HIP_MEMORY_SCOPE_AGENT); }
__device__ __forceinline__ unsigned xb_add(unsigned* p, unsigned v) { return __hip_atomic_fetch_add(p, v, __ATOMIC_RELAXED, __HIP_MEMORY_SCOPE_AGENT); }
__device__ __forceinline__ unsigned xb_xcc_id() { return (unsigned)__builtin_amdgcn_s_getreg((3 << 11) | 20) & 0xFu; }
#define XB_SPIN(cond, bar) do { unsigned _sp = 0; while (cond) { __builtin_amdgcn_s_sleep(1); \
    if ((++_sp & 255u) == 0u) { if (xb_ld(&(bar)[XB_TMO])) break; if (_sp > XB_SPIN_CAP) { atomicAdd(&(bar)[XB_TMO], 1u); break; } } } } while (0)
struct XcdBarrier { unsigned* bar; unsigned x; volatile LAS unsigned* st; };
__device__ __forceinline__ XcdBarrier xcd_barrier_post(unsigned* bar, volatile LAS unsigned* st) {
    XcdBarrier b; b.bar = bar; b.x = xb_xcc_id(); b.st = st;
    if (threadIdx.x == 0) (void)xb_add(&bar[XB_XCNT(b.x)], 1u);
    return b;
}
__device__ __forceinline__ void xcd_barrier_complete(unsigned* bar, unsigned x, unsigned& nloc, unsigned& nx) {
    const unsigned G = gridDim.x * gridDim.y * gridDim.z;
    unsigned sum, cnt, mine, sp = 0u;
    for (;;) {
        sum = 0u; cnt = 0u; mine = 0u;
#pragma unroll
        for (unsigned j = 0; j < 16; ++j) { const unsigned c = xb_ld(&bar[XB_XCNT(j)]); sum += c; cnt += (c > 0u) ? 1u : 0u; mine = (j == x) ? c : mine; }
        if (sum == G) break;
        __builtin_amdgcn_s_sleep(1);
        if ((++sp & 255u) == 0u) { if (xb_ld(&bar[XB_TMO])) break; if (sp > XB_SPIN_CAP) { atomicAdd(&bar[XB_TMO], 1u); break; } }
    }
    nloc = mine > 0u ? mine : 1u; nx = cnt > 0u ? cnt : 1u;
}
__device__ __forceinline__ void xcd_barrier(const XcdBarrier& b) {
    asm volatile("s_waitcnt vmcnt(0)" ::: "memory");
    __syncthreads();
    if (otid() == 0) {
        unsigned* bar = b.bar;
        __builtin_amdgcn_s_waitcnt(0);
        unsigned nloc = b.st[0], nx = b.st[1];
        if (nloc == 0u) { xcd_barrier_complete(bar, b.x, nloc, nx); b.st[0] = nloc; b.st[1] = nx; }
        const unsigned old = xb_add(&bar[XB_XSUB(b.x)], 1u);
        const unsigned gen = old / nloc;
        if (old + 1u == (gen + 1u) * nloc) {
            __builtin_amdgcn_fence(__ATOMIC_RELEASE, "agent");
            asm volatile("s_waitcnt vmcnt(0)" ::: "memory");
            const unsigned og = xb_add(&bar[XB_TOP], 1u);
            const unsigned tg = og / nx;
            if (og + 1u == (tg + 1u) * nx) xb_add(&bar[XB_TOPGEN], 1u);
            else XB_SPIN(xb_ld(&bar[XB_TOPGEN]) == tg, bar);
            __builtin_amdgcn_fence(__ATOMIC_ACQUIRE, "agent");
            xb_add(&bar[XB_XGEN(b.x)], 1u);
            asm volatile("s_waitcnt vmcnt(0)" ::: "memory");
        } else {
            XB_SPIN(xb_ld(&bar[XB_XGEN(b.x)]) == gen, bar);
            __builtin_amdgcn_fence(__ATOMIC_ACQUIRE, "agent");
            asm volatile("s_waitcnt vmcnt(0)" ::: "memory");
        }
    }
    __syncthreads();
}

namespace g8 {
constexpr int BM = 256, BK = 64, HALF = 128, HTB = HALF * BK * 2, NXCD = 8, WGM = 8;
__host__ __device__ __forceinline__ int lds_byte(int r, int c) { const int st = (r >> 4) * 2 + (c >> 5), rr = r & 15, cc = c & 31, ob = rr * 64 + cc * 2; return st * 1024 + (ob ^ (((ob >> 9) & 1) << 5)); }
__host__ __device__ __forceinline__ void stage_rc(int b, int& R, int& C) { const int st = b / 1024, sb = b % 1024, swz = sb ^ (((sb >> 9) & 1) << 5); R = (st >> 1) * 16 + swz / 64; C = (st & 1) * 32 + (swz % 64) / 2; }

struct Unit { int pm, pn, e, nt, gm, slot; };
struct GemmP { const bf16* A; int lda; const bf16* Bt; int K; };

struct StaticOrder {
    static constexpr bool GATHER = false;
    int nM, nN, nwg, G, c;
    __device__ void init(int nM_, int nN_, int G_, int c_) { nM = nM_; nN = nN_; nwg = nM * nN; G = G_; c = c_; }
    __device__ __forceinline__ bool next(int i, Unit& u) const {
        const long L = (long)i * G + c; if (L >= nwg) return false;
        int wgid = (int)L; { const int q = nwg / NXCD, r = nwg % NXCD, xcd = wgid % NXCD, off = wgid / NXCD; wgid = (xcd < r ? xcd * (q + 1) : r * (q + 1) + (xcd - r) * q) + off; }
        const int nig = WGM * nN, gid = wgid / nig, fm = gid * WGM, gsz = (nM - fm) < WGM ? (nM - fm) : WGM;
        u.pm = fm + ((wgid % nig) % gsz); u.pn = (wgid % nig) / gsz; u.e = 0; u.nt = u.pn; u.gm = u.pm; u.slot = 0; return true;
    }
    __device__ __forceinline__ int arow(const Unit& u, int r) const { return u.pm * BM + r; }
};
template <bool GATHER_> struct MoeOrder {
    static constexpr bool GATHER = GATHER_;
    const LAS int* tab; const LAS int* idx;
    __device__ __forceinline__ bool next(int i, Unit& u) const {
        if (i >= tab[127]) return false;
        u.gm = tab[128 + 4 * i]; u.pn = tab[129 + 4 * i]; u.e = tab[130 + 4 * i]; u.nt = tab[131 + 4 * i]; u.slot = i; u.pm = u.gm; return true;
    }
    __device__ __forceinline__ int arow(const Unit& u, int r) const {
        if (GATHER_) { const int s = idx[u.slot * 256 + r]; return s < 0 ? 0 : (s >> 2); }
        return u.gm * BM + r;
    }
};

template <class Epi, class Sched>
__device__ __forceinline__ void gemm_phase(LAS unsigned char* lds, const GemmP g, const Sched& S, const Epi& E) {
    const int tid = otid(), wid = __builtin_amdgcn_readfirstlane(tid >> 6), lane = tid & 63, wr = wid >> 2, wc = wid & 3, fr = lane & 15, fq = lane >> 4;
    const int K = g.K, nt = K / BK;
    int RR[2], CC[2]; unsigned voffB[2], voffA[2];
    const unsigned lda2 = (unsigned)g.lda * 2u;
#pragma unroll
    for (int i = 0; i < 2; ++i) { stage_rc(tid * 16 + i * 8192, RR[i], CC[i]); voffB[i] = (unsigned)(RR[i] * K + CC[i]) * 2u; voffA[i] = (unsigned)RR[i] * lda2 + (unsigned)CC[i] * 2u; }
    const size_t hstepA = (size_t)HALF * lda2, tstepA = 2 * hstepA;
    const size_t kstep = (size_t)(BK * 2);
    const size_t hstepB = (size_t)HALF * K * 2;
    const size_t tstepB = 2 * hstepB;
    const unsigned ldsw = (unsigned)wid * 1024u;
    const int aoff = lds_byte(wr * 64 + fr, fq * 8), boff = lds_byte(wc * 32 + fr, fq * 8);
#define G8_SA(b, h) (((b) * 2 + (h)) * HTB)
#define G8_SB(b, h) ((4 + (b) * 2 + (h)) * HTB)
#define G8_STAGE(bufoff, gbase, voff) do { _Pragma("unroll") for (int _i = 0; _i < 2; ++_i) \
        __builtin_amdgcn_global_load_lds((const unsigned*)((const char*)(gbase) + (voff)[_i]), (LAS unsigned*)(lds + (bufoff) + ldsw + _i * 8192), 16, 0, 0); } while (0)
#define G8_LDA(dst, b, h) do { _Pragma("unroll") for (int m = 0; m < 4; ++m) _Pragma("unroll") for (int k = 0; k < 2; ++k) dst[m][k] = *(const LAS bf16x8*)(lds + G8_SA(b, h) + aoff + m * 2048 + k * 1024); } while (0)
#define G8_LDB(dst, b, h) do { _Pragma("unroll") for (int n = 0; n < 2; ++n) _Pragma("unroll") for (int k = 0; k < 2; ++k) dst[n][k] = *(const LAS bf16x8*)(lds + G8_SB(b, h) + boff + n * 2048 + k * 1024); } while (0)
#define G8_MMA(ai, bj, At, Bt) do { __builtin_amdgcn_s_setprio(1); _Pragma("unroll") for (int m = 0; m < 4; ++m) _Pragma("unroll") for (int n = 0; n < 2; ++n) _Pragma("unroll") for (int k = 0; k < 2; ++k) \
        acc[ai][bj][m][n] = __builtin_amdgcn_mfma_f32_16x16x32_bf16(Bt[n][k], At[m][k], acc[ai][bj][m][n], 0, 0, 0); __builtin_amdgcn_s_setprio(0); } while (0)
#define G8_WAIT_V(n) asm volatile("s_waitcnt vmcnt(" #n ")" ::: "memory")
#define G8_WAIT_L(n) asm volatile("s_waitcnt lgkmcnt(" #n ")" ::: "memory")
#define G8_BAR __builtin_amdgcn_s_barrier()
#define G8_SCHED __builtin_amdgcn_sched_barrier(0)
#define G8_MKOFF(u, o) do { if constexpr (Sched::GATHER) { _Pragma("unroll") for (int _i = 0; _i < 2; ++_i) { int _R, _C; stage_rc(tid * 16 + _i * 8192, _R, _C); \
        _Pragma("unroll") for (int _h = 0; _h < 2; ++_h) o[_h][_i] = (unsigned)S.arow(u, _h * HALF + _R) * lda2 + (unsigned)_C * 2u; } } } while (0)
#define G8_STAGE_A(bufoff, kofs, h, usenext) do { if constexpr (Sched::GATHER) { unsigned _o[2]; _o[0] = (usenext) ? no[h][0] : co[h][0]; _o[1] = (usenext) ? no[h][1] : co[h][1]; G8_STAGE(bufoff, Ab + (kofs), _o); } \
        else { const char* _p = ((usenext) ? nAp : cAp) + (size_t)(h) * hstepA + (kofs); G8_STAGE(bufoff, _p, voffA); } } while (0)
    Unit cur, nxt; int ui = 0;
    if (!S.next(0, cur)) return;
    f32x4 acc[2][2][4][2];
#pragma unroll
    for (int a = 0; a < 2; ++a)
#pragma unroll
        for (int b = 0; b < 2; ++b)
#pragma unroll
            for (int m = 0; m < 4; ++m)
#pragma unroll
                for (int n = 0; n < 2; ++n) acc[a][b][m][n] = (f32x4){0.f, 0.f, 0.f, 0.f};
    bf16x8 At[4][2], B0[2][2], B1[2][2];
    unsigned co[2][2], no[2][2];
    G8_MKOFF(cur, co);
    if (Sched::GATHER) { G8_WAIT_L(0); }
    const char* Ab = (const char*)g.A;
    const char* cAp = Ab + (size_t)cur.pm * tstepA; const char* nAp = cAp;
    const char* cB = (const char*)g.Bt + (size_t)cur.pn * tstepB;
    G8_STAGE(G8_SB(0, 0), cB, voffB); G8_STAGE(G8_SB(0, 1), cB + hstepB, voffB); G8_STAGE_A(G8_SA(0, 0), 0, 0, false); G8_STAGE_A(G8_SA(0, 1), 0, 1, false);
    if (wr == 1) G8_BAR;
    G8_WAIT_V(2); G8_BAR;
    G8_STAGE(G8_SB(1, 0), cB + kstep, voffB); G8_STAGE_A(G8_SA(1, 0), kstep, 0, false); G8_STAGE(G8_SB(1, 1), cB + hstepB + kstep, voffB);
    G8_WAIT_V(6); G8_BAR;
    for (;;) {
        const bool has_next = S.next(ui + 1, nxt);
        if (has_next) { G8_MKOFF(nxt, no); if (Sched::GATHER) { G8_WAIT_L(0); } nAp = Ab + (size_t)nxt.pm * tstepA; }
        else {
            nAp = cAp;
            if constexpr (Sched::GATHER) {
#pragma unroll
                for (int h = 0; h < 2; ++h)
#pragma unroll
                    for (int i = 0; i < 2; ++i) no[h][i] = co[h][i];
            }
        }
        G8_SCHED;
        const char* nB = has_next ? (const char*)g.Bt + (size_t)nxt.pn * tstepB : cB;
#pragma unroll 1
        for (int t = 0; t < nt; t += 2) {
            const bool last = (t == nt - 2);
            const size_t k1 = (size_t)(t + 1) * kstep, k2 = last ? 0 : (size_t)(t + 2) * kstep, k3 = k2 + kstep;
            const char* b2 = last ? nB : cB + (size_t)(t + 2) * kstep; const char* b3 = b2 + kstep;
            G8_LDB(B0, 0, 0); G8_LDB(B1, 0, 1); G8_SCHED; G8_LDA(At, 0, 0); G8_STAGE_A(G8_SA(1, 1), k1, 1, false);
            G8_WAIT_V(8); G8_WAIT_L(0); G8_BAR; G8_MMA(0, 0, At, B0); G8_MMA(0, 1, At, B1); G8_BAR; G8_SCHED;
            G8_LDA(At, 0, 1); G8_STAGE(G8_SB(0, 0), b2, voffB); G8_STAGE(G8_SB(0, 1), b2 + hstepB, voffB); G8_STAGE_A(G8_SA(0, 0), k2, 0, last);
            G8_WAIT_V(8); G8_WAIT_L(0); G8_BAR; G8_MMA(1, 0, At, B0); G8_MMA(1, 1, At, B1); G8_BAR; G8_SCHED;
            G8_LDB(B0, 1, 0); G8_LDB(B1, 1, 1); G8_SCHED; G8_LDA(At, 1, 0); G8_STAGE_A(G8_SA(0, 1), k2, 1, last);
            G8_WAIT_V(8); G8_WAIT_L(0); G8_BAR; G8_MMA(0, 0, At, B0); G8_MMA(0, 1, At, B1); G8_BAR; G8_SCHED;
            G8_LDA(At, 1, 1); G8_STAGE(G8_SB(1, 0), b3, voffB); G8_STAGE(G8_SB(1, 1), b3 + hstepB, voffB); G8_STAGE_A(G8_SA(1, 0), k3, 0, last);
            G8_WAIT_V(8); G8_WAIT_L(0); G8_BAR; G8_MMA(1, 0, At, B0); G8_MMA(1, 1, At, B1); G8_BAR; G8_SCHED;
        }
        if (wr == 0) G8_BAR;
        E(acc, cur, wr, wc, fr, fq, lds);
        if (!has_next) break;
#pragma unroll
        for (int a = 0; a < 2; ++a)
#pragma unroll
            for (int b = 0; b < 2; ++b)
#pragma unroll
                for (int m = 0; m < 4; ++m)
#pragma unroll
                    for (int n = 0; n < 2; ++n) acc[a][b][m][n] = (f32x4){0.f, 0.f, 0.f, 0.f};
        cur = nxt; cB = nB; cAp = nAp; ++ui;
        if constexpr (Sched::GATHER) {
#pragma unroll
            for (int h = 0; h < 2; ++h)
#pragma unroll
                for (int i = 0; i < 2; ++i) co[h][i] = no[h][i];
        }
        if (wr == 1) G8_BAR;
    }
    G8_WAIT_V(0);
    G8_BAR;
#undef G8_SA
#undef G8_SB
#undef G8_STAGE
#undef G8_LDA
#undef G8_LDB
#undef G8_MMA
#undef G8_WAIT_V
#undef G8_WAIT_L
#undef G8_BAR
#undef G8_SCHED
#undef G8_MKOFF
#undef G8_STAGE_A
}
}

using g8::Unit;
typedef f32x4 Acc[2][2][4][2];
__device__ __forceinline__ u32x4 pack8(const f32x4 a, const f32x4 b) { u32x4 w; w.x = pk2(a[0], a[1]); w.y = pk2(a[2], a[3]); w.z = pk2(b[0], b[1]); w.w = pk2(b[2], b[3]); return w; }

struct EpiInA {
    bf16 *Qa, *Ka, *Va, *Z; const float *qg, *kg, *cosA, *sinA;
    __device__ __forceinline__ void operator()(const Acc& acc, const Unit& u, int wr, int wc, int fr, int fq, LAS unsigned char*) const {
        const int row0 = u.pm * 256 + wr * 64 + fr, pn = u.pn, a = fq >> 1, b = fq & 1;
        if (pn < 3) {
            const bool isv = (pn == 2 && wc >= 2), isq = pn < 2;
            const int dbase = 32 * a + 8 * b;
            if (isv) {
#pragma unroll
                for (int ai = 0; ai < 2; ++ai)
#pragma unroll
                    for (int m = 0; m < 4; ++m) { const int row = row0 + ai * 128 + m * 16; bf16* o = Va + (size_t)row * 128 + (wc - 2) * 64 + dbase;
#pragma unroll
                        for (int bj = 0; bj < 2; ++bj) *(u32x4*)(o + 16 * bj) = pack8(acc[ai][bj][m][0], acc[ai][bj][m][1]); }
                return;
            }
            const float* g = isq ? qg : kg;
            f32x4 gv[2][2];
#pragma unroll
            for (int bj = 0; bj < 2; ++bj)
#pragma unroll
                for (int n = 0; n < 2; ++n) gv[bj][n] = *(const f32x4*)(g + dbase + 16 * bj + 4 * n);
            const float sc = isq ? QSCALE_A : 1.f;
            bf16* obase = isq ? (Qa + (pn * 4 + wc) * 64 + dbase) : (Ka + wc * 64 + dbase);
            const int opitch = isq ? 512 : 128;
            f32x4 cc[2], sn[2], cn[2], snn[2];
            { const int t = row0 & 4095;
#pragma unroll
              for (int n = 0; n < 2; ++n) { cc[n] = *(const f32x4*)(cosA + t * 32 + 16 * a + 8 * b + 4 * n); sn[n] = *(const f32x4*)(sinA + t * 32 + 16 * a + 8 * b + 4 * n); } }
#pragma unroll
            for (int gidx = 0; gidx < 8; ++gidx) {
                    const int ai = gidx >> 2, m = gidx & 3;
                    const int row = row0 + ai * 128 + m * 16;
                    if (gidx < 7) { const int tn = (row0 + ((gidx + 1) >> 2) * 128 + ((gidx + 1) & 3) * 16) & 4095;
#pragma unroll
                        for (int n = 0; n < 2; ++n) { cn[n] = *(const f32x4*)(cosA + tn * 32 + 16 * a + 8 * b + 4 * n); snn[n] = *(const f32x4*)(sinA + tn * 32 + 16 * a + 8 * b + 4 * n); } }
                    float ss = 0.f;
#pragma unroll
                    for (int bj = 0; bj < 2; ++bj)
#pragma unroll
                        for (int n = 0; n < 2; ++n) { const f32x4 v = acc[ai][bj][m][n]; ss += (v[0] * v[0] + v[1] * v[1]) + (v[2] * v[2] + v[3] * v[3]); }
                    ss += __shfl_xor(ss, 16); ss += __shfl_xor(ss, 32);
                    const float rs = rsqrtf(ss * (1.f / 64.f) + EPS);
                    f32x4 y[2][2];
#pragma unroll
                    for (int bj = 0; bj < 2; ++bj)
#pragma unroll
                        for (int n = 0; n < 2; ++n) y[bj][n] = acc[ai][bj][m][n] * rs * gv[bj][n];
                    if (row < NL) {
#pragma unroll
                        for (int n = 0; n < 2; ++n) { const f32x4 y0 = y[0][n], y1 = y[1][n]; y[0][n] = y0 * cc[n] - y1 * sn[n]; y[1][n] = y1 * cc[n] + y0 * sn[n]; }
                    }
                    bf16* o = obase + (size_t)row * opitch;
#pragma unroll
                    for (int bj = 0; bj < 2; ++bj) *(u32x4*)(o + 16 * bj) = pack8(y[bj][0] * sc, y[bj][1] * sc);
                    asm volatile("" ::: "memory");
#pragma unroll
                    for (int n = 0; n < 2; ++n) { cc[n] = cn[n]; sn[n] = snn[n]; }
            }
        } else {
            const int j0 = 128 * (pn - 3) + 32 * wc + 8 * fq;
#pragma unroll
            for (int ai = 0; ai < 2; ++ai)
#pragma unroll
                for (int m = 0; m < 4; ++m) {
                    const int row = row0 + ai * 128 + m * 16; f32x4 z[2];
#pragma unroll
                    for (int n = 0; n < 2; ++n) { const f32x4 av = acc[ai][0][m][n], gt = acc[ai][1][m][n];
#pragma unroll
                        for (int r = 0; r < 4; ++r) z[n][r] = av[r] * fsigm(gt[r]); }
                    *(u32x4*)(Z + (size_t)row * 512 + j0) = pack8(z[0], z[1]);
                }
        }
    }
};
struct EpiResid {
    float* X; const float* Xlat; const float* Xctx; const float* gmod; float* SSX;
    __device__ __forceinline__ void operator()(const Acc& acc, const Unit& u, int wr, int wc, int fr, int fq, LAS unsigned char*) const {
        const int row0 = u.pm * 256 + wr * 64 + fr; const int mr = u.pm < 64 ? (u.pm >> 4) : 4;
        const float* gp = gmod + (size_t)mr * 6144; const float* src = u.pm < 64 ? Xlat : Xctx - (size_t)NL * D;
        float ssr[2][4];
#pragma unroll
        for (int ai = 0; ai < 2; ++ai)
#pragma unroll
            for (int m = 0; m < 4; ++m) ssr[ai][m] = 0.f;
#pragma unroll
        for (int bj = 0; bj < 2; ++bj) {
            const int c0 = 256 * u.pn + 128 * bj + 32 * wc + 4 * fq;
            const f32x4 g0 = *(const f32x4*)(gp + c0), g1 = *(const f32x4*)(gp + c0 + 16);
#pragma unroll
            for (int ai = 0; ai < 2; ++ai) {
                f32x4 xo[4][2];
#pragma unroll
                for (int m = 0; m < 4; ++m) { const float* xp = src + (size_t)(row0 + ai * 128 + m * 16) * D + c0; xo[m][0] = *(const f32x4*)xp; xo[m][1] = *(const f32x4*)(xp + 16); }
#pragma unroll
                for (int m = 0; m < 4; ++m) { float* op = X + (size_t)(row0 + ai * 128 + m * 16) * D + c0;
                    const f32x4 y0 = xo[m][0] + g0 * acc[ai][bj][m][0], y1 = xo[m][1] + g1 * acc[ai][bj][m][1];
                    *(f32x4*)op = y0; *(f32x4*)(op + 16) = y1;
                    ssr[ai][m] += (y0[0] * y0[0] + y0[1] * y0[1]) + (y0[2] * y0[2] + y0[3] * y0[3]) + (y1[0] * y1[0] + y1[1] * y1[1]) + (y1[2] * y1[2] + y1[3] * y1[3]); }
                asm volatile("" ::: "memory");
            }
        }
#pragma unroll
        for (int ai = 0; ai < 2; ++ai)
#pragma unroll
            for (int m = 0; m < 4; ++m) { float ss = ssr[ai][m]; ss += __shfl_xor(ss, 16); ss += __shfl_xor(ss, 32);
                if (fq == 0) SSX[(size_t)(row0 + ai * 128 + m * 16) * 16 + 4 * u.pn + wc] = ss; }
    }
};
struct EpiBf16 {
    bf16* O; int ldo, ncols;
    __device__ __forceinline__ void operator()(const Acc& acc, const Unit& u, int wr, int wc, int fr, int fq, LAS unsigned char*) const {
        const int row0 = u.pm * 256 + wr * 64 + fr;
#pragma unroll
        for (int bj = 0; bj < 2; ++bj) {
            const int c0 = 256 * u.pn + 128 * bj + 32 * wc + 8 * fq;
            if (c0 < ncols) {
#pragma unroll
                for (int ai = 0; ai < 2; ++ai)
#pragma unroll
                    for (int m = 0; m < 4; ++m) *(u32x4*)(O + (size_t)(row0 + ai * 128 + m * 16) * ldo + c0) = pack8(acc[ai][bj][m][0], acc[ai][bj][m][1]);
            }
        }
    }
};
struct EpiP {
    bf16* P; float* SSP; bf16* Kc; const float* krg; const float* cosC; const float* sinC;
    __device__ __forceinline__ void operator()(const Acc& acc, const Unit& u, int wr, int wc, int fr, int fq, LAS unsigned char*) const {
        const int row0 = u.pm * 256 + wr * 64 + fr;
        if (u.pn < 4) {
#pragma unroll
            for (int ai = 0; ai < 2; ++ai)
#pragma unroll
                for (int m = 0; m < 4; ++m) { const int row = row0 + ai * 128 + m * 16; float ss = 0.f;
#pragma unroll
                    for (int bj = 0; bj < 2; ++bj) { const f32x4 y0 = acc[ai][bj][m][0], y1 = acc[ai][bj][m][1];
                        *(u32x4*)(P + (size_t)row * PP + 256 * u.pn + 128 * bj + 32 * wc + 8 * fq) = pack8(y0, y1);
                        ss += (y0[0] * y0[0] + y0[1] * y0[1]) + (y0[2] * y0[2] + y0[3] * y0[3]) + (y1[0] * y1[0] + y1[1] * y1[1]) + (y1[2] * y1[2] + y1[3] * y1[3]); }
                    ss += __shfl_xor(ss, 16); ss += __shfl_xor(ss, 32);
                    if (fq == 0) SSP[(size_t)row * 16 + 4 * u.pn + wc] = ss; }
        } else if (wc == 0) {
            const f32x4 g0 = *(const f32x4*)(krg + 8 * fq), g1 = *(const f32x4*)(krg + 8 * fq + 4);
#pragma unroll
            for (int ai = 0; ai < 2; ++ai)
#pragma unroll
                for (int m = 0; m < 4; ++m) { const int row = row0 + ai * 128 + m * 16; const f32x4 v0 = acc[ai][0][m][0], v1 = acc[ai][0][m][1];
                    *(u32x4*)(P + (size_t)row * PP + 1024 + 8 * fq) = pack8(v0, v1);
                    float ss = (v0[0] * v0[0] + v0[1] * v0[1]) + (v0[2] * v0[2] + v0[3] * v0[3]) + (v1[0] * v1[0] + v1[1] * v1[1]) + (v1[2] * v1[2] + v1[3] * v1[3]);
                    ss += __shfl_xor(ss, 16); ss += __shfl_xor(ss, 32);
                    const float rk = rsqrtf(ss * (1.f / 32.f) + EPS);
                    f32x4 y0 = v0 * rk * g0, y1 = v1 * rk * g1;
                    const int t = row & 4095, ax = fq >> 1;
                    const f32x4 c0 = *(const f32x4*)(cosC + t * 16 + 8 * ax), c1 = *(const f32x4*)(cosC + t * 16 + 8 * ax + 4), s0 = *(const f32x4*)(sinC + t * 16 + 8 * ax), s1 = *(const f32x4*)(sinC + t * 16 + 8 * ax + 4);
                    f32x4 p0, p1;
#pragma unroll
                    for (int j = 0; j < 4; ++j) { p0[j] = __shfl_xor(y0[j], 16); p1[j] = __shfl_xor(y1[j], 16); }
                    if (row < NL) { if ((fq & 1) == 0) { y0 = y0 * c0 - p0 * s0; y1 = y1 * c1 - p1 * s1; } else { y0 = y0 * c0 + p0 * s0; y1 = y1 * c1 + p1 * s1; } }
                    const u32x4 wv = pack8(y0, y1);
#pragma unroll
                    for (int hd = 0; hd < 16; ++hd) *(u32x4*)(Kc + (size_t)row * 1536 + hd * 96 + 64 + 8 * fq) = wv;
                    asm volatile("" ::: "memory"); }
        }
    }
};
struct EpiKV {
    bf16 *Kc, *Vc; const float* SSP; const float* kg;
    __device__ __forceinline__ void operator()(const Acc& acc, const Unit& u, int wr, int wc, int fr, int fq, LAS unsigned char*) const {
        const int row0 = u.pm * 256 + wr * 64 + fr, head = 2 * u.pn + (wc >> 1), dbase = 8 * fq;
        const bool isk = (wc & 1) == 0;
        float rr[2][4];
#pragma unroll
        for (int ai = 0; ai < 2; ++ai)
#pragma unroll
            for (int m = 0; m < 4; ++m) { const f32x4 pq = *(const f32x4*)(SSP + (size_t)(row0 + ai * 128 + m * 16) * 16 + 12); rr[ai][m] = (pq[0] + pq[1]) + (pq[2] + pq[3]); }
        f32x4 gv[2][2];
#pragma unroll
        for (int bj = 0; bj < 2; ++bj)
#pragma unroll
            for (int n = 0; n < 2; ++n) gv[bj][n] = isk ? *(const f32x4*)(kg + dbase + 32 * bj + 4 * n) : (f32x4){1.f, 1.f, 1.f, 1.f};
#pragma unroll
        for (int ai = 0; ai < 2; ++ai)
#pragma unroll
            for (int m = 0; m < 4; ++m) {
                const int row = row0 + ai * 128 + m * 16; const float r = rsqrtf(rr[ai][m] * (1.f / 256.f) + EPS);
                float f = r;
                if (isk) {
                    float ss = 0.f;
#pragma unroll
                    for (int bj = 0; bj < 2; ++bj)
#pragma unroll
                        for (int n = 0; n < 2; ++n) { const f32x4 v = acc[ai][bj][m][n]; ss += (v[0] * v[0] + v[1] * v[1]) + (v[2] * v[2] + v[3] * v[3]); }
                    ss += __shfl_xor(ss, 16); ss += __shfl_xor(ss, 32);
                    f = r * rsqrtf(r * r * ss * (1.f / 64.f) + EPS);
                }
                bf16* o = isk ? (Kc + (size_t)row * 1536 + head * 96 + dbase) : (Vc + (size_t)row * 1024 + head * 64 + dbase);
#pragma unroll
                for (int bj = 0; bj < 2; ++bj) *(u32x4*)(o + 32 * bj) = pack8(acc[ai][bj][m][0] * f * gv[bj][0], acc[ai][bj][m][1] * f * gv[bj][1]);
            }
    }
};
struct EpiGU {
    bf16* ACT; const float* bgu;
    __device__ __forceinline__ void operator()(const Acc& acc, const Unit& u, int wr, int wc, int fr, int fq, LAS unsigned char*) const {
        const int row0 = u.gm * 256 + wr * 64 + fr, j0 = 128 * u.nt + 32 * wc + 8 * fq;
        const float* bp = bgu + (size_t)u.e * 2048;
        f32x4 bg[2], bu[2];
#pragma unroll
        for (int n = 0; n < 2; ++n) { bg[n] = *(const f32x4*)(bp + j0 + 4 * n); bu[n] = *(const f32x4*)(bp + 1024 + j0 + 4 * n); }
#pragma unroll
        for (int ai = 0; ai < 2; ++ai)
#pragma unroll
            for (int m = 0; m < 4; ++m) {
                f32x4 z[2];
#pragma unroll
                for (int n = 0; n < 2; ++n) { const f32x4 gt = acc[ai][0][m][n] + bg[n], up = acc[ai][1][m][n] + bu[n];
#pragma unroll
                    for (int r = 0; r < 4; ++r) { const float gg = fminf(gt[r], 7.f), uu = fminf(fmaxf(up[r], -7.f), 7.f); z[n][r] = (uu + 1.f) * (gg * fsigm(1.702f * gg)); } }
                *(u32x4*)(ACT + (size_t)(row0 + ai * 128 + m * 16) * 1024 + j0) = pack8(z[0], z[1]);
            }
    }
};
struct EpiDown {
    bf16* YB; const float* bdn; const float* gate; const LAS int* idx;
    __device__ __forceinline__ void operator()(const Acc& acc, const Unit& u, int wr, int wc, int fr, int fq, LAS unsigned char*) const {
        const int r0 = wr * 64 + fr; const float* bp = bdn + (size_t)u.e * 1024;
        f32x4 bv[2][2]; int c0[2];
#pragma unroll
        for (int bj = 0; bj < 2; ++bj) { c0[bj] = 256 * u.nt + 128 * bj + 32 * wc + 8 * fq; bv[bj][0] = *(const f32x4*)(bp + c0[bj]); bv[bj][1] = *(const f32x4*)(bp + c0[bj] + 4); }
#pragma unroll
        for (int ai = 0; ai < 2; ++ai)
#pragma unroll
            for (int m = 0; m < 4; ++m) {
                const int slot = idx[u.slot * 256 + r0 + ai * 128 + m * 16];
                if (slot >= 0) {
                    const float gw = gate[slot]; bf16* o = YB + (size_t)slot * 1024;
#pragma unroll
                    for (int bj = 0; bj < 2; ++bj) *(u32x4*)(o + c0[bj]) = pack8((acc[ai][bj][m][0] + bv[bj][0]) * gw, (acc[ai][bj][m][1] + bv[bj][1]) * gw);
                }
            }
    }
};

enum { LAY_STD = 0, LAY_HEAD = 1, LAY_INA = 2, LAY_GU = 3, LAY_F32 = 4, LAY_HEAD2 = 5 };
template <int LAY> __device__ __forceinline__ int colmap(int pn, int rho) {
    const int bj = rho >> 7, wc = (rho >> 5) & 3, n = (rho >> 4) & 1, fq = (rho >> 2) & 3, reg = rho & 3;
    const int std_c = 128 * bj + 32 * wc + 8 * fq + 4 * n + reg;
    const int head_c = 64 * wc + 32 * (fq >> 1) + 8 * (fq & 1) + 16 * bj + 4 * n + reg;
    if (LAY == LAY_STD) return 256 * pn + std_c;
    if (LAY == LAY_F32) return 256 * pn + rho;
    if (LAY == LAY_HEAD) return 256 * pn + head_c;
    if (LAY == LAY_HEAD2) return 256 * pn + 64 * wc + 32 * bj + 8 * fq + 4 * n + reg;
    if (LAY == LAY_INA) return pn < 3 ? 256 * pn + head_c : 768 + (bj ? 512 : 0) + 128 * (pn - 3) + 32 * wc + 8 * fq + 4 * n + reg;
    return (bj ? 1024 : 0) + 128 * pn + 32 * wc + 8 * fq + 4 * n + reg;
}
template <int LAY>
__device__ __forceinline__ void cvt_matrix(const float* src, size_t mat_stride, int ld, int nvalid, int K, int tiles_per_mat, int ntiles, bf16* dst, const float* kscale,
                                           LAS float* scr, int it_begin, int it_step, int lane, int it_end = 0x7fffffff) {
    const int kblocks = K / 64; int nitems = ntiles * 8 * kblocks; nitems = nitems < it_end ? nitems : it_end;
    const int gw = it_begin, NGW = it_step;
    const int i = lane & 31, kh = lane >> 5;
    float v[32], vn[32];
#define CVT_LOAD(it_, dstv) do { const int _kb = (it_) % kblocks, _tg = (it_) / kblocks, _grp = _tg & 7, _tile = _tg >> 3; \
        const int _mat = _tile / tiles_per_mat, _pn = _tile - _mat * tiles_per_mat; const int _c = colmap<LAY>(_pn, _grp * 32 + i); const bool _ok = _c < nvalid; \
        const float* _s = src + (size_t)_mat * mat_stride + (size_t)(_kb * 64 + kh) * ld + (_ok ? _c : 0); \
        _Pragma("unroll") for (int ii = 0; ii < 32; ++ii) dstv[ii] = _ok ? _s[(size_t)(2 * ii) * ld] : 0.f; } while (0)
    int it = gw;
    if (it < nitems) CVT_LOAD(it, v);
    for (; it < nitems; it += NGW) {
        const int itn = it + NGW;
        if (itn < nitems) CVT_LOAD(itn, vn);
        const int kb = it % kblocks, tg = it / kblocks, grp = tg & 7, tile = tg >> 3;
        if (kscale) {
#pragma unroll
            for (int ii = 0; ii < 32; ++ii) v[ii] *= kscale[kb * 64 + 2 * ii + kh];
        }
#pragma unroll
        for (int ii = 0; ii < 32; ++ii) scr[(2 * ii + kh) * 33 + i] = v[ii];
        LDS_WAIT(); asm volatile("" ::: "memory");
        const int c8 = lane & 7;
#pragma unroll
        for (int j = 0; j < 4; ++j) { const int n = (lane >> 3) + 8 * j; const LAS float* q = scr + (8 * c8) * 33 + n;
            u32x4 o; o.x = pk2(q[0 * 33], q[1 * 33]); o.y = pk2(q[2 * 33], q[3 * 33]); o.z = pk2(q[4 * 33], q[5 * 33]); o.w = pk2(q[6 * 33], q[7 * 33]);
            *(u32x4*)(dst + ((size_t)tile * 256 + grp * 32 + n) * K + kb * 64 + 8 * c8) = o; }
        LDS_WAIT(); asm volatile("" ::: "memory");
#pragma unroll
        for (int ii = 0; ii < 32; ++ii) v[ii] = vn[ii];
    }
#undef CVT_LOAD
}

struct CvtBg {
    const float* wgu; const float* wdn; bf16* dgu; bf16* ddn; int cl0, vcu, j, jend, step, tick;
    __device__ __forceinline__ void init(const float* wgu_, const float* wdn_, bf16* dgu_, bf16* ddn_, int cl0_, int nlay, int vcu_, int j0, int step_) {
        wgu = wgu_; wdn = wdn_; dgu = dgu_; ddn = ddn_; cl0 = cl0_; vcu = vcu_; j = j0; step = step_; jend = nlay * 192; tick = 0; }
    __device__ __forceinline__ void decode(int jj, bool& isgu, int& cl, int& it) const { cl = cl0 + jj / 192; const int r = jj % 192; isgu = r < 128; it = isgu ? vcu * 128 + r : vcu * 64 + (r - 128); }
    __device__ __forceinline__ int issue_dma(int lane, LAS unsigned char* buf, bf16*& dst_) {
        const int jj = __builtin_amdgcn_readfirstlane(j);
        if (jj >= jend) return -1;
        bool isgu; int cl, it; decode(jj, isgu, cl, it);
        const int kb = it & 15, tg = it >> 4, grp = tg & 7, tile = tg >> 3;
        const int kr = lane >> 3, p = lane & 7;
        const float* s; unsigned ld;
        if (isgu) { const int mat = tile >> 3, pn = tile & 7; s = wgu + ((size_t)(cl * 32 + mat) * 1024 + kb * 64) * 2048 + colmap<LAY_GU>(pn, grp * 32); ld = 2048; dst_ = dgu + ((size_t)(cl * 256 + tile) * 256 + grp * 32) * 1024 + kb * 64; }
        else { const int mat = tile >> 2, pn = tile & 3; s = wdn + ((size_t)(cl * 32 + mat) * 1024 + kb * 64) * 1024 + colmap<LAY_STD>(pn, grp * 32); ld = 1024; dst_ = ddn + ((size_t)(cl * 128 + tile) * 256 + grp * 32) * 1024 + kb * 64; }
        const unsigned rowoff = (unsigned)kr * ld * 4u;
#pragma unroll
        for (int q = 0; q < 8; ++q) { const int cq = p ^ q; const unsigned coff = (unsigned)(8 * (cq & 3) + 4 * (cq >> 2)) * 4u;
            __builtin_amdgcn_global_load_lds((const unsigned*)((const char*)s + (size_t)(8 * q) * ld * 4 + rowoff + coff), (LAS unsigned*)(buf + q * 1024), 16, 0, 2); }
        j = jj + step; return jj;
    }
    __device__ __forceinline__ void out_pair(const LAS unsigned char* buf, size_t d  , int n, int o) const {
        const LAS unsigned char* b = buf + (8 * o) * 128 + (((n >> 2) ^ o) << 4) + (n & 3) * 4;
        f32x2 v[8];
#pragma unroll
        for (int q = 0; q < 8; ++q) v[q] = *(const LAS f32x2*)(b + q * 128);
        u32x4 w0, w1;
        w0.x = pk2(v[0][0], v[1][0]); w0.y = pk2(v[2][0], v[3][0]); w0.z = pk2(v[4][0], v[5][0]); w0.w = pk2(v[6][0], v[7][0]);
        w1.x = pk2(v[0][1], v[1][1]); w1.y = pk2(v[2][1], v[3][1]); w1.z = pk2(v[4][1], v[5][1]); w1.w = pk2(v[6][1], v[7][1]);
        typedef __attribute__((address_space(1))) u32x4 g_u32x4;
        g_u32x4* o_ = (g_u32x4*)(d + ((size_t)n * 1024 + 8 * o) * 2);
        o_[0] = w0; o_[128] = w1; }
    __device__ __forceinline__ void process_slot(int tid, const LAS unsigned char* lds, int sl) const {
        const int c = tid >> 7; const i32x4 h = *(const LAS i32x4*)(lds + CV_HDR + (2 * c + sl) * 16);
        if (h[0] >= 0) { const size_t d = ((size_t)(unsigned)h[2] << 32) | (size_t)(unsigned)h[1]; out_pair(lds + CV_BUF + (2 * c + sl) * 8192, d, 2 * ((tid >> 3) & 15), tid & 7); }
    }
    __device__ __forceinline__ void tail_loop(int lane, LAS unsigned char* buf) {
        bf16* da; bf16* db;
        int a = issue_dma(lane, buf, da), sl = 0;
        while (a >= 0) {
            const int b = issue_dma(lane, buf + (sl ^ 1) * 8192, db);
            if (b >= 0) asm volatile("s_waitcnt vmcnt(8)" ::: "memory"); else asm volatile("s_waitcnt vmcnt(0)" ::: "memory");
#pragma unroll
            for (int x = 0; x < 2; ++x) { const int id = lane + 64 * x; out_pair(buf + sl * 8192, (size_t)da, 2 * (id >> 3), id & 7); }
            asm volatile("s_waitcnt lgkmcnt(0)" ::: "memory");
            a = b; da = db; sl ^= 1;
        }
    }
};
struct NoBg { __device__ __forceinline__ void issue(int) {} __device__ __forceinline__ void finish(int) {} };

__device__ __forceinline__ void normmod_store(const f32x4 (&v)[4], float rstd, const float* g, const float* mvec  , int sh_off, int sc_off, bf16* orow, int lane) {
#pragma unroll
    for (int j = 0; j < 4; ++j) { const int c = 4 * lane + 256 * j;
        const f32x4 gg = *(const f32x4*)(g + c), sc = *(const f32x4*)(mvec + sc_off + c), sh = *(const f32x4*)(mvec + sh_off + c);
        const f32x4 y = v[j] * rstd * gg * (sc + 1.f) + sh;
        u32x2 w; w.x = pk2(y[0], y[1]); w.y = pk2(y[2], y[3]); *(u32x2*)(orow + c) = w; }
}

template <int DQK> struct AT {
    static constexpr int CK = DQK / 8, KT = 64 * DQK * 2, VT = 64 * 128, STG = KT + VT, NKS = DQK / 16, NKI = CK / 4;
};
#define MFMA32(a, b, c) __builtin_amdgcn_mfma_f32_32x32x16_bf16((a), (b), (c), 0, 0, 0)
struct TileList { int nloc, row_loc0, kpos_loc0, row_ctx0, ntiles; };
__device__ __forceinline__ float at_max3(float a, float b, float c) { float r; asm("v_max3_f32 %0, %1, %2, %3" : "=v"(r) : "v"(a), "v"(b), "v"(c)); return r; }
template <int DQK, bool MASK, class Bg, int CAD, int XP = 0>
__device__ __forceinline__ void attn_core(LAS unsigned char* lds, const bf16x8 (&qf)[DQK / 16], const TileList tl, const char* Kg, int kpitchB, const char* Vg, int vpitchB,
                                          int qpos, float& m, float& l, f32x16 (&O)[2], Bg& bg) {
    typedef AT<DQK> A;
    const int tid = otid(), lane = tid & 63, h = lane >> 5;
    const int wv = __builtin_amdgcn_readfirstlane(tid >> 6);
    const bool stager = wv < 4;
    unsigned koff[A::NKI], voff;
#pragma unroll
    for (int t = 0; t < A::NKI; ++t) { const int sl_ = 64 * t + lane; int rr, ch;
        if (DQK == 96) { rr = sl_ / 12; const int p = sl_ % 12, rot = (rr >> 2) & 3; ch = p - rot; ch = ch < 0 ? ch + 12 : ch; }
        else { rr = sl_ >> 3; ch = (sl_ & 7) ^ ((rr >> 1) & 7); }
        koff[t] = (unsigned)(rr * kpitchB + ch * 16); }
    voff = (unsigned)((lane >> 3) * vpitchB + (((lane & 7) ^ (4 * ((lane >> 4) & 1))) * 16));
    unsigned kf0, kf4 = 0, kf5 = 0;
    if (DQK == 96) { const int x = 16 * (h + ((lane >> 2) & 3)); kf0 = (unsigned)((lane & 31) * 192 + x); kf4 = kf0 + (x >= 64 ? 128 - 192 : 128); kf5 = kf0 + (x >= 32 ? 160 - 192 : 160); }
    else { const int sw = (lane >> 1) & 7; kf0 = (unsigned)((lane & 31) * 128 + 16 * (h ^ (sw & 1)) + 32 * (sw >> 1)); }
#define AT_KADDR(ks) (DQK == 96 ? ((ks) == 4 ? kf4 : (ks) == 5 ? kf5 : kf0 + 32u * (ks)) : (kf0 ^ (32u * (ks))))
    const unsigned vrow = (unsigned)((((lane & 15) >> 2) + 4 * h) * 128 + 32 * ((lane >> 4) & 1) + 8 * (lane & 3));
    const unsigned vfA = vrow + 64u * ((lane >> 3) & 1), vfB = vrow + 64u * (1 - ((lane >> 3) & 1));
    LAS int* cvh = (LAS int*)(lds + CV_HDR);
    const int cw = wv & 3;
#define AT_ROW0(i) ((i) < tl.nloc ? tl.row_loc0 + 64 * (i) : tl.row_ctx0 + 64 * ((i) - tl.nloc))
#define AT_DMA_K(i) do { const char* _kp = Kg + (size_t)(AT_ROW0(i) + 16 * wv) * kpitchB; LAS unsigned char* _b = lds + ((i) & 1) * A::KT + (A::NKI * wv) * 1024; \
        _Pragma("unroll") for (int t = 0; t < A::NKI; ++t) __builtin_amdgcn_global_load_lds((const unsigned*)(_kp + koff[t]), (LAS unsigned*)(_b + t * 1024), 16, 0, 0); } while (0)
#define AT_DMA_V(i) do { const char* _vp = Vg + (size_t)(AT_ROW0(i) + 16 * wv) * vpitchB; LAS unsigned char* _b = lds + 2 * A::KT + ((i) & 1) * A::VT + (2 * wv) * 1024; \
        _Pragma("unroll") for (int t = 0; t < 2; ++t) __builtin_amdgcn_global_load_lds((const unsigned*)(_vp + (size_t)(8 * t) * vpitchB + voff), (LAS unsigned*)(_b + t * 1024), 16, 0, 0); } while (0)
#define AT_BAR() do { asm volatile("s_waitcnt lgkmcnt(0)" ::: "memory"); if (!(XP & 1)) __builtin_amdgcn_s_barrier(); asm volatile("" ::: "memory"); } while (0)
#define AT_SB() __builtin_amdgcn_sched_barrier(0)
#define AT_TR(dst, ad, off) asm volatile("ds_read_b64_tr_b16 %0, %1 offset:" #off : "=v"(dst) : "v"(ad))
#define AT_VWAIT() asm volatile("s_waitcnt lgkmcnt(0)" : "+v"(vlo[0][0]), "+v"(vlo[0][1]), "+v"(vlo[1][0]), "+v"(vlo[1][1]), "+v"(vhi[0][0]), "+v"(vhi[0][1]), "+v"(vhi[1][0]), "+v"(vhi[1][1]))
#define AT_QK(C0, C1, j) do { if (XP & 16) { C0 = zero16; C1 = zero16; C0[0] = (float)(j); break; } const LAS unsigned char* kt = lds + ((j) & 1) * A::KT; bf16x8 ka[A::NKS][2]; \
        _Pragma("unroll") for (int ks = 0; ks < A::NKS; ++ks) { ka[ks][0] = *(const LAS bf16x8*)(kt + AT_KADDR(ks)); ka[ks][1] = *(const LAS bf16x8*)(kt + AT_KADDR(ks) + 32 * DQK * 2); } \
        C0 = MFMA32(ka[0][0], qf[0], zero16); C1 = MFMA32(ka[0][1], qf[0], zero16); \
        _Pragma("unroll") for (int ks = 1; ks < A::NKS; ++ks) { C0 = MFMA32(ka[ks][0], qf[ks], C0); C1 = MFMA32(ka[ks][1], qf[ks], C1); } } while (0)
#define AT_FSM(P0, P1) do { \
        if (!(XP & 4)) { _Pragma("unroll") for (int r = 0; r < 16; ++r) { P0[r] = __builtin_amdgcn_exp2f(P0[r]); P1[r] = __builtin_amdgcn_exp2f(P1[r]); } } \
        _Pragma("unroll") for (int sp = 0; sp < 2; ++sp) { u32x4 pw; \
            pw.x = pk2(P0[8 * sp + 0], P0[8 * sp + 1]); pw.y = pk2(P0[8 * sp + 2], P0[8 * sp + 3]); pw.z = pk2(P0[8 * sp + 4], P0[8 * sp + 5]); pw.w = pk2(P0[8 * sp + 6], P0[8 * sp + 7]); pp[0][sp] = __builtin_bit_cast(bf16x8, pw); \
            pw.x = pk2(P1[8 * sp + 0], P1[8 * sp + 1]); pw.y = pk2(P1[8 * sp + 2], P1[8 * sp + 3]); pw.z = pk2(P1[8 * sp + 4], P1[8 * sp + 5]); pw.w = pk2(P1[8 * sp + 6], P1[8 * sp + 7]); pp[1][sp] = __builtin_bit_cast(bf16x8, pw); } } while (0)
#define AT_RMAX(C0, C1, j) do { if (XP & 32) { tm = C0[0] - m; break; } \
        if (MASK) { const int k0_ = tl.kpos_loc0 + 64 * (j); if ((j) < tl.nloc && (k0_ + 63 - qw > 128 || qw + 31 - k0_ > 128)) { const int kb = k0_ + 4 * h - qpos;     \
            _Pragma("unroll") for (int r = 0; r < 16; ++r) { const int d0 = kb + (r & 3) + 8 * (r >> 2), d1 = d0 + 32; \
                if (d0 > 128 || d0 < -128) C0[r] = -1e30f; if (d1 > 128 || d1 < -128) C1[r] = -1e30f; } } } \
        tm = at_max3(C0[0], C0[1], C1[0]); tm = at_max3(tm, C1[1], C0[2]); \
        _Pragma("unroll") for (int r = 2; r < 16; r += 2) { if (r > 2) tm = at_max3(tm, C0[r - 1], C0[r]); tm = at_max3(tm, C1[r], C1[r + 1]); } \
        tm = fmaxf(tm, C0[15]); \
        { const auto sw_ = __builtin_amdgcn_permlane32_swap(__builtin_bit_cast(unsigned, tm), __builtin_bit_cast(unsigned, tm), false, false); \
          tm = fmaxf(__builtin_bit_cast(float, sw_[0]), __builtin_bit_cast(float, sw_[1])) - m; } } while (0)
#define AT_RESC(C0, C1) do { \
        if (__builtin_amdgcn_ballot_w64(tm > 8.f) != 0ull) { const float dlt = fmaxf(tm, 0.f), alpha = __builtin_amdgcn_exp2f(-dlt); m += dlt; l *= alpha; \
            _Pragma("unroll") for (int r = 0; r < 16; ++r) { O[0][r] *= alpha; O[1][r] *= alpha; Lacc[r] *= alpha; } } \
        if (__builtin_amdgcn_ballot_w64(m != 0.f) != 0ull) { _Pragma("unroll") for (int r = 0; r < 16; ++r) { C0[r] -= m; C1[r] -= m; } } } while (0)
#define AT_PV(t, MID) do { if (XP & 8) { MID; break; } const unsigned _vb = (unsigned)(size_t)lds + 2 * A::KT + ((t) & 1) * A::VT; const unsigned vta = _vb + vfA, vtb = _vb + vfB; s16x4 vlo[2][2], vhi[2][2]; \
        AT_TR(vlo[0][0], vta, 0); AT_TR(vhi[0][0], vta, 1024); AT_TR(vlo[0][1], vtb, 0); AT_TR(vhi[0][1], vtb, 1024); \
        AT_TR(vlo[1][0], vta, 2048); AT_TR(vhi[1][0], vta, 3072); AT_TR(vlo[1][1], vtb, 2048); AT_TR(vhi[1][1], vtb, 3072); \
        MID; \
        Lacc = MFMA32(ones8, pp[0][0], Lacc); Lacc = MFMA32(ones8, pp[0][1], Lacc); Lacc = MFMA32(ones8, pp[1][0], Lacc); Lacc = MFMA32(ones8, pp[1][1], Lacc); \
        asm volatile("" : "+v"(tm), "+v"(Lacc));              \
        AT_VWAIT(); \
        _Pragma("unroll") for (int sp = 0; sp < 2; ++sp) _Pragma("unroll") for (int dvb = 0; dvb < 2; ++dvb) { \
            const bf16x8 va = __builtin_shufflevector(vlo[sp][dvb], vhi[sp][dvb], 0, 1, 2, 3, 4, 5, 6, 7); O[dvb] = MFMA32(va, pp[0][sp], O[dvb]); } \
        AT_TR(vlo[0][0], vta, 4096); AT_TR(vhi[0][0], vta, 5120); AT_TR(vlo[0][1], vtb, 4096); AT_TR(vhi[0][1], vtb, 5120); \
        AT_TR(vlo[1][0], vta, 6144); AT_TR(vhi[1][0], vta, 7168); AT_TR(vlo[1][1], vtb, 6144); AT_TR(vhi[1][1], vtb, 7168); \
        AT_VWAIT(); \
        _Pragma("unroll") for (int sp = 0; sp < 2; ++sp) _Pragma("unroll") for (int dvb = 0; dvb < 2; ++dvb) { \
            const bf16x8 va = __builtin_shufflevector(vlo[sp][dvb], vhi[sp][dvb], 0, 1, 2, 3, 4, 5, 6, 7); O[dvb] = MFMA32(va, pp[1][sp], O[dvb]); } } while (0)
#define AT_HEAD(j) do { if (stager && !(XP & 2)) { if ((j) + 1 < n) AT_DMA_K((j) + 1); AT_DMA_V(j); } \
        issued = false; \
        if ((bg.tick & 1) == 0) { if (!stager) { const int sl_ = (bg.tick >> 1) & 1; bf16* dd_ = nullptr; const int jj = bg.issue_dma(lane, lds + CV_BUF + (2 * cw + sl_) * 8192, dd_); \
                if (lane == 0) *(LAS i32x4*)(lds + CV_HDR + (2 * cw + sl_) * 16) = (i32x4){jj, (int)(unsigned)(size_t)dd_, (int)(unsigned)((size_t)dd_ >> 32), 0}; issued = jj >= 0; } } \
        else bg.process_slot(tid, lds, ((bg.tick + 1) >> 1) & 1); } while (0)
#define AT_TAILSYNC() do { if (stager) asm volatile("s_waitcnt vmcnt(0)" ::: "memory"); \
        else if ((bg.tick & 1) == 0) { if (issued) asm volatile("s_waitcnt vmcnt(8)" ::: "memory"); else asm volatile("s_waitcnt vmcnt(0)" ::: "memory"); } \
        ++bg.tick; AT_BAR(); } while (0)
#define AT_QKF(C0, C1, P0, P1, j) do { const LAS unsigned char* kt = lds + ((j) & 1) * A::KT; bf16x8 ka[A::NKS][2]; \
        _Pragma("unroll") for (int ks = 0; ks < A::NKS; ++ks) { ka[ks][0] = *(const LAS bf16x8*)(kt + AT_KADDR(ks)); ka[ks][1] = *(const LAS bf16x8*)(kt + AT_KADDR(ks) + 32 * DQK * 2); } \
        _Pragma("unroll") for (int r = 0; r < 16; ++r) P0[r] = __builtin_amdgcn_exp2f(P0[r]); \
        asm volatile("" : "+v"(ka[0][0]), "+v"(ka[0][1]), "+v"(P0)); \
        C0 = MFMA32(ka[0][0], qf[0], zero16); C1 = MFMA32(ka[0][1], qf[0], zero16); \
        _Pragma("unroll") for (int ks = 1; ks < A::NKS; ++ks) { C0 = MFMA32(ka[ks][0], qf[ks], C0); C1 = MFMA32(ka[ks][1], qf[ks], C1); } \
        _Pragma("unroll") for (int r = 0; r < 16; ++r) P1[r] = __builtin_amdgcn_exp2f(P1[r]); \
        _Pragma("unroll") for (int sp = 0; sp < 2; ++sp) { u32x4 pw; \
            pw.x = pk2(P0[8 * sp + 0], P0[8 * sp + 1]); pw.y = pk2(P0[8 * sp + 2], P0[8 * sp + 3]); pw.z = pk2(P0[8 * sp + 4], P0[8 * sp + 5]); pw.w = pk2(P0[8 * sp + 6], P0[8 * sp + 7]); pp[0][sp] = __builtin_bit_cast(bf16x8, pw); \
            pw.x = pk2(P1[8 * sp + 0], P1[8 * sp + 1]); pw.y = pk2(P1[8 * sp + 2], P1[8 * sp + 3]); pw.z = pk2(P1[8 * sp + 4], P1[8 * sp + 5]); pw.w = pk2(P1[8 * sp + 6], P1[8 * sp + 7]); pp[1][sp] = __builtin_bit_cast(bf16x8, pw); } } while (0)
#define AT_STEP(C0, C1, P0, P1, j) do { AT_HEAD(j); AT_SB(); \
        if (!(XP & 64)) { AT_QK(C0, C1, j); AT_FSM(P0, P1); } else AT_QKF(C0, C1, P0, P1, j); \
        if (MASK) asm volatile("" : "+v"(pp[0][0]), "+v"(pp[0][1]), "+v"(pp[1][0]), "+v"(pp[1][1]));     \
        AT_SB(); \
        AT_PV((j) - 1, AT_RMAX(C0, C1, j)); AT_SB(); \
        AT_RESC(C0, C1); \
        AT_TAILSYNC(); } while (0)
    f32x16 zero16;
#pragma unroll
    for (int r = 0; r < 16; ++r) zero16[r] = 0.f;
    const int n = tl.ntiles;
    const int qw = __builtin_amdgcn_readfirstlane(qpos);
    bool issued; float tm;
    bf16x8 pp[2][2];
    f32x16 A0, A1, B0, B1, Lacc = zero16;
    const bf16x8 ones8 = (bf16x8){0x3F80, 0x3F80, 0x3F80, 0x3F80, 0x3F80, 0x3F80, 0x3F80, 0x3F80};
    if (stager) AT_DMA_K(0);
    asm volatile("s_waitcnt vmcnt(0)" ::: "memory");
    AT_BAR();
    AT_HEAD(0); AT_SB();
    AT_QK(A0, A1, 0); AT_RMAX(A0, A1, 0); AT_RESC(A0, A1);
    AT_TAILSYNC();
    int j = 1;
    for (; j + 1 < n; j += 2) { AT_STEP(B0, B1, A0, A1, j); AT_STEP(A0, A1, B0, B1, j + 1); }
    if (j < n) { AT_STEP(B0, B1, A0, A1, j); AT_FSM(B0, B1); } else { AT_FSM(A0, A1); }
    AT_SB();
    AT_PV(n - 1, (void)0);
    l += 0.5f * Lacc[0];
#undef AT_ROW0
#undef AT_DMA_K
#undef AT_DMA_V
#undef AT_KADDR
#undef AT_BAR
#undef AT_SB
#undef AT_TR
#undef AT_VWAIT
#undef AT_QK
#undef AT_QKF
#undef AT_FSM
#undef AT_RMAX
#undef AT_RESC
#undef AT_PV
#undef AT_HEAD
#undef AT_TAILSYNC
#undef AT_STEP
}
__device__ __forceinline__ void attn_store(const f32x16 (&O)[2], float l, bf16* orow, int h) {
    const float lt = l + __shfl_xor(l, 32); const float inv = 1.f / lt;
#pragma unroll
    for (int dvb = 0; dvb < 2; ++dvb)
#pragma unroll
        for (int g4 = 0; g4 < 4; ++g4) { u32x2 w; w.x = pk2(O[dvb][4 * g4] * inv, O[dvb][4 * g4 + 1] * inv); w.y = pk2(O[dvb][4 * g4 + 2] * inv, O[dvb][4 * g4 + 3] * inv);
            *(u32x2*)(orow + 32 * dvb + 8 * g4 + 4 * h) = w; }
}

__device__ __forceinline__ void wattn_unit(LAS unsigned char* lds, int unit, const bf16* Qa, const bf16* Ka, const bf16* Va, const float* sink, bf16* MIX, CvtBg& bg) {
    const int tid = otid(), w = tid >> 6, lane = tid & 63, h = lane >> 5;
    int b, kvh, hp, tq, qpos; TileList tl;
    if (unit < 512) { b = unit >> 7; kvh = (unit >> 6) & 1; const int nb = (unit >> 1) & 31; hp = unit & 1;
        const int t0 = max(0, 128 * nb - 128), t1 = min(4096, 128 * nb + 256);
        tl.nloc = (t1 - t0) >> 6; tl.row_loc0 = b * S + t0; tl.kpos_loc0 = t0; tl.row_ctx0 = NL + b * CL; tl.ntiles = tl.nloc + 4;
        qpos = 128 * nb + (w & 3) * 32 + (lane & 31); tq = b * S + qpos;
    } else { const int u = unit - 512; b = u >> 3; kvh = (u >> 2) & 1; hp = (u >> 1) & 1; const int half = u & 1;
        tl.nloc = 0; tl.row_loc0 = 0; tl.kpos_loc0 = 0; tl.row_ctx0 = NL + b * CL; tl.ntiles = 4;
        qpos = 0; tq = NL + b * CL + half * 128 + (w & 3) * 32 + (lane & 31); }
    const int hq = kvh * 4 + hp * 2 + (w >> 2);
    bf16x8 qf[4];
#pragma unroll
    for (int ks = 0; ks < 4; ++ks) qf[ks] = *(const bf16x8*)(Qa + (size_t)tq * 512 + hq * 64 + 16 * ks + 8 * h);
    float m = 0.f, l = (h == 0) ? __expf(sink[hq]) : 0.f;
    f32x16 O[2];
#pragma unroll
    for (int r = 0; r < 16; ++r) { O[0][r] = 0.f; O[1][r] = 0.f; }
    attn_core<64, true, CvtBg, 2>(lds, qf, tl, (const char*)(Ka + kvh * 64), 256, (const char*)(Va + kvh * 64), 256, qpos, m, l, O, bg);
    attn_store(O, l, MIX + (size_t)tq * 1024 + hq * 64, h);
}
template <int XP = 0>
__device__ __forceinline__ void mla_unit(LAS unsigned char* lds, int unit, const bf16* Qc, const bf16* Kc, const bf16* Vc, const float* RS, const float* qg,
                                         const float* cosC, const float* sinC, bf16* MIX, CvtBg& bg) {
    const int tid = otid(), w = tid >> 6, lane = tid & 63, h = lane >> 5;
    int b, head, tq; TileList tl; bool lat;
    if (unit < 1024) { b = unit >> 8; head = (unit >> 4) & 15; const int qb = unit & 15; lat = true;
        tl.nloc = 64; tl.row_loc0 = b * S; tl.kpos_loc0 = 0; tl.row_ctx0 = NL + b * CL; tl.ntiles = 68; tq = b * S + qb * 256 + w * 32 + (lane & 31);
    } else { const int u = unit - 1024; b = u >> 4; head = u & 15; lat = false;
        tl.nloc = 0; tl.row_loc0 = 0; tl.kpos_loc0 = 0; tl.row_ctx0 = NL + b * CL; tl.ntiles = 4; tq = NL + b * CL + w * 32 + (lane & 31); }
    float v[6][8]; float ss = 0.f;
    const bf16* qp = Qc + (size_t)tq * 1536 + head * 96 + 8 * h;
#pragma unroll
    for (int ks = 0; ks < 6; ++ks) { const u32x4 raw = *(const u32x4*)(qp + 16 * ks);
        v[ks][0] = bflo(raw.x); v[ks][1] = bfhi(raw.x); v[ks][2] = bflo(raw.y); v[ks][3] = bfhi(raw.y); v[ks][4] = bflo(raw.z); v[ks][5] = bfhi(raw.z); v[ks][6] = bflo(raw.w); v[ks][7] = bfhi(raw.w);
#pragma unroll
        for (int j = 0; j < 8; ++j) ss += v[ks][j] * v[ks][j]; }
    ss += __shfl_xor(ss, 32);
    float r; { const f32x4 p0 = *(const f32x4*)(RS + (size_t)tq * 16), p1 = *(const f32x4*)(RS + (size_t)tq * 16 + 4), p2 = *(const f32x4*)(RS + (size_t)tq * 16 + 8);
      r = rsqrtf((((p0[0] + p0[1]) + (p0[2] + p0[3])) + ((p1[0] + p1[1]) + (p1[2] + p1[3])) + ((p2[0] + p2[1]) + (p2[2] + p2[3]))) * (1.f / 768.f) + EPS); }
    const float inv = r * rsqrtf(r * r * ss * (1.f / 96.f) + EPS);
#pragma unroll
    for (int ks = 0; ks < 6; ++ks) { const f32x4 g0 = *(const f32x4*)(qg + 16 * ks + 8 * h), g1 = *(const f32x4*)(qg + 16 * ks + 8 * h + 4);
#pragma unroll
        for (int j = 0; j < 4; ++j) { v[ks][j] *= inv * g0[j]; v[ks][4 + j] *= inv * g1[j]; } }
    {
        const int t = tq & 4095;
#pragma unroll
        for (int ax = 0; ax < 2; ++ax) {
            const f32x4 c0 = *(const f32x4*)(cosC + t * 16 + 8 * ax), c1 = *(const f32x4*)(cosC + t * 16 + 8 * ax + 4);
            const f32x4 s0 = *(const f32x4*)(sinC + t * 16 + 8 * ax), s1 = *(const f32x4*)(sinC + t * 16 + 8 * ax + 4);
#pragma unroll
            for (int j = 0; j < 8; ++j) { const float y = v[4 + ax][j], po = __shfl_xor(y, 32); const float c = j < 4 ? c0[j & 3] : c1[j & 3], s = j < 4 ? s0[j & 3] : s1[j & 3];
                const float yr = (h == 0) ? (y * c - po * s) : (y * c + po * s); v[4 + ax][j] = lat ? yr : y; }
        }
    }
    bf16x8 qf[6];
#pragma unroll
    for (int ks = 0; ks < 6; ++ks) { u32x4 pw; pw.x = pk2(v[ks][0] * QSCALE_C, v[ks][1] * QSCALE_C); pw.y = pk2(v[ks][2] * QSCALE_C, v[ks][3] * QSCALE_C);
        pw.z = pk2(v[ks][4] * QSCALE_C, v[ks][5] * QSCALE_C); pw.w = pk2(v[ks][6] * QSCALE_C, v[ks][7] * QSCALE_C); qf[ks] = __builtin_bit_cast(bf16x8, pw); }
    float m = 0.f, l = 0.f;
    f32x16 O[2];
#pragma unroll
    for (int rr = 0; rr < 16; ++rr) { O[0][rr] = 0.f; O[1][rr] = 0.f; }
    attn_core<96, false, CvtBg, 4, XP>(lds, qf, tl, (const char*)(Kc + head * 96), 3072, (const char*)(Vc + head * 64), 2048, 0, m, l, O, bg);
    attn_store(O, l, MIX + (size_t)tq * 1024 + head * 64, h);
}

template <int NTOK>
__device__ __forceinline__ void conv_strip(LAS unsigned char* lds, int seq0, int len, int t0, const bf16* Z, const float* dw_w, const float* dw_b, const float* ln_g, const float* ln_b, bf16* MIX) {
    const int tid = otid(), w = tid >> 6, lane = tid & 63;
    constexpr int NROW = NTOK + 30, NCH = NROW * 64, NLD = (NCH + NTHR - 1) / NTHR, NSUB = (NTOK + 15) / 16;
    LAS bf16* zt = (LAS bf16*)lds; LAS float* ot = (LAS float*)(lds + 98304);
    u32x4 st[NLD];
#pragma unroll
    for (int i = 0; i < NLD; ++i) { const int q = tid + i * NTHR, r = q >> 6, cc = q & 63, tt = t0 - 15 + r; st[i] = (u32x4){0u, 0u, 0u, 0u};
        if (q < NCH && tt >= 0 && tt < len) st[i] = *(const u32x4*)(Z + (size_t)(seq0 + tt) * 512 + cc * 8); }
    float wt[31];
#pragma unroll
    for (int j = 0; j < 31; ++j) wt[j] = dw_w[j * 512 + tid];
    const float bias = dw_b[tid];
#pragma unroll
    for (int i = 0; i < NLD; ++i) { const int q = tid + i * NTHR; if (q < NCH) *(LAS u32x4*)(zt + (q >> 6) * 512 + (q & 63) * 8) = st[i]; }
    const f32x4 g0 = *(const f32x4*)(ln_g + 8 * lane), g1 = *(const f32x4*)(ln_g + 8 * lane + 4), b0 = *(const f32x4*)(ln_b + 8 * lane), b1 = *(const f32x4*)(ln_b + 8 * lane + 4);
    __syncthreads();
#pragma unroll 1
    for (int sb = 0; sb < NSUB; ++sb) {
        float acc[16];
#pragma unroll
        for (int t = 0; t < 16; ++t) acc[t] = bias;
        const LAS bf16* zp = zt + sb * 16 * 512 + tid;
        constexpr int NR = (NTOK >= 16 ? 16 : NTOK) + 30;
#pragma unroll
        for (int r = 0; r < NR; ++r) { const float zv = bf1(zp[r * 512]);
#pragma unroll
            for (int t = 0; t < 16; ++t) { const int j = r - t; if (j >= 0 && j < 31 && t < NTOK) acc[t] += zv * wt[j]; } }
#pragma unroll
        for (int t = 0; t < 16; ++t) ot[t * 512 + tid] = acc[t];
        __syncthreads();
#pragma unroll
        for (int q = 0; q < 2; ++q) { const int t = 2 * w + q, tok = sb * 16 + t;
            if (tok < NTOK) {
                const f32x4 x0 = *(const LAS f32x4*)(ot + t * 512 + 8 * lane), x1 = *(const LAS f32x4*)(ot + t * 512 + 8 * lane + 4);
                const float mu = wave_sum((x0[0] + x0[1]) + (x0[2] + x0[3]) + (x1[0] + x1[1]) + (x1[2] + x1[3])) * (1.f / 512.f);
                const f32x4 d0 = x0 - mu, d1 = x1 - mu;
                const float var = wave_sum((d0[0] * d0[0] + d0[1] * d0[1]) + (d0[2] * d0[2] + d0[3] * d0[3]) + (d1[0] * d1[0] + d1[1] * d1[1]) + (d1[2] * d1[2] + d1[3] * d1[3])) * (1.f / 512.f);
                const float rstd = rsqrtf(var + EPS);
                f32x4 y0 = d0 * rstd * g0 + b0, y1 = d1 * rstd * g1 + b1;
#pragma unroll
                for (int j = 0; j < 4; ++j) { y0[j] = fsilu(y0[j]); y1[j] = fsilu(y1[j]); }
                *(u32x4*)(MIX + (size_t)(seq0 + t0 + tok) * 1024 + 512 + 8 * lane) = pack8(y0, y1); } }
        __syncthreads();
    }
}

__device__ __forceinline__ void mla_stats_row(int row, int lane, const bf16* P, const float* krg, const float* cosC, const float* sinC, float* RS, bf16* Kc) {
    const bf16* p = P + (size_t)row * PP;
    const u32x4 a = *(const u32x4*)(p + 8 * lane);
    const u32x4 b = *(const u32x4*)(p + 8 * (lane + 64));
    u32x4 c = (u32x4){0u, 0u, 0u, 0u};
    if (lane < 4) c = *(const u32x4*)(p + 8 * (lane + 128));
    auto sq = [](u32x4 u) { float s = 0.f; s += bflo(u.x) * bflo(u.x) + bfhi(u.x) * bfhi(u.x); s += bflo(u.y) * bflo(u.y) + bfhi(u.y) * bfhi(u.y);
                            s += bflo(u.z) * bflo(u.z) + bfhi(u.z) * bfhi(u.z); s += bflo(u.w) * bflo(u.w) + bfhi(u.w) * bfhi(u.w); return s; };
    const float sa = sq(a), sb = sq(b), sc = sq(c);
    const float ssq = wave_sum(sa + (lane < 32 ? sb : 0.f)), skv = wave_sum(lane >= 32 ? sb : 0.f), skr = wave_sum(sc);
    if (lane == 0) { RS[(size_t)row * 2] = rsqrtf(ssq * (1.f / 768.f) + EPS); RS[(size_t)row * 2 + 1] = rsqrtf(skv * (1.f / 256.f) + EPS); }
    const float rk = rsqrtf(skr * (1.f / 32.f) + EPS);
    float y[8]; const int l4 = lane & 3;
    { const f32x4 g0 = *(const f32x4*)(krg + 8 * l4), g1 = *(const f32x4*)(krg + 8 * l4 + 4);
      y[0] = bflo(c.x) * rk * g0[0]; y[1] = bfhi(c.x) * rk * g0[1]; y[2] = bflo(c.y) * rk * g0[2]; y[3] = bfhi(c.y) * rk * g0[3];
      y[4] = bflo(c.z) * rk * g1[0]; y[5] = bfhi(c.z) * rk * g1[1]; y[6] = bflo(c.w) * rk * g1[2]; y[7] = bfhi(c.w) * rk * g1[3]; }
    const int t = row & 4095, ax = l4 >> 1, half = l4 & 1;
    const f32x4 c0 = *(const f32x4*)(cosC + t * 16 + 8 * ax), c1 = *(const f32x4*)(cosC + t * 16 + 8 * ax + 4), s0 = *(const f32x4*)(sinC + t * 16 + 8 * ax), s1 = *(const f32x4*)(sinC + t * 16 + 8 * ax + 4);
    float o[8];
#pragma unroll
    for (int j = 0; j < 8; ++j) { const float po = __shfl_xor(y[j], 1); const float cc = j < 4 ? c0[j & 3] : c1[j & 3], sn = j < 4 ? s0[j & 3] : s1[j & 3];
        const float yr = half == 0 ? (y[j] * cc - po * sn) : (y[j] * cc + po * sn); o[j] = row < NL ? yr : y[j]; }
    if (lane < 4) { u32x4 wv; wv.x = pk2(o[0], o[1]); wv.y = pk2(o[2], o[3]); wv.z = pk2(o[4], o[5]); wv.w = pk2(o[6], o[7]);
#pragma unroll
        for (int hd = 0; hd < 16; ++hd) *(u32x4*)(Kc + (size_t)row * 1536 + hd * 96 + 64 + 8 * lane) = wv; }
}

template <int NT>
__device__ __forceinline__ void moe_setup(LAS unsigned char* lds, const int* cntG, const int* list, int layer, int vcu, int G) {
    LAS int* tab = (LAS int*)(lds + LDS_TAB); LAS int* idx = (LAS int*)(lds + LDS_IDX);
    const int tid = otid(); constexpr int MG = 32 / NT;
    if (tid < 32) tab[tid] = cntG[tid * 64];
    __syncthreads();
    if (tid == 0) { int acc = 0; for (int e = 0; e < 32; ++e) { tab[32 + e] = acc; acc += (tab[e] + 255) >> 8; } tab[64] = acc;
        int n = 0;
        for (int i = 0; i < MAXU; ++i) { const int v = i * G + vcu, gm = (v >> 5) * MG + (v & 31) / NT, nt = v % NT; if (gm >= acc) break;
            int e = 0; while (e < 31 && tab[33 + e] <= gm) ++e;
            tab[128 + 4 * i] = gm; tab[129 + 4 * i] = (layer * 32 + e) * NT + nt; tab[130 + 4 * i] = e; tab[131 + 4 * i] = nt; n = i + 1; }
        tab[127] = n; }
    __syncthreads();
    const int n = tab[127];
    for (int q = tid; q < n * 256; q += NTHR) { const int i = q >> 8, r = q & 255, gm = tab[128 + 4 * i], e = tab[130 + 4 * i], rr = (gm - tab[32 + e]) * 256 + r;
        idx[q] = rr < tab[e] ? list[(size_t)e * T + rr] : -1; }
    __syncthreads();
}

__device__ __forceinline__ void ctx_minigemm(LAS unsigned char* lds, const bf16* MIX, const bf16* W  , float* X, const float* srcctx  ,
                                             const float* gmod  , float* SSX, int bx) {
    const int tid = otid(), lane = tid & 63, w = __builtin_amdgcn_readfirstlane(tid >> 6), fr = lane & 15, fq = lane >> 4;
    const int tr = bx >> 4, tc = bx & 15;
    const bf16* ap = MIX + (size_t)(NL + 64 * tr + fr) * 1024 + 128 * w + 8 * fq;
    const bf16* bp = W + (size_t)(64 * tc + fr) * 1024 + 128 * w + 8 * fq;
    bf16x8 a[4][4], b[4][4];
#pragma unroll
    for (int t = 0; t < 4; ++t)
#pragma unroll
        for (int ks = 0; ks < 4; ++ks) { a[t][ks] = *(const bf16x8*)(ap + (size_t)(16 * t) * 1024 + 32 * ks); b[t][ks] = *(const bf16x8*)(bp + (size_t)(16 * t) * 1024 + 32 * ks); }
    f32x4 acc[4][4];
#pragma unroll
    for (int mt = 0; mt < 4; ++mt)
#pragma unroll
        for (int nt = 0; nt < 4; ++nt) { acc[mt][nt] = (f32x4){0.f, 0.f, 0.f, 0.f};
#pragma unroll
            for (int ks = 0; ks < 4; ++ks) acc[mt][nt] = __builtin_amdgcn_mfma_f32_16x16x32_bf16(b[nt][ks], a[mt][ks], acc[mt][nt], 0, 0, 0); }
    LAS f32x4* part = (LAS f32x4*)lds;
#pragma unroll
    for (int mt = 0; mt < 4; ++mt)
#pragma unroll
        for (int nt = 0; nt < 4; ++nt) part[(w * 16 + mt * 4 + nt) * 64 + lane] = acc[mt][nt];
    __syncthreads();
    LAS float* ssq = (LAS float*)(lds + LDS_IDX);
    const float* gp = gmod + (size_t)4 * 6144;
#pragma unroll
    for (int hf = 0; hf < 2; ++hf) { const int o = tid + 512 * hf, tile = o >> 6, ol = o & 63, mt = tile >> 2, nt = tile & 3, r = 16 * mt + (ol & 15), c = 64 * tc + 16 * nt + 4 * (ol >> 4);
        f32x4 s = part[o];
#pragma unroll
        for (int ww = 1; ww < 8; ++ww) s += part[ww * 1024 + o];
        const size_t gi = (size_t)(64 * tr + r) * D + c;
        const f32x4 y = *(const f32x4*)(srcctx + gi) + *(const f32x4*)(gp + c) * s;
        *(f32x4*)(X + (size_t)NL * D + gi) = y;
        ssq[r * 16 + nt * 4 + (ol >> 4)] = (y[0] * y[0] + y[1] * y[1]) + (y[2] * y[2] + y[3] * y[3]); }
    __syncthreads();
    if (tid < 64) { float ss = 0.f;
#pragma unroll
        for (int q = 0; q < 16; ++q) ss += ssq[tid * 16 + q];
        SSX[(size_t)(NL + 64 * tr + tid) * 16 + tc] = ss; }
    __syncthreads();
}

__device__ __forceinline__ void combine_row(int row, int lane, float* X, const bf16* YB, const float* mcur  , const float* gnext, const float* mnext, bf16* H, float* out) {
    const int mr = modrow(row); const float* mv = mcur + (size_t)mr * 6144 + 5120;
    f32x4 v[2][2]; float ss = 0.f;
    u32x4 y[2][4];
#pragma unroll
    for (int j = 0; j < 2; ++j)
#pragma unroll
        for (int k = 0; k < 4; ++k) y[j][k] = *(const u32x4*)(YB + ((size_t)row * 4 + k) * 1024 + 8 * lane + 512 * j);
#pragma unroll
    for (int j = 0; j < 2; ++j) { const int c = 8 * lane + 512 * j; f32x4 a0 = (f32x4){0.f, 0.f, 0.f, 0.f}, a1 = a0;
#pragma unroll
        for (int k = 0; k < 4; ++k) { a0 += (f32x4){bflo(y[j][k].x), bfhi(y[j][k].x), bflo(y[j][k].y), bfhi(y[j][k].y)}; a1 += (f32x4){bflo(y[j][k].z), bfhi(y[j][k].z), bflo(y[j][k].w), bfhi(y[j][k].w)}; }
        float* xp = X + (size_t)row * D + c; const f32x4 g0 = *(const f32x4*)(mv + c), g1 = *(const f32x4*)(mv + c + 4);
        v[j][0] = *(const f32x4*)xp + g0 * a0; v[j][1] = *(const f32x4*)(xp + 4) + g1 * a1;
        float* op = out ? out + (size_t)row * D + c : xp;
        *(f32x4*)op = v[j][0]; *(f32x4*)(op + 4) = v[j][1];
#pragma unroll
        for (int q = 0; q < 2; ++q) ss += (v[j][q][0] * v[j][q][0] + v[j][q][1] * v[j][q][1]) + (v[j][q][2] * v[j][q][2] + v[j][q][3] * v[j][q][3]); }
    if (H) { const float rstd = rsqrtf(wave_sum(ss) * (1.f / D) + EPS); const float* mn = mnext + (size_t)mr * 6144;
#pragma unroll
        for (int j = 0; j < 2; ++j) { const int c = 8 * lane + 512 * j; f32x4 o[2];
#pragma unroll
            for (int q = 0; q < 2; ++q) { const f32x4 gg = *(const f32x4*)(gnext + c + 4 * q), sc = *(const f32x4*)(mn + 1024 + c + 4 * q), sh = *(const f32x4*)(mn + c + 4 * q); o[q] = v[j][q] * rstd * gg * (sc + 1.f) + sh; }
            *(u32x4*)(H + (size_t)row * D + c) = pack8(o[0], o[1]); } }
}

#define MFMA16(a, b, c) __builtin_amdgcn_mfma_f32_16x16x32_bf16((a), (b), (c), 0, 0, 0)
__device__ __forceinline__ void router_load_table(LAS unsigned char* lds, const bf16* Wr, int tid) {
    u32x4 v[16];
#pragma unroll
    for (int i = 0; i < 16; ++i) v[i] = *(const u32x4*)(Wr + (size_t)(tid + i * NTHR) * 8);
#pragma unroll
    for (int i = 0; i < 16; ++i) { const int q = tid + i * NTHR, row = q >> 7, c = q & 127; *(LAS u32x4*)(lds + row * 2048 + ((c ^ (row & 15)) << 4)) = v[i]; }
}
__device__ __forceinline__ void router_group(LAS unsigned char* lds, int g, int w, int lane, const float* X, const float* SSX, const float* gffn, const float* mvec, const float* rb,
                                             bf16* F, float* gate) {
    LAS float* lg = (LAS float*)(lds + LDS_IDX) + w * 512; LAS int* pend = (LAS int*)(lds + LDS_IDX + 10240) + w * 64; LAS int* cntL = (LAS int*)(lds + LDS_TAB);
    const int i = lane & 15, kq = lane >> 4, row = 16 * g + i;
    const float* xr = X + (size_t)row * D + 8 * kq;
    float ss; { const f32x4 pq = *(const f32x4*)(SSX + (size_t)row * 16 + 4 * kq); ss = (pq[0] + pq[1]) + (pq[2] + pq[3]); }
    ss += __shfl_xor(ss, 16); ss += __shfl_xor(ss, 32);
    const float rstd = rsqrtf(ss * (1.f / D) + EPS);
    f32x4 acc[2] = {(f32x4){0.f, 0.f, 0.f, 0.f}, (f32x4){0.f, 0.f, 0.f, 0.f}};
    const LAS unsigned char* tb = lds + i * 2048;
#pragma unroll 8
    for (int s = 0; s < 32; ++s) {
        const int k = 32 * s + 8 * kq;
        const f32x4 a = *(const f32x4*)(xr + 32 * s), b = *(const f32x4*)(xr + 32 * s + 4);
        const f32x4 g0 = *(const f32x4*)(gffn + k), g1 = *(const f32x4*)(gffn + k + 4), c0 = *(const f32x4*)(mvec + 4096 + k), c1 = *(const f32x4*)(mvec + 4096 + k + 4);
        const f32x4 h0 = *(const f32x4*)(mvec + 3072 + k), h1 = *(const f32x4*)(mvec + 3072 + k + 4);
        const f32x4 f0 = a * rstd * g0 * (c0 + 1.f) + h0, f1 = b * rstd * g1 * (c1 + 1.f) + h1;
        u32x4 hi; hi.x = pk2(f0[0], f0[1]); hi.y = pk2(f0[2], f0[3]); hi.z = pk2(f1[0], f1[1]); hi.w = pk2(f1[2], f1[3]);
        *(u32x4*)(F + (size_t)row * D + k) = hi;
        u32x4 lo; lo.x = pk2(f0[0] - bflo(hi.x), f0[1] - bfhi(hi.x)); lo.y = pk2(f0[2] - bflo(hi.y), f0[3] - bfhi(hi.y));
        lo.z = pk2(f1[0] - bflo(hi.z), f1[1] - bfhi(hi.z)); lo.w = pk2(f1[2] - bflo(hi.w), f1[3] - bfhi(hi.w));
        const bf16x8 ah = __builtin_bit_cast(bf16x8, hi), al = __builtin_bit_cast(bf16x8, lo);
        const int cs = ((4 * s + kq) ^ i) << 4;
#pragma unroll
        for (int et = 0; et < 2; ++et) { const bf16x8 bh = *(const LAS bf16x8*)(tb + et * 16 * 2048 + cs), bl = *(const LAS bf16x8*)(tb + (32 + et * 16) * 2048 + cs);
            acc[et] = MFMA16(ah, bh, acc[et]); acc[et] = MFMA16(al, bh, acc[et]); acc[et] = MFMA16(ah, bl, acc[et]); }
    }
#pragma unroll
    for (int et = 0; et < 2; ++et) { const float bias = rb[16 * et + i];
#pragma unroll
        for (int r = 0; r < 4; ++r) lg[(4 * kq + r) * 32 + 16 * et + i] = acc[et][r] + bias; }
    LDS_WAIT(); asm volatile("" ::: "memory");
    if (lane < 16) {
        const LAS float* my = lg + lane * 32; unsigned used = 0u; int bi[4]; float bv[4];
#pragma unroll
        for (int k = 0; k < 4; ++k) { float best = -3.0e38f; int be = 0;
#pragma unroll
            for (int e = 0; e < 32; ++e) { const float v = my[e]; const bool ok = !((used >> e) & 1u) && v > best; best = ok ? v : best; be = ok ? e : be; }
            used |= 1u << be; bi[k] = be; bv[k] = best; }
        float ex[4], sum = 0.f;
#pragma unroll
        for (int k = 0; k < 4; ++k) { ex[k] = __expf(bv[k] - bv[0]); sum += ex[k]; }
        const float inv = 1.f / sum; const int trow = 16 * g + lane;
#pragma unroll
        for (int k = 0; k < 4; ++k) { const int rl = __hip_atomic_fetch_add(cntL + bi[k], 1, __ATOMIC_RELAXED, __HIP_MEMORY_SCOPE_WORKGROUP);
            pend[lane * 4 + k] = (trow * 4 + k) | (bi[k] << 17) | (rl << 22); gate[trow * 4 + k] = ex[k] * inv; }
    }
}

struct Args { const float* in[32]; float* out; unsigned char* ws; int lo, hi, flags, pad; };
constexpr int N_PHASES = 2 + 2 * (7 + 8);

__global__ void __launch_bounds__(NTHR, 2) mega(Args args) {
    extern __shared__ __attribute__((aligned(16))) unsigned char lds_raw[];
    LAS unsigned char* lds = (LAS unsigned char*)lds_raw;
    const int tid = threadIdx.x, lane = tid & 63, wave = __builtin_amdgcn_readfirstlane(tid >> 6);
    constexpr int G = 256;
    const int bx = blockIdx.x & (G - 1), vcu = (bx % 8) * (G / 8) + bx / 8;
    const int gw = vcu * NWAVES + wave, NGW = G * NWAVES;
    unsigned* ctl = (unsigned*)(args.ws + WS_CTL);
#define PH_LOCALS \
    unsigned zsg_; asm volatile("s_mov_b32 %0, 0" : "=s"(zsg_)); unsigned char* ws = args.ws + zsg_;   const int tid = otid(), lane = tid & 63, wave = __builtin_amdgcn_readfirstlane(tid >> 6), gw = vcu * NWAVES + wave; (void)lane; (void)gw; \
    const float* x_in = args.in[0]; const float* c_in = args.in[1]; const float* ctx_in = args.in[2]; const float* cctx_in = args.in[3]; \
    const float* mod_w = args.in[4]; const float* mod_b = args.in[5]; const float* norm_mix_g = args.in[6]; const float* norm_ffn_g = args.in[7]; \
    float* MOD = (float*)(ws + WS_MOD); float* cosA = (float*)(ws + WS_COSA); float* sinA = (float*)(ws + WS_SINA); float* cosC = (float*)(ws + WS_COSC); float* sinC = (float*)(ws + WS_SINC); \
    bf16* WR = (bf16*)(ws + WS_WR); bf16* WINA = (bf16*)(ws + WS_WINA); bf16* WOUTA = (bf16*)(ws + WS_WOUTA); bf16* WINC = (bf16*)(ws + WS_WINC); bf16* WQB = (bf16*)(ws + WS_WQB); \
    bf16* WKVB = (bf16*)(ws + WS_WKVB); bf16* WOUTC = (bf16*)(ws + WS_WOUTC); bf16* WGU = (bf16*)(ws + WS_WGU); bf16* WDN = (bf16*)(ws + WS_WDN); \
    float* X = (float*)(ws + WS_X); bf16* H = (bf16*)(ws + WS_H); bf16* QA = (bf16*)(ws + WS_QA); bf16* KA = (bf16*)(ws + WS_KA); bf16* VA = (bf16*)(ws + WS_VA); bf16* Z = (bf16*)(ws + WS_Z); \
    bf16* P = (bf16*)(ws + WS_P); float* RS = (float*)(ws + WS_RS); bf16* QC = (bf16*)(ws + WS_QC); bf16* KC = (bf16*)(ws + WS_KC); bf16* VC = (bf16*)(ws + WS_VC); \
    bf16* MIX = (bf16*)(ws + WS_MIX); bf16* F = (bf16*)(ws + WS_F); float* GATE = (float*)(ws + WS_GATE); int* LIST = (int*)(ws + WS_LIST); bf16* ACT = (bf16*)(ws + WS_ACT); bf16* YB = (bf16*)(ws + WS_YB); \
    int* CNT = (int*)(ws + WS_CTL) + CW_CNT; float* SSX = (float*)(ws + WS_SSX); float* SSP = (float*)(ws + WS_SSP); (void)SSX; (void)SSP; const float* ML = MOD + (size_t)layer_ * 5 * 6144; \
    (void)x_in; (void)c_in; (void)ctx_in; (void)cctx_in; (void)mod_w; (void)mod_b; (void)norm_mix_g; (void)norm_ffn_g; (void)MOD; (void)cosA; (void)sinA; (void)cosC; (void)sinC; (void)WR; (void)WINA; (void)WOUTA; \
    (void)WINC; (void)WQB; (void)WKVB; (void)WOUTC; (void)WGU; (void)WDN; (void)X; (void)H; (void)QA; (void)KA; (void)VA; (void)Z; (void)P; (void)RS; (void)QC; (void)KC; (void)VC; (void)MIX; (void)F; (void)GATE; \
    (void)LIST; (void)ACT; (void)YB; (void)CNT; (void)ML;
    if (tid < 64) ((LAS unsigned*)(lds + LDS_MISC))[tid] = 0u;
    __syncthreads();
    const int lo = args.lo, hi = args.hi;
    XcdBarrier bar; bar.bar = ctl + CW_BAR; bar.x = 0; bar.st = nullptr;
    if (hi - lo > 1) bar = xcd_barrier_post(ctl + CW_BAR, (volatile LAS unsigned*)(lds + LDS_MISC));
    int ph = 0; int layer_ = 0;
#ifndef MK_EN
#define MK_EN 0xffffffffu
#endif
#ifdef MK_PROBE_PH
#define PFLAG(b) (args.flags & (b))
#else
#define PFLAG(b) 0
#endif
#define EN(k) (((MK_EN) >> (k)) & 1u)
#define PH_ON (ph >= lo && ph < hi)
#define CVT_HEAD do { if (tid < 8) ((LAS int*)(lds + CV_HDR))[tid * 4] = -1; } while (0)
#define CVT_TAIL(bg) do { LAS int* _jn = (LAS int*)(lds + CV_HDR + 256); asm volatile("s_waitcnt vmcnt(0)" ::: "memory"); if (wave >= 4 && lane == 0) _jn[wave - 4] = bg.j; __syncthreads(); \
        bg.process_slot(tid, lds, 0); bg.process_slot(tid, lds, 1); \
        { const int _j = _jn[wave & 3]; bg.j = _j + (wave < 4 ? 0 : 4); bg.step = 8; } __syncthreads(); \
        bg.tail_loop(lane, lds + wave * 16384); __syncthreads(); } while (0)
#define PH_END do { const bool _b = (ph >= lo) && (ph + 1 < hi); ++ph; if (_b) xcd_barrier(bar); } while (0)

    if (EN(0) && PH_ON) { PH_LOCALS
        LAS float* st = (LAS float*)(lds + 73728);
        for (int q = tid; q < 5 * 1024; q += NTHR) { const float v = q < 4096 ? c_in[q] : cctx_in[q - 4096]; st[q] = fsilu(v); }
        __syncthreads();
        for (int u = vcu; u < 384; u += G) {
            const int l = u / 96, col = (u % 96) * 64 + lane;
            const float* wp = mod_w + ((size_t)l * D + 128 * wave) * 6144 + col; float a0 = 0.f, a1 = 0.f, a2 = 0.f, a3 = 0.f, a4 = 0.f;
#pragma unroll 1
            for (int k0 = 0; k0 < 128; k0 += 64) { float wv[64];
#pragma unroll
                for (int kk = 0; kk < 64; ++kk) wv[kk] = __builtin_nontemporal_load(wp + (size_t)(k0 + kk) * 6144);
#pragma unroll
                for (int kk = 0; kk < 64; ++kk) { const int k = 128 * wave + k0 + kk; a0 += st[k] * wv[kk]; a1 += st[1024 + k] * wv[kk]; a2 += st[2048 + k] * wv[kk]; a3 += st[3072 + k] * wv[kk]; a4 += st[4096 + k] * wv[kk]; } }
            LAS float* part = (LAS float*)(lds + 98304);
            part[(wave * 5 + 0) * 64 + lane] = a0; part[(wave * 5 + 1) * 64 + lane] = a1; part[(wave * 5 + 2) * 64 + lane] = a2; part[(wave * 5 + 3) * 64 + lane] = a3; part[(wave * 5 + 4) * 64 + lane] = a4;
            __syncthreads();
            if (wave < 5) { float s = mod_b[l * 6144 + col];
#pragma unroll
                for (int w8 = 0; w8 < 8; ++w8) s += part[(w8 * 5 + wave) * 64 + lane];
                MOD[((size_t)l * 5 + wave) * 6144 + col] = s; }
            __syncthreads();
        }
        for (int q = gw * 64 + lane; q < 4096 * 32; q += NGW * 64) {
            { const int t = q >> 5, j = q & 31, ax = j >> 4, i = j & 15; const float pos = (float)(ax == 0 ? (t >> 6) : (t & 63)); const float a = pos * powf(10000.f, -((float)i * 2.f) / 32.f); cosA[q] = cosf(a); sinA[q] = sinf(a); }
            if (q < 4096 * 16) { const int t = q >> 4, j = q & 15, ax = j >> 3, i = j & 7; const float pos = (float)(ax == 0 ? (t >> 6) : (t & 63)); const float a = pos * powf(10000.f, -((float)i * 2.f) / 16.f); cosC[q] = cosf(a); sinC[q] = sinf(a); }
        }
        { const float* rw = args.in[26];
          for (int q = gw * 64 + lane; q < 4 * 32 * 1024; q += NGW * 64) { const int l = q >> 15, e = (q >> 10) & 31, k = q & 1023; const float wv = rw[((size_t)l * 1024 + k) * 32 + e];
              const unsigned hb = pk2(wv, 0.f) & 0xffffu; const float hf = __uint_as_float(hb << 16); const unsigned lb = pk2(wv - hf, 0.f) & 0xffffu;
              WR[((size_t)(l * 2 + 0) * 32 + e) * 1024 + k] = (bf16)hb; WR[((size_t)(l * 2 + 1) * 32 + e) * 1024 + k] = (bf16)lb; } }
        LAS float* scr = (LAS float*)(lds + wave * 8448);
        cvt_matrix<LAY_INA>(args.in[8], (size_t)D * 1792, 1792, 1792, 1024, 7, 14, WINA, nullptr, scr, gw, NGW, lane);
        cvt_matrix<LAY_F32>(args.in[9], (size_t)D * 1024, 1024, 1024, 1024, 4, 8, WOUTA, nullptr, scr, gw, NGW, lane);
        cvt_matrix<LAY_STD>(args.in[17], (size_t)D * 1056, 1056, 1056, 1024, 5, 10, WINC, nullptr, scr, gw, NGW, lane);
        cvt_matrix<LAY_STD>(args.in[20], (size_t)768 * 1536, 1536, 1536, 768, 6, 6, WQB, args.in[18], scr, gw, NGW, lane);
        cvt_matrix<LAY_STD>(args.in[20] + (size_t)768 * 1536, 0, 1536, 1536, 768, 6, 6, WQB + (size_t)1536 * 768, args.in[18] + 768, scr, gw, NGW, lane);
        cvt_matrix<LAY_HEAD2>(args.in[21], (size_t)256 * 2048, 2048, 2048, 256, 8, 8, WKVB, args.in[19], scr, gw, NGW, lane);
        cvt_matrix<LAY_HEAD2>(args.in[21] + (size_t)256 * 2048, 0, 2048, 2048, 256, 8, 8, WKVB + (size_t)2048 * 256, args.in[19] + 256, scr, gw, NGW, lane);
        cvt_matrix<LAY_F32>(args.in[25], (size_t)D * 1024, 1024, 1024, 1024, 4, 8, WOUTC, nullptr, scr, gw, NGW, lane);
        __syncthreads();
    }
    PH_END;
    if (EN(1) && PH_ON) { PH_LOCALS
        for (int row = gw; row < T; row += NGW) {
            const float* xrow = row < NL ? x_in + (size_t)row * D : ctx_in + (size_t)(row - NL) * D; const float* mn = MOD + (size_t)modrow(row) * 6144;
            f32x4 v[2][2]; float ss = 0.f;
#pragma unroll
            for (int j = 0; j < 2; ++j)
#pragma unroll
                for (int q = 0; q < 2; ++q) { v[j][q] = *(const f32x4*)(xrow + 8 * lane + 512 * j + 4 * q); ss += (v[j][q][0] * v[j][q][0] + v[j][q][1] * v[j][q][1]) + (v[j][q][2] * v[j][q][2] + v[j][q][3] * v[j][q][3]); }
            const float rstd = rsqrtf(wave_sum(ss) * (1.f / D) + EPS);
#pragma unroll
            for (int j = 0; j < 2; ++j) { const int c = 8 * lane + 512 * j; f32x4 o[2];
#pragma unroll
                for (int q = 0; q < 2; ++q) { const f32x4 gg = *(const f32x4*)(norm_mix_g + c + 4 * q), sc = *(const f32x4*)(mn + 1024 + c + 4 * q), sh = *(const f32x4*)(mn + c + 4 * q); o[q] = v[j][q] * rstd * gg * (sc + 1.f) + sh; }
                *(u32x4*)(H + (size_t)row * D + c) = pack8(o[0], o[1]); }
        }
    }
    PH_END;

    for (int layer = 0; layer < 4; ++layer) {
        const bool keep = layer < 3; const int li = layer >> 1; const int nrt = keep ? 68 : 64;
        layer_ = layer;
        if ((layer & 1) == 0) {
            if (EN(2) && PH_ON) { PH_LOCALS
                g8::GemmP g{H, D, WINA + (size_t)li * 1792 * 1024, 1024}; g8::StaticOrder S_; S_.init(68, 7, G, bx);
                EpiInA E{QA, KA, VA, Z, args.in[10] + li * 64, args.in[11] + li * 64, cosA, sinA};
                g8::gemm_phase(lds, g, S_, E);
            }
            PH_END;
            if (EN(3) && PH_ON) { PH_LOCALS
                const int nau = keep ? 544 : 512;
                if (!(PFLAG(1))) {
                    CvtBg bg; bg.init(args.in[28], args.in[30], WGU, WDN, 0, layer == 0 ? 1 : 0, vcu, wave >= 4 ? wave - 4 : 0x40000000, 4); CVT_HEAD;
                    for (int u = vcu; u < nau; u += G) wattn_unit(lds, u, QA, KA, VA, args.in[12] + li * 8, MIX, bg);
                    CVT_TAIL(bg);
                }
                if (!(PFLAG(2))) {
                    const float* dww = args.in[13] + (size_t)li * 31 * 512; const float* dwb = args.in[14] + li * 512; const float* lng = args.in[15] + li * 512; const float* lnb = args.in[16] + li * 512;
                    conv_strip<64>(lds, (vcu >> 6) * S, S, (vcu & 63) * 64, Z, dww, dwb, lng, lnb, MIX);
                    if (keep) conv_strip<4>(lds, NL + (vcu >> 6) * CL, CL, (vcu & 63) * 4, Z, dww, dwb, lng, lnb, MIX);
                }
            }
            PH_END;
            if (EN(4) && PH_ON) { PH_LOCALS
                g8::GemmP g{MIX, D, WOUTA + (size_t)li * 1024 * 1024, 1024}; g8::StaticOrder S_; S_.init(64, 4, G, bx);
                EpiResid E{X, layer == 0 ? x_in : X, layer == 0 ? ctx_in : X + (size_t)NL * D, ML + 2048, SSX};
                g8::gemm_phase(lds, g, S_, E);
                if (keep) ctx_minigemm(lds, MIX, WOUTA + (size_t)li * 1024 * 1024, X, layer == 0 ? ctx_in : X + (size_t)NL * D, ML + 2048, SSX, bx);
            }
            PH_END;
        } else {
            if (EN(5) && PH_ON) { PH_LOCALS
                g8::GemmP g{H, D, WINC + (size_t)li * 1280 * 1024, 1024}; g8::StaticOrder S_; S_.init(68, 5, G, bx);
                EpiP E{P, SSP, KC, args.in[24] + li * 32, cosC, sinC};
                g8::gemm_phase(lds, g, S_, E);
            }
            PH_END;
            if (EN(7) && PH_ON) { PH_LOCALS
#ifndef MK_O3
#define MK_O3 3
#endif
                if ((MK_O3 & 1) && !(PFLAG(16))) { g8::GemmP g{P, PP, WQB + (size_t)li * 1536 * 768, 768}; g8::StaticOrder S_; S_.init(nrt, 6, G, bx); EpiBf16 E{QC, 1536, 1536}; g8::gemm_phase(lds, g, S_, E); }
                if ((MK_O3 & 2) && !(PFLAG(32))) { g8::GemmP g{P + 768, PP, WKVB + (size_t)li * 2048 * 256, 256}; g8::StaticOrder S_; S_.init(68, 8, G, (bx + 104) & 255);         EpiKV E{KC, VC, SSP, args.in[23] + li * 64}; g8::gemm_phase(lds, g, S_, E); }
            }
            PH_END;
            if (EN(8) && PH_ON) { PH_LOCALS
                const int nau = keep ? 1088 : 1024;
                CvtBg bg; bg.init(args.in[28], args.in[30], WGU, WDN, layer, (PFLAG(8)) ? 0 : ((layer == 1) ? 2 : 1), vcu, wave >= 4 ? wave - 4 : 0x40000000, 4); CVT_HEAD;
#if defined(MK_XP) && MK_XP != 0
                if (PFLAG(64)) { for (int u = vcu; u < nau; u += G) mla_unit<MK_XP>(lds, u, QC, KC, VC, SSP, args.in[22] + li * 96, cosC, sinC, MIX, bg); } else
#endif
                for (int u = vcu; u < nau; u += G) mla_unit(lds, u, QC, KC, VC, SSP, args.in[22] + li * 96, cosC, sinC, MIX, bg);
                CVT_TAIL(bg);
            }
            PH_END;
            if (EN(9) && PH_ON) { PH_LOCALS
                g8::GemmP g{MIX, D, WOUTC + (size_t)li * 1024 * 1024, 1024}; g8::StaticOrder S_; S_.init(64, 4, G, bx);
                EpiResid E{X, X, X + (size_t)NL * D, ML + 2048, SSX};
                g8::gemm_phase(lds, g, S_, E);
                if (keep) ctx_minigemm(lds, MIX, WOUTC + (size_t)li * 1024 * 1024, X, X + (size_t)NL * D, ML + 2048, SSX, bx);
            }
            PH_END;
        }
        if (EN(10) && PH_ON) { PH_LOCALS
            LAS int* cntL = (LAS int*)(lds + LDS_TAB); LAS int* baseL = cntL + 32; LAS int* pend = (LAS int*)(lds + LDS_IDX + 10240);
            if (tid < 32) cntL[tid] = 0;
            router_load_table(lds, WR + (size_t)layer * 2 * 32 * 1024, tid);
            __syncthreads();
            int g = -1;
            if (wave < 4) g = bx * 4 + wave; else if (wave == 4 && keep && bx < 64) g = 1024 + bx;
            if (g >= 0) router_group(lds, g, wave, lane, X, SSX, norm_ffn_g + layer * D, ML + (size_t)(g < 1024 ? (g >> 8) : 4) * 6144, args.in[27] + layer * 32, F, GATE);
            __syncthreads();
            if (tid < 32) baseL[tid] = (PFLAG(4)) ? 0 : atomicAdd(CNT + (layer * 32 + tid) * 64, cntL[tid])    ;
            __syncthreads();
            if (tid < 320) { const int wv = tid >> 6; const bool has = (wv < 4) || (wv == 4 && keep && bx < 64);
                if (has) { const int pe = pend[tid], slot = pe & 0x1ffff, e = (pe >> 17) & 31, rl = pe >> 22; LIST[(size_t)e * T + baseL[e] + rl] = slot; } }
            __syncthreads();
        }
        PH_END;
        if (EN(11) && PH_ON) { PH_LOCALS
            moe_setup<8>(lds, CNT + layer * 32 * 64, LIST, layer, vcu, G);
            g8::GemmP g{F, D, WGU, 1024}; g8::MoeOrder<true> S_{(const LAS int*)(lds + LDS_TAB), (const LAS int*)(lds + LDS_IDX)};
            EpiGU E{ACT, args.in[29] + (size_t)layer * 32 * 2048};
            g8::gemm_phase(lds, g, S_, E);
        }
        PH_END;
        if (EN(12) && PH_ON) { PH_LOCALS
            moe_setup<4>(lds, CNT + layer * 32 * 64, LIST, layer, vcu, G);
            g8::GemmP g{ACT, 1024, WDN, 1024}; g8::MoeOrder<false> S_{(const LAS int*)(lds + LDS_TAB), (const LAS int*)(lds + LDS_IDX)};
            EpiDown E{YB, args.in[31] + (size_t)layer * 32 * 1024, GATE, (const LAS int*)(lds + LDS_IDX)};
            g8::gemm_phase(lds, g, S_, E);
        }
        PH_END;
        if (EN(13) && PH_ON) { PH_LOCALS
            const int nrows = keep ? T : NL;
            for (int row = gw; row < nrows; row += NGW)
                combine_row(row, lane, X, YB, ML, norm_mix_g + (layer + 1 < 4 ? layer + 1 : 0) * D, MOD + (size_t)(layer + 1 < 4 ? layer + 1 : 0) * 5 * 6144, layer < 3 ? H : nullptr, layer < 3 ? nullptr : args.out);
        }
        PH_END;
    }
#undef PH_ON
#undef PH_END
}
}

#ifndef MK_MULTI
#define MK_MULTI 0
#endif
#ifndef MK_DEBUG
#define MK_DEBUG 0
#endif
#if MK_DEBUG
namespace dbg {
__global__ void k_cmp_bf(const unsigned short* a, int lda, const float* b, int ldb, int rows, int cols, float s, float* acc, int cp) {
    float d2 = 0.f, r2 = 0.f;
    for (size_t i = (size_t)blockIdx.x * blockDim.x + threadIdx.x; i < (size_t)rows * cols; i += (size_t)gridDim.x * blockDim.x) {
        const size_t r = i / cols, c = i % cols; const float av = __uint_as_float(((unsigned)a[r * lda + c]) << 16), bv = s * b[r * ldb + c]; d2 += (av - bv) * (av - bv); r2 += bv * bv; }
    for (int o = 32; o >= 1; o >>= 1) { d2 += __shfl_xor(d2, o); r2 += __shfl_xor(r2, o); }
    if ((threadIdx.x & 63) == 0) { atomicAdd(acc + 2 * cp, d2); atomicAdd(acc + 2 * cp + 1, r2); }
}
__global__ void k_cmp_f(const float* a, const float* b, size_t n, float* acc, int cp) {
    float d2 = 0.f, r2 = 0.f;
    for (size_t i = (size_t)blockIdx.x * blockDim.x + threadIdx.x; i < n; i += (size_t)gridDim.x * blockDim.x) { const float av = a[i], bv = b[i]; d2 += (av - bv) * (av - bv); r2 += bv * bv; }
    for (int o = 32; o >= 1; o >>= 1) { d2 += __shfl_xor(d2, o); r2 += __shfl_xor(r2, o); }
    if ((threadIdx.x & 63) == 0) { atomicAdd(acc + 2 * cp, d2); atomicAdd(acc + 2 * cp + 1, r2); }
}
__global__ void k_report(const float* acc, int ncp, float thr, float* out) {
    if (blockIdx.x == 0 && threadIdx.x == 0) { int bad = -1; for (int i = 0; i < ncp; ++i) { const float d = acc[2 * i], r = acc[2 * i + 1]; if (!(d <= thr * r)) { bad = i; break; } }
        if (bad >= 0) out[0] += 100.f * (float)(bad + 1); }
}
}
#endif

extern "C" void kernel_launch(void* const* d_in, const int* in_sizes, int n_in, void* d_out, int out_size, void* d_ws, size_t ws_size, hipStream_t stream) {
    using namespace mk;
    static int grid = 0;
    if (grid == 0) {
        int dev = 0, cus = 0, per_cu = 0;
        if (hipGetDevice(&dev) != hipSuccess || hipDeviceGetAttribute(&cus, hipDeviceAttributeMultiprocessorCount, dev) != hipSuccess) { fprintf(stderr, "kernel_launch: device query failed\n"); grid = -1; return; }
        if (hipFuncSetAttribute((const void*)mega, hipFuncAttributeMaxDynamicSharedMemorySize, LDS_BYTES) != hipSuccess) { fprintf(stderr, "kernel_launch: hipFuncSetAttribute(%d B LDS) failed\n", LDS_BYTES); grid = -1; return; }
        if (hipOccupancyMaxActiveBlocksPerMultiprocessor(&per_cu, (const void*)mega, NTHR, LDS_BYTES) != hipSuccess || per_cu < 1) fprintf(stderr, "kernel_launch: occupancy query reports %d blocks per CU\n", per_cu);
        (void)hipGetLastError();
        grid = 256;
        if (cus < 256) { fprintf(stderr, "kernel_launch: %d CUs < 256: the persistent grid would not be resident; nothing launched\n", cus); grid = -1; return; }
        if (n_in != 32 || ws_size < WS_END) { fprintf(stderr, "kernel_launch: n_in %d ws %zu (need %zu)\n", n_in, ws_size, (size_t)WS_END); grid = -1; return; }
    }
    if (grid < 0) return;
    (void)hipMemsetAsync((char*)d_ws + WS_CTL, 0, CTL_BYTES, stream);
    Args a{};
    for (int i = 0; i < 32; ++i) a.in[i] = (const float*)d_in[i];
    a.out = (float*)d_out; a.ws = (unsigned char*)d_ws;
#if !MK_DEBUG
#if MK_MULTI
    for (int p = 0; p < N_PHASES; ++p) { a.lo = p; a.hi = p + 1; hipLaunchKernelGGL(mega, dim3(grid), dim3(NTHR), LDS_BYTES, stream, a); }
#else
    a.lo = 0; a.hi = N_PHASES; hipLaunchKernelGGL(mega, dim3(grid), dim3(NTHR), LDS_BYTES, stream, a);
#ifdef MK_PROBE_PH
    for (int r = 0; r < MK_PROBE_N; ++r) { a.lo = MK_PROBE_PH; a.hi = MK_PROBE_PH + 1; a.flags = MK_PROBE_FLAGS; hipLaunchKernelGGL(mega, dim3(grid), dim3(NTHR), LDS_BYTES, stream, a); }
#endif
#endif
    { const hipError_t le = hipPeekAtLastError(); if (le != hipSuccess) fprintf(stderr, "kernel_launch: launch failed: %s\n", hipGetErrorName(le)); }
#else
#endif
}
```

```cpp
#include <hip/hip_runtime.h>
#include <cstdio>
#include <cstdint>
#define MK_MULTI 0
#define MK_DEBUG 0
#define MK_DBG_THR 1e-3f
namespace mk {
#define LAS __attribute__((address_space(3)))
#define GAS __attribute__((address_space(1)))
typedef unsigned short bf16;
typedef short bf16x8 __attribute__((ext_vector_type(8)));
typedef short s16x4 __attribute__((ext_vector_type(4)));
typedef float f32x2 __attribute__((ext_vector_type(2)));
typedef int i32x4 __attribute__((ext_vector_type(4)));
typedef float f32x4 __attribute__((ext_vector_type(4)));
typedef float f32x16 __attribute__((ext_vector_type(16)));
typedef unsigned u32x2 __attribute__((ext_vector_type(2)));
typedef unsigned u32x4 __attribute__((ext_vector_type(4)));

constexpr int D = 1024, NBATCH = 4, S = 4096, CL = 256, NL = NBATCH * S, NC = NBATCH * CL, T = NL + NC;
constexpr int NWAVES = 8, NTHR = 512;
constexpr float EPS = 1e-6f;
constexpr float LOG2E = 1.4426950408889634f;
constexpr float QSCALE_A = 0.125f * LOG2E;
constexpr float QSCALE_C = 0.10206207261596575f * LOG2E;

constexpr size_t al256(size_t x) { return (x + 255) & ~(size_t)255; }
constexpr size_t CTL_BYTES = 65536;
constexpr int CW_BAR = 1024, CW_CNT = 8192;
constexpr size_t WS_CTL = 0;
constexpr size_t WS_MOD = WS_CTL + CTL_BYTES;
constexpr size_t WS_COSA = WS_MOD + al256((size_t)4 * 5 * 6144 * 4);
constexpr size_t WS_SINA = WS_COSA + 4096 * 32 * 4;
constexpr size_t WS_COSC = WS_SINA + 4096 * 32 * 4;
constexpr size_t WS_SINC = WS_COSC + 4096 * 16 * 4;
constexpr size_t WS_WR = WS_SINC + 4096 * 16 * 4;
constexpr size_t WS_WINA = WS_WR + (size_t)4 * 2 * 32 * 1024 * 2;
constexpr size_t WS_WOUTA = WS_WINA + (size_t)2 * 1792 * 1024 * 2;
constexpr size_t WS_WINC = WS_WOUTA + (size_t)2 * 1024 * 1024 * 2;
constexpr size_t WS_WQB = WS_WINC + (size_t)2 * 1280 * 1024 * 2;
constexpr size_t WS_WKVB = WS_WQB + (size_t)2 * 1536 * 768 * 2;
constexpr size_t WS_WOUTC = WS_WKVB + (size_t)2 * 2048 * 256 * 2;
constexpr size_t WS_WGU = WS_WOUTC + (size_t)2 * 1024 * 1024 * 2;
constexpr size_t WS_WDN = WS_WGU + (size_t)128 * 2048 * 1024 * 2;
constexpr size_t WS_X = WS_WDN + (size_t)128 * 1024 * 1024 * 2;
constexpr size_t WS_H = WS_X + (size_t)T * D * 4;
constexpr size_t WS_QA = WS_H + (size_t)T * D * 2;
constexpr size_t WS_KA = WS_QA + (size_t)T * 512 * 2;
constexpr size_t WS_VA = WS_KA + (size_t)T * 128 * 2;
constexpr size_t WS_Z = WS_VA + (size_t)T * 128 * 2;
constexpr size_t WS_P = WS_Z + (size_t)T * 512 * 2;
constexpr int PP = 1056;
constexpr size_t WS_RS = WS_P + (size_t)T * PP * 2;
constexpr size_t WS_QC = WS_RS + (size_t)T * 2 * 4;
constexpr size_t WS_KC = WS_QC + (size_t)T * 1536 * 2;
constexpr size_t WS_VC = WS_KC + (size_t)T * 1536 * 2;
constexpr size_t WS_MIX = WS_VC + (size_t)T * 1024 * 2;
constexpr size_t WS_F = WS_MIX + (size_t)T * 1024 * 2;
constexpr size_t WS_GATE = WS_F + (size_t)T * 1024 * 2;
constexpr size_t WS_LIST = WS_GATE + (size_t)T * 4 * 4;
constexpr int ACT_ROWS = 304 * 256;
constexpr size_t WS_ACT = WS_LIST + (size_t)32 * T * 4;
constexpr size_t WS_YB = WS_ACT + (size_t)ACT_ROWS * 1024 * 2;
constexpr size_t WS_SSX = WS_YB + (size_t)T * 4 * 1024 * 2;
constexpr size_t WS_SSP = WS_SSX + (size_t)T * 16 * 4;
constexpr size_t WS_END = WS_SSP + (size_t)T * 16 * 4;

constexpr int STAGE_BYTES = 131072;
constexpr int LDS_IDX = 131072;
constexpr int MAXU = 12;
constexpr int LDS_TAB = LDS_IDX + MAXU * 1024;
constexpr int LDS_MISC = LDS_TAB + 1024;
constexpr int LDS_BYTES = LDS_MISC + 256;
constexpr int CV_HDR = 56320, CV_BUF = 57344;

__device__ __forceinline__ unsigned pk2(float lo, float hi) {
    typedef __bf16 bf2 __attribute__((ext_vector_type(2)));
    return __builtin_bit_cast(unsigned, __builtin_convertvector((f32x2){lo, hi}, bf2));
}
__device__ __forceinline__ float bflo(unsigned u) { return __uint_as_float(u << 16); }
__device__ __forceinline__ float bfhi(unsigned u) { return __uint_as_float(u & 0xffff0000u); }
__device__ __forceinline__ float bf1(bf16 u) { return __uint_as_float(((unsigned)u) << 16); }
__device__ __forceinline__ float fsigm(float v) { return __builtin_amdgcn_rcpf(1.f + __builtin_amdgcn_exp2f(-1.4426950408889634f * v)); }
__device__ __forceinline__ float fsilu(float v) { return v * fsigm(v); }
__device__ __forceinline__ int modrow(int row) { return row < NL ? (row >> 12) : 4; }
#define WS_DPP(v, ctrl) ((v) + __int_as_float(__builtin_amdgcn_update_dpp(0, __float_as_int(v), (ctrl), 0xF, 0xF, false)))
__device__ __forceinline__ float wave_sum(float v) {
    v = WS_DPP(v, 0xB1); v = WS_DPP(v, 0x4E); v = WS_DPP(v, 0x141); v = WS_DPP(v, 0x140);
    v += __shfl_xor(v, 16); v += __shfl_xor(v, 32);
    return v;
}
__device__ __forceinline__ int otid() { int t = threadIdx.x; asm volatile("" : "+v"(t)); return t; }
#define LDS_WAIT() asm volatile("s_waitcnt lgkmcnt(0)" ::: "memory")
#define VM_WAIT() asm volatile("s_waitcnt vmcnt(0)" ::: "memory")

#define XB_TMO      128
#define XB_XCNT(j)  (256  + 64 * (j))
#define XB_XSUB(j)  (1280 + 64 * (j))
#define XB_XGEN(j)  (2304 + 64 * (j))
#define XB_TOP      3328
#define XB_TOPGEN   3392
#define XCD_BAR_WORDS 3456
#define XB_SPIN_CAP (1u << 18)
__device__ __forceinline__ unsigned xb_ld(unsigned* p)              { return __hip_atomic_load(p, __ATOMIC_RELAXED, __HIP_MEMORY_SCOPE_AGENT); }
__device__ __forceinline__ unsigned xb_add(unsigned* p, unsigned v) { return __hip_atomic_fetch_add(p, v, __ATOMIC_RELAXED, __HIP_MEMORY_SCOPE_AGENT); }
__device__ __forceinline__ unsigned xb_xcc_id() { return (unsigned)__builtin_amdgcn_s_getreg((3 << 11) | 20) & 0xFu; }
#define XB_SPIN(cond, bar) do { unsigned _sp = 0; while (cond) { __builtin_amdgcn_s_sleep(1); \
    if ((++_sp & 255u) == 0u) { if (xb_ld(&(bar)[XB_TMO])) break; if (_sp > XB_SPIN_CAP) { atomicAdd(&(bar)[XB_TMO], 1u); break; } } } } while (0)
struct XcdBarrier { unsigned* bar; unsigned x; volatile LAS unsigned* st; };
__device__ __forceinline__ XcdBarrier xcd_barrier_post(unsigned* bar, volatile LAS unsigned* st) {
    XcdBarrier b; b.bar = bar; b.x = xb_xcc_id(); b.st = st;
    if (threadIdx.x == 0) (void)xb_add(&bar[XB_XCNT(b.x)], 1u);
    return b;
}
__device__ __forceinline__ void xcd_barrier_complete(unsigned* bar, unsigned x, unsigned& nloc, unsigned& nx) {
    const unsigned G = gridDim.x * gridDim.y * gridDim.z;
    unsigned sum, cnt, mine, sp = 0u;
    for (;;) {
        sum = 0u; cnt = 0u; mine = 0u;
#pragma unroll
        for (unsigned j = 0; j < 16; ++j) { const unsigned c = xb_ld(&bar[XB_XCNT(j)]); sum += c; cnt += (c > 0u) ? 1u : 0u; mine = (j == x) ? c : mine; }
        if (sum == G) break;
        __builtin_amdgcn_s_sleep(1);
        if ((++sp & 255u) == 0u) { if (xb_ld(&bar[XB_TMO])) break; if (sp > XB_SPIN_CAP) { atomicAdd(&bar[XB_TMO], 1u); break; } }
    }
    nloc = mine > 0u ? mine : 1u; nx = cnt > 0u ? cnt : 1u;
}
__device__ __forceinline__ void xcd_barrier(const XcdBarrier& b) {
    asm volatile("s_waitcnt vmcnt(0)" ::: "memory");
    __syncthreads();
    if (otid() == 0) {
        unsigned* bar = b.bar;
        __builtin_amdgcn_s_waitcnt(0);
        unsigned nloc = b.st[0], nx = b.st[1];
        if (nloc == 0u) { xcd_barrier_complete(bar, b.x, nloc, nx); b.st[0] = nloc; b.st[1] = nx; }
        const unsigned old = xb_add(&bar[XB_XSUB(b.x)], 1u);
        const unsigned gen = old / nloc;
        if (old + 1u == (gen + 1u) * nloc) {
            __builtin_amdgcn_fence(__ATOMIC_RELEASE, "agent");
            asm volatile("s_waitcnt vmcnt(0)" ::: "memory");
            const unsigned og = xb_add(&bar[XB_TOP], 1u);
            const unsigned tg = og / nx;
            if (og + 1u == (tg + 1u) * nx) xb_add(&bar[XB_TOPGEN], 1u);
            else XB_SPIN(xb_ld(&bar[XB_TOPGEN]) == tg, bar);
            __builtin_amdgcn_fence(__ATOMIC_ACQUIRE, "agent");
            xb_add(&bar[XB_XGEN(b.x)], 1u);
            asm volatile("s_waitcnt vmcnt(0)" ::: "memory");
        } else {
            XB_SPIN(xb_ld(&bar[XB_XGEN(b.x)]) == gen, bar);
            __builtin_amdgcn_fence(__ATOMIC_ACQUIRE, "agent");
            asm volatile("s_waitcnt vmcnt(0)" ::: "memory");
        }
    }
    __syncthreads();
}

namespace g8 {
constexpr int BM = 256, BK = 64, HALF = 128, HTB = HALF * BK * 2, NXCD = 8, WGM = 8;
__host__ __device__ __forceinline__ int lds_byte(int r, int c) { const int st = (r >> 4) * 2 + (c >> 5), rr = r & 15, cc = c & 31, ob = rr * 64 + cc * 2; return st * 1024 + (ob ^ (((ob >> 9) & 1) << 5)); }
__host__ __device__ __forceinline__ void stage_rc(int b, int& R, int& C) { const int st = b / 1024, sb = b % 1024, swz = sb ^ (((sb >> 9) & 1) << 5); R = (st >> 1) * 16 + swz / 64; C = (st & 1) * 32 + (swz % 64) / 2; }

struct Unit { int pm, pn, e, nt, gm, slot; };
struct GemmP { const bf16* A; int lda; const bf16* Bt; int K; };

struct StaticOrder {
    static constexpr bool GATHER = false;
    int nM, nN, nwg, G, c;
    __device__ void init(int nM_, int nN_, int G_, int c_) { nM = nM_; nN = nN_; nwg = nM * nN; G = G_; c = c_; }
    __device__ __forceinline__ bool next(int i, Unit& u) const {
        const long L = (long)i * G + c; if (L >= nwg) return false;
        int wgid = (int)L; { const int q = nwg / NXCD, r = nwg % NXCD, xcd = wgid % NXCD, off = wgid / NXCD; wgid = (xcd < r ? xcd * (q + 1) : r * (q + 1) + (xcd - r) * q) + off; }
        const int nig = WGM * nN, gid = wgid / nig, fm = gid * WGM, gsz = (nM - fm) < WGM ? (nM - fm) : WGM;
        u.pm = fm + ((wgid % nig) % gsz); u.pn = (wgid % nig) / gsz; u.e = 0; u.nt = u.pn; u.gm = u.pm; u.slot = 0; return true;
    }
    __device__ __forceinline__ int arow(const Unit& u, int r) const { return u.pm * BM + r; }
};
template <bool GATHER_> struct MoeOrder {
    static constexpr bool GATHER = GATHER_;
    const LAS int* tab; const LAS int* idx;
    __device__ __forceinline__ bool next(int i, Unit& u) const {
        if (i >= tab[127]) return false;
        u.gm = tab[128 + 4 * i]; u.pn = tab[129 + 4 * i]; u.e = tab[130 + 4 * i]; u.nt = tab[131 + 4 * i]; u.slot = i; u.pm = u.gm; return true;
    }
    __device__ __forceinline__ int arow(const Unit& u, int r) const {
        if (GATHER_) { const int s = idx[u.slot * 256 + r]; return s < 0 ? 0 : (s >> 2); }
        return u.gm * BM + r;
    }
};

template <class Epi, class Sched>
__device__ __forceinline__ void gemm_phase(LAS unsigned char* lds, const GemmP g, const Sched& S, const Epi& E) {
    const int tid = otid(), wid = __builtin_amdgcn_readfirstlane(tid >> 6), lane = tid & 63, wr = wid >> 2, wc = wid & 3, fr = lane & 15, fq = lane >> 4;
    const int K = g.K, nt = K / BK;
    int RR[2], CC[2]; unsigned voffB[2], voffA[2];
    const unsigned lda2 = (unsigned)g.lda * 2u;
#pragma unroll
    for (int i = 0; i < 2; ++i) { stage_rc(tid * 16 + i * 8192, RR[i], CC[i]); voffB[i] = (unsigned)(RR[i] * K + CC[i]) * 2u; voffA[i] = (unsigned)RR[i] * lda2 + (unsigned)CC[i] * 2u; }
    const size_t hstepA = (size_t)HALF * lda2, tstepA = 2 * hstepA;
    const size_t kstep = (size_t)(BK * 2);
    const size_t hstepB = (size_t)HALF * K * 2;
    const size_t tstepB = 2 * hstepB;
    const unsigned ldsw = (unsigned)wid * 1024u;
    const int aoff = lds_byte(wr * 64 + fr, fq * 8), boff = lds_byte(wc * 32 + fr, fq * 8);
#define G8_SA(b, h) (((b) * 2 + (h)) * HTB)
#define G8_SB(b, h) ((4 + (b) * 2 + (h)) * HTB)
#define G8_STAGE(bufoff, gbase, voff) do { _Pragma("unroll") for (int _i = 0; _i < 2; ++_i) \
        __builtin_amdgcn_global_load_lds((const unsigned*)((const char*)(gbase) + (voff)[_i]), (LAS unsigned*)(lds + (bufoff) + ldsw + _i * 8192), 16, 0, 0); } while (0)
#define G8_LDA(dst, b, h) do { _Pragma("unroll") for (int m = 0; m < 4; ++m) _Pragma("unroll") for (int k = 0; k < 2; ++k) dst[m][k] = *(const LAS bf16x8*)(lds + G8_SA(b, h) + aoff + m * 2048 + k * 1024); } while (0)
#define G8_LDB(dst, b, h) do { _Pragma("unroll") for (int n = 0; n < 2; ++n) _Pragma("unroll") for (int k = 0; k < 2; ++k) dst[n][k] = *(const LAS bf16x8*)(lds + G8_SB(b, h) + boff + n * 2048 + k * 1024); } while (0)
#define G8_MMA(ai, bj, At, Bt) do { __builtin_amdgcn_s_setprio(1); _Pragma("unroll") for (int m = 0; m < 4; ++m) _Pragma("unroll") for (int n = 0; n < 2; ++n) _Pragma("unroll") for (int k = 0; k < 2; ++k) \
        acc[ai][bj][m][n] = __builtin_amdgcn_mfma_f32_16x16x32_bf16(Bt[n][k], At[m][k], acc[ai][bj][m][n], 0, 0, 0); __builtin_amdgcn_s_setprio(0); } while (0)
#define G8_WAIT_V(n) asm volatile("s_waitcnt vmcnt(" #n ")" ::: "memory")
#define G8_WAIT_L(n) asm volatile("s_waitcnt lgkmcnt(" #n ")" ::: "memory")
#define G8_BAR __builtin_amdgcn_s_barrier()
#define G8_SCHED __builtin_amdgcn_sched_barrier(0)
#define G8_MKOFF(u, o) do { if constexpr (Sched::GATHER) { _Pragma("unroll") for (int _i = 0; _i < 2; ++_i) { int _R, _C; stage_rc(tid * 16 + _i * 8192, _R, _C); \
        _Pragma("unroll") for (int _h = 0; _h < 2; ++_h) o[_h][_i] = (unsigned)S.arow(u, _h * HALF + _R) * lda2 + (unsigned)_C * 2u; } } } while (0)
#define G8_STAGE_A(bufoff, kofs, h, usenext) do { if constexpr (Sched::GATHER) { unsigned _o[2]; _o[0] = (usenext) ? no[h][0] : co[h][0]; _o[1] = (usenext) ? no[h][1] : co[h][1]; G8_STAGE(bufoff, Ab + (kofs), _o); } \
        else { const char* _p = ((usenext) ? nAp : cAp) + (size_t)(h) * hstepA + (kofs); G8_STAGE(bufoff, _p, voffA); } } while (0)
    Unit cur, nxt; int ui = 0;
    if (!S.next(0, cur)) return;
    f32x4 acc[2][2][4][2];
#pragma unroll
    for (int a = 0; a < 2; ++a)
#pragma unroll
        for (int b = 0; b < 2; ++b)
#pragma unroll
            for (int m = 0; m < 4; ++m)
#pragma unroll
                for (int n = 0; n < 2; ++n) acc[a][b][m][n] = (f32x4){0.f, 0.f, 0.f, 0.f};
    bf16x8 At[4][2], B0[2][2], B1[2][2];
    unsigned co[2][2], no[2][2];
    G8_MKOFF(cur, co);
    if (Sched::GATHER) { G8_WAIT_L(0); }
    const char* Ab = (const char*)g.A;
    const char* cAp = Ab + (size_t)cur.pm * tstepA; const char* nAp = cAp;
    const char* cB = (const char*)g.Bt + (size_t)cur.pn * tstepB;
    G8_STAGE(G8_SB(0, 0), cB, voffB); G8_STAGE(G8_SB(0, 1), cB + hstepB, voffB); G8_STAGE_A(G8_SA(0, 0), 0, 0, false); G8_STAGE_A(G8_SA(0, 1), 0, 1, false);
    if (wr == 1) G8_BAR;
    G8_WAIT_V(2); G8_BAR;
    G8_STAGE(G8_SB(1, 0), cB + kstep, voffB); G8_STAGE_A(G8_SA(1, 0), kstep, 0, false); G8_STAGE(G8_SB(1, 1), cB + hstepB + kstep, voffB);
    G8_WAIT_V(6); G8_BAR;
    for (;;) {
        const bool has_next = S.next(ui + 1, nxt);
        if (has_next) { G8_MKOFF(nxt, no); if (Sched::GATHER) { G8_WAIT_L(0); } nAp = Ab + (size_t)nxt.pm * tstepA; }
        else {
            nAp = cAp;
            if constexpr (Sched::GATHER) {
#pragma unroll
                for (int h = 0; h < 2; ++h)
#pragma unroll
                    for (int i = 0; i < 2; ++i) no[h][i] = co[h][i];
            }
        }
        G8_SCHED;
        const char* nB = has_next ? (const char*)g.Bt + (size_t)nxt.pn * tstepB : cB;
#pragma unroll 1
        for (int t = 0; t < nt; t += 2) {
            const bool last = (t == nt - 2);
            const size_t k1 = (size_t)(t + 1) * kstep, k2 = last ? 0 : (size_t)(t + 2) * kstep, k3 = k2 + kstep;
            const char* b2 = last ? nB : cB + (size_t)(t + 2) * kstep; const char* b3 = b2 + kstep;
            G8_LDB(B0, 0, 0); G8_LDB(B1, 0, 1); G8_SCHED; G8_LDA(At, 0, 0); G8_STAGE_A(G8_SA(1, 1), k1, 1, false);
            G8_WAIT_V(8); G8_WAIT_L(0); G8_BAR; G8_MMA(0, 0, At, B0); G8_MMA(0, 1, At, B1); G8_BAR; G8_SCHED;
            G8_LDA(At, 0, 1); G8_STAGE(G8_SB(0, 0), b2, voffB); G8_STAGE(G8_SB(0, 1), b2 + hstepB, voffB); G8_STAGE_A(G8_SA(0, 0), k2, 0, last);
            G8_WAIT_V(8); G8_WAIT_L(0); G8_BAR; G8_MMA(1, 0, At, B0); G8_MMA(1, 1, At, B1); G8_BAR; G8_SCHED;
            G8_LDB(B0, 1, 0); G8_LDB(B1, 1, 1); G8_SCHED; G8_LDA(At, 1, 0); G8_STAGE_A(G8_SA(0, 1), k2, 1, last);
            G8_WAIT_V(8); G8_WAIT_L(0); G8_BAR; G8_MMA(0, 0, At, B0); G8_MMA(0, 1, At, B1); G8_BAR; G8_SCHED;
            G8_LDA(At, 1, 1); G8_STAGE(G8_SB(1, 0), b3, voffB); G8_STAGE(G8_SB(1, 1), b3 + hstepB, voffB); G8_STAGE_A(G8_SA(1, 0), k3, 0, last);
            G8_WAIT_V(8); G8_WAIT_L(0); G8_BAR; G8_MMA(1, 0, At, B0); G8_MMA(1, 1, At, B1); G8_BAR; G8_SCHED;
        }
        if (wr == 0) G8_BAR;
        E(acc, cur, wr, wc, fr, fq, lds);
        if (!has_next) break;
#pragma unroll
        for (int a = 0; a < 2; ++a)
#pragma unroll
            for (int b = 0; b < 2; ++b)
#pragma unroll
                for (int m = 0; m < 4; ++m)
#pragma unroll
                    for (int n = 0; n < 2; ++n) acc[a][b][m][n] = (f32x4){0.f, 0.f, 0.f, 0.f};
        cur = nxt; cB = nB; cAp = nAp; ++ui;
        if constexpr (Sched::GATHER) {
#pragma unroll
            for (int h = 0; h < 2; ++h)
#pragma unroll
                for (int i = 0; i < 2; ++i) co[h][i] = no[h][i];
        }
        if (wr == 1) G8_BAR;
    }
    G8_WAIT_V(0);
    G8_BAR;
#undef G8_SA
#undef G8_SB
#undef G8_STAGE
#undef G8_LDA
#undef G8_LDB
#undef G8_MMA
#undef G8_WAIT_V
#undef G8_WAIT_L
#undef G8_BAR
#undef G8_SCHED
#undef G8_MKOFF
#undef G8_STAGE_A
}
}

using g8::Unit;
typedef f32x4 Acc[2][2][4][2];
__device__ __forceinline__ u32x4 pack8(const f32x4 a, const f32x4 b) { u32x4 w; w.x = pk2(a[0], a[1]); w.y = pk2(a[2], a[3]); w.z = pk2(b[0], b[1]); w.w = pk2(b[2], b[3]); return w; }

struct EpiInA {
    bf16 *Qa, *Ka, *Va, *Z; const float *qg, *kg, *cosA, *sinA;
    __device__ __forceinline__ void operator()(const Acc& acc, const Unit& u, int wr, int wc, int fr, int fq, LAS unsigned char*) const {
        const int row0 = u.pm * 256 + wr * 64 + fr, pn = u.pn, a = fq >> 1, b = fq & 1;
        if (pn < 3) {
            const bool isv = (pn == 2 && wc >= 2), isq = pn < 2;
            const int dbase = 32 * a + 8 * b;
            if (isv) {
#pragma unroll
                for (int ai = 0; ai < 2; ++ai)
#pragma unroll
                    for (int m = 0; m < 4; ++m) { const int row = row0 + ai * 128 + m * 16; bf16* o = Va + (size_t)row * 128 + (wc - 2) * 64 + dbase;
#pragma unroll
                        for (int bj = 0; bj < 2; ++bj) *(u32x4*)(o + 16 * bj) = pack8(acc[ai][bj][m][0], acc[ai][bj][m][1]); }
                return;
            }
            const float* g = isq ? qg : kg;
            f32x4 gv[2][2];
#pragma unroll
            for (int bj = 0; bj < 2; ++bj)
#pragma unroll
                for (int n = 0; n < 2; ++n) gv[bj][n] = *(const f32x4*)(g + dbase + 16 * bj + 4 * n);
            const float sc = isq ? QSCALE_A : 1.f;
            bf16* obase = isq ? (Qa + (pn * 4 + wc) * 64 + dbase) : (Ka + wc * 64 + dbase);
            const int opitch = isq ? 512 : 128;
            f32x4 cc[2], sn[2], cn[2], snn[2];
            { const int t = row0 & 4095;
#pragma unroll
              for (int n = 0; n < 2; ++n) { cc[n] = *(const f32x4*)(cosA + t * 32 + 16 * a + 8 * b + 4 * n); sn[n] = *(const f32x4*)(sinA + t * 32 + 16 * a + 8 * b + 4 * n); } }
#pragma unroll
            for (int gidx = 0; gidx < 8; ++gidx) {
                    const int ai = gidx >> 2, m = gidx & 3;
                    const int row = row0 + ai * 128 + m * 16;
                    if (gidx < 7) { const int tn = (row0 + ((gidx + 1) >> 2) * 128 + ((gidx + 1) & 3) * 16) & 4095;
#pragma unroll
                        for (int n = 0; n < 2; ++n) { cn[n] = *(const f32x4*)(cosA + tn * 32 + 16 * a + 8 * b + 4 * n); snn[n] = *(const f32x4*)(sinA + tn * 32 + 16 * a + 8 * b + 4 * n); } }
                    float ss = 0.f;
#pragma unroll
                    for (int bj = 0; bj < 2; ++bj)
#pragma unroll
                        for (int n = 0; n < 2; ++n) { const f32x4 v = acc[ai][bj][m][n]; ss += (v[0] * v[0] + v[1] * v[1]) + (v[2] * v[2] + v[3] * v[3]); }
                    ss += __shfl_xor(ss, 16); ss += __shfl_xor(ss, 32);
                    const float rs = rsqrtf(ss * (1.f / 64.f) + EPS);
                    f32x4 y[2][2];
#pragma unroll
                    for (int bj = 0; bj < 2; ++bj)
#pragma unroll
                        for (int n = 0; n < 2; ++n) y[bj][n] = acc[ai][bj][m][n] * rs * gv[bj][n];
                    if (row < NL) {
#pragma unroll
                        for (int n = 0; n < 2; ++n) { const f32x4 y0 = y[0][n], y1 = y[1][n]; y[0][n] = y0 * cc[n] - y1 * sn[n]; y[1][n] = y1 * cc[n] + y0 * sn[n]; }
                    }
                    bf16* o = obase + (size_t)row * opitch;
#pragma unroll
                    for (int bj = 0; bj < 2; ++bj) *(u32x4*)(o + 16 * bj) = pack8(y[bj][0] * sc, y[bj][1] * sc);
                    asm volatile("" ::: "memory");
#pragma unroll
                    for (int n = 0; n < 2; ++n) { cc[n] = cn[n]; sn[n] = snn[n]; }
            }
        } else {
            const int j0 = 128 * (pn - 3) + 32 * wc + 8 * fq;
#pragma unroll
            for (int ai = 0; ai < 2; ++ai)
#pragma unroll
                for (int m = 0; m < 4; ++m) {
                    const int row = row0 + ai * 128 + m * 16; f32x4 z[2];
#pragma unroll
                    for (int n = 0; n < 2; ++n) { const f32x4 av = acc[ai][0][m][n], gt = acc[ai][1][m][n];
#pragma unroll
                        for (int r = 0; r < 4; ++r) z[n][r] = av[r] * fsigm(gt[r]); }
                    *(u32x4*)(Z + (size_t)row * 512 + j0) = pack8(z[0], z[1]);
                }
        }
    }
};
struct EpiResid {
    float* X; const float* Xlat; const float* Xctx; const float* gmod; float* SSX;
    __device__ __forceinline__ void operator()(const Acc& acc, const Unit& u, int wr, int wc, int fr, int fq, LAS unsigned char*) const {
        const int row0 = u.pm * 256 + wr * 64 + fr; const int mr = u.pm < 64 ? (u.pm >> 4) : 4;
        const float* gp = gmod + (size_t)mr * 6144; const float* src = u.pm < 64 ? Xlat : Xctx - (size_t)NL * D;
        float ssr[2][4];
#pragma unroll
        for (int ai = 0; ai < 2; ++ai)
#pragma unroll
            for (int m = 0; m < 4; ++m) ssr[ai][m] = 0.f;
#pragma unroll
        for (int bj = 0; bj < 2; ++bj) {
            const int c0 = 256 * u.pn + 128 * bj + 32 * wc + 4 * fq;
            const f32x4 g0 = *(const f32x4*)(gp + c0), g1 = *(const f32x4*)(gp + c0 + 16);
#pragma unroll
            for (int ai = 0; ai < 2; ++ai) {
                f32x4 xo[4][2];
#pragma unroll
                for (int m = 0; m < 4; ++m) { const float* xp = src + (size_t)(row0 + ai * 128 + m * 16) * D + c0; xo[m][0] = *(const f32x4*)xp; xo[m][1] = *(const f32x4*)(xp + 16); }
#pragma unroll
                for (int m = 0; m < 4; ++m) { float* op = X + (size_t)(row0 + ai * 128 + m * 16) * D + c0;
                    const f32x4 y0 = xo[m][0] + g0 * acc[ai][bj][m][0], y1 = xo[m][1] + g1 * acc[ai][bj][m][1];
                    *(f32x4*)op = y0; *(f32x4*)(op + 16) = y1;
                    ssr[ai][m] += (y0[0] * y0[0] + y0[1] * y0[1]) + (y0[2] * y0[2] + y0[3] * y0[3]) + (y1[0] * y1[0] + y1[1] * y1[1]) + (y1[2] * y1[2] + y1[3] * y1[3]); }
                asm volatile("" ::: "memory");
            }
        }
#pragma unroll
        for (int ai = 0; ai < 2; ++ai)
#pragma unroll
            for (int m = 0; m < 4; ++m) { float ss = ssr[ai][m]; ss += __shfl_xor(ss, 16); ss += __shfl_xor(ss, 32);
                if (fq == 0) SSX[(size_t)(row0 + ai * 128 + m * 16) * 16 + 4 * u.pn + wc] = ss; }
    }
};
struct EpiBf16 {
    bf16* O; int ldo, ncols;
    __device__ __forceinline__ void operator()(const Acc& acc, const Unit& u, int wr, int wc, int fr, int fq, LAS unsigned char*) const {
        const int row0 = u.pm * 256 + wr * 64 + fr;
#pragma unroll
        for (int bj = 0; bj < 2; ++bj) {
            const int c0 = 256 * u.pn + 128 * bj + 32 * wc + 8 * fq;
            if (c0 < ncols) {
#pragma unroll
                for (int ai = 0; ai < 2; ++ai)
#pragma unroll
                    for (int m = 0; m < 4; ++m) *(u32x4*)(O + (size_t)(row0 + ai * 128 + m * 16) * ldo + c0) = pack8(acc[ai][bj][m][0], acc[ai][bj][m][1]);
            }
        }
    }
};
struct EpiP {
    bf16* P; float* SSP; bf16* Kc; const float* krg; const float* cosC; const float* sinC;
    __device__ __forceinline__ void operator()(const Acc& acc, const Unit& u, int wr, int wc, int fr, int fq, LAS unsigned char*) const {
        const int row0 = u.pm * 256 + wr * 64 + fr;
        if (u.pn < 4) {
#pragma unroll
            for (int ai = 0; ai < 2; ++ai)
#pragma unroll
                for (int m = 0; m < 4; ++m) { const int row = row0 + ai * 128 + m * 16; float ss = 0.f;
#pragma unroll
                    for (int bj = 0; bj < 2; ++bj) { const f32x4 y0 = acc[ai][bj][m][0], y1 = acc[ai][bj][m][1];
                        *(u32x4*)(P + (size_t)row * PP + 256 * u.pn + 128 * bj + 32 * wc + 8 * fq) = pack8(y0, y1);
                        ss += (y0[0] * y0[0] + y0[1] * y0[1]) + (y0[2] * y0[2] + y0[3] * y0[3]) + (y1[0] * y1[0] + y1[1] * y1[1]) + (y1[2] * y1[2] + y1[3] * y1[3]); }
                    ss += __shfl_xor(ss, 16); ss += __shfl_xor(ss, 32);
                    if (fq == 0) SSP[(size_t)row * 16 + 4 * u.pn + wc] = ss; }
        } else if (wc == 0) {
            const f32x4 g0 = *(const f32x4*)(krg + 8 * fq), g1 = *(const f32x4*)(krg + 8 * fq + 4);
#pragma unroll
            for (int ai = 0; ai < 2; ++ai)
#pragma unroll
                for (int m = 0; m < 4; ++m) { const int row = row0 + ai * 128 + m * 16; const f32x4 v0 = acc[ai][0][m][0], v1 = acc[ai][0][m][1];
                    *(u32x4*)(P + (size_t)row * PP + 1024 + 8 * fq) = pack8(v0, v1);
                    float ss = (v0[0] * v0[0] + v0[1] * v0[1]) + (v0[2] * v0[2] + v0[3] * v0[3]) + (v1[0] * v1[0] + v1[1] * v1[1]) + (v1[2] * v1[2] + v1[3] * v1[3]);
                    ss += __shfl_xor(ss, 16); ss += __shfl_xor(ss, 32);
                    const float rk = rsqrtf(ss * (1.f / 32.f) + EPS);
                    f32x4 y0 = v0 * rk * g0, y1 = v1 * rk * g1;
                    const int t = row & 4095, ax = fq >> 1;
                    const f32x4 c0 = *(const f32x4*)(cosC + t * 16 + 8 * ax), c1 = *(const f32x4*)(cosC + t * 16 + 8 * ax + 4), s0 = *(const f32x4*)(sinC + t * 16 + 8 * ax), s1 = *(const f32x4*)(sinC + t * 16 + 8 * ax + 4);
                    f32x4 p0, p1;
#pragma unroll
                    for (int j = 0; j < 4; ++j) { p0[j] = __shfl_xor(y0[j], 16); p1[j] = __shfl_xor(y1[j], 16); }
                    if (row < NL) { if ((fq & 1) == 0) { y0 = y0 * c0 - p0 * s0; y1 = y1 * c1 - p1 * s1; } else { y0 = y0 * c0 + p0 * s0; y1 = y1 * c1 + p1 * s1; } }
                    const u32x4 wv = pack8(y0, y1);
#pragma unroll
                    for (int hd = 0; hd < 16; ++hd) *(u32x4*)(Kc + (size_t)row * 1536 + hd * 96 + 64 + 8 * fq) = wv;
                    asm volatile("" ::: "memory"); }
        }
    }
};
struct EpiKV {
    bf16 *Kc, *Vc; const float* SSP; const float* kg;
    __device__ __forceinline__ void operator()(const Acc& acc, const Unit& u, int wr, int wc, int fr, int fq, LAS unsigned char*) const {
        const int row0 = u.pm * 256 + wr * 64 + fr, head = 2 * u.pn + (wc >> 1), dbase = 8 * fq;
        const bool isk = (wc & 1) == 0;
        float rr[2][4];
#pragma unroll
        for (int ai = 0; ai < 2; ++ai)
#pragma unroll
            for (int m = 0; m < 4; ++m) { const f32x4 pq = *(const f32x4*)(SSP + (size_t)(row0 + ai * 128 + m * 16) * 16 + 12); rr[ai][m] = (pq[0] + pq[1]) + (pq[2] + pq[3]); }
        f32x4 gv[2][2];
#pragma unroll
        for (int bj = 0; bj < 2; ++bj)
#pragma unroll
            for (int n = 0; n < 2; ++n) gv[bj][n] = isk ? *(const f32x4*)(kg + dbase + 32 * bj + 4 * n) : (f32x4){1.f, 1.f, 1.f, 1.f};
#pragma unroll
        for (int ai = 0; ai < 2; ++ai)
#pragma unroll
            for (int m = 0; m < 4; ++m) {
                const int row = row0 + ai * 128 + m * 16; const float r = rsqrtf(rr[ai][m] * (1.f / 256.f) + EPS);
                float f = r;
                if (isk) {
                    float ss = 0.f;
#pragma unroll
                    for (int bj = 0; bj < 2; ++bj)
#pragma unroll
                        for (int n = 0; n < 2; ++n) { const f32x4 v = acc[ai][bj][m][n]; ss += (v[0] * v[0] + v[1] * v[1]) + (v[2] * v[2] + v[3] * v[3]); }
                    ss += __shfl_xor(ss, 16); ss += __shfl_xor(ss, 32);
                    f = r * rsqrtf(r * r * ss * (1.f / 64.f) + EPS);
                }
                bf16* o = isk ? (Kc + (size_t)row * 1536 + head * 96 + dbase) : (Vc + (size_t)row * 1024 + head * 64 + dbase);
#pragma unroll
                for (int bj = 0; bj < 2; ++bj) *(u32x4*)(o + 32 * bj) = pack8(acc[ai][bj][m][0] * f * gv[bj][0], acc[ai][bj][m][1] * f * gv[bj][1]);
            }
    }
};
struct EpiGU {
    bf16* ACT; const float* bgu;
    __device__ __forceinline__ void operator()(const Acc& acc, const Unit& u, int wr, int wc, int fr, int fq, LAS unsigned char*) const {
        const int row0 = u.gm * 256 + wr * 64 + fr, j0 = 128 * u.nt + 32 * wc + 8 * fq;
        const float* bp = bgu + (size_t)u.e * 2048;
        f32x4 bg[2], bu[2];
#pragma unroll
        for (int n = 0; n < 2; ++n) { bg[n] = *(const f32x4*)(bp + j0 + 4 * n); bu[n] = *(const f32x4*)(bp + 1024 + j0 + 4 * n); }
#pragma unroll
        for (int ai = 0; ai < 2; ++ai)
#pragma unroll
            for (int m = 0; m < 4; ++m) {
                f32x4 z[2];
#pragma unroll
                for (int n = 0; n < 2; ++n) { const f32x4 gt = acc[ai][0][m][n] + bg[n], up = acc[ai][1][m][n] + bu[n];
#pragma unroll
                    for (int r = 0; r < 4; ++r) { const float gg = fminf(gt[r], 7.f), uu = fminf(fmaxf(up[r], -7.f), 7.f); z[n][r] = (uu + 1.f) * (gg * __builtin_amdgcn_rcpf(1.f + __builtin_amdgcn_exp2f(gg * (-1.702f * 1.4426950408889634f)))); } }
                *(u32x4*)(ACT + (size_t)(row0 + ai * 128 + m * 16) * 1024 + j0) = pack8(z[0], z[1]);
            }
    }
};
struct EpiDown {
    bf16* YB; const float* bdn; const float* gate; const LAS int* idx;
    __device__ __forceinline__ void operator()(const Acc& acc, const Unit& u, int wr, int wc, int fr, int fq, LAS unsigned char*) const {
        const int r0 = wr * 64 + fr; const float* bp = bdn + (size_t)u.e * 1024;
        f32x4 bv[2][2]; int c0[2];
#pragma unroll
        for (int bj = 0; bj < 2; ++bj) { c0[bj] = 256 * u.nt + 128 * bj + 32 * wc + 8 * fq; bv[bj][0] = *(const f32x4*)(bp + c0[bj]); bv[bj][1] = *(const f32x4*)(bp + c0[bj] + 4); }
#pragma unroll
        for (int ai = 0; ai < 2; ++ai)
#pragma unroll
            for (int m = 0; m < 4; ++m) {
                const int slot = idx[u.slot * 256 + r0 + ai * 128 + m * 16];
                if (slot >= 0) {
                    const float gw = gate[slot]; bf16* o = YB + (size_t)slot * 1024;
#pragma unroll
                    for (int bj = 0; bj < 2; ++bj) *(u32x4*)(o + c0[bj]) = pack8((acc[ai][bj][m][0] + bv[bj][0]) * gw, (acc[ai][bj][m][1] + bv[bj][1]) * gw);
                }
            }
    }
};

enum { LAY_STD = 0, LAY_HEAD = 1, LAY_INA = 2, LAY_GU = 3, LAY_F32 = 4, LAY_HEAD2 = 5 };
template <int LAY> __device__ __forceinline__ int colmap(int pn, int rho) {
    const int bj = rho >> 7, wc = (rho >> 5) & 3, n = (rho >> 4) & 1, fq = (rho >> 2) & 3, reg = rho & 3;
    const int std_c = 128 * bj + 32 * wc + 8 * fq + 4 * n + reg;
    const int head_c = 64 * wc + 32 * (fq >> 1) + 8 * (fq & 1) + 16 * bj + 4 * n + reg;
    if (LAY == LAY_STD) return 256 * pn + std_c;
    if (LAY == LAY_F32) return 256 * pn + rho;
    if (LAY == LAY_HEAD) return 256 * pn + head_c;
    if (LAY == LAY_HEAD2) return 256 * pn + 64 * wc + 32 * bj + 8 * fq + 4 * n + reg;
    if (LAY == LAY_INA) return pn < 3 ? 256 * pn + head_c : 768 + (bj ? 512 : 0) + 128 * (pn - 3) + 32 * wc + 8 * fq + 4 * n + reg;
    return (bj ? 1024 : 0) + 128 * pn + 32 * wc + 8 * fq + 4 * n + reg;
}
template <int LAY>
__device__ __forceinline__ void cvt_matrix(const float* src, size_t mat_stride, int ld, int nvalid, int K, int tiles_per_mat, int ntiles, bf16* dst, const float* kscale,
                                           LAS float* scr, int it_begin, int it_step, int lane, int it_end = 0x7fffffff) {
    const int kblocks = K / 64; int nitems = ntiles * 8 * kblocks; nitems = nitems < it_end ? nitems : it_end;
    const int gw = it_begin, NGW = it_step;
    const int i = lane & 31, kh = lane >> 5;
    float v[32], vn[32];
#define CVT_LOAD(it_, dstv) do { const int _kb = (it_) % kblocks, _tg = (it_) / kblocks, _grp = _tg & 7, _tile = _tg >> 3; \
        const int _mat = _tile / tiles_per_mat, _pn = _tile - _mat * tiles_per_mat; const int _c = colmap<LAY>(_pn, _grp * 32 + i); const bool _ok = _c < nvalid; \
        const float* _s = src + (size_t)_mat * mat_stride + (size_t)(_kb * 64 + kh) * ld + (_ok ? _c : 0); \
        _Pragma("unroll") for (int ii = 0; ii < 32; ++ii) dstv[ii] = _ok ? _s[(size_t)(2 * ii) * ld] : 0.f; } while (0)
    int it = gw;
    if (it < nitems) CVT_LOAD(it, v);
    for (; it < nitems; it += NGW) {
        const int itn = it + NGW;
        if (itn < nitems) CVT_LOAD(itn, vn);
        const int kb = it % kblocks, tg = it / kblocks, grp = tg & 7, tile = tg >> 3;
        if (kscale) {
#pragma unroll
            for (int ii = 0; ii < 32; ++ii) v[ii] *= kscale[kb * 64 + 2 * ii + kh];
        }
#pragma unroll
        for (int ii = 0; ii < 32; ++ii) scr[(2 * ii + kh) * 33 + i] = v[ii];
        LDS_WAIT(); asm volatile("" ::: "memory");
        const int c8 = lane & 7;
#pragma unroll
        for (int j = 0; j < 4; ++j) { const int n = (lane >> 3) + 8 * j; const LAS float* q = scr + (8 * c8) * 33 + n;
            u32x4 o; o.x = pk2(q[0 * 33], q[1 * 33]); o.y = pk2(q[2 * 33], q[3 * 33]); o.z = pk2(q[4 * 33], q[5 * 33]); o.w = pk2(q[6 * 33], q[7 * 33]);
            *(u32x4*)(dst + ((size_t)tile * 256 + grp * 32 + n) * K + kb * 64 + 8 * c8) = o; }
        LDS_WAIT(); asm volatile("" ::: "memory");
#pragma unroll
        for (int ii = 0; ii < 32; ++ii) v[ii] = vn[ii];
    }
#undef CVT_LOAD
}

struct CvtBg {
    const float* wgu; const float* wdn; bf16* dgu; bf16* ddn; int cl0, vcu, j, jend, step, tick;
    __device__ __forceinline__ void init(const float* wgu_, const float* wdn_, bf16* dgu_, bf16* ddn_, int cl0_, int nlay, int vcu_, int j0, int step_) {
        wgu = wgu_; wdn = wdn_; dgu = dgu_; ddn = ddn_; cl0 = cl0_; vcu = vcu_; j = j0; step = step_; jend = nlay * 192; tick = 0; }
    __device__ __forceinline__ void decode(int jj, bool& isgu, int& cl, int& it) const { cl = cl0 + jj / 192; const int r = jj % 192; isgu = r < 128; it = isgu ? vcu * 128 + r : vcu * 64 + (r - 128); }
    __device__ __forceinline__ int issue_dma(int lane, LAS unsigned char* buf, bf16*& dst_) {
        const int jj = __builtin_amdgcn_readfirstlane(j);
        if (jj >= jend) return -1;
        bool isgu; int cl, it; decode(jj, isgu, cl, it);
        const int kb = it & 15, tg = it >> 4, grp = tg & 7, tile = tg >> 3;
        const int kr = lane >> 3, p = lane & 7;
        const float* s; unsigned ld;
        if (isgu) { const int mat = tile >> 3, pn = tile & 7; s = wgu + ((size_t)(cl * 32 + mat) * 1024 + kb * 64) * 2048 + colmap<LAY_GU>(pn, grp * 32); ld = 2048; dst_ = dgu + ((size_t)(cl * 256 + tile) * 256 + grp * 32) * 1024 + kb * 64; }
        else { const int mat = tile >> 2, pn = tile & 3; s = wdn + ((size_t)(cl * 32 + mat) * 1024 + kb * 64) * 1024 + colmap<LAY_STD>(pn, grp * 32); ld = 1024; dst_ = ddn + ((size_t)(cl * 128 + tile) * 256 + grp * 32) * 1024 + kb * 64; }
        const unsigned rowoff = (unsigned)kr * ld * 4u;
#pragma unroll
        for (int q = 0; q < 8; ++q) { const int cq = p ^ q; const unsigned coff = (unsigned)(8 * (cq & 3) + 4 * (cq >> 2)) * 4u;
            __builtin_amdgcn_global_load_lds((const unsigned*)((const char*)s + (size_t)(8 * q) * ld * 4 + rowoff + coff), (LAS unsigned*)(buf + q * 1024), 16, 0, 2); }
        j = jj + step; return jj;
    }
    __device__ __forceinline__ void out_pair(const LAS unsigned char* buf, size_t d  , int n, int o) const {
        const LAS unsigned char* b = buf + (8 * o) * 128 + (((n >> 2) ^ o) << 4) + (n & 3) * 4;
        f32x2 v[8];
#pragma unroll
        for (int q = 0; q < 8; ++q) v[q] = *(const LAS f32x2*)(b + q * 128);
        u32x4 w0, w1;
        w0.x = pk2(v[0][0], v[1][0]); w0.y = pk2(v[2][0], v[3][0]); w0.z = pk2(v[4][0], v[5][0]); w0.w = pk2(v[6][0], v[7][0]);
        w1.x = pk2(v[0][1], v[1][1]); w1.y = pk2(v[2][1], v[3][1]); w1.z = pk2(v[4][1], v[5][1]); w1.w = pk2(v[6][1], v[7][1]);
        typedef __attribute__((address_space(1))) u32x4 g_u32x4;
        g_u32x4* o_ = (g_u32x4*)(d + ((size_t)n * 1024 + 8 * o) * 2);
        __builtin_nontemporal_store(w0, o_); __builtin_nontemporal_store(w1, o_ + 128); }
    __device__ __forceinline__ void process_slot(int tid, const LAS unsigned char* lds, int sl) const {
        const int c = tid >> 7; const i32x4 h = *(const LAS i32x4*)(lds + CV_HDR + (2 * c + sl) * 16);
        if (h[0] >= 0) { const size_t d = ((size_t)(unsigned)h[2] << 32) | (size_t)(unsigned)h[1]; out_pair(lds + CV_BUF + (2 * c + sl) * 8192, d, 2 * ((tid >> 3) & 15), tid & 7); }
    }
    __device__ __forceinline__ void tail_loop(int lane, LAS unsigned char* buf) {
        bf16* da; bf16* db;
        int a = issue_dma(lane, buf, da), sl = 0;
        while (a >= 0) {
            const int b = issue_dma(lane, buf + (sl ^ 1) * 8192, db);
            if (b >= 0) asm volatile("s_waitcnt vmcnt(8)" ::: "memory"); else asm volatile("s_waitcnt vmcnt(0)" ::: "memory");
#pragma unroll
            for (int x = 0; x < 2; ++x) { const int id = lane + 64 * x; out_pair(buf + sl * 8192, (size_t)da, 2 * (id >> 3), id & 7); }
            asm volatile("s_waitcnt lgkmcnt(0)" ::: "memory");
            a = b; da = db; sl ^= 1;
        }
    }
};
struct NoBg { __device__ __forceinline__ void issue(int) {} __device__ __forceinline__ void finish(int) {} };

__device__ __forceinline__ void normmod_store(const f32x4 (&v)[4], float rstd, const float* g, const float* mvec  , int sh_off, int sc_off, bf16* orow, int lane) {
#pragma unroll
    for (int j = 0; j < 4; ++j) { const int c = 4 * lane + 256 * j;
        const f32x4 gg = *(const f32x4*)(g + c), sc = *(const f32x4*)(mvec + sc_off + c), sh = *(const f32x4*)(mvec + sh_off + c);
        const f32x4 y = v[j] * rstd * gg * (sc + 1.f) + sh;
        u32x2 w; w.x = pk2(y[0], y[1]); w.y = pk2(y[2], y[3]); *(u32x2*)(orow + c) = w; }
}

template <int DQK> struct AT {
    static constexpr int CK = DQK / 8, KT = 64 * DQK * 2, VT = 64 * 128, STG = KT + VT, NKS = DQK / 16, NKI = CK / 4;
};
#define MFMA32(a, b, c) __builtin_amdgcn_mfma_f32_32x32x16_bf16((a), (b), (c), 0, 0, 0)
struct TileList { int nloc, row_loc0, kpos_loc0, row_ctx0, ntiles; };
template <int DQK>
__device__ __forceinline__ void attn_k0(LAS unsigned char* lds, const TileList& tl, const char* Kg, int kpitchB) {
    typedef AT<DQK> A;
    const int tid = otid(), lane = tid & 63; const int wv = __builtin_amdgcn_readfirstlane(tid >> 6);
    if (wv < 4) {
        const char* kp = Kg + (size_t)((tl.nloc > 0 ? tl.row_loc0 : tl.row_ctx0) + 16 * wv) * kpitchB; LAS unsigned char* b = lds + (A::NKI * wv) * 1024;
#pragma unroll
        for (int t = 0; t < A::NKI; ++t) { const int sl_ = 64 * t + lane; int rr, ch;
            if (DQK == 96) { rr = sl_ / 12; const int p = sl_ % 12, rot = (rr >> 2) & 3; ch = p - rot; ch = ch < 0 ? ch + 12 : ch; }
            else { rr = sl_ >> 3; ch = (sl_ & 7) ^ ((rr >> 1) & 7); }
            __builtin_amdgcn_global_load_lds((const unsigned*)(kp + (unsigned)(rr * kpitchB + ch * 16)), (LAS unsigned*)(b + t * 1024), 16, 0, 0); }
    }
}
__device__ __forceinline__ float at_max3(float a, float b, float c) { float r; asm("v_max3_f32 %0, %1, %2, %3" : "=v"(r) : "v"(a), "v"(b), "v"(c)); return r; }
template <int DQK, bool MASK, class Bg, int CAD, int XP = 0>
__device__ __forceinline__ void attn_core(LAS unsigned char* lds, const bf16x8 (&qf)[DQK / 16], const TileList tl, const char* Kg, int kpitchB, const char* Vg, int vpitchB,
                                          int qpos, float& m, float& l, f32x16 (&O)[2], Bg& bg) {
    typedef AT<DQK> A;
    const int tid = otid(), lane = tid & 63, h = lane >> 5;
    const int wv = __builtin_amdgcn_readfirstlane(tid >> 6);
    const bool stager = wv < 4;
    unsigned koff[A::NKI], voff;
#pragma unroll
    for (int t = 0; t < A::NKI; ++t) { const int sl_ = 64 * t + lane; int rr, ch;
        if (DQK == 96) { rr = sl_ / 12; const int p = sl_ % 12, rot = (rr >> 2) & 3; ch = p - rot; ch = ch < 0 ? ch + 12 : ch; }
        else { rr = sl_ >> 3; ch = (sl_ & 7) ^ ((rr >> 1) & 7); }
        koff[t] = (unsigned)(rr * kpitchB + ch * 16); }
    voff = (unsigned)((lane >> 3) * vpitchB + (((lane & 7) ^ (4 * ((lane >> 4) & 1))) * 16));
    unsigned kf0, kf4 = 0, kf5 = 0;
    if (DQK == 96) { const int x = 16 * (h + ((lane >> 2) & 3)); kf0 = (unsigned)((lane & 31) * 192 + x); kf4 = kf0 + (x >= 64 ? 128 - 192 : 128); kf5 = kf0 + (x >= 32 ? 160 - 192 : 160); }
    else { const int sw = (lane >> 1) & 7; kf0 = (unsigned)((lane & 31) * 128 + 16 * (h ^ (sw & 1)) + 32 * (sw >> 1)); }
#define AT_KADDR(ks) (DQK == 96 ? ((ks) == 4 ? kf4 : (ks) == 5 ? kf5 : kf0 + 32u * (ks)) : (kf0 ^ (32u * (ks))))
    const unsigned vrow = (unsigned)((((lane & 15) >> 2) + 4 * h) * 128 + 32 * ((lane >> 4) & 1) + 8 * (lane & 3));
    const unsigned vfA = vrow + 64u * ((lane >> 3) & 1), vfB = vrow + 64u * (1 - ((lane >> 3) & 1));
    LAS int* cvh = (LAS int*)(lds + CV_HDR);
    const int cw = wv & 3;
#define AT_ROW0(i) ((i) < tl.nloc ? tl.row_loc0 + 64 * (i) : tl.row_ctx0 + 64 * ((i) - tl.nloc))
#define AT_DMA_K(i) do { const char* _kp = Kg + (size_t)(AT_ROW0(i) + 16 * wv) * kpitchB; LAS unsigned char* _b = lds + ((i) & 1) * A::KT + (A::NKI * wv) * 1024; \
        _Pragma("unroll") for (int t = 0; t < A::NKI; ++t) __builtin_amdgcn_global_load_lds((const unsigned*)(_kp + koff[t]), (LAS unsigned*)(_b + t * 1024), 16, 0, 0); } while (0)
#define AT_DMA_V(i) do { const char* _vp = Vg + (size_t)(AT_ROW0(i) + 16 * wv) * vpitchB; LAS unsigned char* _b = lds + 2 * A::KT + ((i) & 1) * A::VT + (2 * wv) * 1024; \
        _Pragma("unroll") for (int t = 0; t < 2; ++t) __builtin_amdgcn_global_load_lds((const unsigned*)(_vp + (size_t)(8 * t) * vpitchB + voff), (LAS unsigned*)(_b + t * 1024), 16, 0, 0); } while (0)
#define AT_BAR() do { asm volatile("s_waitcnt lgkmcnt(0)" ::: "memory"); if (!(XP & 1)) __builtin_amdgcn_s_barrier(); asm volatile("" ::: "memory"); } while (0)
#define AT_SB() __builtin_amdgcn_sched_barrier(0)
#define AT_TR(dst, ad, off) asm volatile("ds_read_b64_tr_b16 %0, %1 offset:" #off : "=v"(dst) : "v"(ad))
#define AT_VWAIT() asm volatile("s_waitcnt lgkmcnt(0)" : "+v"(vlo[0][0]), "+v"(vlo[0][1]), "+v"(vlo[1][0]), "+v"(vlo[1][1]), "+v"(vhi[0][0]), "+v"(vhi[0][1]), "+v"(vhi[1][0]), "+v"(vhi[1][1]))
#define AT_QK(C0, C1, j) do { if (XP & 16) { C0 = zero16; C1 = zero16; C0[0] = (float)(j); break; } const LAS unsigned char* kt = lds + ((j) & 1) * A::KT; bf16x8 ka[A::NKS][2]; \
        _Pragma("unroll") for (int ks = 0; ks < A::NKS; ++ks) { ka[ks][0] = *(const LAS bf16x8*)(kt + AT_KADDR(ks)); ka[ks][1] = *(const LAS bf16x8*)(kt + AT_KADDR(ks) + 32 * DQK * 2); } \
        C0 = MFMA32(ka[0][0], qf[0], zero16); C1 = MFMA32(ka[0][1], qf[0], zero16); \
        _Pragma("unroll") for (int ks = 1; ks < A::NKS; ++ks) { C0 = MFMA32(ka[ks][0], qf[ks], C0); C1 = MFMA32(ka[ks][1], qf[ks], C1); } } while (0)
#define AT_FSM(P0, P1) do { \
        if (!(XP & 4)) { _Pragma("unroll") for (int r = 0; r < 16; ++r) { P0[r] = __builtin_amdgcn_exp2f(P0[r]); P1[r] = __builtin_amdgcn_exp2f(P1[r]); } } \
        _Pragma("unroll") for (int sp = 0; sp < 2; ++sp) { u32x4 pw; \
            pw.x = pk2(P0[8 * sp + 0], P0[8 * sp + 1]); pw.y = pk2(P0[8 * sp + 2], P0[8 * sp + 3]); pw.z = pk2(P0[8 * sp + 4], P0[8 * sp + 5]); pw.w = pk2(P0[8 * sp + 6], P0[8 * sp + 7]); pp[0][sp] = __builtin_bit_cast(bf16x8, pw); \
            pw.x = pk2(P1[8 * sp + 0], P1[8 * sp + 1]); pw.y = pk2(P1[8 * sp + 2], P1[8 * sp + 3]); pw.z = pk2(P1[8 * sp + 4], P1[8 * sp + 5]); pw.w = pk2(P1[8 * sp + 6], P1[8 * sp + 7]); pp[1][sp] = __builtin_bit_cast(bf16x8, pw); } } while (0)
#define AT_RMAX(C0, C1, j) do { if (XP & 32) { tm = C0[0] - m; break; } \
        if (MASK) { const int k0_ = tl.kpos_loc0 + 64 * (j); if ((j) < tl.nloc && (k0_ + 63 - qw > 128 || qw + 31 - k0_ > 128)) { const int kb = k0_ + 4 * h - qpos;     \
            _Pragma("unroll") for (int r = 0; r < 16; ++r) { const int d0 = kb + (r & 3) + 8 * (r >> 2), d1 = d0 + 32; \
                if (d0 > 128 || d0 < -128) C0[r] = -1e30f; if (d1 > 128 || d1 < -128) C1[r] = -1e30f; } } } \
        tm = at_max3(C0[0], C0[1], C1[0]); tm = at_max3(tm, C1[1], C0[2]); \
        _Pragma("unroll") for (int r = 2; r < 16; r += 2) { if (r > 2) tm = at_max3(tm, C0[r - 1], C0[r]); tm = at_max3(tm, C1[r], C1[r + 1]); } \
        tm = fmaxf(tm, C0[15]); \
        { const auto sw_ = __builtin_amdgcn_permlane32_swap(__builtin_bit_cast(unsigned, tm), __builtin_bit_cast(unsigned, tm), false, false); \
          tm = fmaxf(__builtin_bit_cast(float, sw_[0]), __builtin_bit_cast(float, sw_[1])) - m; } } while (0)
#define AT_RESC(C0, C1) do { \
        if (__builtin_amdgcn_ballot_w64(tm > 8.f) != 0ull) { const float dlt = fmaxf(tm, 0.f), alpha = __builtin_amdgcn_exp2f(-dlt); m += dlt; l *= alpha; \
            _Pragma("unroll") for (int r = 0; r < 16; ++r) { O[0][r] *= alpha; O[1][r] *= alpha; Lacc[r] *= alpha; } } \
        if (__builtin_amdgcn_ballot_w64(m != 0.f) != 0ull) { _Pragma("unroll") for (int r = 0; r < 16; ++r) { C0[r] -= m; C1[r] -= m; } } } while (0)
#define AT_PV(t, MID) do { if (XP & 8) { MID; break; } const unsigned _vb = (unsigned)(size_t)lds + 2 * A::KT + ((t) & 1) * A::VT; const unsigned vta = _vb + vfA, vtb = _vb + vfB; s16x4 vlo[2][2], vhi[2][2]; \
        AT_TR(vlo[0][0], vta, 0); AT_TR(vhi[0][0], vta, 1024); AT_TR(vlo[0][1], vtb, 0); AT_TR(vhi[0][1], vtb, 1024); \
        AT_TR(vlo[1][0], vta, 2048); AT_TR(vhi[1][0], vta, 3072); AT_TR(vlo[1][1], vtb, 2048); AT_TR(vhi[1][1], vtb, 3072); \
        MID; \
        Lacc = MFMA32(ones8, pp[0][0], Lacc); Lacc = MFMA32(ones8, pp[0][1], Lacc); Lacc = MFMA32(ones8, pp[1][0], Lacc); Lacc = MFMA32(ones8, pp[1][1], Lacc); \
        asm volatile("" : "+v"(tm), "+v"(Lacc));              \
        AT_VWAIT(); \
        _Pragma("unroll") for (int sp = 0; sp < 2; ++sp) _Pragma("unroll") for (int dvb = 0; dvb < 2; ++dvb) { \
            const bf16x8 va = __builtin_shufflevector(vlo[sp][dvb], vhi[sp][dvb], 0, 1, 2, 3, 4, 5, 6, 7); O[dvb] = MFMA32(va, pp[0][sp], O[dvb]); } \
        AT_TR(vlo[0][0], vta, 4096); AT_TR(vhi[0][0], vta, 5120); AT_TR(vlo[0][1], vtb, 4096); AT_TR(vhi[0][1], vtb, 5120); \
        AT_TR(vlo[1][0], vta, 6144); AT_TR(vhi[1][0], vta, 7168); AT_TR(vlo[1][1], vtb, 6144); AT_TR(vhi[1][1], vtb, 7168); \
        AT_VWAIT(); \
        _Pragma("unroll") for (int sp = 0; sp < 2; ++sp) _Pragma("unroll") for (int dvb = 0; dvb < 2; ++dvb) { \
            const bf16x8 va = __builtin_shufflevector(vlo[sp][dvb], vhi[sp][dvb], 0, 1, 2, 3, 4, 5, 6, 7); O[dvb] = MFMA32(va, pp[1][sp], O[dvb]); } } while (0)
#define AT_HEAD(j) do { if (stager && !(XP & 2)) { if ((j) + 1 < n) AT_DMA_K((j) + 1); AT_DMA_V(j); } \
        issued = false; \
        if ((bg.tick & 1) == 0) { if (!stager) { const int sl_ = (bg.tick >> 1) & 1; bf16* dd_ = nullptr; const int jj = bg.issue_dma(lane, lds + CV_BUF + (2 * cw + sl_) * 8192, dd_); \
                if (lane == 0) *(LAS i32x4*)(lds + CV_HDR + (2 * cw + sl_) * 16) = (i32x4){jj, (int)(unsigned)(size_t)dd_, (int)(unsigned)((size_t)dd_ >> 32), 0}; issued = jj >= 0; } } \
        else bg.process_slot(tid, lds, ((bg.tick + 1) >> 1) & 1); } while (0)
#define AT_TAILSYNC() do { if (stager) asm volatile("s_waitcnt vmcnt(0)" ::: "memory"); \
        else if ((bg.tick & 1) == 0) { if (issued) asm volatile("s_waitcnt vmcnt(8)" ::: "memory"); else asm volatile("s_waitcnt vmcnt(0)" ::: "memory"); } \
        ++bg.tick; AT_BAR(); } while (0)
#define AT_QKF(C0, C1, P0, P1, j) do { const LAS unsigned char* kt = lds + ((j) & 1) * A::KT; bf16x8 ka[A::NKS][2]; \
        _Pragma("unroll") for (int ks = 0; ks < A::NKS; ++ks) { ka[ks][0] = *(const LAS bf16x8*)(kt + AT_KADDR(ks)); ka[ks][1] = *(const LAS bf16x8*)(kt + AT_KADDR(ks) + 32 * DQK * 2); } \
        _Pragma("unroll") for (int r = 0; r < 16; ++r) P0[r] = __builtin_amdgcn_exp2f(P0[r]); \
        asm volatile("" : "+v"(ka[0][0]), "+v"(ka[0][1]), "+v"(P0)); \
        C0 = MFMA32(ka[0][0], qf[0], zero16); C1 = MFMA32(ka[0][1], qf[0], zero16); \
        _Pragma("unroll") for (int ks = 1; ks < A::NKS; ++ks) { C0 = MFMA32(ka[ks][0], qf[ks], C0); C1 = MFMA32(ka[ks][1], qf[ks], C1); } \
        _Pragma("unroll") for (int r = 0; r < 16; ++r) P1[r] = __builtin_amdgcn_exp2f(P1[r]); \
        _Pragma("unroll") for (int sp = 0; sp < 2; ++sp) { u32x4 pw; \
            pw.x = pk2(P0[8 * sp + 0], P0[8 * sp + 1]); pw.y = pk2(P0[8 * sp + 2], P0[8 * sp + 3]); pw.z = pk2(P0[8 * sp + 4], P0[8 * sp + 5]); pw.w = pk2(P0[8 * sp + 6], P0[8 * sp + 7]); pp[0][sp] = __builtin_bit_cast(bf16x8, pw); \
            pw.x = pk2(P1[8 * sp + 0], P1[8 * sp + 1]); pw.y = pk2(P1[8 * sp + 2], P1[8 * sp + 3]); pw.z = pk2(P1[8 * sp + 4], P1[8 * sp + 5]); pw.w = pk2(P1[8 * sp + 6], P1[8 * sp + 7]); pp[1][sp] = __builtin_bit_cast(bf16x8, pw); } } while (0)
#define AT_STEP(C0, C1, P0, P1, j) do { AT_HEAD(j); AT_SB(); \
        if (!(XP & 64)) { AT_QK(C0, C1, j); AT_FSM(P0, P1); } else AT_QKF(C0, C1, P0, P1, j); \
        if (MASK) asm volatile("" : "+v"(pp[0][0]), "+v"(pp[0][1]), "+v"(pp[1][0]), "+v"(pp[1][1]));     \
        AT_SB(); \
        AT_PV((j) - 1, AT_RMAX(C0, C1, j)); AT_SB(); \
        AT_RESC(C0, C1); \
        AT_TAILSYNC(); } while (0)
    f32x16 zero16;
#pragma unroll
    for (int r = 0; r < 16; ++r) zero16[r] = 0.f;
    const int n = tl.ntiles;
    const int qw = __builtin_amdgcn_readfirstlane(qpos);
    bool issued; float tm;
    bf16x8 pp[2][2];
    f32x16 A0, A1, B0, B1, Lacc = zero16;
    const bf16x8 ones8 = (bf16x8){0x3F80, 0x3F80, 0x3F80, 0x3F80, 0x3F80, 0x3F80, 0x3F80, 0x3F80};
    if (wv >= 4) __builtin_amdgcn_s_setprio(1);
    asm volatile("s_waitcnt vmcnt(0)" ::: "memory");
    AT_BAR();
    AT_HEAD(0); AT_SB();
    AT_QK(A0, A1, 0); AT_RMAX(A0, A1, 0); AT_RESC(A0, A1);
    AT_TAILSYNC();
    int j = 1;
    for (; j + 1 < n; j += 2) { AT_STEP(B0, B1, A0, A1, j); AT_STEP(A0, A1, B0, B1, j + 1); }
    if (j < n) { AT_STEP(B0, B1, A0, A1, j); AT_FSM(B0, B1); } else { AT_FSM(A0, A1); }
    AT_SB();
    AT_PV(n - 1, (void)0);
    __builtin_amdgcn_s_setprio(0);
    l += 0.5f * Lacc[0];
#undef AT_ROW0
#undef AT_DMA_K
#undef AT_DMA_V
#undef AT_KADDR
#undef AT_BAR
#undef AT_SB
#undef AT_TR
#undef AT_VWAIT
#undef AT_QK
#undef AT_QKF
#undef AT_FSM
#undef AT_RMAX
#undef AT_RESC
#undef AT_PV
#undef AT_HEAD
#undef AT_TAILSYNC
#undef AT_STEP
}
__device__ __forceinline__ void attn_store(const f32x16 (&O)[2], float l, bf16* orow, int h) {
    float lt; { const auto sw_ = __builtin_amdgcn_permlane32_swap(__builtin_bit_cast(unsigned, l), __builtin_bit_cast(unsigned, l), false, false);
                lt = __builtin_bit_cast(float, sw_[0]) + __builtin_bit_cast(float, sw_[1]); }
    const float inv = 1.f / lt;
#pragma unroll
    for (int dvb = 0; dvb < 2; ++dvb)
#pragma unroll
        for (int gp = 0; gp < 2; ++gp) {
            unsigned ax = pk2(O[dvb][8 * gp] * inv, O[dvb][8 * gp + 1] * inv), ay = pk2(O[dvb][8 * gp + 2] * inv, O[dvb][8 * gp + 3] * inv);
            unsigned bx = pk2(O[dvb][8 * gp + 4] * inv, O[dvb][8 * gp + 5] * inv), by = pk2(O[dvb][8 * gp + 6] * inv, O[dvb][8 * gp + 7] * inv);
            const auto rx = __builtin_amdgcn_permlane32_swap(ax, bx, false, false); const auto ry = __builtin_amdgcn_permlane32_swap(ay, by, false, false);
            u32x4 w; w.x = rx[0]; w.y = ry[0]; w.z = rx[1]; w.w = ry[1];
            *(u32x4*)(orow + 32 * dvb + 16 * gp + 8 * h) = w; }
}

__device__ __forceinline__ void wattn_unit(LAS unsigned char* lds, int unit, const bf16* Qa, const bf16* Ka, const bf16* Va, const float* sink, bf16* MIX, CvtBg& bg) {
    const int tid = otid(), w = tid >> 6, lane = tid & 63, h = lane >> 5;
    int b, kvh, hp, tq, qpos; TileList tl;
    if (unit < 512) { b = unit >> 7; kvh = (unit >> 6) & 1; const int nb = (unit >> 1) & 31; hp = unit & 1;
        const int t0 = max(0, 128 * nb - 128), t1 = min(4096, 128 * nb + 256);
        tl.nloc = (t1 - t0) >> 6; tl.row_loc0 = b * S + t0; tl.kpos_loc0 = t0; tl.row_ctx0 = NL + b * CL; tl.ntiles = tl.nloc + 4;
        qpos = 128 * nb + (w & 3) * 32 + (lane & 31); tq = b * S + qpos;
    } else { const int u = unit - 512; b = u >> 3; kvh = (u >> 2) & 1; hp = (u >> 1) & 1; const int half = u & 1;
        tl.nloc = 0; tl.row_loc0 = 0; tl.kpos_loc0 = 0; tl.row_ctx0 = NL + b * CL; tl.ntiles = 4;
        qpos = 0; tq = NL + b * CL + half * 128 + (w & 3) * 32 + (lane & 31); }
    const int hq = kvh * 4 + hp * 2 + (w >> 2);
    attn_k0<64>(lds, tl, (const char*)(Ka + kvh * 64), 256);
    bf16x8 qf[4];
#pragma unroll
    for (int ks = 0; ks < 4; ++ks) qf[ks] = *(const bf16x8*)(Qa + (size_t)tq * 512 + hq * 64 + 16 * ks + 8 * h);
    float m = 0.f, l = (h == 0) ? __expf(sink[hq]) : 0.f;
    f32x16 O[2];
#pragma unroll
    for (int r = 0; r < 16; ++r) { O[0][r] = 0.f; O[1][r] = 0.f; }
    attn_core<64, true, CvtBg, 2>(lds, qf, tl, (const char*)(Ka + kvh * 64), 256, (const char*)(Va + kvh * 64), 256, qpos, m, l, O, bg);
    attn_store(O, l, MIX + (size_t)tq * 1024 + hq * 64, h);
}
template <int XP = 0>
__device__ __forceinline__ void mla_unit(LAS unsigned char* lds, int unit, const bf16* Qc, const bf16* Kc, const bf16* Vc, const float* RS, const float* qg,
                                         const float* cosC, const float* sinC, bf16* MIX, CvtBg& bg) {
    const int tid = otid(), w = tid >> 6, lane = tid & 63, h = lane >> 5;
    int b, head, tq; TileList tl; bool lat;
    if (unit < 1024) { b = unit >> 8; head = (unit >> 4) & 15; const int qb = unit & 15; lat = true;
        tl.nloc = 64; tl.row_loc0 = b * S; tl.kpos_loc0 = 0; tl.row_ctx0 = NL + b * CL; tl.ntiles = 68; tq = b * S + qb * 256 + w * 32 + (lane & 31);
    } else { const int u = unit - 1024; b = u >> 4; head = u & 15; lat = false;
        tl.nloc = 0; tl.row_loc0 = 0; tl.kpos_loc0 = 0; tl.row_ctx0 = NL + b * CL; tl.ntiles = 4; tq = NL + b * CL + w * 32 + (lane & 31); }
    attn_k0<96>(lds, tl, (const char*)(Kc + head * 96), 3072);
    float v[6][8]; float ss = 0.f;
    const bf16* qp = Qc + (size_t)tq * 1536 + head * 96 + 8 * h;
#pragma unroll
    for (int ks = 0; ks < 6; ++ks) { const u32x4 raw = *(const u32x4*)(qp + 16 * ks);
        v[ks][0] = bflo(raw.x); v[ks][1] = bfhi(raw.x); v[ks][2] = bflo(raw.y); v[ks][3] = bfhi(raw.y); v[ks][4] = bflo(raw.z); v[ks][5] = bfhi(raw.z); v[ks][6] = bflo(raw.w); v[ks][7] = bfhi(raw.w);
#pragma unroll
        for (int j = 0; j < 8; ++j) ss += v[ks][j] * v[ks][j]; }
    ss += __shfl_xor(ss, 32);
    float r; { const f32x4 p0 = *(const f32x4*)(RS + (size_t)tq * 16), p1 = *(const f32x4*)(RS + (size_t)tq * 16 + 4), p2 = *(const f32x4*)(RS + (size_t)tq * 16 + 8);
      r = rsqrtf((((p0[0] + p0[1]) + (p0[2] + p0[3])) + ((p1[0] + p1[1]) + (p1[2] + p1[3])) + ((p2[0] + p2[1]) + (p2[2] + p2[3]))) * (1.f / 768.f) + EPS); }
    const float inv = r * rsqrtf(r * r * ss * (1.f / 96.f) + EPS);
#pragma unroll
    for (int ks = 0; ks < 6; ++ks) { const f32x4 g0 = *(const f32x4*)(qg + 16 * ks + 8 * h), g1 = *(const f32x4*)(qg + 16 * ks + 8 * h + 4);
#pragma unroll
        for (int j = 0; j < 4; ++j) { v[ks][j] *= inv * g0[j]; v[ks][4 + j] *= inv * g1[j]; } }
    {
        const int t = tq & 4095;
#pragma unroll
        for (int ax = 0; ax < 2; ++ax) {
            const f32x4 c0 = *(const f32x4*)(cosC + t * 16 + 8 * ax), c1 = *(const f32x4*)(cosC + t * 16 + 8 * ax + 4);
            const f32x4 s0 = *(const f32x4*)(sinC + t * 16 + 8 * ax), s1 = *(const f32x4*)(sinC + t * 16 + 8 * ax + 4);
#pragma unroll
            for (int j = 0; j < 8; ++j) { const float y = v[4 + ax][j], po = __shfl_xor(y, 32); const float c = j < 4 ? c0[j & 3] : c1[j & 3], s = j < 4 ? s0[j & 3] : s1[j & 3];
                const float yr = (h == 0) ? (y * c - po * s) : (y * c + po * s); v[4 + ax][j] = lat ? yr : y; }
        }
    }
    bf16x8 qf[6];
#pragma unroll
    for (int ks = 0; ks < 6; ++ks) { u32x4 pw; pw.x = pk2(v[ks][0] * QSCALE_C, v[ks][1] * QSCALE_C); pw.y = pk2(v[ks][2] * QSCALE_C, v[ks][3] * QSCALE_C);
        pw.z = pk2(v[ks][4] * QSCALE_C, v[ks][5] * QSCALE_C); pw.w = pk2(v[ks][6] * QSCALE_C, v[ks][7] * QSCALE_C); qf[ks] = __builtin_bit_cast(bf16x8, pw); }
    float m = 0.f, l = 0.f;
    f32x16 O[2];
#pragma unroll
    for (int rr = 0; rr < 16; ++rr) { O[0][rr] = 0.f; O[1][rr] = 0.f; }
    attn_core<96, false, CvtBg, 4, XP>(lds, qf, tl, (const char*)(Kc + head * 96), 3072, (const char*)(Vc + head * 64), 2048, 0, m, l, O, bg);
    attn_store(O, l, MIX + (size_t)tq * 1024 + head * 64, h);
}

template <int NTOK>
__device__ __forceinline__ void conv_strip(LAS unsigned char* lds, int seq0, int len, int t0, const bf16* Z, const float* dw_w, const float* dw_b, const float* ln_g, const float* ln_b, bf16* MIX) {
    const int tid = otid(), w = tid >> 6, lane = tid & 63;
    constexpr int NROW = NTOK + 30, NCH = NROW * 64, NLD = (NCH + NTHR - 1) / NTHR, NSUB = (NTOK + 15) / 16;
    LAS bf16* zt = (LAS bf16*)lds; LAS float* ot = (LAS float*)(lds + 98304);
    u32x4 st[NLD];
#pragma unroll
    for (int i = 0; i < NLD; ++i) { const int q = tid + i * NTHR, r = q >> 6, cc = q & 63, tt = t0 - 15 + r; st[i] = (u32x4){0u, 0u, 0u, 0u};
        if (q < NCH && tt >= 0 && tt < len) st[i] = *(const u32x4*)(Z + (size_t)(seq0 + tt) * 512 + cc * 8); }
    float wt[31];
#pragma unroll
    for (int j = 0; j < 31; ++j) wt[j] = dw_w[j * 512 + tid];
    const float bias = dw_b[tid];
#pragma unroll
    for (int i = 0; i < NLD; ++i) { const int q = tid + i * NTHR; if (q < NCH) *(LAS u32x4*)(zt + (q >> 6) * 512 + (q & 63) * 8) = st[i]; }
    const f32x4 g0 = *(const f32x4*)(ln_g + 8 * lane), g1 = *(const f32x4*)(ln_g + 8 * lane + 4), b0 = *(const f32x4*)(ln_b + 8 * lane), b1 = *(const f32x4*)(ln_b + 8 * lane + 4);
    __syncthreads();
#pragma unroll 1
    for (int sb = 0; sb < NSUB; ++sb) {
        float acc[16];
#pragma unroll
        for (int t = 0; t < 16; ++t) acc[t] = bias;
        const LAS bf16* zp = zt + sb * 16 * 512 + tid;
        constexpr int NR = (NTOK >= 16 ? 16 : NTOK) + 30;
#pragma unroll
        for (int r = 0; r < NR; ++r) { const float zv = bf1(zp[r * 512]);
#pragma unroll
            for (int t = 0; t < 16; ++t) { const int j = r - t; if (j >= 0 && j < 31 && t < NTOK) acc[t] += zv * wt[j]; } }
#pragma unroll
        for (int t = 0; t < 16; ++t) ot[t * 512 + tid] = acc[t];
        __syncthreads();
#pragma unroll
        for (int q = 0; q < 2; ++q) { const int t = 2 * w + q, tok = sb * 16 + t;
            if (tok < NTOK) {
                const f32x4 x0 = *(const LAS f32x4*)(ot + t * 512 + 8 * lane), x1 = *(const LAS f32x4*)(ot + t * 512 + 8 * lane + 4);
                const float mu = wave_sum((x0[0] + x0[1]) + (x0[2] + x0[3]) + (x1[0] + x1[1]) + (x1[2] + x1[3])) * (1.f / 512.f);
                const f32x4 d0 = x0 - mu, d1 = x1 - mu;
                const float var = wave_sum((d0[0] * d0[0] + d0[1] * d0[1]) + (d0[2] * d0[2] + d0[3] * d0[3]) + (d1[0] * d1[0] + d1[1] * d1[1]) + (d1[2] * d1[2] + d1[3] * d1[3])) * (1.f / 512.f);
                const float rstd = rsqrtf(var + EPS);
                f32x4 y0 = d0 * rstd * g0 + b0, y1 = d1 * rstd * g1 + b1;
#pragma unroll
                for (int j = 0; j < 4; ++j) { y0[j] = fsilu(y0[j]); y1[j] = fsilu(y1[j]); }
                *(u32x4*)(MIX + (size_t)(seq0 + t0 + tok) * 1024 + 512 + 8 * lane) = pack8(y0, y1); } }
        __syncthreads();
    }
}

__device__ __forceinline__ void mla_stats_row(int row, int lane, const bf16* P, const float* krg, const float* cosC, const float* sinC, float* RS, bf16* Kc) {
    const bf16* p = P + (size_t)row * PP;
    const u32x4 a = *(const u32x4*)(p + 8 * lane);
    const u32x4 b = *(const u32x4*)(p + 8 * (lane + 64));
    u32x4 c = (u32x4){0u, 0u, 0u, 0u};
    if (lane < 4) c = *(const u32x4*)(p + 8 * (lane + 128));
    auto sq = [](u32x4 u) { float s = 0.f; s += bflo(u.x) * bflo(u.x) + bfhi(u.x) * bfhi(u.x); s += bflo(u.y) * bflo(u.y) + bfhi(u.y) * bfhi(u.y);
                            s += bflo(u.z) * bflo(u.z) + bfhi(u.z) * bfhi(u.z); s += bflo(u.w) * bflo(u.w) + bfhi(u.w) * bfhi(u.w); return s; };
    const float sa = sq(a), sb = sq(b), sc = sq(c);
    const float ssq = wave_sum(sa + (lane < 32 ? sb : 0.f)), skv = wave_sum(lane >= 32 ? sb : 0.f), skr = wave_sum(sc);
    if (lane == 0) { RS[(size_t)row * 2] = rsqrtf(ssq * (1.f / 768.f) + EPS); RS[(size_t)row * 2 + 1] = rsqrtf(skv * (1.f / 256.f) + EPS); }
    const float rk = rsqrtf(skr * (1.f / 32.f) + EPS);
    float y[8]; const int l4 = lane & 3;
    { const f32x4 g0 = *(const f32x4*)(krg + 8 * l4), g1 = *(const f32x4*)(krg + 8 * l4 + 4);
      y[0] = bflo(c.x) * rk * g0[0]; y[1] = bfhi(c.x) * rk * g0[1]; y[2] = bflo(c.y) * rk * g0[2]; y[3] = bfhi(c.y) * rk * g0[3];
      y[4] = bflo(c.z) * rk * g1[0]; y[5] = bfhi(c.z) * rk * g1[1]; y[6] = bflo(c.w) * rk * g1[2]; y[7] = bfhi(c.w) * rk * g1[3]; }
    const int t = row & 4095, ax = l4 >> 1, half = l4 & 1;
    const f32x4 c0 = *(const f32x4*)(cosC + t * 16 + 8 * ax), c1 = *(const f32x4*)(cosC + t * 16 + 8 * ax + 4), s0 = *(const f32x4*)(sinC + t * 16 + 8 * ax), s1 = *(const f32x4*)(sinC + t * 16 + 8 * ax + 4);
    float o[8];
#pragma unroll
    for (int j = 0; j < 8; ++j) { const float po = __shfl_xor(y[j], 1); const float cc = j < 4 ? c0[j & 3] : c1[j & 3], sn = j < 4 ? s0[j & 3] : s1[j & 3];
        const float yr = half == 0 ? (y[j] * cc - po * sn) : (y[j] * cc + po * sn); o[j] = row < NL ? yr : y[j]; }
    if (lane < 4) { u32x4 wv; wv.x = pk2(o[0], o[1]); wv.y = pk2(o[2], o[3]); wv.z = pk2(o[4], o[5]); wv.w = pk2(o[6], o[7]);
#pragma unroll
        for (int hd = 0; hd < 16; ++hd) *(u32x4*)(Kc + (size_t)row * 1536 + hd * 96 + 64 + 8 * lane) = wv; }
}

template <int NT>
__device__ __forceinline__ void moe_setup(LAS unsigned char* lds, const int* cntG, const int* list, int layer, int vcu, int G) {
    LAS int* tab = (LAS int*)(lds + LDS_TAB); LAS int* idx = (LAS int*)(lds + LDS_IDX);
    const int tid = otid(); constexpr int MG = 32 / NT;
    if (tid < 32) tab[tid] = cntG[tid * 64];
    __syncthreads();
    if (tid == 0) { int acc = 0; for (int e = 0; e < 32; ++e) { tab[32 + e] = acc; acc += (tab[e] + 255) >> 8; } tab[64] = acc;
        int n = 0;
        const int U = acc * NT;
        for (int i = 0; i < MAXU; ++i) { const int v0 = i * G + vcu; if (v0 >= U) break; const int v = (NT == 4) ? U - 1 - v0 : v0; const int gm = (v >> 5) * MG + (v & 31) / NT, nt = v % NT;
            int e = 0; while (e < 31 && tab[33 + e] <= gm) ++e;
            tab[128 + 4 * i] = gm; tab[129 + 4 * i] = (layer * 32 + e) * NT + nt; tab[130 + 4 * i] = e; tab[131 + 4 * i] = nt; n = i + 1; }
        tab[127] = n; }
    __syncthreads();
    const int n = tab[127];
    for (int q = tid; q < n * 256; q += NTHR) { const int i = q >> 8, r = q & 255, gm = tab[128 + 4 * i], e = tab[130 + 4 * i], rr = (gm - tab[32 + e]) * 256 + r;
        idx[q] = rr < tab[e] ? list[(size_t)e * T + rr] : -1; }
    __syncthreads();
}

__device__ __forceinline__ void ctx_minigemm(LAS unsigned char* lds, const bf16* MIX, const bf16* W  , float* X, const float* srcctx  ,
                                             const float* gmod  , float* SSX, int bx) {
    const int tid = otid(), lane = tid & 63, w = __builtin_amdgcn_readfirstlane(tid >> 6), fr = lane & 15, fq = lane >> 4;
    const int tr = bx >> 4, tc = bx & 15;
    const bf16* ap = MIX + (size_t)(NL + 64 * tr + fr) * 1024 + 128 * w + 8 * fq;
    const bf16* bp = W + (size_t)(64 * tc + fr) * 1024 + 128 * w + 8 * fq;
    bf16x8 a[4][4], b[4][4];
#pragma unroll
    for (int t = 0; t < 4; ++t)
#pragma unroll
        for (int ks = 0; ks < 4; ++ks) { a[t][ks] = *(const bf16x8*)(ap + (size_t)(16 * t) * 1024 + 32 * ks); b[t][ks] = *(const bf16x8*)(bp + (size_t)(16 * t) * 1024 + 32 * ks); }
    f32x4 acc[4][4];
#pragma unroll
    for (int mt = 0; mt < 4; ++mt)
#pragma unroll
        for (int nt = 0; nt < 4; ++nt) { acc[mt][nt] = (f32x4){0.f, 0.f, 0.f, 0.f};
#pragma unroll
            for (int ks = 0; ks < 4; ++ks) acc[mt][nt] = __builtin_amdgcn_mfma_f32_16x16x32_bf16(b[nt][ks], a[mt][ks], acc[mt][nt], 0, 0, 0); }
    LAS f32x4* part = (LAS f32x4*)lds;
#pragma unroll
    for (int mt = 0; mt < 4; ++mt)
#pragma unroll
        for (int nt = 0; nt < 4; ++nt) part[(w * 16 + mt * 4 + nt) * 64 + lane] = acc[mt][nt];
    __syncthreads();
    LAS float* ssq = (LAS float*)(lds + LDS_IDX);
    const float* gp = gmod + (size_t)4 * 6144;
#pragma unroll
    for (int hf = 0; hf < 2; ++hf) { const int o = tid + 512 * hf, tile = o >> 6, ol = o & 63, mt = tile >> 2, nt = tile & 3, r = 16 * mt + (ol & 15), c = 64 * tc + 16 * nt + 4 * (ol >> 4);
        f32x4 s = part[o];
#pragma unroll
        for (int ww = 1; ww < 8; ++ww) s += part[ww * 1024 + o];
        const size_t gi = (size_t)(64 * tr + r) * D + c;
        const f32x4 y = *(const f32x4*)(srcctx + gi) + *(const f32x4*)(gp + c) * s;
        *(f32x4*)(X + (size_t)NL * D + gi) = y;
        ssq[r * 16 + nt * 4 + (ol >> 4)] = (y[0] * y[0] + y[1] * y[1]) + (y[2] * y[2] + y[3] * y[3]); }
    __syncthreads();
    if (tid < 64) { float ss = 0.f;
#pragma unroll
        for (int q = 0; q < 16; ++q) ss += ssq[tid * 16 + q];
        SSX[(size_t)(NL + 64 * tr + tid) * 16 + tc] = ss; }
    __syncthreads();
}

struct CRow { u32x4 y[2][4]; f32x4 x[2][2]; };
__device__ __forceinline__ void combine_load(int row, int lane, const float* X, const bf16* YB, CRow& r) {
#pragma unroll
    for (int j = 0; j < 2; ++j) {
#pragma unroll
        for (int k = 0; k < 4; ++k) r.y[j][k] = __builtin_nontemporal_load((const u32x4*)(YB + ((size_t)row * 4 + k) * 1024 + 8 * lane + 512 * j));
        const float* xp = X + (size_t)row * D + 8 * lane + 512 * j; r.x[j][0] = *(const f32x4*)xp; r.x[j][1] = *(const f32x4*)(xp + 4); }
}
__device__ __forceinline__ void combine_finish(int row, int lane, const CRow& r, float* X, const float* mcur  , const float* gnext, const float* mnext, bf16* H, float* out) {
    const int mr = modrow(row); const float* mv = mcur + (size_t)mr * 6144 + 5120;
    f32x4 v[2][2]; float ss = 0.f;
#pragma unroll
    for (int j = 0; j < 2; ++j) { const int c = 8 * lane + 512 * j; f32x4 a0 = (f32x4){0.f, 0.f, 0.f, 0.f}, a1 = a0;
#pragma unroll
        for (int k = 0; k < 4; ++k) { a0 += (f32x4){bflo(r.y[j][k].x), bfhi(r.y[j][k].x), bflo(r.y[j][k].y), bfhi(r.y[j][k].y)}; a1 += (f32x4){bflo(r.y[j][k].z), bfhi(r.y[j][k].z), bflo(r.y[j][k].w), bfhi(r.y[j][k].w)}; }
        const f32x4 g0 = *(const f32x4*)(mv + c), g1 = *(const f32x4*)(mv + c + 4);
        v[j][0] = r.x[j][0] + g0 * a0; v[j][1] = r.x[j][1] + g1 * a1;
        float* op = out ? out + (size_t)row * D + c : X + (size_t)row * D + c;
        *(f32x4*)op = v[j][0]; *(f32x4*)(op + 4) = v[j][1];
#pragma unroll
        for (int q = 0; q < 2; ++q) ss += (v[j][q][0] * v[j][q][0] + v[j][q][1] * v[j][q][1]) + (v[j][q][2] * v[j][q][2] + v[j][q][3] * v[j][q][3]); }
    if (H) { const float rstd = rsqrtf(wave_sum(ss) * (1.f / D) + EPS); const float* mn = mnext + (size_t)mr * 6144;
#pragma unroll
        for (int j = 0; j < 2; ++j) { const int c = 8 * lane + 512 * j; f32x4 o[2];
#pragma unroll
            for (int q = 0; q < 2; ++q) { const f32x4 gg = *(const f32x4*)(gnext + c + 4 * q), sc = *(const f32x4*)(mn + 1024 + c + 4 * q), sh = *(const f32x4*)(mn + c + 4 * q); o[q] = v[j][q] * rstd * gg * (sc + 1.f) + sh; }
            *(u32x4*)(H + (size_t)row * D + c) = pack8(o[0], o[1]); } }
}

#define MFMA16(a, b, c) __builtin_amdgcn_mfma_f32_16x16x32_bf16((a), (b), (c), 0, 0, 0)
__device__ __forceinline__ void router_load_table(LAS unsigned char* lds, const bf16* Wr, int tid) {
    u32x4 v[16];
#pragma unroll
    for (int i = 0; i < 16; ++i) v[i] = *(const u32x4*)(Wr + (size_t)(tid + i * NTHR) * 8);
#pragma unroll
    for (int i = 0; i < 16; ++i) { const int q = tid + i * NTHR, row = q >> 7, c = q & 127; *(LAS u32x4*)(lds + row * 2048 + ((c ^ (row & 15)) << 4)) = v[i]; }
}
__device__ __forceinline__ void router_group(LAS unsigned char* lds, int g, int w, int lane, const float* X, const float* SSX, const float* gffn, const float* mvec, const float* rb,
                                             bf16* F, float* gate) {
    LAS float* lg = (LAS float*)(lds + LDS_IDX) + w * 512; LAS int* pend = (LAS int*)(lds + LDS_IDX + 10240) + w * 64; LAS int* cntL = (LAS int*)(lds + LDS_TAB);
    const int i = lane & 15, kq = lane >> 4, row = 16 * g + i;
    const float* xr = X + (size_t)row * D + 8 * kq;
    float ss; { const f32x4 pq = *(const f32x4*)(SSX + (size_t)row * 16 + 4 * kq); ss = (pq[0] + pq[1]) + (pq[2] + pq[3]); }
    ss += __shfl_xor(ss, 16); ss += __shfl_xor(ss, 32);
    const float rstd = rsqrtf(ss * (1.f / D) + EPS);
    f32x4 acc[2] = {(f32x4){0.f, 0.f, 0.f, 0.f}, (f32x4){0.f, 0.f, 0.f, 0.f}};
    const LAS unsigned char* tb = lds + i * 2048;
#pragma unroll 8
    for (int s = 0; s < 32; ++s) {
        const int k = 32 * s + 8 * kq;
        const f32x4 a = *(const f32x4*)(xr + 32 * s), b = *(const f32x4*)(xr + 32 * s + 4);
        const f32x4 g0 = *(const f32x4*)(gffn + k), g1 = *(const f32x4*)(gffn + k + 4), c0 = *(const f32x4*)(mvec + 4096 + k), c1 = *(const f32x4*)(mvec + 4096 + k + 4);
        const f32x4 h0 = *(const f32x4*)(mvec + 3072 + k), h1 = *(const f32x4*)(mvec + 3072 + k + 4);
        const f32x4 f0 = a * rstd * g0 * (c0 + 1.f) + h0, f1 = b * rstd * g1 * (c1 + 1.f) + h1;
        u32x4 hi; hi.x = pk2(f0[0], f0[1]); hi.y = pk2(f0[2], f0[3]); hi.z = pk2(f1[0], f1[1]); hi.w = pk2(f1[2], f1[3]);
        *(u32x4*)(F + (size_t)row * D + k) = hi;
        u32x4 lo; lo.x = pk2(f0[0] - bflo(hi.x), f0[1] - bfhi(hi.x)); lo.y = pk2(f0[2] - bflo(hi.y), f0[3] - bfhi(hi.y));
        lo.z = pk2(f1[0] - bflo(hi.z), f1[1] - bfhi(hi.z)); lo.w = pk2(f1[2] - bflo(hi.w), f1[3] - bfhi(hi.w));
        const bf16x8 ah = __builtin_bit_cast(bf16x8, hi), al = __builtin_bit_cast(bf16x8, lo);
        const int cs = ((4 * s + kq) ^ i) << 4;
#pragma unroll
        for (int et = 0; et < 2; ++et) { const bf16x8 bh = *(const LAS bf16x8*)(tb + et * 16 * 2048 + cs), bl = *(const LAS bf16x8*)(tb + (32 + et * 16) * 2048 + cs);
            acc[et] = MFMA16(ah, bh, acc[et]); acc[et] = MFMA16(al, bh, acc[et]); acc[et] = MFMA16(ah, bl, acc[et]); }
    }
#pragma unroll
    for (int et = 0; et < 2; ++et) { const float bias = rb[16 * et + i];
#pragma unroll
        for (int r = 0; r < 4; ++r) lg[(4 * kq + r) * 32 + 16 * et + i] = acc[et][r] + bias; }
    LDS_WAIT(); asm volatile("" ::: "memory");
    if (lane < 16) {
        const LAS float* my = lg + lane * 32; unsigned used = 0u; int bi[4]; float bv[4];
#pragma unroll
        for (int k = 0; k < 4; ++k) { float best = -3.0e38f; int be = 0;
#pragma unroll
            for (int e = 0; e < 32; ++e) { const float v = my[e]; const bool ok = !((used >> e) & 1u) && v > best; best = ok ? v : best; be = ok ? e : be; }
            used |= 1u << be; bi[k] = be; bv[k] = best; }
        float ex[4], sum = 0.f;
#pragma unroll
        for (int k = 0; k < 4; ++k) { ex[k] = __expf(bv[k] - bv[0]); sum += ex[k]; }
        const float inv = 1.f / sum; const int trow = 16 * g + lane;
#pragma unroll
        for (int k = 0; k < 4; ++k) { const int rl = __hip_atomic_fetch_add(cntL + bi[k], 1, __ATOMIC_RELAXED, __HIP_MEMORY_SCOPE_WORKGROUP);
            pend[lane * 4 + k] = (trow * 4 + k) | (bi[k] << 17) | (rl << 22); gate[trow * 4 + k] = ex[k] * inv; }
    }
}

struct Args { const float* in[32]; float* out; unsigned char* ws; int lo, hi, flags, pad; };
constexpr int N_PHASES = 2 + 2 * (7 + 8);

__global__ void __launch_bounds__(NTHR, 2) mega(Args args) {
    extern __shared__ __attribute__((aligned(16))) unsigned char lds_raw[];
    LAS unsigned char* lds = (LAS unsigned char*)lds_raw;
    const int tid = threadIdx.x, lane = tid & 63, wave = __builtin_amdgcn_readfirstlane(tid >> 6);
    constexpr int G = 256;
    const int bx = blockIdx.x & (G - 1), vcu = (bx % 8) * (G / 8) + bx / 8;
    const int gw = vcu * NWAVES + wave, NGW = G * NWAVES;
    unsigned* ctl = (unsigned*)(args.ws + WS_CTL);
#define PH_LOCALS \
    unsigned zsg_; asm volatile("s_mov_b32 %0, 0" : "=s"(zsg_)); unsigned char* ws = args.ws + zsg_;   const int tid = otid(), lane = tid & 63, wave = __builtin_amdgcn_readfirstlane(tid >> 6), gw = vcu * NWAVES + wave; (void)lane; (void)gw; \
    const float* x_in = args.in[0]; const float* c_in = args.in[1]; const float* ctx_in = args.in[2]; const float* cctx_in = args.in[3]; \
    const float* mod_w = args.in[4]; const float* mod_b = args.in[5]; const float* norm_mix_g = args.in[6]; const float* norm_ffn_g = args.in[7]; \
    float* MOD = (float*)(ws + WS_MOD); float* cosA = (float*)(ws + WS_COSA); float* sinA = (float*)(ws + WS_SINA); float* cosC = (float*)(ws + WS_COSC); float* sinC = (float*)(ws + WS_SINC); \
    bf16* WR = (bf16*)(ws + WS_WR); bf16* WINA = (bf16*)(ws + WS_WINA); bf16* WOUTA = (bf16*)(ws + WS_WOUTA); bf16* WINC = (bf16*)(ws + WS_WINC); bf16* WQB = (bf16*)(ws + WS_WQB); \
    bf16* WKVB = (bf16*)(ws + WS_WKVB); bf16* WOUTC = (bf16*)(ws + WS_WOUTC); bf16* WGU = (bf16*)(ws + WS_WGU); bf16* WDN = (bf16*)(ws + WS_WDN); \
    float* X = (float*)(ws + WS_X); bf16* H = (bf16*)(ws + WS_H); bf16* QA = (bf16*)(ws + WS_QA); bf16* KA = (bf16*)(ws + WS_KA); bf16* VA = (bf16*)(ws + WS_VA); bf16* Z = (bf16*)(ws + WS_Z); \
    bf16* P = (bf16*)(ws + WS_P); float* RS = (float*)(ws + WS_RS); bf16* QC = (bf16*)(ws + WS_QC); bf16* KC = (bf16*)(ws + WS_KC); bf16* VC = (bf16*)(ws + WS_VC); \
    bf16* MIX = (bf16*)(ws + WS_MIX); bf16* F = (bf16*)(ws + WS_F); float* GATE = (float*)(ws + WS_GATE); int* LIST = (int*)(ws + WS_LIST); bf16* ACT = (bf16*)(ws + WS_ACT); bf16* YB = (bf16*)(ws + WS_YB); \
    int* CNT = (int*)(ws + WS_CTL) + CW_CNT; float* SSX = (float*)(ws + WS_SSX); float* SSP = (float*)(ws + WS_SSP); (void)SSX; (void)SSP; const float* ML = MOD + (size_t)layer_ * 5 * 6144; \
    (void)x_in; (void)c_in; (void)ctx_in; (void)cctx_in; (void)mod_w; (void)mod_b; (void)norm_mix_g; (void)norm_ffn_g; (void)MOD; (void)cosA; (void)sinA; (void)cosC; (void)sinC; (void)WR; (void)WINA; (void)WOUTA; \
    (void)WINC; (void)WQB; (void)WKVB; (void)WOUTC; (void)WGU; (void)WDN; (void)X; (void)H; (void)QA; (void)KA; (void)VA; (void)Z; (void)P; (void)RS; (void)QC; (void)KC; (void)VC; (void)MIX; (void)F; (void)GATE; \
    (void)LIST; (void)ACT; (void)YB; (void)CNT; (void)ML;
    if (tid < 64) ((LAS unsigned*)(lds + LDS_MISC))[tid] = 0u;
    __syncthreads();
    const int lo = args.lo, hi = args.hi;
    XcdBarrier bar; bar.bar = ctl + CW_BAR; bar.x = 0; bar.st = nullptr;
    if (hi - lo > 1) bar = xcd_barrier_post(ctl + CW_BAR, (volatile LAS unsigned*)(lds + LDS_MISC));
    int ph = 0; int layer_ = 0;
#ifndef MK_EN
#define MK_EN 0xffffffffu
#endif
#ifdef MK_PROBE_PH
#define PFLAG(b) (args.flags & (b))
#else
#define PFLAG(b) 0
#endif
#define EN(k) (((MK_EN) >> (k)) & 1u)
#define PH_ON (ph >= lo && ph < hi)
#define CVT_HEAD do { if (tid < 8) ((LAS int*)(lds + CV_HDR))[tid * 4] = -1; } while (0)
#define CVT_TAIL(bg) do { LAS int* _jn = (LAS int*)(lds + CV_HDR + 256); asm volatile("s_waitcnt vmcnt(0)" ::: "memory"); if (wave >= 4 && lane == 0) _jn[wave - 4] = bg.j; __syncthreads(); \
        bg.process_slot(tid, lds, 0); bg.process_slot(tid, lds, 1); \
        { const int _j = _jn[wave & 3]; bg.j = _j + (wave < 4 ? 0 : 4); bg.step = 8; } __syncthreads(); \
        bg.tail_loop(lane, lds + wave * 16384); __syncthreads(); } while (0)
#define PH_END do { const bool _b = (ph >= lo) && (ph + 1 < hi); ++ph; if (_b) xcd_barrier(bar); } while (0)

    if (EN(0) && PH_ON) { PH_LOCALS
        LAS float* st = (LAS float*)(lds + 73728);
        for (int q = tid; q < 5 * 1024; q += NTHR) { const float v = q < 4096 ? c_in[q] : cctx_in[q - 4096]; st[q] = fsilu(v); }
        __syncthreads();
        for (int u = vcu; u < 384; u += G) {
            const int l = u / 96, col = (u % 96) * 64 + lane;
            const float* wp = mod_w + ((size_t)l * D + 128 * wave) * 6144 + col; float a0 = 0.f, a1 = 0.f, a2 = 0.f, a3 = 0.f, a4 = 0.f;
#pragma unroll 1
            for (int k0 = 0; k0 < 128; k0 += 64) { float wv[64];
#pragma unroll
                for (int kk = 0; kk < 64; ++kk) wv[kk] = __builtin_nontemporal_load(wp + (size_t)(k0 + kk) * 6144);
#pragma unroll
                for (int kk = 0; kk < 64; ++kk) { const int k = 128 * wave + k0 + kk; a0 += st[k] * wv[kk]; a1 += st[1024 + k] * wv[kk]; a2 += st[2048 + k] * wv[kk]; a3 += st[3072 + k] * wv[kk]; a4 += st[4096 + k] * wv[kk]; } }
            LAS float* part = (LAS float*)(lds + 98304);
            part[(wave * 5 + 0) * 64 + lane] = a0; part[(wave * 5 + 1) * 64 + lane] = a1; part[(wave * 5 + 2) * 64 + lane] = a2; part[(wave * 5 + 3) * 64 + lane] = a3; part[(wave * 5 + 4) * 64 + lane] = a4;
            __syncthreads();
            if (wave < 5) { float s = mod_b[l * 6144 + col];
#pragma unroll
                for (int w8 = 0; w8 < 8; ++w8) s += part[(w8 * 5 + wave) * 64 + lane];
                MOD[((size_t)l * 5 + wave) * 6144 + col] = s; }
            __syncthreads();
        }
        for (int q = gw * 64 + lane; q < 4096 * 32; q += NGW * 64) {
            { const int t = q >> 5, j = q & 31, ax = j >> 4, i = j & 15; const float pos = (float)(ax == 0 ? (t >> 6) : (t & 63)); const float a = pos * powf(10000.f, -((float)i * 2.f) / 32.f); cosA[q] = cosf(a); sinA[q] = sinf(a); }
            if (q < 4096 * 16) { const int t = q >> 4, j = q & 15, ax = j >> 3, i = j & 7; const float pos = (float)(ax == 0 ? (t >> 6) : (t & 63)); const float a = pos * powf(10000.f, -((float)i * 2.f) / 16.f); cosC[q] = cosf(a); sinC[q] = sinf(a); }
        }
        { const float* rw = args.in[26];
          for (int q = gw * 64 + lane; q < 4 * 32 * 1024; q += NGW * 64) { const int l = q >> 15, e = (q >> 10) & 31, k = q & 1023; const float wv = rw[((size_t)l * 1024 + k) * 32 + e];
              const unsigned hb = pk2(wv, 0.f) & 0xffffu; const float hf = __uint_as_float(hb << 16); const unsigned lb = pk2(wv - hf, 0.f) & 0xffffu;
              WR[((size_t)(l * 2 + 0) * 32 + e) * 1024 + k] = (bf16)hb; WR[((size_t)(l * 2 + 1) * 32 + e) * 1024 + k] = (bf16)lb; } }
        LAS float* scr = (LAS float*)(lds + wave * 8448);
        cvt_matrix<LAY_INA>(args.in[8], (size_t)D * 1792, 1792, 1792, 1024, 7, 14, WINA, nullptr, scr, gw, NGW, lane);
        cvt_matrix<LAY_F32>(args.in[9], (size_t)D * 1024, 1024, 1024, 1024, 4, 8, WOUTA, nullptr, scr, gw, NGW, lane);
        cvt_matrix<LAY_STD>(args.in[17], (size_t)D * 1056, 1056, 1056, 1024, 5, 10, WINC, nullptr, scr, gw, NGW, lane);
        cvt_matrix<LAY_STD>(args.in[20], (size_t)768 * 1536, 1536, 1536, 768, 6, 6, WQB, args.in[18], scr, gw, NGW, lane);
        cvt_matrix<LAY_STD>(args.in[20] + (size_t)768 * 1536, 0, 1536, 1536, 768, 6, 6, WQB + (size_t)1536 * 768, args.in[18] + 768, scr, gw, NGW, lane);
        cvt_matrix<LAY_HEAD2>(args.in[21], (size_t)256 * 2048, 2048, 2048, 256, 8, 8, WKVB, args.in[19], scr, gw, NGW, lane);
        cvt_matrix<LAY_HEAD2>(args.in[21] + (size_t)256 * 2048, 0, 2048, 2048, 256, 8, 8, WKVB + (size_t)2048 * 256, args.in[19] + 256, scr, gw, NGW, lane);
        cvt_matrix<LAY_F32>(args.in[25], (size_t)D * 1024, 1024, 1024, 1024, 4, 8, WOUTC, nullptr, scr, gw, NGW, lane);
        __syncthreads();
    }
    PH_END;
    if (EN(1) && PH_ON) { PH_LOCALS
        for (int row = gw; row < T; row += NGW) {
            const float* xrow = row < NL ? x_in + (size_t)row * D : ctx_in + (size_t)(row - NL) * D; const float* mn = MOD + (size_t)modrow(row) * 6144;
            f32x4 v[2][2]; float ss = 0.f;
#pragma unroll
            for (int j = 0; j < 2; ++j)
#pragma unroll
                for (int q = 0; q < 2; ++q) { v[j][q] = *(const f32x4*)(xrow + 8 * lane + 512 * j + 4 * q); ss += (v[j][q][0] * v[j][q][0] + v[j][q][1] * v[j][q][1]) + (v[j][q][2] * v[j][q][2] + v[j][q][3] * v[j][q][3]); }
            const float rstd = rsqrtf(wave_sum(ss) * (1.f / D) + EPS);
#pragma unroll
            for (int j = 0; j < 2; ++j) { const int c = 8 * lane + 512 * j; f32x4 o[2];
#pragma unroll
                for (int q = 0; q < 2; ++q) { const f32x4 gg = *(const f32x4*)(norm_mix_g + c + 4 * q), sc = *(const f32x4*)(mn + 1024 + c + 4 * q), sh = *(const f32x4*)(mn + c + 4 * q); o[q] = v[j][q] * rstd * gg * (sc + 1.f) + sh; }
                *(u32x4*)(H + (size_t)row * D + c) = pack8(o[0], o[1]); }
        }
    }
    PH_END;

    for (int layer = 0; layer < 4; ++layer) {
        const bool keep = layer < 3; const int li = layer >> 1; const int nrt = keep ? 68 : 64;
        layer_ = layer;
        if ((layer & 1) == 0) {
            if (EN(2) && PH_ON) { PH_LOCALS
                g8::GemmP g{H, D, WINA + (size_t)li * 1792 * 1024, 1024}; g8::StaticOrder S_; S_.init(68, 7, G, bx);
                EpiInA E{QA, KA, VA, Z, args.in[10] + li * 64, args.in[11] + li * 64, cosA, sinA};
                g8::gemm_phase(lds, g, S_, E);
            }
            PH_END;
            if (EN(3) && PH_ON) { PH_LOCALS
                const int nau = keep ? 544 : 512;
                if (!(PFLAG(1))) {
                    CvtBg bg; bg.init(args.in[28], args.in[30], WGU, WDN, 0, layer == 0 ? 1 : 0, vcu, wave >= 4 ? wave - 4 : 0x40000000, 4); CVT_HEAD;
                    for (int u = vcu; u < nau; u += G) wattn_unit(lds, u, QA, KA, VA, args.in[12] + li * 8, MIX, bg);
                    CVT_TAIL(bg);
                }
                if (!(PFLAG(2))) {
                    const float* dww = args.in[13] + (size_t)li * 31 * 512; const float* dwb = args.in[14] + li * 512; const float* lng = args.in[15] + li * 512; const float* lnb = args.in[16] + li * 512;
                    conv_strip<64>(lds, (vcu >> 6) * S, S, (vcu & 63) * 64, Z, dww, dwb, lng, lnb, MIX);
                    if (keep) conv_strip<4>(lds, NL + (vcu >> 6) * CL, CL, (vcu & 63) * 4, Z, dww, dwb, lng, lnb, MIX);
                }
            }
            PH_END;
            if (EN(4) && PH_ON) { PH_LOCALS
                g8::GemmP g{MIX, D, WOUTA + (size_t)li * 1024 * 1024, 1024}; g8::StaticOrder S_; S_.init(64, 4, G, bx);
                EpiResid E{X, layer == 0 ? x_in : X, layer == 0 ? ctx_in : X + (size_t)NL * D, ML + 2048, SSX};
                g8::gemm_phase(lds, g, S_, E);
                if (keep) ctx_minigemm(lds, MIX, WOUTA + (size_t)li * 1024 * 1024, X, layer == 0 ? ctx_in : X + (size_t)NL * D, ML + 2048, SSX, bx);
            }
            PH_END;
        } else {
            if (EN(5) && PH_ON) { PH_LOCALS
                g8::GemmP g{H, D, WINC + (size_t)li * 1280 * 1024, 1024}; g8::StaticOrder S_; S_.init(68, 5, G, bx);
                EpiP E{P, SSP, KC, args.in[24] + li * 32, cosC, sinC};
                g8::gemm_phase(lds, g, S_, E);
            }
            PH_END;
            if (EN(7) && PH_ON) { PH_LOCALS
#ifndef MK_O3
#define MK_O3 3
#endif
                if ((MK_O3 & 1) && !(PFLAG(16))) { g8::GemmP g{P, PP, WQB + (size_t)li * 1536 * 768, 768}; g8::StaticOrder S_; S_.init(nrt, 6, G, bx); EpiBf16 E{QC, 1536, 1536}; g8::gemm_phase(lds, g, S_, E); }
                if ((MK_O3 & 2) && !(PFLAG(32))) { g8::GemmP g{P + 768, PP, WKVB + (size_t)li * 2048 * 256, 256}; g8::StaticOrder S_; S_.init(68, 8, G, (bx + 104) & 255);         EpiKV E{KC, VC, SSP, args.in[23] + li * 64}; g8::gemm_phase(lds, g, S_, E); }
            }
            PH_END;
            if (EN(8) && PH_ON) { PH_LOCALS
                const int nau = keep ? 1088 : 1024;
                CvtBg bg; bg.init(args.in[28], args.in[30], WGU, WDN, layer, (PFLAG(8)) ? 0 : ((layer == 1) ? 2 : 1), vcu, wave >= 4 ? wave - 4 : 0x40000000, 4); CVT_HEAD;
#if defined(MK_XP) && MK_XP != 0
                if (PFLAG(64)) { for (int u = vcu; u < nau; u += G) mla_unit<MK_XP>(lds, u, QC, KC, VC, SSP, args.in[22] + li * 96, cosC, sinC, MIX, bg); } else
#endif
                for (int u = vcu; u < nau; u += G) mla_unit(lds, u, QC, KC, VC, SSP, args.in[22] + li * 96, cosC, sinC, MIX, bg);
                CVT_TAIL(bg);
            }
            PH_END;
            if (EN(9) && PH_ON) { PH_LOCALS
                g8::GemmP g{MIX, D, WOUTC + (size_t)li * 1024 * 1024, 1024}; g8::StaticOrder S_; S_.init(64, 4, G, bx);
                EpiResid E{X, X, X + (size_t)NL * D, ML + 2048, SSX};
                g8::gemm_phase(lds, g, S_, E);
                if (keep) ctx_minigemm(lds, MIX, WOUTC + (size_t)li * 1024 * 1024, X, X + (size_t)NL * D, ML + 2048, SSX, bx);
            }
            PH_END;
        }
        if (EN(10) && PH_ON) { PH_LOCALS
            LAS int* cntL = (LAS int*)(lds + LDS_TAB); LAS int* baseL = cntL + 32; LAS int* pend = (LAS int*)(lds + LDS_IDX + 10240);
            if (tid < 32) cntL[tid] = 0;
            router_load_table(lds, WR + (size_t)layer * 2 * 32 * 1024, tid);
            __syncthreads();
            int g = -1;
            if (wave < 4) g = bx * 4 + wave; else if (wave == 4 && keep && bx < 64) g = 1024 + bx;
            if (g >= 0) router_group(lds, g, wave, lane, X, SSX, norm_ffn_g + layer * D, ML + (size_t)(g < 1024 ? (g >> 8) : 4) * 6144, args.in[27] + layer * 32, F, GATE);
            __syncthreads();
            if (tid < 32) baseL[tid] = (PFLAG(4)) ? 0 : atomicAdd(CNT + (layer * 32 + tid) * 64, cntL[tid])    ;
            __syncthreads();
            if (tid < 320) { const int wv = tid >> 6; const bool has = (wv < 4) || (wv == 4 && keep && bx < 64);
                if (has) { const int pe = pend[tid], slot = pe & 0x1ffff, e = (pe >> 17) & 31, rl = pe >> 22; LIST[(size_t)e * T + baseL[e] + rl] = slot; } }
            __syncthreads();
        }
        PH_END;
        if (EN(11) && PH_ON) { PH_LOCALS
            moe_setup<8>(lds, CNT + layer * 32 * 64, LIST, layer, vcu, G);
            g8::GemmP g{F, D, WGU, 1024}; g8::MoeOrder<true> S_{(const LAS int*)(lds + LDS_TAB), (const LAS int*)(lds + LDS_IDX)};
            EpiGU E{ACT, args.in[29] + (size_t)layer * 32 * 2048};
            g8::gemm_phase(lds, g, S_, E);
        }
        PH_END;
        if (EN(12) && PH_ON) { PH_LOCALS
            moe_setup<4>(lds, CNT + layer * 32 * 64, LIST, layer, vcu, G);
            g8::GemmP g{ACT, 1024, WDN, 1024}; g8::MoeOrder<false> S_{(const LAS int*)(lds + LDS_TAB), (const LAS int*)(lds + LDS_IDX)};
            EpiDown E{YB, args.in[31] + (size_t)layer * 32 * 1024, GATE, (const LAS int*)(lds + LDS_IDX)};
            g8::gemm_phase(lds, g, S_, E);
        }
        PH_END;
        if (EN(13) && PH_ON) { PH_LOCALS
            const int nrows = keep ? T : NL;
            { const float* gn_ = norm_mix_g + (layer + 1 < 4 ? layer + 1 : 0) * D; const float* mn_ = MOD + (size_t)(layer + 1 < 4 ? layer + 1 : 0) * 5 * 6144;
              bf16* Hn_ = layer < 3 ? H : nullptr; float* on_ = layer < 3 ? nullptr : args.out;
              CRow ra, rb; int row = gw;
              if (row < nrows) { combine_load(row, lane, X, YB, ra);
                  for (;;) {
                      const int r1 = row + NGW; combine_load(r1 < nrows ? r1 : row, lane, X, YB, rb);
                      combine_finish(row, lane, ra, X, ML, gn_, mn_, Hn_, on_);
                      if (r1 >= nrows) break;
                      const int r2 = r1 + NGW; combine_load(r2 < nrows ? r2 : r1, lane, X, YB, ra);
                      combine_finish(r1, lane, rb, X, ML, gn_, mn_, Hn_, on_);
                      if (r2 >= nrows) break;
                      row = r2; } } }
        }
        PH_END;
    }
#undef PH_ON
#undef PH_END
}
}

#ifndef MK_MULTI
#define MK_MULTI 0
#endif
#ifndef MK_DEBUG
#define MK_DEBUG 0
#endif
#if MK_DEBUG
namespace dbg {
__global__ void k_cmp_bf(const unsigned short* a, int lda, const float* b, int ldb, int rows, int cols, float s, float* acc, int cp) {
    float d2 = 0.f, r2 = 0.f;
    for (size_t i = (size_t)blockIdx.x * blockDim.x + threadIdx.x; i < (size_t)rows * cols; i += (size_t)gridDim.x * blockDim.x) {
        const size_t r = i / cols, c = i % cols; const float av = __uint_as_float(((unsigned)a[r * lda + c]) << 16), bv = s * b[r * ldb + c]; d2 += (av - bv) * (av - bv); r2 += bv * bv; }
    for (int o = 32; o >= 1; o >>= 1) { d2 += __shfl_xor(d2, o); r2 += __shfl_xor(r2, o); }
    if ((threadIdx.x & 63) == 0) { atomicAdd(acc + 2 * cp, d2); atomicAdd(acc + 2 * cp + 1, r2); }
}
__global__ void k_cmp_f(const float* a, const float* b, size_t n, float* acc, int cp) {
    float d2 = 0.f, r2 = 0.f;
    for (size_t i = (size_t)blockIdx.x * blockDim.x + threadIdx.x; i < n; i += (size_t)gridDim.x * blockDim.x) { const float av = a[i], bv = b[i]; d2 += (av - bv) * (av - bv); r2 += bv * bv; }
    for (int o = 32; o >= 1; o >>= 1) { d2 += __shfl_xor(d2, o); r2 += __shfl_xor(r2, o); }
    if ((threadIdx.x & 63) == 0) { atomicAdd(acc + 2 * cp, d2); atomicAdd(acc + 2 * cp + 1, r2); }
}
__global__ void k_report(const float* acc, int ncp, float thr, float* out) {
    if (blockIdx.x == 0 && threadIdx.x == 0) { int bad = -1; for (int i = 0; i < ncp; ++i) { const float d = acc[2 * i], r = acc[2 * i + 1]; if (!(d <= thr * r)) { bad = i; break; } }
        if (bad >= 0) out[0] += 100.f * (float)(bad + 1); }
}
}
#endif

extern "C" void kernel_launch(void* const* d_in, const int* in_sizes, int n_in, void* d_out, int out_size, void* d_ws, size_t ws_size, hipStream_t stream) {
    using namespace mk;
    static int grid = 0;
    if (grid == 0) {
        int dev = 0, cus = 0, per_cu = 0;
        if (hipGetDevice(&dev) != hipSuccess || hipDeviceGetAttribute(&cus, hipDeviceAttributeMultiprocessorCount, dev) != hipSuccess) { fprintf(stderr, "kernel_launch: device query failed\n"); grid = -1; return; }
        if (hipFuncSetAttribute((const void*)mega, hipFuncAttributeMaxDynamicSharedMemorySize, LDS_BYTES) != hipSuccess) { fprintf(stderr, "kernel_launch: hipFuncSetAttribute(%d B LDS) failed\n", LDS_BYTES); grid = -1; return; }
        if (hipOccupancyMaxActiveBlocksPerMultiprocessor(&per_cu, (const void*)mega, NTHR, LDS_BYTES) != hipSuccess || per_cu < 1) fprintf(stderr, "kernel_launch: occupancy query reports %d blocks per CU\n", per_cu);
        (void)hipGetLastError();
        grid = 256;
        if (cus < 256) { fprintf(stderr, "kernel_launch: %d CUs < 256: the persistent grid would not be resident; nothing launched\n", cus); grid = -1; return; }
        if (n_in != 32 || ws_size < WS_END) { fprintf(stderr, "kernel_launch: n_in %d ws %zu (need %zu)\n", n_in, ws_size, (size_t)WS_END); grid = -1; return; }
    }
    if (grid < 0) return;
    (void)hipMemsetAsync((char*)d_ws + WS_CTL, 0, CTL_BYTES, stream);
    Args a{};
    for (int i = 0; i < 32; ++i) a.in[i] = (const float*)d_in[i];
    a.out = (float*)d_out; a.ws = (unsigned char*)d_ws;
#if !MK_DEBUG
#if MK_MULTI
    for (int p = 0; p < N_PHASES; ++p) { a.lo = p; a.hi = p + 1; hipLaunchKernelGGL(mega, dim3(grid), dim3(NTHR), LDS_BYTES, stream, a); }
#else
    a.lo = 0; a.hi = N_PHASES; hipLaunchKernelGGL(mega, dim3(grid), dim3(NTHR), LDS_BYTES, stream, a);
#ifdef MK_PROBE_PH
    for (int r = 0; r < MK_PROBE_N; ++r) { a.lo = MK_PROBE_PH; a.hi = MK_PROBE_PH + 1; a.flags = MK_PROBE_FLAGS; hipLaunchKernelGGL(mega, dim3(grid), dim3(NTHR), LDS_BYTES, stream, a); }
#endif
#endif
    { const hipError_t le = hipPeekAtLastError(); if (le != hipSuccess) fprintf(stderr, "kernel_launch: launch failed: %s\n", hipGetErrorName(le)); }
#else
#endif
}
```
